# Optimizing an MI355X kernel written in HIP

```python
import math
import jax, jax.numpy as jnp
from jax import lax
import numpy as np

D_MODEL = 2048
BATCH = 16
SEQ = 2048
DEPTH = 4

HEAD_DIM = 128
FOX_HEADS = 6
DIFF_HEADS = 4
DIFF_QK_DIM = HEAD_DIM // 2
NSA_HEADS = 6
NSA_KV_GROUPS = 2
NSA_HPG = NSA_HEADS // NSA_KV_GROUPS
CMP_LEN = 32
CMP_STRIDE = 16
SEL_LEN = 64
SEL_TOPN = 8
WINDOW = 512
Q_BLOCK = 128
N_BUCKETS = 32
MAX_DISTANCE = 128
D_FF = 5632
CONV_W = 3
EPS = 1e-6
NEG_INF = -1e30
FORCE_SCORE = 1e4

IN_SIZES = (
    FOX_HEADS * HEAD_DIM, FOX_HEADS * HEAD_DIM, FOX_HEADS * HEAD_DIM, FOX_HEADS,
    DIFF_HEADS * 2 * DIFF_QK_DIM, DIFF_HEADS * 2 * DIFF_QK_DIM, DIFF_HEADS * HEAD_DIM,
    NSA_HEADS * HEAD_DIM,
    NSA_KV_GROUPS * HEAD_DIM, NSA_KV_GROUPS * HEAD_DIM,
    NSA_KV_GROUPS * HEAD_DIM, NSA_KV_GROUPS * HEAD_DIM,
    NSA_KV_GROUPS * HEAD_DIM, NSA_KV_GROUPS * HEAD_DIM,
    NSA_HEADS * 3,
)
N_IN = sum(IN_SIZES)

kernel_name = "hybrid_fox_diff_nsa_convffn_trunk"


def rmsnorm(x, g):
    xf = x.astype(jnp.float32)
    y = xf * lax.rsqrt(jnp.mean(xf * xf, axis=-1, keepdims=True) + EPS)
    return (y * g.astype(jnp.float32)).astype(x.dtype)


def masked_softmax(scores, mask):
    s = jnp.where(mask, scores.astype(jnp.float32), NEG_INF)
    return jax.nn.softmax(s, axis=-1)


def t5_bucket(rel):
    n = jnp.maximum(rel, 0)
    max_exact = N_BUCKETS // 2
    nf = jnp.maximum(n, 1).astype(jnp.float32)
    large = max_exact + (jnp.log(nf / max_exact) / math.log(MAX_DISTANCE / max_exact)
                         * (N_BUCKETS - max_exact)).astype(jnp.int32)
    large = jnp.minimum(large, N_BUCKETS - 1)
    return jnp.where(n < max_exact, n, large)


def to_blocks(a):
    b, s = a.shape[:2]
    a = a.reshape((b, s // Q_BLOCK, Q_BLOCK) + a.shape[2:])
    return jnp.moveaxis(a, 1, 0)


def from_blocks(a):
    a = jnp.moveaxis(a, 0, 1)
    return a.reshape((a.shape[0], a.shape[1] * a.shape[2]) + a.shape[3:])


def fox_attention(q, k, v, f_logit, f_bias):
    b, s, h, dh = q.shape
    log_f = jax.nn.log_sigmoid(f_logit.astype(jnp.float32) + f_bias.astype(jnp.float32))
    cum = jnp.cumsum(log_f, axis=1)
    cum_k = jnp.transpose(cum, (0, 2, 1))
    k_pos = jnp.arange(s)
    scale = dh ** -0.5

    def block(args):
        qb, cb, i = args
        q_pos = i * Q_BLOCK + jnp.arange(Q_BLOCK)
        sc = jnp.einsum('bqhd,bkhd->bhqk', qb, k).astype(jnp.float32) * scale
        sc = sc + jnp.transpose(cb, (0, 2, 1))[..., None] - cum_k[:, :, None, :]
        p = masked_softmax(sc, k_pos[None, :] <= q_pos[:, None])
        return jnp.einsum('bhqk,bkhd->bqhd', p.astype(v.dtype), v)

    out = lax.map(block, (to_blocks(q), to_blocks(cum), jnp.arange(s // Q_BLOCK)))
    return from_blocks(out).reshape(b, s, h * dh)


def diff_attention(q, k, v, rel_table, lam, lam_init, subln_g):
    b, s, h, _, dqk = q.shape
    k_pos = jnp.arange(s)
    scale = dqk ** -0.5

    def block(args):
        qb, i = args
        q_pos = i * Q_BLOCK + jnp.arange(Q_BLOCK)
        bias = jnp.moveaxis(rel_table[t5_bucket(q_pos[:, None] - k_pos[None, :])], -1, 0).astype(jnp.float32)
        sc = jnp.einsum('bqhmd,bkhmd->mbhqk', qb, k).astype(jnp.float32) * scale + bias
        p = masked_softmax(sc, k_pos[None, :] <= q_pos[:, None])
        attn = p[0] - lam * p[1]
        return jnp.einsum('bhqk,bkhd->bqhd', attn.astype(v.dtype), v)

    out = from_blocks(lax.map(block, (to_blocks(q), jnp.arange(s // Q_BLOCK))))
    out = rmsnorm(out, subln_g) * (1.0 - lam_init)
    return out.reshape(b, s, h * v.shape[-1])


def nsa_attention(q, kc, vc, ks, vs, kw, vw, gate_logit, rel_table, cmp_pos, wk1, wk2, wv1, wv2):
    b, s, g, hpg, dh = q.shape
    scale = dh ** -0.5
    t_pos = jnp.arange(s)

    n_cmp = (s - CMP_LEN) // CMP_STRIDE + 1
    n_sel = s // SEL_LEN
    n_top = min(SEL_TOPN, n_sel)
    cmp_starts = np.arange(n_cmp) * CMP_STRIDE
    sel_starts = np.arange(n_sel) * SEL_LEN
    tok = cmp_starts[:, None] + np.arange(CMP_LEN)

    def compress(a, w1, w2):
        blocks = a[:, tok] + cmp_pos[None, None, :, None, :]
        flat = jnp.transpose(blocks, (0, 1, 3, 2, 4)).reshape(b, n_cmp, g, CMP_LEN * dh)
        return jax.nn.gelu(flat @ w1) @ w2

    k_cmp = compress(kc, wk1, wk2)
    v_cmp = compress(vc, wv1, wv2)
    block_end = jnp.asarray(cmp_starts + CMP_LEN - 1)
    sc = jnp.einsum('bsghd,bngd->bghsn', q, k_cmp).astype(jnp.float32) * scale
    sc = sc + jnp.transpose(rel_table[t5_bucket(t_pos[:, None] - block_end[None, :])], (2, 3, 0, 1)).astype(jnp.float32)
    cmp_mask = block_end[None, :] <= t_pos[:, None]
    p_cmp = masked_softmax(sc, cmp_mask) * jnp.any(cmp_mask, axis=-1)[:, None]
    o_cmp = jnp.einsum('bghsn,bngd->bsghd', p_cmp.astype(vc.dtype), v_cmp)

    overlap = np.clip(np.minimum(cmp_starts[:, None] + CMP_LEN, sel_starts[None, :] + SEL_LEN)
                      - np.maximum(cmp_starts[:, None], sel_starts[None, :]), 0, None).astype(np.float32) / CMP_LEN
    imp = jnp.einsum('bghsn,nm->bgsm', p_cmp, jnp.asarray(overlap))
    blk_t = t_pos // SEL_LEN
    j = jnp.arange(n_sel)
    valid = j[None, :] <= blk_t[:, None]
    forced = (j[None, :] == 0) | (j[None, :] == blk_t[:, None]) | (j[None, :] == blk_t[:, None] - 1)
    score = jnp.where(valid, imp + jnp.where(forced, FORCE_SCORE, 0.0), NEG_INF)
    top_score, sel_idx = lax.top_k(score, n_top)
    sel_valid = top_score > 0.5 * NEG_INF
    sel_idx = jnp.transpose(sel_idx, (0, 2, 1, 3))
    sel_valid = jnp.transpose(sel_valid, (0, 2, 1, 3))

    ks_blk = jnp.transpose(ks.reshape(b, n_sel, SEL_LEN, g, dh), (0, 3, 1, 2, 4))
    vs_blk = jnp.transpose(vs.reshape(b, n_sel, SEL_LEN, g, dh), (0, 3, 1, 2, 4))
    kw_pad = jnp.pad(kw, ((0, 0), (WINDOW, 0), (0, 0), (0, 0)))
    vw_pad = jnp.pad(vw, ((0, 0), (WINDOW, 0), (0, 0), (0, 0)))
    rel_g = jnp.transpose(rel_table, (1, 0, 2))
    bi = jnp.arange(b)[:, None, None, None]
    gi = jnp.arange(g)[None, :, None, None]

    def block(args):
        qb, idxb, validb, i = args
        q_pos = i * Q_BLOCK + jnp.arange(Q_BLOCK)
        idx = jnp.transpose(idxb, (0, 2, 1, 3))
        kg = ks_blk[bi, gi, idx]
        vg = vs_blk[bi, gi, idx]
        tok_pos = idx[..., None] * SEL_LEN + jnp.arange(SEL_LEN)
        bias = rel_g[gi[..., None], t5_bucket(q_pos[:, None, None] - tok_pos)]
        scs = jnp.einsum('bqghd,bgqnkd->bghqnk', qb, kg).astype(jnp.float32) * scale \
            + jnp.moveaxis(bias, -1, 2).astype(jnp.float32)
        smask = jnp.transpose(validb, (0, 2, 1, 3))[..., None] & (tok_pos <= q_pos[:, None, None])
        ps = masked_softmax(scs.reshape(b, g, hpg, Q_BLOCK, n_top * SEL_LEN),
                            smask[:, :, None].reshape(b, g, 1, Q_BLOCK, n_top * SEL_LEN))
        o_sel = jnp.einsum('bghqk,bgqkd->bqghd', ps.astype(vs.dtype),
                           vg.reshape(b, g, Q_BLOCK, n_top * SEL_LEN, dh))
        kwb = lax.dynamic_slice_in_dim(kw_pad, i * Q_BLOCK, WINDOW + Q_BLOCK, axis=1)
        vwb = lax.dynamic_slice_in_dim(vw_pad, i * Q_BLOCK, WINDOW + Q_BLOCK, axis=1)
        k_pos = i * Q_BLOCK - WINDOW + jnp.arange(WINDOW + Q_BLOCK)
        rel = q_pos[:, None] - k_pos[None, :]
        wmask = (rel >= 0) & (rel < WINDOW) & (k_pos[None, :] >= 0)
        wbias = jnp.transpose(rel_table[t5_bucket(rel)], (2, 3, 0, 1)).astype(jnp.float32)
        scw = jnp.einsum('bqghd,bkgd->bghqk', qb, kwb).astype(jnp.float32) * scale + wbias
        pw = masked_softmax(scw, wmask)
        o_win = jnp.einsum('bghqk,bkgd->bqghd', pw.astype(vw.dtype), vwb)
        return o_sel, o_win

    o_sel, o_win = lax.map(block, (to_blocks(q), to_blocks(sel_idx), to_blocks(sel_valid), jnp.arange(s // Q_BLOCK)))
    o_sel = from_blocks(o_sel)
    o_win = from_blocks(o_win)
    gates = jax.nn.sigmoid(gate_logit.astype(jnp.float32)).astype(q.dtype)
    out = gates[..., 0:1] * o_cmp + gates[..., 1:2] * o_sel + gates[..., 2:3] * o_win
    return out.reshape(b, s, g * hpg * dh)


def conv_ffn(u, w_up, conv_w, conv_b, w_down):
    s = u.shape[1]
    hdn = u @ w_up
    hp = jnp.pad(hdn, ((0, 0), (CONV_W - 1, 0), (0, 0)))
    hdn = sum(hp[:, tap:tap + s] * conv_w[tap] for tap in range(CONV_W)) + conv_b
    gate, up = jnp.split(hdn, 2, axis=-1)
    return (jax.nn.silu(gate) * up) @ w_down


def setup_inputs(seed: int = 0) -> dict:
    key = jax.random.key(seed)
    ks = jax.random.split(key, 24)
    f32 = jnp.float32
    nrm = lambda k, shape, scale: jax.random.normal(k, shape, f32) * scale
    return {
        "x": jax.random.normal(ks[0], (BATCH, SEQ, D_MODEL), f32),
        "attn_norm_g": 1.0 + nrm(ks[1], (DEPTH, D_MODEL), 0.02),
        "w_in": nrm(ks[2], (DEPTH, D_MODEL, N_IN), D_MODEL ** -0.5),
        "fox_f_bias": jax.random.uniform(ks[3], (DEPTH, FOX_HEADS), f32, 1.0, 4.0),
        "diff_lq1": nrm(ks[4], (DEPTH, DIFF_QK_DIM), 0.1),
        "diff_lk1": nrm(ks[5], (DEPTH, DIFF_QK_DIM), 0.1),
        "diff_lq2": nrm(ks[6], (DEPTH, DIFF_QK_DIM), 0.1),
        "diff_lk2": nrm(ks[7], (DEPTH, DIFF_QK_DIM), 0.1),
        "diff_subln_g": 1.0 + nrm(ks[8], (DEPTH, 2 * DIFF_QK_DIM), 0.02),
        "nsa_cmp_pos": nrm(ks[9], (DEPTH, CMP_LEN, HEAD_DIM), 0.02),
        "nsa_cmp_wk1": nrm(ks[10], (DEPTH, CMP_LEN * HEAD_DIM, HEAD_DIM), (CMP_LEN * HEAD_DIM) ** -0.5),
        "nsa_cmp_wk2": nrm(ks[11], (DEPTH, HEAD_DIM, HEAD_DIM), HEAD_DIM ** -0.5),
        "nsa_cmp_wv1": nrm(ks[12], (DEPTH, CMP_LEN * HEAD_DIM, HEAD_DIM), (CMP_LEN * HEAD_DIM) ** -0.5),
        "nsa_cmp_wv2": nrm(ks[13], (DEPTH, HEAD_DIM, HEAD_DIM), HEAD_DIM ** -0.5),
        "w_out": nrm(ks[14], (DEPTH, D_MODEL, D_MODEL), D_MODEL ** -0.5),
        "ffn_norm_g": 1.0 + nrm(ks[15], (DEPTH, D_MODEL), 0.02),
        "ffn_w_up": nrm(ks[16], (DEPTH, D_MODEL, 2 * D_FF), D_MODEL ** -0.5),
        "ffn_conv_w": nrm(ks[17], (DEPTH, CONV_W, 2 * D_FF), CONV_W ** -0.5),
        "ffn_conv_b": nrm(ks[18], (DEPTH, 2 * D_FF), 0.01),
        "ffn_w_down": nrm(ks[19], (DEPTH, D_FF, D_MODEL), D_FF ** -0.5),
        "rel_bias": nrm(ks[20], (N_BUCKETS, DIFF_HEADS + NSA_HEADS), 0.2),
        "final_norm_g": 1.0 + nrm(ks[21], (D_MODEL,), 0.02),
    }


def reference(x, attn_norm_g, w_in, fox_f_bias, diff_lq1, diff_lk1, diff_lq2, diff_lk2, diff_subln_g,
              nsa_cmp_pos, nsa_cmp_wk1, nsa_cmp_wk2, nsa_cmp_wv1, nsa_cmp_wv2, w_out, ffn_norm_g,
              ffn_w_up, ffn_conv_w, ffn_conv_b, ffn_w_down, rel_bias, final_norm_g):
    b, s, _ = x.shape
    split_points = np.cumsum(IN_SIZES)[:-1].tolist()
    diff_table = rel_bias[:, :DIFF_HEADS]
    nsa_table = rel_bias[:, DIFF_HEADS:].reshape(N_BUCKETS, NSA_KV_GROUPS, NSA_HPG)
    G, HPG, Dh = NSA_KV_GROUPS, NSA_HPG, HEAD_DIM
    h = x
    for l in range(DEPTH):
        u = rmsnorm(h, attn_norm_g[l])
        proj = u @ w_in[l]
        (fq, fk, fv, ff, dq, dk, dv, nq, nkc, nvc, nks, nvs, nkw, nvw, ng) = jnp.split(proj, split_points, axis=-1)

        fox_o = fox_attention(fq.reshape(b, s, FOX_HEADS, Dh), fk.reshape(b, s, FOX_HEADS, Dh),
                              fv.reshape(b, s, FOX_HEADS, Dh), ff, fox_f_bias[l])

        lam_init = 0.8 - 0.6 * math.exp(-0.3 * l)
        lam = (jnp.exp(jnp.sum(diff_lq1[l].astype(jnp.float32) * diff_lk1[l].astype(jnp.float32)))
               - jnp.exp(jnp.sum(diff_lq2[l].astype(jnp.float32) * diff_lk2[l].astype(jnp.float32))) + lam_init)
        diff_o = diff_attention(dq.reshape(b, s, DIFF_HEADS, 2, DIFF_QK_DIM), dk.reshape(b, s, DIFF_HEADS, 2, DIFF_QK_DIM),
                                dv.reshape(b, s, DIFF_HEADS, Dh), diff_table, lam, lam_init, diff_subln_g[l])

        nsa_o = nsa_attention(nq.reshape(b, s, G, HPG, Dh),
                              nkc.reshape(b, s, G, Dh), nvc.reshape(b, s, G, Dh),
                              nks.reshape(b, s, G, Dh), nvs.reshape(b, s, G, Dh),
                              nkw.reshape(b, s, G, Dh), nvw.reshape(b, s, G, Dh),
                              ng.reshape(b, s, G, HPG, 3), nsa_table, nsa_cmp_pos[l],
                              nsa_cmp_wk1[l], nsa_cmp_wk2[l], nsa_cmp_wv1[l], nsa_cmp_wv2[l])

        mixed = jnp.concatenate([fox_o, diff_o, nsa_o], axis=-1)
        h = h + mixed @ w_out[l]
        h = h + conv_ffn(rmsnorm(h, ffn_norm_g[l]), ffn_w_up[l], ffn_conv_w[l], ffn_conv_b[l], ffn_w_down[l])
    return rmsnorm(h, final_norm_g)
```

```cpp
#include <hip/hip_runtime.h>
#include <cstdio>
#include <cstdint>

#ifndef MK_DEBUG
#define MK_DEBUG 0
#endif

namespace pg8 {
#define PG8_LAS __attribute__((address_space(3)))
typedef unsigned short bf16_t;
typedef short bf16x8 __attribute__((ext_vector_type(8)));
typedef float f32x4 __attribute__((ext_vector_type(4)));
typedef unsigned u32x4 __attribute__((ext_vector_type(4)));
constexpr int BM = 256, BK = 64, HALF = 128, HTB = HALF * BK * 2  , STAGE_BYTES = 8 * HTB, NXCD = 8, WGM = 8;

__host__ __device__ __forceinline__ int lds_byte(int r, int c) { const int st = (r >> 4) * 2 + (c >> 5), rr = r & 15, cc = c & 31, ob = rr * 64 + cc * 2; return st * 1024 + (ob ^ (((ob >> 9) & 1) << 5)); }
__host__ __device__ __forceinline__ void stage_rc(int b, int& R, int& C) { const int st = b / 1024, sb = b % 1024, swz = sb ^ (((sb >> 9) & 1) << 5); R = (st >> 1) * 16 + swz / 64; C = (st & 1) * 32 + (swz % 64) / 2; }
__host__ __device__ __forceinline__ int perm32(int rho) { const int n = rho >> 4, i = rho & 15; return 8 * (i >> 2) + 4 * n + (i & 3); }

struct Unit { int pm, pn; };
struct Gemm { const bf16_t* A; const bf16_t* Bt; int M, N, K; };

struct StaticOrder {
    int nM, nN, nwg, G, c;
    __host__ __device__ void init(int M, int N, int G_, int c_) { nM = M / BM; nN = N / BM; nwg = nM * nN; G = G_; c = c_; }
    __host__ __device__ bool next(int i, Unit& u) const {
        const long L = (long)i * G + c; if (L >= nwg) return false;
        int wgid = (int)L; { const int q = nwg / NXCD, r = nwg % NXCD, xcd = wgid % NXCD, off = wgid / NXCD; wgid = (xcd < r ? xcd * (q + 1) : r * (q + 1) + (xcd - r) * q) + off; }
        const int nig = WGM * nN, gid = wgid / nig, fm = gid * WGM, gsz = (nM - fm) < WGM ? (nM - fm) : WGM;
        u.pm = fm + ((wgid % nig) % gsz); u.pn = (wgid % nig) / gsz; return true;
    }
    __device__ __forceinline__ void a_ready(const Unit&) const {}
    __device__ __forceinline__ void done(const Unit&) const {}
};
__device__ __forceinline__ unsigned cvt_pk_bf16(float lo, float hi) { unsigned r; asm volatile("v_cvt_pk_bf16_f32 %0, %1, %2" : "=v"(r) : "v"(lo), "v"(hi)); return r; }
typedef float f32x2 __attribute__((ext_vector_type(2)));
template <class Epi, class Sched, bool ALIGN_EPI = false, bool SP2 = false>
__device__ __forceinline__ void gemm_phase(PG8_LAS unsigned char* lds, const Gemm g, const Sched& S, const Epi& E) {
    int tid_l = threadIdx.x; asm volatile("" : "+v"(tid_l));
    const int tid = tid_l, wid = __builtin_amdgcn_readfirstlane(tid >> 6), lane = tid & 63, wr = wid >> 2, wc = wid & 3, fr = lane & 15, fq = lane >> 4;
    const int K = g.K, nt = K / BK;
    unsigned voffA[2], voffB[2]; int aoff, boff;
#define PG8_LANESET() do { int t_ = tid_l; asm volatile("" : "+v"(t_)); const int l_ = t_ & 63, fr_ = l_ & 15, fq_ = l_ >> 4; \
        _Pragma("unroll") for (int i = 0; i < 2; ++i) { int R, C; stage_rc(t_ * 16 + i * 8192, R, C); const int Rb = Epi::PERM ? ((R & ~31) + perm32(R & 31)) : R; \
            const int Ra = Epi::PERMA ? ((R & ~63) + 4 * (R & 15) + ((R >> 4) & 3)) : R; \
            voffA[i] = (unsigned)(Ra * K + C) * 2u; voffB[i] = (unsigned)(Rb * K + C) * 2u; } \
        aoff = lds_byte(wr * 64 + fr_, fq_ * 8); boff = lds_byte(wc * 32 + fr_, fq_ * 8); } while (0)
    PG8_LANESET();
    const size_t kstep = (size_t)(BK * 2);
    const size_t hstep = (size_t)HALF * K * 2;
    const size_t tstep = 2 * hstep;
    const unsigned ldsw = (unsigned)wid * 1024u;
#define PG8_SA(b, h) (((b) * 2 + (h)) * HTB)
#define PG8_SB(b, h) ((4 + (b) * 2 + (h)) * HTB)
#define PG8_STAGE(bufoff, gbase, voff) do { _Pragma("unroll") for (int _i = 0; _i < 2; ++_i) \
        __builtin_amdgcn_global_load_lds((const unsigned*)((const char*)(gbase) + (voff)[_i]), (PG8_LAS unsigned*)(lds + (bufoff) + ldsw + _i * 8192), 16, 0, 0); } while (0)
#define PG8_LDA(dst, b, h) do { _Pragma("unroll") for (int m = 0; m < 4; ++m) _Pragma("unroll") for (int k = 0; k < 2; ++k) dst[m][k] = *(const PG8_LAS bf16x8*)(lds + PG8_SA(b, h) + aoff + m * 2048 + k * 1024); } while (0)
#define PG8_LDB(dst, b, h) do { _Pragma("unroll") for (int n = 0; n < 2; ++n) _Pragma("unroll") for (int k = 0; k < 2; ++k) dst[n][k] = *(const PG8_LAS bf16x8*)(lds + PG8_SB(b, h) + boff + n * 2048 + k * 1024); } while (0)
#define PG8_MMA(ai, bj, At, Bt) do { __builtin_amdgcn_s_setprio(1); _Pragma("unroll") for (int m = 0; m < 4; ++m) _Pragma("unroll") for (int n = 0; n < 2; ++n) _Pragma("unroll") for (int k = 0; k < 2; ++k) \
        acc[ai][bj][m][n] = __builtin_amdgcn_mfma_f32_16x16x32_bf16(Bt[n][k], At[m][k], acc[ai][bj][m][n], 0, 0, 0); __builtin_amdgcn_s_setprio(0); } while (0)
#define PG8_WAIT_V(n) asm volatile("s_waitcnt vmcnt(" #n ")" ::: "memory")
#define PG8_WAIT_L(n) asm volatile("s_waitcnt lgkmcnt(" #n ")" ::: "memory")
#define PG8_BAR __builtin_amdgcn_s_barrier()
#define PG8_SCHED __builtin_amdgcn_sched_barrier(0)
    Unit cur, nxt; int ui = 0;
    if (!S.next(0, cur)) return;
    f32x4 acc[2][2][4][2];
#pragma unroll
    for (int a = 0; a < 2; ++a)
#pragma unroll
        for (int b = 0; b < 2; ++b)
#pragma unroll
            for (int m = 0; m < 4; ++m)
#pragma unroll
                for (int n = 0; n < 2; ++n) acc[a][b][m][n] = (f32x4){0.f, 0.f, 0.f, 0.f};
    bf16x8 At[4][2], B0[2][2], B1[2][2];
    const char* cA = (const char*)g.A + (size_t)cur.pm * tstep; const char* cB = (const char*)g.Bt + (size_t)cur.pn * tstep;
    S.a_ready(cur);
    if constexpr (SP2) {
        PG8_STAGE(PG8_SB(0, 0), cB, voffB); PG8_STAGE(PG8_SB(0, 1), cB + hstep, voffB); PG8_STAGE(PG8_SA(0, 0), cA, voffA); PG8_STAGE(PG8_SA(0, 1), cA + hstep, voffA);
        if (wr == 1) PG8_BAR;
        PG8_WAIT_V(2); PG8_BAR;
        PG8_STAGE(PG8_SB(1, 0), cB + kstep, voffB); PG8_STAGE(PG8_SA(1, 0), cA + kstep, voffA); PG8_STAGE(PG8_SB(1, 1), cB + hstep + kstep, voffB);
        PG8_WAIT_V(6); PG8_BAR;
    } else {
        PG8_STAGE(PG8_SB(0, 0), cB, voffB); PG8_STAGE(PG8_SA(0, 0), cA, voffA); PG8_STAGE(PG8_SB(0, 1), cB + hstep, voffB); PG8_STAGE(PG8_SA(0, 1), cA + hstep, voffA);
        if (wr == 1) PG8_BAR;
        PG8_WAIT_V(4); PG8_BAR;
        PG8_STAGE(PG8_SB(1, 0), cB + kstep, voffB); PG8_STAGE(PG8_SA(1, 0), cA + kstep, voffA); PG8_STAGE(PG8_SB(1, 1), cB + hstep + kstep, voffB);
        PG8_WAIT_V(6); PG8_BAR;
    }
    for (;;) {
        PG8_LANESET();
        const bool has_next = S.next(ui + 1, nxt);
        const char* nA = has_next ? (const char*)g.A + (size_t)nxt.pm * tstep : cA; const char* nB = has_next ? (const char*)g.Bt + (size_t)nxt.pn * tstep : cB;
        for (int t = 0; t < nt; t += 2) {
            const bool last = (t == nt - 2);
            const char* a1 = cA + (size_t)(t + 1) * kstep;
            const char* a2 = last ? nA : cA + (size_t)(t + 2) * kstep; const char* b2 = last ? nB : cB + (size_t)(t + 2) * kstep;
            const char* a3 = a2 + kstep; const char* b3 = b2 + kstep;
            if (last && has_next) S.a_ready(nxt);
            if constexpr (SP2) {
            PG8_LDB(B0, 0, 0); PG8_LDB(B1, 0, 1); PG8_SCHED; PG8_LDA(At, 0, 0); PG8_STAGE(PG8_SA(1, 1), a1 + hstep, voffA);
            PG8_WAIT_V(8); PG8_WAIT_L(0); PG8_BAR; PG8_MMA(0, 0, At, B0); PG8_MMA(0, 1, At, B1); PG8_BAR; PG8_SCHED;
            PG8_LDA(At, 0, 1); PG8_STAGE(PG8_SB(0, 0), b2, voffB); PG8_STAGE(PG8_SB(0, 1), b2 + hstep, voffB); PG8_STAGE(PG8_SA(0, 0), a2, voffA);
            PG8_WAIT_V(8); PG8_WAIT_L(0); PG8_BAR; PG8_MMA(1, 0, At, B0); PG8_MMA(1, 1, At, B1); PG8_BAR; PG8_SCHED;
            PG8_LDB(B0, 1, 0); PG8_LDB(B1, 1, 1); PG8_SCHED; PG8_LDA(At, 1, 0); PG8_STAGE(PG8_SA(0, 1), a2 + hstep, voffA);
            PG8_WAIT_V(8); PG8_WAIT_L(0); PG8_BAR; PG8_MMA(0, 0, At, B0); PG8_MMA(0, 1, At, B1); PG8_BAR; PG8_SCHED;
            PG8_LDA(At, 1, 1); PG8_STAGE(PG8_SB(1, 0), b3, voffB); PG8_STAGE(PG8_SB(1, 1), b3 + hstep, voffB); PG8_STAGE(PG8_SA(1, 0), a3, voffA);
            PG8_WAIT_V(8); PG8_WAIT_L(0); PG8_BAR; PG8_MMA(1, 0, At, B0); PG8_MMA(1, 1, At, B1); PG8_BAR; PG8_SCHED;
            } else {
            PG8_LDB(B0, 0, 0); PG8_SCHED; PG8_LDA(At, 0, 0); PG8_STAGE(PG8_SA(1, 1), a1 + hstep, voffA);
            PG8_WAIT_L(8); PG8_BAR; PG8_WAIT_L(0); PG8_MMA(0, 0, At, B0); PG8_BAR; PG8_SCHED;
            PG8_LDB(B1, 0, 1); PG8_STAGE(PG8_SB(0, 0), b2, voffB);
            PG8_BAR; PG8_WAIT_L(0); PG8_MMA(0, 1, At, B1); PG8_BAR;
            PG8_LDA(At, 0, 1); PG8_STAGE(PG8_SA(0, 0), a2, voffA);
            PG8_BAR; PG8_WAIT_L(0); PG8_MMA(1, 0, At, B0); PG8_BAR; PG8_SCHED;
            PG8_STAGE(PG8_SB(0, 1), b2 + hstep, voffB);
            PG8_WAIT_V(6); PG8_BAR; PG8_MMA(1, 1, At, B1); PG8_BAR;
            PG8_LDB(B0, 1, 0); PG8_SCHED; PG8_LDA(At, 1, 0); PG8_STAGE(PG8_SA(0, 1), a2 + hstep, voffA);
            PG8_WAIT_L(8); PG8_BAR; PG8_WAIT_L(0); PG8_MMA(0, 0, At, B0); PG8_BAR; PG8_SCHED;
            PG8_LDB(B1, 1, 1); PG8_STAGE(PG8_SB(1, 0), b3, voffB);
            PG8_BAR; PG8_WAIT_L(0); PG8_MMA(0, 1, At, B1); PG8_BAR;
            PG8_LDA(At, 1, 1); PG8_STAGE(PG8_SA(1, 0), a3, voffA);
            PG8_BAR; PG8_WAIT_L(0); PG8_MMA(1, 0, At, B0); PG8_BAR; PG8_SCHED;
            PG8_STAGE(PG8_SB(1, 1), b3 + hstep, voffB);
            PG8_WAIT_V(6); PG8_BAR; PG8_MMA(1, 1, At, B1); PG8_BAR;
            }
        }
        if constexpr (ALIGN_EPI) { if (wr == 0) PG8_BAR; }
        if constexpr (!Epi::AFTER_DRAIN) { E(acc, cur, wr, wc, fr, fq); S.done(cur); }
        if (!has_next) break;
#pragma unroll
        for (int a = 0; a < 2; ++a)
#pragma unroll
            for (int b = 0; b < 2; ++b)
#pragma unroll
                for (int m = 0; m < 4; ++m)
#pragma unroll
                    for (int n = 0; n < 2; ++n) acc[a][b][m][n] = (f32x4){0.f, 0.f, 0.f, 0.f};
        cur = nxt; cA = nA; cB = nB; ++ui;
        if constexpr (ALIGN_EPI) { if (wr == 1) PG8_BAR; }
    }
    PG8_WAIT_V(0);
    if constexpr (!ALIGN_EPI) { if (wr == 0) PG8_BAR; }
    PG8_BAR;
    if constexpr (Epi::AFTER_DRAIN) { E.fused(acc, cur, wr, wc, fr, fq, lds, wid, lane); S.done(cur); }
#undef PG8_LANESET
#undef PG8_SA
#undef PG8_SB
#undef PG8_STAGE
#undef PG8_LDA
#undef PG8_LDB
#undef PG8_MMA
#undef PG8_WAIT_V
#undef PG8_WAIT_L
#undef PG8_BAR
#undef PG8_SCHED
}
}
#define GAS __attribute__((address_space(1)))
#define LAS __attribute__((address_space(3)))

constexpr int DM = 2048, NBATCH = 16, SEQ = 2048, DEPTH = 4, MROWS = NBATCH * SEQ;
constexpr int NIN = 6168, NINP = 6176, PROJ_LD = 6144;
constexpr int DFF = 5632, NUP = 2 * DFF;
constexpr float RMS_EPS = 1e-6f;
constexpr float LOG2E = 1.4426950408889634f;
constexpr int C_FQ = 0, C_FK = 768, C_FV = 1536, C_DQ = 2304, C_DK = 2816, C_DV = 3328, C_NQ = 3840, C_NKC = 4608, C_NVC = 4864, C_NKS = 5120, C_NVS = 5376, C_NKW = 5632, C_NVW = 5888;
constexpr int GATE_LD = 32;
__device__ __forceinline__ int win_colmap(int c) {
    if (c < 2304) return c; if (c < 6144) return c + 6; if (c < 6150) return 2304 + (c - 6144); if (c < 6168) return c; return -1;
}
__device__ __forceinline__ int wup_colmap(int c) { const int pn = c >> 8, w = c & 255; return (w < 128) ? (pn * 128 + w) : (DFF + pn * 128 + (w - 128)); }

__constant__ unsigned char T5B[128] = {0, 1, 2, 3, 4, 5, 6, 7, 8, 9, 10, 11, 12, 13, 14, 15, 16, 16, 16, 17, 17, 18, 18, 18, 19, 19, 19, 20, 20, 20, 20, 21, 21, 21, 21, 22, 22, 22, 22, 22, 23, 23, 23, 23, 23, 23, 24, 24, 24, 24, 24, 24, 25, 25, 25, 25, 25, 25, 25, 26, 26, 26, 26, 26, 26, 26, 26, 27, 27, 27, 27, 27, 27, 27, 27, 27, 27, 28, 28, 28, 28, 28, 28, 28, 28, 28, 28, 29, 29, 29, 29, 29, 29, 29, 29, 29, 29, 29, 29, 30, 30, 30, 30, 30, 30, 30, 30, 30, 30, 30, 30, 30, 30, 31, 31, 31, 31, 31, 31, 31, 31, 31, 31, 31, 31, 31, 31, 31};

constexpr size_t al256(size_t x) { return (x + 255) & ~(size_t)255; }
constexpr size_t WS_CTL = 0, CTL_ZERO_BYTES = 1u << 20;
constexpr size_t WS_WIN = CTL_ZERO_BYTES;
constexpr size_t WS_WOUT = WS_WIN + (size_t)DEPTH * NINP * DM * 2;
constexpr size_t WS_WUP = WS_WOUT + (size_t)DEPTH * DM * DM * 2;
constexpr size_t WS_WDN = WS_WUP + (size_t)DEPTH * NUP * DM * 2;
constexpr size_t WS_W1T = WS_WDN + (size_t)DEPTH * DM * DFF * 2;
constexpr size_t WS_W2T = WS_W1T + (size_t)DEPTH * 2 * 128 * 4096 * 2;
constexpr size_t WS_POSC = WS_W2T + (size_t)DEPTH * 2 * 128 * 128 * 2;
constexpr size_t WS_HB = al256(WS_POSC + (size_t)DEPTH * 2 * 128 * 4);
constexpr size_t WS_MIXED = WS_HB + (size_t)MROWS * DM * 2;
constexpr size_t WS_PROJ = WS_MIXED + (size_t)MROWS * DM * 2;
constexpr size_t WS_GATES = WS_PROJ + (size_t)MROWS * PROJ_LD * 2;
constexpr size_t WS_SSQP = WS_GATES + (size_t)MROWS * GATE_LD * 4;
constexpr size_t WS_RSTD = WS_SSQP + (size_t)MROWS * 32 * 4;
constexpr size_t WS_HALO = WS_RSTD + (size_t)MROWS * 4;
constexpr size_t WS_KCMP = WS_HALO + (size_t)128 * 4 * NUP * 4;
constexpr size_t WS_VCMP = WS_KCMP + (size_t)NBATCH * 2 * 128 * 128 * 2;
constexpr size_t WS_CUM = WS_VCMP + (size_t)NBATCH * 2 * 128 * 128 * 2;
constexpr size_t WS_SCR = WS_CUM + (size_t)NBATCH * 6 * SEQ * 4;
constexpr size_t WS_DIAG = WS_SCR + (size_t)256 * 131072;
constexpr size_t WS_END = WS_DIAG + 65536;
static_assert(WS_END + (size_t)MROWS * DM * 4 <= (size_t)4 * DEPTH * DM * NUP * 4, "workspace map (+ the debug build's copy of h) must fit 4x the largest tensor");
constexpr int CW_BAR = 4096;
constexpr int CW_QUEUE = 65536;
constexpr int CW_CONV = 131072;
constexpr int CW_CMPDONE = 98304;

constexpr int RING_BYTES = 131072;
constexpr int LX_CONV = RING_BYTES;
constexpr int LX_MISC = RING_BYTES + 8192;
constexpr int LX_CW = LX_MISC + 256 + 2048;
constexpr int LX_RSTAB = LX_MISC + 256;
static_assert(LX_MISC + 256 + 2048 + 4096 <= 147456, "LDS map");
constexpr int LDS_BYTES = 147456;

typedef unsigned short bf16_t;
typedef short bf16x8 __attribute__((ext_vector_type(8)));
typedef short s16x4 __attribute__((ext_vector_type(4)));
typedef float f32x4 __attribute__((ext_vector_type(4)));
typedef float f32x2 __attribute__((ext_vector_type(2)));
typedef float f32x16 __attribute__((ext_vector_type(16)));
typedef unsigned u32x4 __attribute__((ext_vector_type(4)));
typedef unsigned u32x2 __attribute__((ext_vector_type(2)));

__device__ __forceinline__ int ltid() { int t = threadIdx.x; asm volatile("" : "+v"(t)); return t; }
typedef __bf16 bf16x2_t __attribute__((ext_vector_type(2)));
__device__ __forceinline__ unsigned cvtpk(float lo, float hi) { const f32x2 v = {lo, hi}; const bf16x2_t b = __builtin_convertvector(v, bf16x2_t); return __builtin_bit_cast(unsigned, b); }
__device__ __forceinline__ float bf2f(bf16_t v) { return __builtin_bit_cast(float, (unsigned)v << 16); }
__device__ __forceinline__ float fast_exp2(float x) { return __builtin_amdgcn_exp2f(x); }
__device__ __forceinline__ float fast_rcp(float x) { return __builtin_amdgcn_rcpf(x); }
__device__ __forceinline__ float shx(float v, int o) { return __builtin_bit_cast(float, __builtin_amdgcn_ds_bpermute(((ltid() & 63) ^ o) << 2, __builtin_bit_cast(int, v))); }
__device__ __forceinline__ float wave_sum(float v) {
    const int a = (ltid() & 63) << 2;
#pragma unroll
    for (int o = 1; o < 64; o <<= 1) v += __builtin_bit_cast(float, __builtin_amdgcn_ds_bpermute(a ^ (o << 2), __builtin_bit_cast(int, v)));
    return v;
}
template <int CTRL> __device__ __forceinline__ float dppf(float v) { return __builtin_bit_cast(float, __builtin_amdgcn_mov_dpp(__builtin_bit_cast(int, v), CTRL, 0xF, 0xF, false)); }
template <int CTRL> __device__ __forceinline__ float dppfo(float o, float v) { return __builtin_bit_cast(float, __builtin_amdgcn_update_dpp(__builtin_bit_cast(int, o), __builtin_bit_cast(int, v), CTRL, 0xF, 0xF, false)); }
template <int CTRL> __device__ __forceinline__ f32x4 dpp4o(f32x4 o, f32x4 v) { f32x4 r; r.x = dppfo<CTRL>(o.x, v.x); r.y = dppfo<CTRL>(o.y, v.y); r.z = dppfo<CTRL>(o.z, v.z); r.w = dppfo<CTRL>(o.w, v.w); return r; }
template <int CTRL> __device__ __forceinline__ f32x4 dpp4(f32x4 v) { f32x4 r; r.x = dppf<CTRL>(v.x); r.y = dppf<CTRL>(v.y); r.z = dppf<CTRL>(v.z); r.w = dppf<CTRL>(v.w); return r; }

namespace epi {
using pg8::Unit;

struct InProj {
    static constexpr bool PERM = true, PERMA = true, AFTER_DRAIN = false;
    bf16_t* proj; const __attribute__((address_space(3))) float* rstab;
    __device__ __forceinline__ void operator()(const f32x4 (&acc)[2][2][4][2], const Unit& u, int wr, int wc, int fr, int fq) const {
        { const int ln = ltid() & 63; fr = ln & 15; fq = ln >> 4; }
        const int row0 = u.pm * 256 + wr * 64 + 4 * fr;
        float cs = 1.f;
        if (u.pn < 3) cs = 0.08838834764831845f * LOG2E;
        else if (u.pn == 9 || u.pn == 10) cs = 0.125f * LOG2E;
        else if (u.pn >= 15 && u.pn <= 17) cs = 0.08838834764831845f * LOG2E;
        {
#pragma unroll
            for (int ai = 0; ai < 2; ++ai)
#pragma unroll
                for (int m = 0; m < 4; ++m) {
                    const int row = row0 + ai * 128 + m; const float s = rstab[((u.pm >> 3) & 1) * 256 + (row & 255)] * cs;
                    bf16_t* rp = proj + (size_t)row * PROJ_LD + u.pn * 256 + wc * 32 + 8 * fq;
#pragma unroll
                    for (int bj = 0; bj < 2; ++bj) { const f32x4 v0 = acc[ai][bj][m][0] * s, v1 = acc[ai][bj][m][1] * s;
                        u32x4 w; w.x = cvtpk(v0[0], v0[1]); w.y = cvtpk(v0[2], v0[3]); w.z = cvtpk(v1[0], v1[1]); w.w = cvtpk(v1[2], v1[3]);
                        *(u32x4*)(rp + bj * 128) = w; }
                }
        }
    }
};

struct Resid {
    static constexpr bool PERM = true, PERMA = true, AFTER_DRAIN = false;
    bf16_t* hb; float* ssqp;
    __device__ __forceinline__ void operator()(const f32x4 (&acc)[2][2][4][2], const Unit& u, int wr, int wc, int fr, int fq) const {
        { const int ln = ltid() & 63; fr = ln & 15; fq = ln >> 4; }
        const int row0 = u.pm * 256 + wr * 64 + 4 * fr, col0 = u.pn * 256 + wc * 32 + 8 * fq;
        u32x4 hv[2][4][2];
#pragma unroll
        for (int ai = 0; ai < 2; ++ai)
#pragma unroll
            for (int m = 0; m < 4; ++m)
#pragma unroll
                for (int bj = 0; bj < 2; ++bj) hv[ai][m][bj] = *(const u32x4*)(hb + (size_t)(row0 + ai * 128 + m) * DM + col0 + bj * 128);
#pragma unroll
        for (int ai = 0; ai < 2; ++ai)
#pragma unroll
            for (int m = 0; m < 4; ++m) {
                const int row = row0 + ai * 128 + m; float ss = 0.f;
#pragma unroll
                for (int bj = 0; bj < 2; ++bj) {
                    const size_t off = (size_t)row * DM + col0 + bj * 128;
                    const u32x4 h = hv[ai][m][bj];
                    f32x4 v0, v1;
                    v0[0] = __builtin_bit_cast(float, h.x << 16) + acc[ai][bj][m][0][0]; v0[1] = __builtin_bit_cast(float, h.x & 0xFFFF0000u) + acc[ai][bj][m][0][1];
                    v0[2] = __builtin_bit_cast(float, h.y << 16) + acc[ai][bj][m][0][2]; v0[3] = __builtin_bit_cast(float, h.y & 0xFFFF0000u) + acc[ai][bj][m][0][3];
                    v1[0] = __builtin_bit_cast(float, h.z << 16) + acc[ai][bj][m][1][0]; v1[1] = __builtin_bit_cast(float, h.z & 0xFFFF0000u) + acc[ai][bj][m][1][1];
                    v1[2] = __builtin_bit_cast(float, h.w << 16) + acc[ai][bj][m][1][2]; v1[3] = __builtin_bit_cast(float, h.w & 0xFFFF0000u) + acc[ai][bj][m][1][3];
                    u32x4 w; w.x = cvtpk(v0[0], v0[1]); w.y = cvtpk(v0[2], v0[3]); w.z = cvtpk(v1[0], v1[1]); w.w = cvtpk(v1[2], v1[3]);
                    *(u32x4*)(hb + off) = w;
                    ss += (v0[0] * v0[0] + v0[1] * v0[1]) + (v0[2] * v0[2] + v0[3] * v0[3]) + (v1[0] * v1[0] + v1[1] * v1[1]) + (v1[2] * v1[2] + v1[3] * v1[3]);
                }
                ss += shx(ss, 16); ss += shx(ss, 32);
                if (fq == 0) ssqp[(size_t)row * 32 + u.pn * 4 + wc] = ss;
            }
    }
};

struct UpConv {
    static constexpr bool PERM = true, PERMA = true, AFTER_DRAIN = false;
    bf16_t* act; const __attribute__((address_space(3))) float* rstab; const float* cw; const float* cb; float* halo; __attribute__((address_space(3))) float* ex;
    __device__ __forceinline__ void operator()(const f32x4 (&acc)[2][2][4][2], const Unit& u, int wr, int wc, int fr, int fq) const {
        { const int ln = ltid() & 63; fr = ln & 15; fq = ln >> 4; }
        const int tcol = wc * 32 + 8 * fq, ch0 = u.pn * 128 + tcol;
        const int row0 = u.pm * 256 + wr * 64 + 4 * fr;
        float rs[2][4];
#pragma unroll
        for (int ai = 0; ai < 2; ++ai)
#pragma unroll
            for (int m = 0; m < 4; ++m) rs[ai][m] = rstab[((u.pm >> 3) & 1) * 256 + ((row0 + ai * 128 + m) & 255)];
        __attribute__((address_space(3))) float* cwl = ex + (LX_CW - LX_CONV) / 4;
        { const int t = ltid();
#pragma unroll
          for (int k = 0; k < 2; ++k) { const int i = t + 512 * k, q = i >> 7, cc = i & 127, tap = q >> 1, bjj = q & 1;
              cwl[i] = (tap < 3 ? cw + tap * NUP : cb)[bjj * DFF + u.pn * 128 + cc]; } }
        if (fr == 15) {
#pragma unroll
            for (int ai = 0; ai < 2; ++ai)
#pragma unroll
                for (int bj = 0; bj < 2; ++bj)
#pragma unroll
                    for (int n = 0; n < 2; ++n)
#pragma unroll
                        for (int q = 0; q < 2; ++q) {
                            const f32x4 v = acc[ai][bj][2 + q][n] * rs[ai][2 + q];
                            *(__attribute__((address_space(3))) f32x4*)(ex + ((ai * 2 + wr) * 2 + q) * 256 + bj * 128 + tcol + 4 * n) = v;
                            if (ai == 1 && wr == 1) *(f32x4*)(halo + ((size_t)(u.pm * 4 + 2 + q) * NUP) + u.pn * 256 + bj * 128 + tcol + 4 * n) = v;
                        }
        }
        if (fr == 0 && wr == 0) {
#pragma unroll
            for (int bj = 0; bj < 2; ++bj)
#pragma unroll
                for (int n = 0; n < 2; ++n)
#pragma unroll
                    for (int q = 0; q < 2; ++q)
                        *(f32x4*)(halo + ((size_t)(u.pm * 4 + q) * NUP) + u.pn * 256 + bj * 128 + tcol + 4 * n) = acc[0][bj][q][n] * rs[0][q];
        }
        asm volatile("s_waitcnt lgkmcnt(0)" ::: "memory");
        __builtin_amdgcn_s_barrier();
#pragma unroll
        for (int ai = 0; ai < 2; ++ai) {
            const bool top = (ai == 0 && wr == 0);
            const int pb = (wr ? ai * 2 : (ai * 2 - 1));
#pragma unroll
            for (int n = 0; n < 2; ++n) {
                f32x4 yg[4];
#pragma unroll
                for (int bj = 0; bj < 2; ++bj) {
                    asm volatile("" ::: "memory"); __builtin_amdgcn_sched_barrier(0);
                    const __attribute__((address_space(3))) float* wl = cwl + bj * 128 + tcol + 4 * n;
                    const f32x4 w0 = *(const __attribute__((address_space(3))) f32x4*)wl, w1 = *(const __attribute__((address_space(3))) f32x4*)(wl + 256), w2 = *(const __attribute__((address_space(3))) f32x4*)(wl + 512), bb = *(const __attribute__((address_space(3))) f32x4*)(wl + 768);
                    f32x4 e62 = {0.f, 0.f, 0.f, 0.f}, e63 = {0.f, 0.f, 0.f, 0.f};
                    if (!top) {
                        e62 = *(const __attribute__((address_space(3))) f32x4*)(ex + (pb * 2 + 0) * 256 + bj * 128 + tcol + 4 * n);
                        e63 = *(const __attribute__((address_space(3))) f32x4*)(ex + (pb * 2 + 1) * 256 + bj * 128 + tcol + 4 * n);
                    }
                    f32x4 v[4];
#pragma unroll
                    for (int m = 0; m < 4; ++m) v[m] = acc[ai][bj][m][n] * rs[ai][m];
                    const f32x4 s3 = dpp4o<0x111>(e63, v[3]), s2 = dpp4o<0x111>(e62, v[2]);
                    f32x4 y[4];
                    y[0] = ((bb + w2 * v[0]) + w1 * s3) + w0 * s2;
                    y[1] = ((bb + w2 * v[1]) + w1 * v[0]) + w0 * s3;
                    y[2] = ((bb + w2 * v[2]) + w1 * v[1]) + w0 * v[0];
                    y[3] = ((bb + w2 * v[3]) + w1 * v[2]) + w0 * v[1];
#pragma unroll
                    for (int m = 0; m < 4; ++m) {
                        if (bj == 0) yg[m] = y[m];
                        else {
                            f32x4 o;
#pragma unroll
                            for (int i = 0; i < 4; ++i) o[i] = yg[m][i] * fast_rcp(1.f + fast_exp2(-yg[m][i] * LOG2E)) * y[m][i];
                            if (!(top && fr == 0 && m < 2)) {
                                u32x2 w; w.x = cvtpk(o[0], o[1]); w.y = cvtpk(o[2], o[3]);
                                *(u32x2*)(act + (size_t)(row0 + ai * 128 + m) * DFF + ch0 + 4 * n) = w;
                            }
                        }
                    }
                }
            }
        }
    }
};
}
#define XB_TMO      128
#define XB_XCNT(j)  (256  + 64 * (j))
#define XB_XSUB(j)  (1280 + 64 * (j))
#define XB_XGEN(j)  (2304 + 64 * (j))
#define XB_TOP      3328
#define XB_TOPGEN   3392
#define XCD_BAR_WORDS 3456
#define XB_SPIN_CAP (1u << 18)

__device__ __forceinline__ unsigned xb_ld(unsigned* p)              { return __hip_atomic_load(p, __ATOMIC_RELAXED, __HIP_MEMORY_SCOPE_AGENT); }
__device__ __forceinline__ unsigned xb_add(unsigned* p, unsigned v) { return __hip_atomic_fetch_add(p, v, __ATOMIC_RELAXED, __HIP_MEMORY_SCOPE_AGENT); }
__device__ __forceinline__ unsigned xb_xcc_id() { return (unsigned)__builtin_amdgcn_s_getreg((3 << 11) | 20) & 0xFu; }
#define XB_SPIN(cond, bar) do { unsigned _sp = 0; while (cond) { __builtin_amdgcn_s_sleep(1); \
    if ((++_sp & 255u) == 0u) { if (xb_ld(&(bar)[XB_TMO])) break; if (_sp > XB_SPIN_CAP) { atomicAdd(&(bar)[XB_TMO], 1u); break; } } } } while (0)

struct XcdBarrier {
    unsigned* bar; unsigned x;
    volatile LAS unsigned* st;
};

__device__ __forceinline__ XcdBarrier xcd_barrier_post(unsigned* bar, volatile LAS unsigned* st) {
    XcdBarrier b; b.bar = bar; b.x = xb_xcc_id(); b.st = st;
    if (threadIdx.x == 0) (void)xb_add(&bar[XB_XCNT(b.x)], 1u);
    return b;
}
__device__ __forceinline__ void xcd_barrier_complete(unsigned* bar, unsigned x, unsigned& nloc, unsigned& nx) {
    const unsigned G = gridDim.x * gridDim.y * gridDim.z;
    unsigned sum, cnt, mine, sp = 0u;
    for (;;) {
        sum = 0u; cnt = 0u; mine = 0u;
#pragma unroll
        for (unsigned j = 0; j < 16; ++j) { const unsigned c = xb_ld(&bar[XB_XCNT(j)]); sum += c; cnt += (c > 0u) ? 1u : 0u; mine = (j == x) ? c : mine; }
        if (sum == G) break;
        __builtin_amdgcn_s_sleep(1);
        if ((++sp & 255u) == 0u) { if (xb_ld(&bar[XB_TMO])) break; if (sp > XB_SPIN_CAP) { atomicAdd(&bar[XB_TMO], 1u); break; } }
    }
    nloc = mine > 0u ? mine : 1u; nx = cnt > 0u ? cnt : 1u;
}

__device__ __forceinline__ void xcd_barrier(const XcdBarrier& b) {
    asm volatile("s_waitcnt vmcnt(0)" ::: "memory");
    __syncthreads();
    if (threadIdx.x == 0) {
        unsigned* bar = b.bar; asm volatile("" : "+s"(bar));
        __builtin_amdgcn_s_waitcnt(0);
        unsigned nloc = b.st[0], nx = b.st[1];
        if (nloc == 0u) { xcd_barrier_complete(bar, b.x, nloc, nx); b.st[0] = nloc; b.st[1] = nx; }
        const unsigned old = xb_add(&bar[XB_XSUB(b.x)], 1u);
        const unsigned gen = old / nloc;
        if (old + 1u == (gen + 1u) * nloc) {
            __builtin_amdgcn_fence(__ATOMIC_RELEASE, "agent");
            asm volatile("s_waitcnt vmcnt(0)" ::: "memory");
            const unsigned og = xb_add(&bar[XB_TOP], 1u);
            const unsigned tg = og / nx;
            if (og + 1u == (tg + 1u) * nx) xb_add(&bar[XB_TOPGEN], 1u);
            else XB_SPIN(xb_ld(&bar[XB_TOPGEN]) == tg, bar);
            __builtin_amdgcn_fence(__ATOMIC_ACQUIRE, "agent");
            xb_add(&bar[XB_XGEN(b.x)], 1u);
            asm volatile("s_waitcnt vmcnt(0)" ::: "memory");
        } else {
            XB_SPIN(xb_ld(&bar[XB_XGEN(b.x)]) == gen, bar);
            __builtin_amdgcn_fence(__ATOMIC_ACQUIRE, "agent");
            asm volatile("s_waitcnt vmcnt(0)" ::: "memory");
        }
    }
    __syncthreads();
}

namespace att {
constexpr int SHM = 16384;
constexpr int L_V = 0, L_K = 2 * SHM, L_WS = 4 * SHM, L_CUM = L_WS + 2048, L_LUT = L_CUM + 8192, L_IMP = L_LUT + 5120, L_SEL = L_IMP + 256 * 33 * 4, L_UNI = L_SEL + 1024, L_END = L_UNI + 64;
static_assert(L_END <= RING_BYTES, "attention scratch inside the ring region");
constexpr float THR2 = 11.5f;
enum { K_FOX = 0, K_DIFF = 1, K_SEL = 2, K_WIN = 3, K_CMP = 4 };

#define KSWZ(row, colB) ((row) * 256 + ((colB) ^ (((row) & 7) << 4)))
#define SBAR() __builtin_amdgcn_sched_barrier(0)
__device__ __forceinline__ int v_st(int k, int c) { const int kk = (k & ~0xC) | ((k & 4) << 1) | ((k & 8) >> 1); return ((kk >> 3) * 4 + (c >> 5)) * 512 + ((kk & 7) * 32 + (c & 31)) * 2; }
__device__ __forceinline__ int v_rd_base(int lane) { return ((lane & 3) << 3) | (((lane >> 2) & 3) << 6) | (((lane >> 4) & 1) << 5) | (((lane >> 5) & 1) << 8); }
constexpr int v_rd_off(int d0, int ks, int half) { return d0 * 512 + ks * 4096 + half * 2048; }
__device__ __forceinline__ int crow(int r, int hi) { return (r & 3) + 8 * (r >> 2) + 4 * hi; }
constexpr int ccol(int r) { return (r & 3) + 8 * (r >> 2); }

typedef LAS char* lptr;

template <int NQ>
__device__ __forceinline__ void qkt(f32x16& p0, f32x16& p1, lptr kbuf, int kf0, int r32, int hi, const bf16x8 (&qr)[8]) {
    p0 = f32x16{}; p1 = f32x16{};
    const int kb0 = (int)(uintptr_t)kbuf + (kf0 >> 2) * 128;
    const int ka0 = kb0 + KSWZ(r32, (0 * 16 + hi * 8) * 2), ka1 = kb0 + KSWZ(r32, (1 * 16 + hi * 8) * 2), ka2 = kb0 + KSWZ(r32, (2 * 16 + hi * 8) * 2), ka3 = kb0 + KSWZ(r32, (3 * 16 + hi * 8) * 2);
#define KRD(dst, addr, off) asm volatile("ds_read_b128 %0, %1 offset:%2" : "=&v"(dst) : "v"(addr), "i"(off) : "memory")
#define KRD4(S, aA, aB, off) do { KRD(S[0], aA, off); KRD(S[1], aA, (off) + 8192); KRD(S[2], aB, off); KRD(S[3], aB, (off) + 8192); } while (0)
#define KMM4(S, d) do { p0 = __builtin_amdgcn_mfma_f32_32x32x16_bf16(S[0], qr[d], p0, 0, 0, 0); p1 = __builtin_amdgcn_mfma_f32_32x32x16_bf16(S[1], qr[d], p1, 0, 0, 0); \
                        p0 = __builtin_amdgcn_mfma_f32_32x32x16_bf16(S[2], qr[(d) + 1], p0, 0, 0, 0); p1 = __builtin_amdgcn_mfma_f32_32x32x16_bf16(S[3], qr[(d) + 1], p1, 0, 0, 0); } while (0)
#define LGK(n) asm volatile("s_waitcnt lgkmcnt(" #n ")" ::: "memory")
    bf16x8 A[4], B[4];
    LGK(0); SBAR();
    if (NQ == 8) {
        KRD4(A, ka0, ka1, 0); KRD4(B, ka2, ka3, 0);
        LGK(4); SBAR(); KMM4(A, 0); SBAR(); KRD4(A, ka0, ka1, 128);
        LGK(4); SBAR(); KMM4(B, 2); SBAR(); KRD4(B, ka2, ka3, 128);
        LGK(4); SBAR(); KMM4(A, 4); SBAR();
        LGK(0); SBAR(); KMM4(B, 6);
    } else {
        KRD4(A, ka0, ka1, 0); KRD4(B, ka2, ka3, 0);
        LGK(4); SBAR(); KMM4(A, 0); SBAR();
        LGK(0); SBAR(); KMM4(B, 2);
    }
#undef KRD
#undef KRD4
#undef KMM4
#undef LGK
}
__device__ __forceinline__ void pv_tile(f32x16 (&o)[4], int vb0, bf16x8 pa0, bf16x8 pa1, bf16x8 pa2, bf16x8 pa3) {
#define TRRD(dst, off) asm volatile("ds_read_b64_tr_b16 %0, %1 offset:%2" : "=&v"(dst) : "v"(vb0), "i"(off) : "memory")
#define PV_RD(S, d0) do { constexpr int b_ = v_rd_off(d0, 0, 0); TRRD(S[0], b_); TRRD(S[1], b_ + 2048); TRRD(S[2], b_ + 4096); TRRD(S[3], b_ + 6144); \
                          TRRD(S[4], b_ + 8192); TRRD(S[5], b_ + 10240); TRRD(S[6], b_ + 12288); TRRD(S[7], b_ + 14336); } while (0)
#define PV_MM(S, d0) do { \
        o[d0] = __builtin_amdgcn_mfma_f32_32x32x16_bf16(pa0, (bf16x8){S[0][0], S[0][1], S[0][2], S[0][3], S[1][0], S[1][1], S[1][2], S[1][3]}, o[d0], 0, 0, 0);   \
        o[d0] = __builtin_amdgcn_mfma_f32_32x32x16_bf16(pa1, (bf16x8){S[2][0], S[2][1], S[2][2], S[2][3], S[3][0], S[3][1], S[3][2], S[3][3]}, o[d0], 0, 0, 0);   \
        o[d0] = __builtin_amdgcn_mfma_f32_32x32x16_bf16(pa2, (bf16x8){S[4][0], S[4][1], S[4][2], S[4][3], S[5][0], S[5][1], S[5][2], S[5][3]}, o[d0], 0, 0, 0);   \
        o[d0] = __builtin_amdgcn_mfma_f32_32x32x16_bf16(pa3, (bf16x8){S[6][0], S[6][1], S[6][2], S[6][3], S[7][0], S[7][1], S[7][2], S[7][3]}, o[d0], 0, 0, 0); } while (0)
#define LGK(n) asm volatile("s_waitcnt lgkmcnt(" #n ")" ::: "memory")
    s16x4 A[8], B[8];
    LGK(0); SBAR();
    PV_RD(A, 0); PV_RD(B, 1);
    LGK(8); SBAR(); PV_MM(A, 0); SBAR(); PV_RD(A, 2);
    LGK(8); SBAR(); PV_MM(B, 1); SBAR(); PV_RD(B, 3);
    LGK(8); SBAR(); PV_MM(A, 2); SBAR();
    LGK(0); SBAR(); PV_MM(B, 3);
#undef TRRD
#undef PV_RD
#undef PV_MM
#undef LGK
}
__device__ __forceinline__ void softmax_tile(f32x16& p0, f32x16& p1, float& m_reg, float& l_reg, float& alpha, bf16x8& pa0, bf16x8& pa1, bf16x8& pa2, bf16x8& pa3) {
    float pmax = p0[0];
#pragma unroll
    for (int r = 1; r < 16; ++r) pmax = fmaxf(pmax, p0[r]);
#pragma unroll
    for (int r = 0; r < 16; ++r) pmax = fmaxf(pmax, p1[r]);
    { auto rr = __builtin_amdgcn_permlane32_swap(__float_as_uint(pmax), __float_as_uint(pmax), false, false);
      pmax = fmaxf(__uint_as_float(rr[0]), __uint_as_float(rr[1])); }
    float mn;
    if (__builtin_expect(__all((pmax - m_reg) <= THR2), 1)) { mn = m_reg; alpha = 1.f; }
    else { mn = fmaxf(m_reg, pmax); alpha = fast_exp2(m_reg - mn); m_reg = mn; }
    float ps = 0.f;
#pragma unroll
    for (int r = 0; r < 16; ++r) { p0[r] = fast_exp2(p0[r] - mn); ps += p0[r]; }
#pragma unroll
    for (int r = 0; r < 16; ++r) { p1[r] = fast_exp2(p1[r] - mn); ps += p1[r]; }
    { auto rr = __builtin_amdgcn_permlane32_swap(__float_as_uint(ps), __float_as_uint(ps), false, false);
      ps = __uint_as_float(rr[0]) + __uint_as_float(rr[1]); }
    l_reg = l_reg * alpha + ps;
#define PK4(P, B_, OUT) do { unsigned a0 = cvtpk(P[B_+0], P[B_+1]), a1 = cvtpk(P[B_+2], P[B_+3]);                          \
        unsigned b0 = cvtpk(P[B_+4], P[B_+5]), b1 = cvtpk(P[B_+6], P[B_+7]);                                             \
        auto r0 = __builtin_amdgcn_permlane32_swap(a0, b0, false, false); auto r1 = __builtin_amdgcn_permlane32_swap(a1, b1, false, false); \
        u32x4 w = {r0[0], r1[0], r0[1], r1[1]}; OUT = __builtin_bit_cast(bf16x8, w); } while (0)
    PK4(p0, 0, pa0); PK4(p0, 8, pa1); PK4(p1, 0, pa2); PK4(p1, 8, pa3);
#undef PK4
}
__device__ __forceinline__ void rowbcast(LAS float* wsl, float v, int r32, int hi, float (&out)[16]) {
    if (hi == 0) wsl[r32] = v;
    asm volatile("s_waitcnt lgkmcnt(0)" ::: "memory");
#pragma unroll
    for (int r = 0; r < 16; ++r) out[r] = wsl[crow(r, hi)];
    asm volatile("s_waitcnt lgkmcnt(0)" ::: "memory");
}

template <int KIND>
__device__ __forceinline__ bool wave_act(int j, int qlo, unsigned selm) {
    const int kb = j * 64;
    if (KIND == K_FOX || KIND == K_DIFF) return kb <= qlo + 31;
    if (KIND == K_WIN) return (kb <= qlo + 31) && (kb + 63 >= qlo - 511);
    if (KIND == K_SEL) return (kb <= qlo + 31) && __any((int)((selm >> j) & 1u));
    return true;
}
template <int KIND>
__device__ __forceinline__ void score_fix(f32x16& p0, f32x16& p1, int j, int qlo, int qpos, int hi, const LAS float* lut, const LAS float* cum, unsigned selm) {
    const float NEG = -__builtin_inff();
    const int kb = j * 64, dq = qpos - kb - 4 * hi;
    if (KIND == K_FOX) {
        const LAS float* cb = cum + kb + 4 * hi;
#pragma unroll
        for (int r = 0; r < 16; ++r) { p0[r] += cb[ccol(r)]; p1[r] += cb[ccol(r) + 32]; }
        if (kb + 63 > qlo) {
#pragma unroll
            for (int r = 0; r < 16; ++r) { if (dq - ccol(r) < 0) p0[r] = NEG; if (dq - ccol(r) - 32 < 0) p1[r] = NEG; }
        }
    } else if (KIND == K_CMP) {
        const int dc = qpos - 31 - 16 * (kb + 4 * hi);
#pragma unroll
        for (int r = 0; r < 16; ++r) {
            const int rel0 = dc - 16 * ccol(r), rel1 = rel0 - 512;
            p0[r] += lut[min(max(rel0, 0), 127)]; p1[r] += lut[min(max(rel1, 0), 127)];
            if (rel0 < 0) p0[r] = NEG;
            if (rel1 < 0 || (kb + 4 * hi + ccol(r) + 32 >= 127)) p1[r] = NEG;
        }
    } else {
        if (qlo - (kb + 63) >= 113) {
            const float c31 = lut[127];
#pragma unroll
            for (int r = 0; r < 16; ++r) { p0[r] += c31; p1[r] += c31; }
        } else {
#pragma unroll
            for (int r = 0; r < 16; ++r) { const int rel0 = dq - ccol(r), rel1 = rel0 - 32;
                p0[r] += lut[min(max(rel0, 0), 127)]; p1[r] += lut[min(max(rel1, 0), 127)];
                if (rel0 < 0) p0[r] = NEG; if (rel1 < 0) p1[r] = NEG; }
        }
        if (KIND == K_WIN) {
            if (qlo + 31 - kb >= 512) {
#pragma unroll
                for (int r = 0; r < 16; ++r) { if (dq - ccol(r) >= 512) p0[r] = NEG; if (dq - ccol(r) - 32 >= 512) p1[r] = NEG; }
            }
        }
        if (KIND == K_SEL) {
            if (((selm >> j) & 1u) == 0u) {
#pragma unroll
                for (int r = 0; r < 16; ++r) { p0[r] = NEG; p1[r] = NEG; }
            }
        }
    }
}

template <int KIND, int NQ, int EXPM = 0>
__device__ __forceinline__ void attn_pass(lptr lds, const bf16_t* __restrict__ Kg, const bf16_t* __restrict__ Vg, int kp, int vp, unsigned tilemask,
                                          const bf16x8 (&qr)[8], int kf0, int P0, const LAS float* lut, const LAS float* cum, unsigned selm,
                                          f32x16 (&o)[4], float& m_reg, float& l_reg) {
    const int tid = ltid(), wid = __builtin_amdgcn_readfirstlane(tid >> 6), lane = tid & 63, r32 = lane & 31, hi = lane >> 5;
    const int sr = tid >> 4, sc = (tid & 15) * 8;
    const int kws = KSWZ(sr, sc * 2), vst0 = v_st(sr, sc), vst1 = v_st(32 + sr, sc);
    const int qlo = P0 + wid * 32, qpos = qlo + r32;
    LAS float* wsl = (LAS float*)(lds + L_WS) + wid * 64;
    const int vbase = (int)(uintptr_t)(lds + L_V) + v_rd_base(lane);
    if (tilemask == 0u) return;
    const int kr_ = wid * 4 + (lane >> 4);
    const int kcol_ = (((lane & 15) ^ (kr_ & 7)) * 8);
    const int vsub_ = wid * 2 + (lane >> 5);
    const int vkk_ = ((vsub_ >> 2) << 3) | ((lane & 31) >> 2);
    const int vkey_ = (vkk_ & ~0xC) | ((vkk_ & 4) << 1) | ((vkk_ & 8) >> 1);
    const int vcol_ = (vsub_ & 3) * 32 + (lane & 3) * 8;
    const unsigned dma_w = (unsigned)wid * 1024u;
#define DMA_TILE(jj, bf) do { \
        const bf16_t* kp0_ = Kg + (size_t)((jj) * 64 + kr_) * kp + kcol_; const bf16_t* vp0_ = Vg + (size_t)((jj) * 64 + vkey_) * vp + vcol_; \
        __builtin_amdgcn_global_load_lds((const unsigned*)kp0_, (LAS unsigned*)(lds + L_K + (bf) * SHM + dma_w), 16, 0, 0); \
        __builtin_amdgcn_global_load_lds((const unsigned*)(kp0_ + (size_t)32 * kp), (LAS unsigned*)(lds + L_K + (bf) * SHM + 8192 + dma_w), 16, 0, 0); \
        __builtin_amdgcn_global_load_lds((const unsigned*)vp0_, (LAS unsigned*)(lds + L_V + (bf) * SHM + dma_w), 16, 0, 0); \
        __builtin_amdgcn_global_load_lds((const unsigned*)(vp0_ + (size_t)32 * vp), (LAS unsigned*)(lds + L_V + (bf) * SHM + 8192 + dma_w), 16, 0, 0); } while (0)
#define NEXT_TILE(jv) do { if (tilemask) { jv = __builtin_ctz(tilemask); tilemask &= tilemask - 1u; } else jv = -1; } while (0)
    int j0, j1;
    NEXT_TILE(j0); NEXT_TILE(j1);
    DMA_TILE(j0, 0);
    asm volatile("s_waitcnt vmcnt(0)" ::: "memory");
    __syncthreads();
    int buf = 0;
    for (;;) {
        if (j1 >= 0) DMA_TILE(j1, buf ^ 1);
        if (wave_act<KIND>(j0, qlo, selm)) {
            f32x16 p0, p1;
            qkt<NQ>(p0, p1, lds + L_K + buf * SHM, kf0, r32, hi, qr);
            score_fix<KIND>(p0, p1, j0, qlo, qpos, hi, lut, cum, selm);
            float alpha; bf16x8 pa0, pa1, pa2, pa3;
            softmax_tile(p0, p1, m_reg, l_reg, alpha, pa0, pa1, pa2, pa3);
            if (__any(alpha < 1.f)) {
                float al[16]; rowbcast(wsl, alpha, r32, hi, al);
#pragma unroll
                for (int d = 0; d < 4; ++d)
#pragma unroll
                    for (int r = 0; r < 16; ++r) o[d][r] *= al[r];
            }
            pv_tile(o, vbase + buf * SHM, pa0, pa1, pa2, pa3);
        }
        asm volatile("s_waitcnt vmcnt(0)" ::: "memory");
        __syncthreads();
        if (j1 < 0) break;
        j0 = j1; NEXT_TILE(j1); buf ^= 1;
    }
#undef DMA_TILE
#undef NEXT_TILE
}

__device__ __forceinline__ void fox_pass(lptr lds, const bf16_t* __restrict__ Kg, const bf16_t* __restrict__ Vg, int ntiles, const bf16x8 (&qr)[8], int P0,
                                         const LAS float* cum, f32x16 (&o)[4], float& m_reg, float& l_reg) {
    const int tid = ltid(), wid = __builtin_amdgcn_readfirstlane(tid >> 6), lane = tid & 63, r32 = lane & 31, hi = lane >> 5;
    const int sr = tid >> 4, sc = (tid & 15) * 8;
    const int kws = KSWZ(sr, sc * 2), vst0 = v_st(sr, sc), vst1 = v_st(32 + sr, sc);
    const int qlo = P0 + wid * 32, qpos = qlo + r32;
    LAS float* wsl = (LAS float*)(lds + L_WS) + wid * 64;
    const int vbase = (int)(uintptr_t)(lds + L_V) + v_rd_base(lane);
    const int kbase = (int)(uintptr_t)(lds + L_K);
    const int ko0 = KSWZ(r32, (0 * 16 + hi * 8) * 2), ko1 = KSWZ(r32, (1 * 16 + hi * 8) * 2), ko2 = KSWZ(r32, (2 * 16 + hi * 8) * 2), ko3 = KSWZ(r32, (3 * 16 + hi * 8) * 2);
    const int PITCH = PROJ_LD;
    bf16x8 st_k0, st_k1, st_v0, st_v1;
#define LOADK(jj) do { const size_t kr = (size_t)((jj) * 64 + sr); st_k0 = *(const bf16x8*)(Kg + kr * PITCH + sc); st_k1 = *(const bf16x8*)(Kg + (kr + 32) * PITCH + sc); } while (0)
#define LOADV(jj) do { const size_t kr = (size_t)((jj) * 64 + sr); st_v0 = *(const bf16x8*)(Vg + kr * PITCH + sc); st_v1 = *(const bf16x8*)(Vg + (kr + 32) * PITCH + sc); } while (0)
#define WRITEK(bf) do { *(LAS bf16x8*)(lds + L_K + (bf) * SHM + kws) = st_k0; *(LAS bf16x8*)(lds + L_K + (bf) * SHM + kws + 32 * 256) = st_k1; } while (0)
#define WRITEV(bf) do { *(LAS bf16x8*)(lds + L_V + (bf) * SHM + vst0) = st_v0; *(LAS bf16x8*)(lds + L_V + (bf) * SHM + vst1) = st_v1; } while (0)
#define KRD(dst, addr, off) asm volatile("ds_read_b128 %0, %1 offset:%2" : "=&v"(dst) : "v"(addr), "i"(off) : "memory")
#define KRD4(S, aA, aB, off) do { KRD(S[0], aA, off); KRD(S[1], aA, (off) + 8192); KRD(S[2], aB, off); KRD(S[3], aB, (off) + 8192); } while (0)
#define KMM4(S, d) do { sn0 = __builtin_amdgcn_mfma_f32_32x32x16_bf16(S[0], qr[d], sn0, 0, 0, 0); sn1 = __builtin_amdgcn_mfma_f32_32x32x16_bf16(S[1], qr[d], sn1, 0, 0, 0); \
                        sn0 = __builtin_amdgcn_mfma_f32_32x32x16_bf16(S[2], qr[(d) + 1], sn0, 0, 0, 0); sn1 = __builtin_amdgcn_mfma_f32_32x32x16_bf16(S[3], qr[(d) + 1], sn1, 0, 0, 0); } while (0)
#define LGK(n) asm volatile("s_waitcnt lgkmcnt(" #n ")" ::: "memory")
    LOADK(0); LOADV(0); WRITEK(0); WRITEV(0);
    if (ntiles > 1) { LOADK(1); WRITEK(1); }
    __syncthreads();
    f32x16 sc0, sc1;
    bool actc = 0 <= qlo + 31;
    if (actc) { qkt<8>(sc0, sc1, lds + L_K, 0, r32, hi, qr); score_fix<K_FOX>(sc0, sc1, 0, qlo, qpos, hi, nullptr, cum, 0u); }
    for (int t = 0; t < ntiles; ++t) {
        const int buf = t & 1; const bool has1 = t + 1 < ntiles, has2 = t + 2 < ntiles;
        if (has1) LOADV(t + 1);
        if (has2) LOADK(t + 2);
        const bool actn = has1 && ((t + 1) * 64 <= qlo + 31);
        f32x16 sn0, sn1;
        if (actc && actn && ((t + 1) * 64 + 63 <= qlo)) {
            const int ka = kbase + (buf ^ 1) * SHM;
            const int ka0 = ka + ko0, ka1 = ka + ko1, ka2 = ka + ko2, ka3 = ka + ko3;
            bf16x8 A[4], B[4];
            SBAR(); LGK(0);
            KRD4(A, ka0, ka1, 0); KRD4(B, ka2, ka3, 0);
            SBAR();
            float pmax = sc0[0];
#pragma unroll
            for (int r = 1; r < 16; ++r) pmax = fmaxf(pmax, sc0[r]);
            sn0 = f32x16{}; sn1 = f32x16{};
            SBAR(); LGK(4); SBAR(); KMM4(A, 0); SBAR(); KRD4(A, ka0, ka1, 128); SBAR();
#pragma unroll
            for (int r = 0; r < 16; ++r) pmax = fmaxf(pmax, sc1[r]);
            { auto rr = __builtin_amdgcn_permlane32_swap(__float_as_uint(pmax), __float_as_uint(pmax), false, false);
              pmax = fmaxf(__uint_as_float(rr[0]), __uint_as_float(rr[1])); }
            const bool keep = __all((pmax - m_reg) <= THR2);
            const float mn = keep ? m_reg : fmaxf(m_reg, pmax);
            const float alpha = fast_exp2(m_reg - mn); m_reg = mn;
            SBAR(); LGK(4); SBAR(); KMM4(B, 2); SBAR(); KRD4(B, ka2, ka3, 128); SBAR();
            float ps = 0.f;
#pragma unroll
            for (int r = 0; r < 16; ++r) { sc0[r] = fast_exp2(sc0[r] - mn); ps += sc0[r]; }
            SBAR(); LGK(4); SBAR(); KMM4(A, 4); SBAR();
#pragma unroll
            for (int r = 0; r < 16; ++r) { sc1[r] = fast_exp2(sc1[r] - mn); ps += sc1[r]; }
            SBAR(); LGK(0); SBAR(); KMM4(B, 6); SBAR();
            { auto rr = __builtin_amdgcn_permlane32_swap(__float_as_uint(ps), __float_as_uint(ps), false, false);
              ps = __uint_as_float(rr[0]) + __uint_as_float(rr[1]); }
            l_reg = l_reg * alpha + ps;
            bf16x8 pa0, pa1, pa2, pa3;
#define PK4(P, B_, OUT) do { unsigned a0 = cvtpk(P[B_+0], P[B_+1]), a1 = cvtpk(P[B_+2], P[B_+3]);                          \
        unsigned b0 = cvtpk(P[B_+4], P[B_+5]), b1 = cvtpk(P[B_+6], P[B_+7]);                                             \
        auto r0 = __builtin_amdgcn_permlane32_swap(a0, b0, false, false); auto r1 = __builtin_amdgcn_permlane32_swap(a1, b1, false, false); \
        u32x4 w = {r0[0], r1[0], r0[1], r1[1]}; OUT = __builtin_bit_cast(bf16x8, w); } while (0)
            PK4(sc0, 0, pa0); PK4(sc0, 8, pa1); PK4(sc1, 0, pa2); PK4(sc1, 8, pa3);
#undef PK4
            SBAR();
            if (__any(alpha < 1.f)) {
                float al[16]; rowbcast(wsl, alpha, r32, hi, al);
#pragma unroll
                for (int d = 0; d < 4; ++d)
#pragma unroll
                    for (int r = 0; r < 16; ++r) o[d][r] *= al[r];
            }
            pv_tile(o, vbase + buf * SHM, pa0, pa1, pa2, pa3);
            { const LAS float* cbp = cum + (t + 1) * 64 + 4 * hi;
#pragma unroll
              for (int r = 0; r < 16; ++r) { sn0[r] += cbp[ccol(r)]; sn1[r] += cbp[ccol(r) + 32]; } }
        } else {
            if (actn) qkt<8>(sn0, sn1, lds + L_K + (buf ^ 1) * SHM, 0, r32, hi, qr);
            if (actc) {
                float alpha; bf16x8 pa0, pa1, pa2, pa3;
                softmax_tile(sc0, sc1, m_reg, l_reg, alpha, pa0, pa1, pa2, pa3);
                if (__any(alpha < 1.f)) {
                    float al[16]; rowbcast(wsl, alpha, r32, hi, al);
#pragma unroll
                    for (int d = 0; d < 4; ++d)
#pragma unroll
                        for (int r = 0; r < 16; ++r) o[d][r] *= al[r];
                }
                pv_tile(o, vbase + buf * SHM, pa0, pa1, pa2, pa3);
            }
            if (actn) score_fix<K_FOX>(sn0, sn1, t + 1, qlo, qpos, hi, nullptr, cum, 0u);
        }
        if (has1) WRITEV(buf ^ 1);
        if (has2) WRITEK(buf);
        __syncthreads();
        sc0 = sn0; sc1 = sn1; actc = actn;
    }
#undef LOADK
#undef LOADV
#undef WRITEK
#undef WRITEV
#undef KRD
#undef KRD4
#undef KMM4
#undef LGK
}

template <int NQ>
__device__ __forceinline__ void load_q(bf16x8 (&qr)[8], const bf16_t* proj, int row_first, int col0) {
    const int lane = ltid() & 63, r32 = lane & 31, hi = lane >> 5, wid = ltid() >> 6;
    const bf16_t* q = proj + (size_t)(row_first + wid * 32 + r32) * PROJ_LD + col0 + hi * 8;
#pragma unroll
    for (int d = 0; d < NQ; ++d) qr[d] = *(const bf16x8*)(q + d * 16);
}
__device__ __forceinline__ void store_o(const f32x16 (&o)[4], bf16_t* mixed, int row_first, int col0) {
    const int lane = ltid() & 63, r32 = lane & 31, hi = lane >> 5, wid = ltid() >> 6;
    bf16_t* base = mixed + (size_t)(row_first + wid * 32) * DM + col0;
#pragma unroll
    for (int r = 0; r < 16; ++r) { const int orow = crow(r, hi);
#pragma unroll
        for (int d = 0; d < 4; ++d) { const float v = o[d][r]; const float vn = shx(v, 1);
            if ((r32 & 1) == 0) *(unsigned*)(base + (size_t)orow * DM + d * 32 + r32) = cvtpk(v, vn); } }
}


__device__ __forceinline__ void scr_acc(float* scr, const f32x16 (&o)[4], const float (&f)[16], bool add) {
    float* s = scr + (ltid() >> 6) * 4096 + (ltid() & 63);
#pragma unroll
    for (int d = 0; d < 4; ++d)
#pragma unroll
        for (int r = 0; r < 16; ++r) { float v = o[d][r] * f[r]; if (add) v += s[(d * 16 + r) * 64]; s[(d * 16 + r) * 64] = v; }
}
__device__ __forceinline__ void scr_load(const float* scr, f32x16 (&o)[4]) {
    const float* s = scr + (ltid() >> 6) * 4096 + (ltid() & 63);
#pragma unroll
    for (int d = 0; d < 4; ++d)
#pragma unroll
        for (int r = 0; r < 16; ++r) o[d][r] = s[(d * 16 + r) * 64];
}

template <int EXPM = 0>
__device__ __forceinline__ void fox_unit(lptr lds, const bf16_t* proj, const float* gates, float fbias, bf16_t* mixed, int b, int h, int qb) {
    const int tid = ltid(), wid = tid >> 6, lane = tid & 63, r32 = lane & 31, hi = lane >> 5;
    const int P0 = qb * 256, rowb = b * SEQ;
    LAS float* cum = (LAS float*)(lds + L_CUM);
    { const int nk = P0 + 256; float run = 0.f; const bool on = 4 * tid < nk;
      float xs[4];
#pragma unroll
      for (int i = 0; i < 4; ++i) xs[i] = gates[(size_t)(rowb + 4 * tid + i) * GATE_LD + h] + fbias;
      if (on) {
#pragma unroll
          for (int i = 0; i < 4; ++i) { const float xx = xs[i];
              run += fminf(xx, 0.f) - __logf(1.f + __expf(-fabsf(xx))); cum[4 * tid + i] = run; }
      }
      float inc = run;
#pragma unroll
      for (int o = 1; o < 64; o <<= 1) { const float t = __builtin_bit_cast(float, __builtin_amdgcn_ds_bpermute(((lane - o) & 63) << 2, __builtin_bit_cast(int, inc))); if (lane >= o) inc += t; }
      LAS float* wsum = (LAS float*)(lds + L_WS);
      if (lane == 63) wsum[wid] = inc;
      __syncthreads();
      float base = 0.f;
#pragma unroll
      for (int w = 0; w < 8; ++w) if (w < wid) base += wsum[w];
      const float ex = base + inc - run;
      if (on) {
#pragma unroll 1
          for (int i = 0; i < 4; ++i) cum[4 * tid + i] = (ex + cum[4 * tid + i]) * LOG2E; }
      __syncthreads();
      const float cref = cum[P0];
      __syncthreads();
      if (on) {
#pragma unroll 1
          for (int i = 0; i < 4; ++i) cum[4 * tid + i] = cref - cum[4 * tid + i]; }
    }
    bf16x8 qr[8]; load_q<8>(qr, proj, rowb + P0, C_FQ + h * 128);
    __syncthreads();
    f32x16 o[4] = {}; float m_reg = -1e30f, l_reg = 0.f;
    const unsigned tm = (qb == 7) ? 0xFFFFFFFFu : ((1u << (4 * (qb + 1))) - 1u);
    if (false) fox_pass(lds, proj + (size_t)rowb * PROJ_LD + C_FK + h * 128, proj + (size_t)rowb * PROJ_LD + C_FV + h * 128, 4 * (qb + 1), qr, P0, cum, o, m_reg, l_reg);
    else attn_pass<K_FOX, 8, EXPM>(lds, proj + (size_t)rowb * PROJ_LD + C_FK + h * 128, proj + (size_t)rowb * PROJ_LD + C_FV + h * 128, PROJ_LD, PROJ_LD, tm, qr, 0, P0, nullptr, cum, 0u, o, m_reg, l_reg);
    float f[16]; rowbcast((LAS float*)(lds + L_WS) + wid * 64, fast_rcp(l_reg), r32, hi, f);
#pragma unroll
    for (int d = 0; d < 4; ++d)
#pragma unroll
        for (int r = 0; r < 16; ++r) o[d][r] *= f[r];
    store_o(o, mixed, rowb + P0, h * 128);
    __syncthreads();
}
__device__ __forceinline__ void diff_unit(lptr lds, const bf16_t* proj, bf16_t* mixed, float* scr, int b, int h, int qb, float lam, float out_scale, const float* subln_g) {
    const int tid = ltid(), wid = tid >> 6, lane = tid & 63, r32 = lane & 31, hi = lane >> 5;
    const int P0 = qb * 256, rowb = b * SEQ;
    const LAS float* lut = (const LAS float*)(lds + L_LUT) + h * 128;
    LAS float* wsl = (LAS float*)(lds + L_WS) + wid * 64;
    const unsigned tm = (qb == 7) ? 0xFFFFFFFFu : ((1u << (4 * (qb + 1))) - 1u);
    const bf16_t* Kg = proj + (size_t)rowb * PROJ_LD + C_DK + h * 128; const bf16_t* Vg = proj + (size_t)rowb * PROJ_LD + C_DV + h * 128;
#pragma unroll 1
    for (int mp = 0; mp < 2; ++mp) {
        bf16x8 qr[8]; load_q<4>(qr, proj, rowb + P0, C_DQ + h * 128 + mp * 64);
        f32x16 o[4] = {}; float m_reg = -1e30f, l_reg = 0.f;
        attn_pass<K_DIFF, 4>(lds, Kg, Vg, PROJ_LD, PROJ_LD, tm, qr, mp * 4, P0, lut, nullptr, 0u, o, m_reg, l_reg);
        float f[16]; rowbcast(wsl, (mp == 0 ? 1.f : -lam) * fast_rcp(l_reg), r32, hi, f);
        scr_acc(scr, o, f, mp != 0);
    }
    f32x16 ot[4]; scr_load(scr, ot);
    float gcol[4];
#pragma unroll
    for (int d = 0; d < 4; ++d) gcol[d] = subln_g[d * 32 + r32] * out_scale;
#pragma unroll
    for (int r = 0; r < 16; ++r) {
        float ss = ot[0][r] * ot[0][r] + ot[1][r] * ot[1][r] + ot[2][r] * ot[2][r] + ot[3][r] * ot[3][r];
        ss += shx(ss, 1); ss += shx(ss, 2); ss += shx(ss, 4); ss += shx(ss, 8); ss += shx(ss, 16);
        const float rn = __builtin_amdgcn_rsqf(ss * (1.f / 128.f) + RMS_EPS);
#pragma unroll
        for (int d = 0; d < 4; ++d) ot[d][r] *= rn * gcol[d];
    }
    store_o(ot, mixed, rowb + P0, 768 + h * 128);
    __syncthreads();
}
__device__ __forceinline__ void nsa_unit(lptr lds, const bf16_t* proj, const float* gates, const bf16_t* kcmp, const bf16_t* vcmp, bf16_t* mixed, float* scr, int b, int g, int qb) {
    const int tid = ltid(), wid = tid >> 6, lane = tid & 63, r32 = lane & 31, hi = lane >> 5;
    const int P0 = qb * 256, rowb = b * SEQ;
    const int qlo = P0 + wid * 32, qpos = qlo + r32;
    LAS float* wsl = (LAS float*)(lds + L_WS) + wid * 64;
    LAS float* imp = (LAS float*)(lds + L_IMP);
    LAS unsigned* sel = (LAS unsigned*)(lds + L_SEL);
    LAS unsigned* uni = (LAS unsigned*)(lds + L_UNI);
    const float NEG = -__builtin_inff();
    const bf16_t* kc = kcmp + (size_t)(b * 2 + g) * 128 * 128; const bf16_t* vc = vcmp + (size_t)(b * 2 + g) * 128 * 128;
    { const int sr = tid >> 4, sc = (tid & 15) * 8, kws = KSWZ(sr, sc * 2);
#pragma unroll
      for (int t = 0; t < 2; ++t) { const bf16x8 a = *(const bf16x8*)(kc + (size_t)(t * 64 + sr) * 128 + sc), c = *(const bf16x8*)(kc + (size_t)(t * 64 + 32 + sr) * 128 + sc);
          *(LAS bf16x8*)(lds + L_K + t * SHM + kws) = a; *(LAS bf16x8*)(lds + L_K + t * SHM + kws + 32 * 256) = c; }
      if (tid == 0) uni[0] = 0u; }
    __syncthreads();
    float ia[16], ic[16];
#pragma unroll
    for (int i = 0; i < 16; ++i) { ia[i] = 0.f; ic[i] = 0.f; }
#pragma unroll 1
    for (int hh = 0; hh < 3; ++hh) {
        const int hd = g * 3 + hh; const LAS float* lut = (const LAS float*)(lds + L_LUT) + (4 + hd) * 128;
        bf16x8 qr[8]; load_q<8>(qr, proj, rowb + P0, C_NQ + hd * 128);
        f32x16 p[4];
        qkt<8>(p[0], p[1], lds + L_K, 0, r32, hi, qr); qkt<8>(p[2], p[3], lds + L_K + SHM, 0, r32, hi, qr);
        float mx = -1e30f;
#pragma unroll
        for (int q4 = 0; q4 < 4; ++q4)
#pragma unroll
            for (int r = 0; r < 16; ++r) { const int n = q4 * 32 + 4 * hi + ccol(r); const int rel = qpos - 31 - 16 * n;
                float s = p[q4][r] + lut[min(max(rel, 0), 127)]; if (rel < 0 || n >= 127) s = NEG; p[q4][r] = s; mx = fmaxf(mx, s); }
        mx = fmaxf(mx, shx(mx, 32));
        float ps = 0.f;
#pragma unroll
        for (int q4 = 0; q4 < 4; ++q4)
#pragma unroll
            for (int r = 0; r < 16; ++r) { p[q4][r] = fast_exp2(p[q4][r] - mx); ps += p[q4][r]; }
        ps += shx(ps, 32);
        const float inv = ps > 0.f ? 1.f / ps : 0.f;
#pragma unroll
        for (int q4 = 0; q4 < 4; ++q4)
#pragma unroll
            for (int i = 0; i < 4; ++i) { const float x0 = p[q4][4 * i] * inv, x1 = p[q4][4 * i + 1] * inv, x2 = p[q4][4 * i + 2] * inv, x3 = p[q4][4 * i + 3] * inv;
                ia[q4 * 4 + i] += x0 + x1 + x2 + 0.5f * x3; ic[q4 * 4 + i] += 0.5f * x3; }
    }
#pragma unroll
    for (int gi = 0; gi < 16; ++gi) {
        const float cp = shx(ic[gi], 32);
        const float cpm = (gi > 0) ? shx(ic[gi > 0 ? gi - 1 : 0], 32) : 0.f;
        const float v = ia[gi] + (hi ? cp : cpm);
        imp[(wid * 32 + r32) * 33 + 2 * gi + hi] = v;
    }
    __syncthreads();
    if (tid < 256) {
        const int t = P0 + tid, blk = t >> 6;
        float sc[32];
#pragma unroll
        for (int j2 = 0; j2 < 32; ++j2) { const bool forced = (j2 == 0) || (j2 == blk) || (j2 == blk - 1);
            sc[j2] = (j2 <= blk) ? (imp[tid * 33 + j2] + (forced ? 1e4f : 0.f)) : -1e30f; }
        unsigned mask = 0u;
#pragma unroll 1
        for (int it = 0; it < 8; ++it) { float best = -1e30f; int bi = -1;
#pragma unroll
            for (int j2 = 0; j2 < 32; ++j2) { const bool free_ = ((mask >> j2) & 1u) == 0u; if (free_ && sc[j2] > best) { best = sc[j2]; bi = j2; } }
            if (bi >= 0 && best > -0.5e30f) mask |= 1u << bi; }
        sel[tid] = mask;
        atomicOr((unsigned*)uni, mask);
    }
    __syncthreads();
    const unsigned selm = sel[wid * 32 + r32];
    const unsigned um = uni[0];
#pragma unroll 1
    for (int hp = 0; hp < 3; ++hp) {
    const int h6 = g * 3 + hp;
    const float* gp = gates + (size_t)(rowb + qpos) * GATE_LD + 6 + h6 * 3;
    const float g0 = 1.f / (1.f + __expf(-gp[0])), g1 = 1.f / (1.f + __expf(-gp[1])), g2 = 1.f / (1.f + __expf(-gp[2]));
    const LAS float* lut = (const LAS float*)(lds + L_LUT) + (4 + h6) * 128;
    bf16x8 qr[8]; load_q<8>(qr, proj, rowb + P0, C_NQ + h6 * 128);
    {
        f32x16 o[4] = {}; float m_reg = -1e30f, l_reg = 0.f;
        attn_pass<K_CMP, 8>(lds, kc, vc, 128, 128, 3u, qr, 0, P0, lut, nullptr, 0u, o, m_reg, l_reg);
        float f[16]; rowbcast(wsl, l_reg > 0.f ? g0 / l_reg : 0.f, r32, hi, f);
        scr_acc(scr, o, f, false);
    }
    {
        f32x16 o[4] = {}; float m_reg = -1e30f, l_reg = 0.f;
        const unsigned cm = (qb == 7) ? 0xFFFFFFFFu : ((1u << (4 * (qb + 1))) - 1u);
        attn_pass<K_SEL, 8>(lds, proj + (size_t)rowb * PROJ_LD + C_NKS + g * 128, proj + (size_t)rowb * PROJ_LD + C_NVS + g * 128, PROJ_LD, PROJ_LD, um & cm, qr, 0, P0, lut, nullptr, selm, o, m_reg, l_reg);
        float f[16]; rowbcast(wsl, l_reg > 0.f ? g1 / l_reg : 0.f, r32, hi, f);
        scr_acc(scr, o, f, true);
    }
    {
        f32x16 o[4] = {}; float m_reg = -1e30f, l_reg = 0.f;
        const int jlo = (P0 - 511) > 0 ? (P0 - 511) >> 6 : 0, jhi = (P0 + 255) >> 6;
        const unsigned hiM = (jhi == 31) ? 0xFFFFFFFFu : ((1u << (jhi + 1)) - 1u);
        const unsigned wm = hiM & ~((1u << jlo) - 1u);
        attn_pass<K_WIN, 8>(lds, proj + (size_t)rowb * PROJ_LD + C_NKW + g * 128, proj + (size_t)rowb * PROJ_LD + C_NVW + g * 128, PROJ_LD, PROJ_LD, wm, qr, 0, P0, lut, nullptr, 0u, o, m_reg, l_reg);
        float f[16]; rowbcast(wsl, l_reg > 0.f ? g2 / l_reg : 0.f, r32, hi, f);
        f32x16 ot[4]; scr_load(scr, ot);
#pragma unroll
        for (int d = 0; d < 4; ++d)
#pragma unroll
            for (int r = 0; r < 16; ++r) ot[d][r] += o[d][r] * f[r];
        store_o(ot, mixed, rowb + P0, 1280 + h6 * 128);
    }
    __syncthreads();
    }
}
#undef KSWZ
}

struct Params {
    const float* x; const float* attn_norm_g; const float* w_in; const float* fox_f_bias; const float* lq1; const float* lk1; const float* lq2; const float* lk2;
    const float* subln_g; const float* cmp_pos; const float* wk1; const float* wk2; const float* wv1; const float* wv2; const float* w_out; const float* ffn_norm_g;
    const float* w_up; const float* conv_w; const float* conv_b; const float* w_down; const float* rel_bias; const float* final_g;
    float* out; unsigned char* ws;
    int l_begin, l_end, do_prologue, do_final, bar_region, ph_mask;
};

typedef const __attribute__((address_space(4))) Params* KP;
__device__ __forceinline__ KP kparams() { unsigned long long a = (unsigned long long)__builtin_amdgcn_kernarg_segment_ptr(); asm volatile("" : "+s"(a)); return (KP)a; }

template <int MAPK>
__device__ __forceinline__ void transpose_item(const float* __restrict__ src, int ldsrc, const float* __restrict__ kscale, bf16_t* __restrict__ dst, int K, int k0, int n0, LAS float* scr, int lane) {
    const int c = n0 + (lane & 31);
    const int oc = (MAPK == 1) ? win_colmap(c) : (MAPK == 2) ? wup_colmap(c) : c;
    const float* sp = src + (size_t)(k0 + (lane >> 5)) * ldsrc + (oc >= 0 ? oc : 0);
    float v[32];
#pragma unroll
    for (int i = 0; i < 32; ++i) v[i] = sp[(size_t)(2 * i) * ldsrc];
    if (kscale) {
#pragma unroll
        for (int i = 0; i < 32; ++i) v[i] *= kscale[k0 + 2 * i + (lane >> 5)];
    }
#pragma unroll
    for (int i = 0; i < 32; ++i) scr[(2 * i + (lane >> 5)) * 33 + (lane & 31)] = (oc < 0) ? 0.f : v[i];
    asm volatile("s_waitcnt lgkmcnt(0)" ::: "memory");
    const int cc = lane & 7;
#pragma unroll
    for (int j = 0; j < 4; ++j) { const int n = (lane >> 3) + 8 * j; const LAS float* s = scr + (8 * cc) * 33 + n;
        u32x4 o; o.x = cvtpk(s[0], s[33]); o.y = cvtpk(s[2 * 33], s[3 * 33]); o.z = cvtpk(s[4 * 33], s[5 * 33]); o.w = cvtpk(s[6 * 33], s[7 * 33]);
        *(u32x4*)(dst + (size_t)(n0 + n) * K + k0 + 8 * cc) = o; }
    asm volatile("s_waitcnt lgkmcnt(0)" ::: "memory");
}

constexpr int T_IN = (DM / 64) * (NINP / 32), T_OUT = (DM / 64) * (DM / 32), T_UP = (DM / 64) * (NUP / 32), T_DN = (DFF / 64) * (DM / 32), T_W1 = (4096 / 64) * 4, T_W2 = 2 * 4;
constexpr int T_LAYER = T_IN + T_OUT + T_UP + T_DN + 2 * T_W1 + 2 * T_W2;
__device__ __forceinline__ void convert_item(KP p, int l, int r, LAS float* scr, int lane) {
    unsigned char* ws = p->ws;
    if (r < T_IN) { const int nb = NINP / 32; transpose_item<1>(p->w_in + (size_t)l * DM * NIN, NIN, p->attn_norm_g + l * DM, (bf16_t*)(ws + WS_WIN) + (size_t)l * NINP * DM, DM, (r / nb) * 64, (r % nb) * 32, scr, lane); return; } r -= T_IN;
    if (r < T_OUT) { const int nb = DM / 32; transpose_item<0>(p->w_out + (size_t)l * DM * DM, DM, nullptr, (bf16_t*)(ws + WS_WOUT) + (size_t)l * DM * DM, DM, (r / nb) * 64, (r % nb) * 32, scr, lane); return; } r -= T_OUT;
    if (r < T_UP) { const int nb = NUP / 32; transpose_item<2>(p->w_up + (size_t)l * DM * NUP, NUP, p->ffn_norm_g + l * DM, (bf16_t*)(ws + WS_WUP) + (size_t)l * NUP * DM, DM, (r / nb) * 64, (r % nb) * 32, scr, lane); return; } r -= T_UP;
    if (r < T_DN) { const int nb = DM / 32; transpose_item<0>(p->w_down + (size_t)l * DFF * DM, DM, nullptr, (bf16_t*)(ws + WS_WDN) + (size_t)l * DM * DFF, DFF, (r / nb) * 64, (r % nb) * 32, scr, lane); return; } r -= T_DN;
    if (r < 2 * T_W1) { const int kv = r / T_W1, rr = r % T_W1; const float* src = (kv ? p->wv1 : p->wk1) + (size_t)l * 4096 * 128;
        transpose_item<0>(src, 128, nullptr, (bf16_t*)(ws + WS_W1T) + (size_t)(l * 2 + kv) * 128 * 4096, 4096, (rr / 4) * 64, (rr % 4) * 32, scr, lane); return; } r -= 2 * T_W1;
    { const int kv = r / T_W2, rr = r % T_W2; const float* src = (kv ? p->wv2 : p->wk2) + (size_t)l * 128 * 128;
        transpose_item<0>(src, 128, nullptr, (bf16_t*)(ws + WS_W2T) + (size_t)(l * 2 + kv) * 128 * 128, 128, (rr / 4) * 64, (rr % 4) * 32, scr, lane); }
}
__device__ __forceinline__ void prologue_phase(KP p, LAS unsigned char* lds) {
    const int tid = ltid(), lane = tid & 63, wave = tid >> 6;
    LAS float* scr = (LAS float*)lds + wave * (64 * 33);
    const int G = gridDim.x, bx = blockIdx.x;
    unsigned char* ws = p->ws;
    for (int it = bx * 8 + wave; it < T_LAYER; it += G * 8) convert_item(p, 0, it, scr, lane);
    __syncthreads();
    { LAS float* scr = (LAS float*)lds;
    for (int it = bx; it < DEPTH * 2 * 8; it += G) {
        const int l = it >> 4, kv = (it >> 3) & 1, c0 = (it & 7) * 16; const float* w1 = (kv ? p->wv1 : p->wk1) + (size_t)l * 4096 * 128; const float* pos = p->cmp_pos + (size_t)l * 4096;
        const int col = c0 + (tid & 15), ks = tid >> 4; float s = 0.f;
#pragma unroll 8
        for (int k = ks * 128; k < ks * 128 + 128; ++k) s += pos[k] * w1[(size_t)k * 128 + col];
        scr[tid] = s; __syncthreads();
        if (tid < 16) { float a = 0.f; for (int j = 0; j < 32; ++j) a += scr[j * 16 + tid]; ((float*)(ws + WS_POSC))[(l * 2 + kv) * 128 + c0 + tid] = a; }
        __syncthreads();
    }
    }
    { const int gw = bx * 8 + wave, NGW = G * 8; bf16_t* hb = (bf16_t*)(ws + WS_HB);
      for (int row = gw; row < MROWS; row += NGW) {
          const f32x4* xr = (const f32x4*)(p->x + (size_t)row * DM) + lane; f32x4 v[8]; float ss = 0.f;
#pragma unroll
          for (int j = 0; j < 8; ++j) { v[j] = xr[64 * j]; ss += (v[j].x * v[j].x + v[j].y * v[j].y) + (v[j].z * v[j].z + v[j].w * v[j].w); }
          ss = wave_sum(ss);
          if (lane < 32) ((float*)(ws + WS_SSQP))[(size_t)row * 32 + lane] = (lane == 0) ? ss : 0.f;
          u32x2* o = (u32x2*)(hb + (size_t)row * DM) + lane;
#pragma unroll
          for (int j = 0; j < 8; ++j) { u32x2 w; w.x = cvtpk(v[j].x, v[j].y); w.y = cvtpk(v[j].z, v[j].w); o[64 * j] = w; }
      } }
}

__device__ __forceinline__ int panel_a() { return 16 * ((int)blockIdx.x & 7) + (((int)blockIdx.x >> 3) & 7); }
__device__ __forceinline__ void rstd_prefix(KP p, LAS unsigned char* lds) {
    const int tid = ltid(); const float* ssqp = (const float*)(p->ws + WS_SSQP); LAS float* rstab = (LAS float*)(lds + LX_RSTAB);
    const int row = (panel_a() + 8 * (tid >> 8)) * 256 + (tid & 255);
    const f32x4* q = (const f32x4*)(ssqp + (size_t)row * 32); float s = 0.f;
#pragma unroll
    for (int j = 0; j < 8; ++j) { const f32x4 v = q[j]; s += (v.x + v.y) + (v.z + v.w); }
    rstab[tid] = __builtin_amdgcn_rsqf(s * (1.f / DM) + RMS_EPS);
    __syncthreads();
}
__device__ __forceinline__ void gate_prefix(KP p, int l, LAS unsigned char* lds) {
    const int tid = ltid(), lane = tid & 63, wave = tid >> 6, r32 = lane & 31, hi = lane >> 5;
    const bf16_t* hb = (const bf16_t*)(p->ws + WS_HB); const bf16_t* wg = (const bf16_t*)(p->ws + WS_WIN) + ((size_t)l * NINP + 6144) * DM;
    float* gates = (float*)(p->ws + WS_GATES); const LAS float* rstab = (const LAS float*)(lds + LX_RSTAB);
    constexpr int WPITCH = DM * 2 + 16;
    for (int i = tid; i < 32 * (DM / 8); i += 512) { const int r = i >> 8, c8 = i & 255; *(LAS bf16x8*)(lds + r * WPITCH + c8 * 16) = *(const bf16x8*)(wg + (size_t)r * DM + c8 * 8); }
    __syncthreads();
    if (wave < 4) {
        const int slot = wave >> 1, prow = ((int)blockIdx.x >> 6) * 64 + (wave & 1) * 32;
        const int row0 = (panel_a() + 8 * slot) * 256 + prow;
        const float rs = rstab[slot * 256 + prow + r32];
        const bf16_t* ap = hb + (size_t)(row0 + r32) * DM + hi * 8; const LAS unsigned char* bp = lds + r32 * WPITCH + hi * 16;
        f32x16 acc = {};
#pragma unroll 1
        for (int k32 = 0; k32 < 4; ++k32) { bf16x8 a[32];
#pragma unroll
            for (int j = 0; j < 32; ++j) a[j] = *(const bf16x8*)(ap + (k32 * 32 + j) * 16);
#pragma unroll
            for (int j = 0; j < 32; ++j) { const bf16x8 b = *(const LAS bf16x8*)(bp + (k32 * 32 + j) * 32); acc = __builtin_amdgcn_mfma_f32_32x32x16_bf16(a[j], b, acc, 0, 0, 0); } }
#pragma unroll
        for (int r = 0; r < 16; ++r) { const int rr = att::crow(r, hi);
            const float rsr = __builtin_bit_cast(float, __builtin_amdgcn_ds_bpermute(rr << 2, __builtin_bit_cast(int, rs)));
            if (r32 < 24) gates[(size_t)(row0 + rr) * GATE_LD + r32] = acc[r] * rsr; }
    }
    __syncthreads();
}
__device__ __forceinline__ void fixup_prefix(KP p, int l) {
    const float* halo = (const float*)(p->ws + WS_HALO); bf16_t* act = (bf16_t*)(p->ws + WS_PROJ);
    const float* cw = p->conv_w + (size_t)l * 3 * NUP; const float* cb = p->conv_b + (size_t)l * NUP;
    const int pa = panel_a();
#pragma unroll 2
    for (int i = ltid(); i < 2 * (DFF / 4); i += 512) {
        const int c4 = i % (DFF / 4), pm = pa + 8 * (i / (DFF / 4)), ch = c4 * 4;
        const int tg = (ch >> 7) * 256 + (ch & 127), tu = tg + 128;
        const bool has_prev = (pm & 7) != 0;
        const float* hc = halo + (size_t)(pm * 4) * NUP; const float* hp = halo + (size_t)((has_prev ? pm - 1 : pm) * 4) * NUP;
        const f32x4 c0g = *(const f32x4*)(hc + tg), c0u = *(const f32x4*)(hc + tu), c1g = *(const f32x4*)(hc + NUP + tg), c1u = *(const f32x4*)(hc + NUP + tu);
        f32x4 p3g = *(const f32x4*)(hp + 3 * NUP + tg), p3u = *(const f32x4*)(hp + 3 * NUP + tu), p2g = *(const f32x4*)(hp + 2 * NUP + tg), p2u = *(const f32x4*)(hp + 2 * NUP + tu);
        const f32x4 w0g = *(const f32x4*)(cw + ch), w1g = *(const f32x4*)(cw + NUP + ch), w2g = *(const f32x4*)(cw + 2 * NUP + ch), bg = *(const f32x4*)(cb + ch);
        const f32x4 w0u = *(const f32x4*)(cw + DFF + ch), w1u = *(const f32x4*)(cw + NUP + DFF + ch), w2u = *(const f32x4*)(cw + 2 * NUP + DFF + ch), bu = *(const f32x4*)(cb + DFF + ch);
        if (!has_prev) { p3g = f32x4{0.f, 0.f, 0.f, 0.f}; p3u = p3g; p2g = p3g; p2u = p3g; }
        float o0[4], o1[4];
#pragma unroll
        for (int e = 0; e < 4; ++e) {
            const float yg0 = w0g[e] * p2g[e] + w1g[e] * p3g[e] + w2g[e] * c0g[e] + bg[e], yu0 = w0u[e] * p2u[e] + w1u[e] * p3u[e] + w2u[e] * c0u[e] + bu[e];
            const float yg1 = w0g[e] * p3g[e] + w1g[e] * c0g[e] + w2g[e] * c1g[e] + bg[e], yu1 = w0u[e] * p3u[e] + w1u[e] * c0u[e] + w2u[e] * c1u[e] + bu[e];
            o0[e] = yg0 * fast_rcp(1.f + fast_exp2(-yg0 * LOG2E)) * yu0; o1[e] = yg1 * fast_rcp(1.f + fast_exp2(-yg1 * LOG2E)) * yu1;
        }
        u32x2 s0, s1; s0.x = cvtpk(o0[0], o0[1]); s0.y = cvtpk(o0[2], o0[3]); s1.x = cvtpk(o1[0], o1[1]); s1.y = cvtpk(o1[2], o1[3]);
        *(u32x2*)(act + (size_t)(pm * 256) * DFF + ch) = s0; *(u32x2*)(act + (size_t)(pm * 256 + 1) * DFF + ch) = s1;
    }
    asm volatile("s_waitcnt vmcnt(0)" ::: "memory");
    __syncthreads();
}
__device__ __forceinline__ void final_phase(KP p) {
    const int lane = ltid() & 63, wave = ltid() >> 6; const float* ssqp = (const float*)(p->ws + WS_SSQP);
    for (int row = blockIdx.x * 8 + wave; row < MROWS; row += gridDim.x * 8) {
        float s = (lane < 32) ? ssqp[(size_t)row * 32 + lane] : 0.f; s = wave_sum(s);
        const float rs = __builtin_amdgcn_rsqf(s * (1.f / DM) + RMS_EPS);
        f32x4* o = (f32x4*)(p->out + (size_t)row * DM) + lane; const f32x4* gq = (const f32x4*)p->final_g + lane;
        const u32x2* hq = (const u32x2*)((const bf16_t*)(p->ws + WS_HB) + (size_t)row * DM) + lane;
#pragma unroll
        for (int j = 0; j < 8; ++j) { const u32x2 hv = hq[64 * j]; const f32x4 gg = gq[64 * j]; f32x4 v;
            v.x = __builtin_bit_cast(float, hv.x << 16); v.y = __builtin_bit_cast(float, hv.x & 0xFFFF0000u); v.z = __builtin_bit_cast(float, hv.y << 16); v.w = __builtin_bit_cast(float, hv.y & 0xFFFF0000u);
            o[64 * j] = v * rs * gg; }
    }
}
__device__ __forceinline__ float gelu_tanh(float x) { const float u = 0.7978845608028654f * (x + 0.044715f * x * x * x); const float e = __expf(2.f * u); const float th = 1.f - 2.f / (e + 1.f); return 0.5f * x * (1.f + th); }
__device__ __forceinline__ void compress_unit(KP p, int l, LAS unsigned char* lds, int upair) {
    const int tid = ltid(), wid = tid >> 6, lane = tid & 63, fr = lane & 15, fq = lane >> 4;
    const int nblk = wid & 3, grp = wid >> 2;
    const int unit = upair * 2 + grp;
    const int mc = unit & 3, kv = (unit >> 2) & 1, g = (unit >> 3) & 1, b = unit >> 4;
    const bf16_t* proj = (const bf16_t*)(p->ws + WS_PROJ);
    const bf16_t* w1t = (const bf16_t*)(p->ws + WS_W1T) + (size_t)(l * 2 + kv) * 128 * 4096;
    const bf16_t* w2t = (const bf16_t*)(p->ws + WS_W2T) + (size_t)(l * 2 + kv) * 128 * 128;
    const float* posc = (const float*)(p->ws + WS_POSC) + (l * 2 + kv) * 128;
    bf16_t* outp = (bf16_t*)(p->ws + (kv ? WS_VCMP : WS_KCMP)) + (size_t)(b * 2 + g) * 128 * 128;
    const bf16_t* arow[2]; const bf16_t* brow[2];
#pragma unroll
    for (int i = 0; i < 2; ++i) { const int n = mc * 32 + i * 16 + fr, nc = n < 127 ? n : 126;
        arow[i] = proj + (size_t)(b * SEQ + 16 * nc) * PROJ_LD + (kv ? C_NVC : C_NKC) + g * 128 + fq * 8;
        brow[i] = w1t + (size_t)(nblk * 32 + i * 16 + fr) * 4096 + fq * 8; }
    f32x4 acc[2][2] = {};
#define CMP_LOAD(A_, B_, LL) do { _Pragma("unroll") for (int i = 0; i < 2; ++i) _Pragma("unroll") for (int j = 0; j < 4; ++j) { \
        A_[i][j] = *(const bf16x8*)(arow[i] + (size_t)(LL) * PROJ_LD + j * 32); B_[i][j] = *(const bf16x8*)(brow[i] + (LL) * 128 + j * 32); } } while (0)
#define CMP_MMA(A_, B_) do { _Pragma("unroll") for (int j = 0; j < 4; ++j) _Pragma("unroll") for (int mi = 0; mi < 2; ++mi) _Pragma("unroll") for (int ni = 0; ni < 2; ++ni) \
        acc[mi][ni] = __builtin_amdgcn_mfma_f32_16x16x32_bf16(A_[mi][j], B_[ni][j], acc[mi][ni], 0, 0, 0); } while (0)
    bf16x8 a0[2][4], b0[2][4], a1[2][4], b1[2][4];
    CMP_LOAD(a0, b0, 0);
#pragma unroll 1
    for (int ll = 0; ll < 32; ll += 2) {
        CMP_LOAD(a1, b1, ll + 1);
        CMP_MMA(a0, b0);
        if (ll + 2 < 32) CMP_LOAD(a0, b0, ll + 2);
        CMP_MMA(a1, b1);
    }
#undef CMP_LOAD
#undef CMP_MMA
    LAS bf16_t* hid = (LAS bf16_t*)(lds + grp * 16384);
#pragma unroll
    for (int ni = 0; ni < 2; ++ni) { const int col = nblk * 32 + ni * 16 + fr; const float pc = posc[col];
#pragma unroll
        for (int mi = 0; mi < 2; ++mi)
#pragma unroll
            for (int i = 0; i < 4; ++i) hid[(mi * 16 + 4 * fq + i) * 136 + col] = (bf16_t)(cvtpk(gelu_tanh(acc[mi][ni][i] + pc), 0.f) & 0xFFFFu); }
    __syncthreads();
    {
        f32x4 acc2[2][2] = {};
#pragma unroll
        for (int j = 0; j < 4; ++j) { bf16x8 a2[2], b2[2];
#pragma unroll
            for (int i = 0; i < 2; ++i) { a2[i] = *(const LAS bf16x8*)(hid + (i * 16 + fr) * 136 + j * 32 + fq * 8); b2[i] = *(const bf16x8*)(w2t + (size_t)(nblk * 32 + i * 16 + fr) * 128 + j * 32 + fq * 8); }
#pragma unroll
            for (int mi = 0; mi < 2; ++mi)
#pragma unroll
                for (int ni = 0; ni < 2; ++ni) acc2[mi][ni] = __builtin_amdgcn_mfma_f32_16x16x32_bf16(a2[mi], b2[ni], acc2[mi][ni], 0, 0, 0); }
#pragma unroll
        for (int mi = 0; mi < 2; ++mi)
#pragma unroll
            for (int ni = 0; ni < 2; ++ni)
#pragma unroll
                for (int i = 0; i < 4; ++i) { const int nr = mc * 32 + mi * 16 + 4 * fq + i; const float v = (nr < 127) ? acc2[mi][ni][i] : 0.f;
                    outp[(size_t)nr * 128 + nblk * 32 + ni * 16 + fr] = (bf16_t)(cvtpk(v, 0.f) & 0xFFFFu); }
    }
    __syncthreads();
}
__device__ __forceinline__ void cumsum_unit(KP p, int l, LAS unsigned char* lds, int unit) {
    const int tid = ltid(), lane = tid & 63, wid = tid >> 6; const int b = unit / 6, h = unit % 6;
    const float* gates = (const float*)(p->ws + WS_GATES); float* c2 = (float*)(p->ws + WS_CUM) + (size_t)unit * SEQ;
    const float fb = p->fox_f_bias[l * 6 + h];
    float v[4], run = 0.f;
#pragma unroll
    for (int i = 0; i < 4; ++i) { const float xx = gates[(size_t)(b * SEQ + 4 * tid + i) * GATE_LD + h] + fb;
        const float ls = fminf(xx, 0.f) - log1pf(__expf(-fabsf(xx))); run += ls; v[i] = run; }
    float inc = run;
#pragma unroll
    for (int o = 1; o < 64; o <<= 1) { const float t = __builtin_bit_cast(float, __builtin_amdgcn_ds_bpermute(((lane - o) & 63) << 2, __builtin_bit_cast(int, inc))); if (lane >= o) inc += t; }
    LAS float* wsum = (LAS float*)lds;
    if (lane == 63) wsum[wid] = inc;
    __syncthreads();
    float base = 0.f;
#pragma unroll
    for (int w = 0; w < 8; ++w) if (w < wid) base += wsum[w];
    const float ex = base + inc - run;
#pragma unroll
    for (int i = 0; i < 4; ++i) c2[4 * tid + i] = (ex + v[i]) * LOG2E;
    __syncthreads();
}

#ifndef ATT_EN
#define ATT_EN 7
#endif
__device__ __forceinline__ void attention_phase(KP p, int lq, LAS unsigned char* lds_u, volatile LAS unsigned* misc) {
#ifdef ATT_DUPK
    const int att_en = (lq >= 4) ? (ATT_DUPK) : (ATT_EN);
#else
    constexpr int att_en = ATT_EN;
#endif
    const int l = lq & 3;
    att::lptr lds = (att::lptr)lds_u;
    const int tid = ltid();
    unsigned* ctl = (unsigned*)(p->ws + WS_CTL);
    const bf16_t* proj = (const bf16_t*)(p->ws + WS_PROJ); bf16_t* mixed = (bf16_t*)(p->ws + WS_MIXED);
    const float* gates = (const float*)(p->ws + WS_GATES);
    float* scr = (float*)(p->ws + WS_SCR) + (size_t)blockIdx.x * 32768;
    const bf16_t* kcmp = (const bf16_t*)(p->ws + WS_KCMP); const bf16_t* vcmp = (const bf16_t*)(p->ws + WS_VCMP);
    { LAS float* lut = (LAS float*)(lds + att::L_LUT);
      for (int i = tid; i < 1280; i += 512) { const int hh = i >> 7, rel = i & 127; lut[i] = p->rel_bias[(int)T5B[rel] * 10 + hh] * LOG2E; } }
    const int lane = tid & 63;
    const float s1 = wave_sum(p->lq1[l * 64 + lane] * p->lk1[l * 64 + lane]), s2 = wave_sum(p->lq2[l * 64 + lane] * p->lk2[l * 64 + lane]);
    const float lam_init = 0.8f - 0.6f * __expf(-0.3f * (float)l);
    const float lam = __expf(s1) - __expf(s2) + lam_init;
    constexpr int QN_CMP = 16, QN_DIFF = 64, QN_NSA = 32, QN_FOX = 96, QN = QN_CMP + QN_DIFF + QN_NSA + QN_FOX;
    if ((tid >> 6) >= 4) __builtin_amdgcn_s_setprio(1); else __builtin_amdgcn_s_setprio(0);
    const int home = (int)(xb_xcc_id() & 7u);
    unsigned cmp_seen = 0u;
    int qx = home;
    __syncthreads();
    for (;;) {
        if (tid == 0) {
            unsigned* qh = ctl + CW_QUEUE + (lq * 8) * 64;
            unsigned iv = __hip_atomic_fetch_add(qh + qx * 64, 1u, __ATOMIC_RELAXED, __HIP_MEMORY_SCOPE_AGENT); int q = qx;
            if (iv >= (unsigned)QN) {
                unsigned hv[7];
#pragma unroll
                for (int k = 1; k < 8; ++k) hv[k - 1] = __hip_atomic_load(qh + ((qx + k) & 7) * 64, __ATOMIC_RELAXED, __HIP_MEMORY_SCOPE_AGENT);
#pragma unroll
                for (int k = 1; k < 8; ++k) if (iv >= (unsigned)QN && hv[k - 1] < (unsigned)QN) {
                    const unsigned t = __hip_atomic_fetch_add(qh + ((qx + k) & 7) * 64, 1u, __ATOMIC_RELAXED, __HIP_MEMORY_SCOPE_AGENT);
                    if (t < (unsigned)QN) { iv = t; q = (qx + k) & 7; } }
            }
            misc[4] = iv; misc[5] = (unsigned)q;
        }
        __syncthreads();
        const int idx = (int)misc[4]; qx = (int)misc[5];
        __syncthreads();
        if (idx >= QN) break;
        unsigned* cdone = ctl + CW_CMPDONE + (lq * 8 + qx) * 64;
        if (idx < QN_CMP) {
            const int gi = qx * 4 + (idx >> 2), pr = idx & 3;
            compress_unit(p, l, lds_u, gi * 4 + pr);
            asm volatile("s_waitcnt vmcnt(0)" ::: "memory");
            __syncthreads();
            if (tid == 0) { __builtin_amdgcn_fence(__ATOMIC_RELEASE, "agent"); asm volatile("s_waitcnt vmcnt(0)" ::: "memory");
                __hip_atomic_fetch_add(cdone, 1u, __ATOMIC_RELAXED, __HIP_MEMORY_SCOPE_AGENT); }
            continue;
        }
        int j = idx - QN_CMP;
        if (j < QN_DIFF) { const int di = qx * 8 + (j & 7), qb = 7 - (j >> 3);
            if (att_en & 2) att::diff_unit(lds, proj, mixed, scr, di >> 2, di & 3, qb, lam, 1.f - lam_init, p->subln_g + l * 128); continue; }
        j -= QN_DIFF;
        if (j < QN_NSA) { const int gi = qx * 4 + (j & 3), qb = 7 - (j >> 2);
            if (!((cmp_seen >> qx) & 1u)) {
                if (tid == 0) { unsigned sp = 0; while (__hip_atomic_load(cdone, __ATOMIC_RELAXED, __HIP_MEMORY_SCOPE_AGENT) < (unsigned)QN_CMP) { __builtin_amdgcn_s_sleep(2); if (++sp > (1u << 22)) break; }
                    __builtin_amdgcn_fence(__ATOMIC_ACQUIRE, "agent"); asm volatile("s_waitcnt vmcnt(0)" ::: "memory"); }
                __syncthreads(); cmp_seen |= 1u << qx; }
            if (att_en & 1) att::nsa_unit(lds, proj, gates, kcmp, vcmp, mixed, scr, gi >> 1, gi & 1, qb); continue; }
        j -= QN_NSA;
        { const int fi = qx * 12 + j % 12, qb = 7 - j / 12;
            if (att_en & 4) att::fox_unit(lds, proj, gates, p->fox_f_bias[l * 6 + fi % 6], mixed, fi / 6, fi % 6, qb); }
    }
    __builtin_amdgcn_s_setprio(0);
    if (l + 1 < DEPTH && lq < 4) {
        const int tid = ltid(); KP p = kparams();
                unsigned* chead = (unsigned*)(p->ws + WS_CTL) + CW_CONV + l * 64;
        LAS float* scrw = (LAS float*)lds_u + (tid >> 6) * (64 * 33);
        constexpr int NCH = (T_LAYER + 63) / 64;
        __syncthreads();
        for (;;) {
            if (tid == 0) misc[4] = __hip_atomic_fetch_add(chead, 1u, __ATOMIC_RELAXED, __HIP_MEMORY_SCOPE_AGENT);
            __syncthreads();
            const int ch = (int)misc[4];
            __syncthreads();
            if (ch >= NCH) break;
#pragma unroll 1
            for (int k = 0; k < 8; ++k) { const int it = ch * 64 + k * 8 + (tid >> 6); if (it < T_LAYER) convert_item(p, l + 1, it, scrw, tid & 63); }
        }
    }
}

#ifndef ATT_EN
#define ATT_EN 7
#endif
#ifndef PH_EN
#define PH_EN 255
#endif
#ifndef DUP
#define DUP 0
#endif
#define DUPLOOP(k) _Pragma("unroll 1") for (int rep_ = 0; rep_ < (((DUP) & (k)) ? 2 : 1); ++rep_)
__global__ void __launch_bounds__(512, 2) mk_fwd(Params p_unused) {
    extern __shared__ __attribute__((aligned(16))) unsigned char lds_raw[];
    LAS unsigned char* lds = (LAS unsigned char*)lds_raw;
    volatile LAS unsigned* misc = (volatile LAS unsigned*)(lds + LX_MISC);
    const int G = gridDim.x;
    if (ltid() < 16) misc[ltid()] = 0u;
    __syncthreads();
    XcdBarrier bar;
    { KP p = kparams(); bar = xcd_barrier_post((unsigned*)(p->ws + WS_CTL) + CW_BAR + p->bar_region * XCD_BAR_WORDS, misc); }
    DUPLOOP(64) { KP p = kparams(); if ((PH_EN & 64) && p->do_prologue) { prologue_phase(p, lds); xcd_barrier(bar); } }

    const int l_begin = kparams()->l_begin, l_end = kparams()->l_end, ph_mask = kparams()->ph_mask;
    for (int l = l_begin; l < l_end; ++l) {
        if ((PH_EN & 1) && (ph_mask & 1)) DUPLOOP(1) {
            KP p = kparams(); unsigned char* ws = p->ws;
            rstd_prefix(p, lds); if (rep_ == 0) gate_prefix(p, l, lds);
            pg8::Gemm g{(const bf16_t*)(ws + WS_HB), (const bf16_t*)(ws + WS_WIN) + (size_t)l * NINP * DM, MROWS, PROJ_LD, DM}; pg8::StaticOrder S; S.init(MROWS, PROJ_LD, G, (int)blockIdx.x);
            epi::InProj E{(bf16_t*)(ws + WS_PROJ), (const LAS float*)(lds + LX_RSTAB)};
            pg8::gemm_phase<epi::InProj, pg8::StaticOrder, true, true>(lds, g, S, E);
            xcd_barrier(bar);
        }
        if ((PH_EN & 4) && (ph_mask & 6)) DUPLOOP(4) {
            attention_phase(kparams(), l + 4 * rep_, lds, misc);
            xcd_barrier(bar);
        }
        if ((PH_EN & 8) && (ph_mask & 8)) DUPLOOP(8) {
            { KP p = kparams(); unsigned char* ws = p->ws;
              pg8::Gemm g{(const bf16_t*)(ws + WS_MIXED), (const bf16_t*)(ws + WS_WOUT) + (size_t)l * DM * DM, MROWS, DM, DM}; pg8::StaticOrder S; S.init(MROWS, DM, G, (int)blockIdx.x);
              epi::Resid E{(bf16_t*)(ws + (rep_ ? WS_END : WS_HB)), (float*)(ws + (rep_ ? WS_END + (size_t)MROWS * DM * 2 : WS_SSQP))};
              pg8::gemm_phase<epi::Resid, pg8::StaticOrder, true, true>(lds, g, S, E); }
            xcd_barrier(bar);
        }
        if ((PH_EN & 16) && (ph_mask & 16)) DUPLOOP(16) {
            { KP p = kparams(); unsigned char* ws = p->ws;
              rstd_prefix(p, lds);
              pg8::Gemm g{(const bf16_t*)(ws + WS_HB), (const bf16_t*)(ws + WS_WUP) + (size_t)l * NUP * DM, MROWS, NUP, DM}; pg8::StaticOrder S; S.init(MROWS, NUP, G, (int)blockIdx.x);
              epi::UpConv E{(bf16_t*)(ws + WS_PROJ), (const LAS float*)(lds + LX_RSTAB), p->conv_w + (size_t)l * 3 * NUP, p->conv_b + (size_t)l * NUP, (float*)(ws + WS_HALO), (LAS float*)(lds + LX_CONV)};
              pg8::gemm_phase<epi::UpConv, pg8::StaticOrder, true, true>(lds, g, S, E); }
            xcd_barrier(bar);
        }
        if ((PH_EN & 32) && (ph_mask & 32)) DUPLOOP(32) {
            { KP p = kparams(); unsigned char* ws = p->ws;
              fixup_prefix(p, l);
              pg8::Gemm g{(const bf16_t*)(ws + WS_PROJ), (const bf16_t*)(ws + WS_WDN) + (size_t)l * DM * DFF, MROWS, DM, DFF}; pg8::StaticOrder S; S.init(MROWS, DM, G, (int)blockIdx.x);
              epi::Resid E{(bf16_t*)(ws + (rep_ ? WS_END : WS_HB)), (float*)(ws + (rep_ ? WS_END + (size_t)MROWS * DM * 2 : WS_SSQP))};
              pg8::gemm_phase<epi::Resid, pg8::StaticOrder, true, true>(lds, g, S, E); }
            xcd_barrier(bar);
        }
    }
    { KP p = kparams(); if ((PH_EN & 128) && p->do_final) final_phase(p); }
}

#if MK_DEBUG
constexpr int NCHK = 16;
#ifndef DBG_SKIP
#define DBG_SKIP 0
#endif
__constant__ int DBG_TS[8] = {0, 1, 255, 256, 700, 1023, 1500, 2047};
__constant__ int DBG_RS[16] = {0, 1, 2, 3, 62, 63, 64, 65, 126, 127, 128, 129, 191, 192, 254, 255};
__constant__ float DBG_TOL[NCHK] = {0, 1e-6f, 1e-3f, 0.03f, 0.03f, 1e-3f, 0.05f, 0.05f, 0.05f, 0.08f, 0.03f, 0.05f, 0.03f, 0, 0, 0};
__device__ __forceinline__ void diag_max(unsigned* diag, int c, float err) { unsigned b = __builtin_bit_cast(unsigned, fabsf(err)); if (err != err) b = 0x7FC00000u; atomicMax(diag + c, b); }
__device__ __forceinline__ void diag_bits(unsigned* diag, int c, unsigned bits) { atomicOr(diag + 16 + c, bits); }
__device__ __forceinline__ unsigned hash_u(unsigned x) { x ^= x >> 16; x *= 0x7feb352du; x ^= x >> 15; x *= 0x846ca68bu; x ^= x >> 16; return x; }
__device__ __forceinline__ float bfr(float v) { return bf2f((bf16_t)(cvtpk(v, 0.f) & 0xFFFFu)); }
__device__ __forceinline__ float blk_sum(float v, float* sh) {
    const int t = threadIdx.x; sh[t] = v; __syncthreads();
    for (int o = 128; o > 0; o >>= 1) { if (t < o) sh[t] += sh[t + o]; __syncthreads(); }
    const float r = sh[0]; __syncthreads(); return r;
}
__device__ __forceinline__ float blk_max(float v, float* sh) {
    const int t = threadIdx.x; sh[t] = v; __syncthreads();
    for (int o = 128; o > 0; o >>= 1) { if (t < o) sh[t] = fmaxf(sh[t], sh[t + o]); __syncthreads(); }
    const float r = sh[0]; __syncthreads(); return r;
}
__device__ __forceinline__ int t5_bucket_ref(int rel) {
    const int n = rel > 0 ? rel : 0; if (n < 16) return n;
    const float nf = (float)n; int large = 16 + (int)(logf(nf / 16.f) / logf(8.f) * 16.f); if (large > 31) large = 31; return large;
}
__device__ __forceinline__ float relerr(float fast, float ref, float scale) { return fabsf(fast - ref) / (fabsf(ref) + scale); }

__global__ void __launch_bounds__(256) chk_kernel(Params p, int stage, const float* out_prev) {
    __shared__ float sh[256];
    __shared__ float sbuf[2304];
    __shared__ float sq[384];
    __shared__ int sidx[16];
    unsigned* diag = (unsigned*)(p.ws + WS_DIAG);
    unsigned char* ws = p.ws;
    const int t = threadIdx.x;
    const bf16_t* hb = (const bf16_t*)(ws + WS_HB); const float* rstd = (const float*)(ws + WS_RSTD);
    const bf16_t* proj = (const bf16_t*)(ws + WS_PROJ); const float* gates = (const float*)(ws + WS_GATES);
    const bf16_t* mixed = (const bf16_t*)(ws + WS_MIXED); const float* c2 = (const float*)(ws + WS_CUM);
    const bf16_t* kcmp = (const bf16_t*)(ws + WS_KCMP); const bf16_t* vcmp = (const bf16_t*)(ws + WS_VCMP);
    const int l = 0;
    if (stage == 2) {
        unsigned bad = 0; const size_t nvec = (size_t)MROWS * PROJ_LD / 8;
        for (size_t i = (size_t)blockIdx.x * 256 + t; i < nvec; i += (size_t)gridDim.x * 256) { const bf16x8 v = ((const bf16x8*)proj)[i];
#pragma unroll
            for (int e = 0; e < 8; ++e) { const float x = bf2f((bf16_t)v[e]); if (!(fabsf(x) < 1000.f)) ++bad; } }
        if (bad) atomicAdd(diag + 13, bad);
    }
    if (stage == 3) {
        unsigned bad = 0;
        for (int i = blockIdx.x * 256 + t; i < NBATCH * 2 * 128 * 128; i += gridDim.x * 256) { const float a = bf2f(kcmp[i]), c = bf2f(vcmp[i]); if (!(fabsf(a) < 1000.f)) ++bad; if (!(fabsf(c) < 1000.f)) bad += 65536u; }
        if (bad & 0xFFFFu) atomicAdd(diag + 14, bad & 0xFFFFu); if (bad >> 16) atomicAdd(diag + 15, bad >> 16);
    }
    for (int smp = blockIdx.x; smp < (stage == 2 ? 512 : 64); smp += gridDim.x) {
        const unsigned h0 = hash_u(smp * 2654435761u + stage * 97u + 12345u), h1 = hash_u(h0 + 1u), h2 = hash_u(h1 + 7u);
        if (stage == 1) {
            const unsigned r0 = hash_u(h0 + t * 31u), r1 = hash_u(r0 + 5u), r2 = hash_u(r1 + 3u);
            { const int ll = r0 & 3, c = r1 % NINP, k = r2 % DM; const int oc = win_colmap(c);
              const float ref = oc >= 0 ? bfr(p.w_in[((size_t)ll * DM + k) * NIN + oc] * p.attn_norm_g[ll * DM + k]) : 0.f;
              diag_max(diag, 1, bf2f(((const bf16_t*)(ws + WS_WIN))[((size_t)ll * NINP + c) * DM + k]) - ref); }
            { const int ll = r0 & 3, c = r1 % DM, k = r2 % DM; const float ref = bfr(p.w_out[((size_t)ll * DM + k) * DM + c]);
              diag_max(diag, 1, bf2f(((const bf16_t*)(ws + WS_WOUT))[((size_t)ll * DM + c) * DM + k]) - ref); }
            { const int ll = r0 & 3, c = r1 % NUP, k = r2 % DM; const int oc = wup_colmap(c); const float ref = bfr(p.w_up[((size_t)ll * DM + k) * NUP + oc] * p.ffn_norm_g[ll * DM + k]);
              diag_max(diag, 1, bf2f(((const bf16_t*)(ws + WS_WUP))[((size_t)ll * NUP + c) * DM + k]) - ref); }
            { const int ll = r0 & 3, c = r1 % DM, k = r2 % DFF; const float ref = bfr(p.w_down[((size_t)ll * DFF + k) * DM + c]);
              diag_max(diag, 1, bf2f(((const bf16_t*)(ws + WS_WDN))[((size_t)ll * DM + c) * DFF + k]) - ref); }
            { const int ll = r0 & 3, kv = (r0 >> 2) & 1, c = r1 % 128, k = r2 % 4096; const float ref = bfr((kv ? p.wv1 : p.wk1)[((size_t)ll * 4096 + k) * 128 + c]);
              diag_max(diag, 1, bf2f(((const bf16_t*)(ws + WS_W1T))[((size_t)(ll * 2 + kv) * 128 + c) * 4096 + k]) - ref); }
            { const int ll = r0 & 3, kv = (r0 >> 2) & 1, c = r1 % 128, k = r2 % 128; const float ref = bfr((kv ? p.wv2 : p.wk2)[((size_t)ll * 128 + k) * 128 + c]);
              diag_max(diag, 1, bf2f(((const bf16_t*)(ws + WS_W2T))[((size_t)(ll * 2 + kv) * 128 + c) * 128 + k]) - ref); }
            { const int row = h0 % MROWS; float ss = 0.f; for (int k = t; k < DM; k += 256) { const float xv = p.x[(size_t)row * DM + k]; ss += xv * xv; diag_max(diag, 2, bf2f(hb[(size_t)row * DM + k]) - bfr(xv)); }
              ss = blk_sum(ss, sh); if (t == 0) diag_max(diag, 2, relerr(rstd[row], 1.f / sqrtf(ss / DM + RMS_EPS), 1e-6f)); }
            { const int ll = h1 & 3, kv = (h1 >> 2) & 1, c = h2 % 128; float s = 0.f; for (int k = t; k < 4096; k += 256) s += p.cmp_pos[(size_t)ll * 4096 + k] * (kv ? p.wv1 : p.wk1)[((size_t)ll * 4096 + k) * 128 + c];
              s = blk_sum(s, sh); if (t == 0) diag_max(diag, 2, relerr(((const float*)(ws + WS_POSC))[(ll * 2 + kv) * 128 + c], s, 1e-3f)); }
        } else if (stage == 2) {
            const int pnn = smp % 25; const int row = h0 % MROWS, c = pnn == 24 ? 6144 + (h1 % 24) : pnn * 256 + (h1 % 256); const int oc = win_colmap(c);
            float ss = 0.f, dot = 0.f;
            for (int k = t; k < DM; k += 256) { const float xv = p.x[(size_t)row * DM + k]; ss += xv * xv; dot += bfr(xv) * bfr(p.w_in[((size_t)l * DM + k) * NIN + oc] * p.attn_norm_g[l * DM + k]); }
            ss = blk_sum(ss, sh); dot = blk_sum(dot, sh);
            if (t == 0) { const float rs = 1.f / sqrtf(ss / DM + RMS_EPS); const int pn = c >> 8;
                float cs = 1.f; if (pn < 3 || (pn >= 15 && pn <= 17)) cs = 0.08838834764831845f * LOG2E; else if (pn == 9 || pn == 10) cs = 0.125f * LOG2E;
                if (c < 6144) { const float fv = bf2f(proj[(size_t)row * PROJ_LD + c]); const float er = relerr(fv, dot * rs * cs, 0.05f); diag_max(diag, 3, er);
                    if (!(er <= 0.03f)) diag_bits(diag, 3, (pn < 9 ? 1u : pn < 15 ? 2u : pn < 18 ? 4u : 8u) | ((row % SEQ) >= 512 ? 16u : 0u) | (fabsf(fv) < 1e-6f ? 32u : 0u)); }
                else diag_max(diag, 4, relerr(gates[(size_t)row * GATE_LD + (c - 6144)], dot * rs, 0.05f)); }
        } else if (stage == 3) {
            if (smp < 24) { if (t == 0) { const int bh = (h0 % 96), b = bh / 6, h = bh % 6; float run = 0.f, worst = 0.f;
                    for (int s = 0; s < SEQ; ++s) { const float xx = gates[(size_t)(b * SEQ + s) * GATE_LD + h] + p.fox_f_bias[l * 6 + h]; run += fminf(xx, 0.f) - log1pf(expf(-fabsf(xx)));
                        worst = fmaxf(worst, relerr(c2[(size_t)bh * SEQ + s], run * LOG2E, 1.f)); float cv = c2[(size_t)bh * SEQ + s]; if (cv != cv) worst = cv; }
                    diag_max(diag, 5, worst); } }
            else { const int b = h0 % NBATCH, g = h1 & 1, kv = (h1 >> 1) & 1, n = (smp & 7) == 7 ? 127 : (smp & 7) == 6 ? 126 : h2 % 127;
                const float* w1 = (kv ? p.wv1 : p.wk1) + (size_t)l * 4096 * 128; const float* w2 = (kv ? p.wv2 : p.wk2) + (size_t)l * 128 * 128;
                if (t < 128) { float s = 0.f; if (n < 127) { for (int ll = 0; ll < 32; ++ll) for (int d = 0; d < 128; ++d)
                        s += bf2f(proj[(size_t)(b * SEQ + 16 * n + ll) * PROJ_LD + (kv ? C_NVC : C_NKC) + g * 128 + d]) * bfr(w1[(size_t)(ll * 128 + d) * 128 + t]);
                        s += ((const float*)(ws + WS_POSC))[(l * 2 + kv) * 128 + t]; const float u = 0.7978845608028654f * (s + 0.044715f * s * s * s); s = 0.5f * s * (1.f + tanhf(u)); }
                    sbuf[t] = bfr(s);
                    if (n < 127) { const int unit = (n >> 5) + 4 * kv + 8 * g + 16 * b; const float hv = ((const float*)(ws + WS_SCR))[(size_t)unit * 4096 + (n & 31) * 128 + t];
                        const float er = relerr(hv, s, 0.05f); if (!(er <= 0.05f)) diag_bits(diag, 6, 1u | (fabsf(hv) > 100.f ? 2u : 0u) | (hv != hv ? 4u : 0u)); } }
                __syncthreads();
                if (t < 128) { float s = 0.f; if (n < 127) for (int j = 0; j < 128; ++j) s += sbuf[j] * bfr(w2[(size_t)j * 128 + t]);
                    const float fv = bf2f((kv ? vcmp : kcmp)[((size_t)(b * 2 + g) * 128 + n) * 128 + t]); const float er = relerr(fv, s, 0.05f);
                    diag_max(diag, 6, er);
                    if (!(er <= 0.05f)) diag_bits(diag, 6, 8u | (kv ? 16u : 0u) | ((n >= 96 && n < 112) ? 32u : 0u)); }
                __syncthreads(); }
        } else if (stage == 4) {
            const int b = h0 % NBATCH, tt = (smp & 1) ? DBG_TS[(smp >> 1) & 7] : (int)(h1 % SEQ);
            const size_t qrow = (size_t)(b * SEQ + tt);
            if (smp < 24) {
                const int h = h2 % 6; const bf16_t* q = proj + qrow * PROJ_LD + C_FQ + h * 128; const float* cc = c2 + (size_t)(b * 6 + h) * SEQ;
                float mx = -1e30f;
                for (int k = t; k <= tt; k += 256) { const bf16_t* kr = proj + (size_t)(b * SEQ + k) * PROJ_LD + C_FK + h * 128; float s = 0.f; for (int d = 0; d < 128; ++d) s += bf2f(q[d]) * bf2f(kr[d]);
                    s += cc[tt] - cc[k]; sbuf[k] = s; mx = fmaxf(mx, s); }
                mx = blk_max(mx, sh); float sum = 0.f;
                for (int k = t; k <= tt; k += 256) { sbuf[k] = exp2f(sbuf[k] - mx); sum += sbuf[k]; }
                sum = blk_sum(sum, sh);
                if (t < 128) { float o = 0.f; for (int k = 0; k <= tt; ++k) o += sbuf[k] * bf2f(proj[(size_t)(b * SEQ + k) * PROJ_LD + C_FV + h * 128 + t]); o /= sum;
                    const float fv = bf2f(mixed[qrow * DM + h * 128 + t]); const float er = relerr(fv, o, 0.05f); diag_max(diag, 7, er);
                    if (!(er <= 0.05f)) diag_bits(diag, 7, (tt < 64 ? 1u : tt < 512 ? 2u : 4u) | ((fabsf(fv) < 1e-6f) ? 8u : 0u) | ((fabsf(fv) > 4.f * fabsf(o) + 0.2f) ? 16u : 0u) | ((fv != fv) ? 32u : 0u)); }
                __syncthreads();
            } else if (smp < 40) {
                const int h = h2 & 3; float* o2 = sq;
                const float lam_init = 0.8f - 0.6f * expf(-0.3f * (float)l);
                float s1 = 0.f, s2 = 0.f; for (int i = 0; i < 64; ++i) { s1 += p.lq1[l * 64 + i] * p.lk1[l * 64 + i]; s2 += p.lq2[l * 64 + i] * p.lk2[l * 64 + i]; }
                const float lam = expf(s1) - expf(s2) + lam_init;
                if (t < 128) o2[t] = 0.f; __syncthreads();
                for (int mp = 0; mp < 2; ++mp) {
                    const bf16_t* q = proj + qrow * PROJ_LD + C_DQ + h * 128 + mp * 64; float mx = -1e30f;
                    for (int k = t; k <= tt; k += 256) { const bf16_t* kr = proj + (size_t)(b * SEQ + k) * PROJ_LD + C_DK + h * 128 + mp * 64; float s = 0.f; for (int d = 0; d < 64; ++d) s += bf2f(q[d]) * bf2f(kr[d]);
                        s += p.rel_bias[t5_bucket_ref(tt - k) * 10 + h] * LOG2E; sbuf[k] = s; mx = fmaxf(mx, s); }
                    mx = blk_max(mx, sh); float sum = 0.f;
                    for (int k = t; k <= tt; k += 256) { sbuf[k] = exp2f(sbuf[k] - mx); sum += sbuf[k]; }
                    sum = blk_sum(sum, sh);
                    if (t < 128) { float o = 0.f; for (int k = 0; k <= tt; ++k) o += sbuf[k] * bf2f(proj[(size_t)(b * SEQ + k) * PROJ_LD + C_DV + h * 128 + t]); o /= sum; o2[t] += (mp == 0 ? o : -lam * o); }
                    __syncthreads();
                }
                float ssq = (t < 128) ? o2[t] * o2[t] : 0.f; ssq = blk_sum(ssq, sh);
                if (t < 128) { const float y = o2[t] * (1.f / sqrtf(ssq / 128.f + RMS_EPS)) * p.subln_g[l * 128 + t] * (1.f - lam_init);
                    const float fv = bf2f(mixed[qrow * DM + 768 + h * 128 + t]); const float er = relerr(fv, y, 0.5f); diag_max(diag, 8, er);
                    if (!(er <= 0.05f)) diag_bits(diag, 8, (tt < 64 ? 1u : tt < 512 ? 2u : 4u) | ((fabsf(fv) < 1e-6f) ? 8u : 0u) | ((fabsf(fv) > 4.f * fabsf(y) + 0.2f) ? 16u : 0u) | ((fv != fv) ? 32u : 0u)); }
                __syncthreads();
            } else {
                const int h6 = h2 % 6, g = h6 / 3; float* pc = sbuf + 2048;
                float* imp = sq + 128; float* oacc = sq + 192;
                if (t < 32) imp[t] = 0.f; if (t < 128) oacc[t] = 0.f; __syncthreads();
                const bf16_t* kc = kcmp + (size_t)(b * 2 + g) * 128 * 128; const bf16_t* vc = vcmp + (size_t)(b * 2 + g) * 128 * 128;
                const float* gp = gates + qrow * GATE_LD + 6 + h6 * 3;
                const float g0 = 1.f / (1.f + expf(-gp[0])), g1 = 1.f / (1.f + expf(-gp[1])), g2 = 1.f / (1.f + expf(-gp[2]));
                for (int hh = 0; hh < 3; ++hh) {
                    const int hd = g * 3 + hh; const bf16_t* q = proj + qrow * PROJ_LD + C_NQ + hd * 128;
                    float s = -1e30f; bool ok = false;
                    if (t < 127) { ok = (16 * t + 31) <= tt; if (ok) { s = 0.f; for (int d = 0; d < 128; ++d) s += bf2f(q[d]) * bf2f(kc[(size_t)t * 128 + d]); s += p.rel_bias[t5_bucket_ref(tt - (16 * t + 31)) * 10 + 4 + hd] * LOG2E; } }
                    const float mx = blk_max(ok ? s : -1e30f, sh); const float e = ok ? exp2f(s - mx) : 0.f; const float sum = blk_sum(e, sh);
                    const float pr = sum > 0.f ? e / sum : 0.f;
                    if (t < 128) pc[t] = pr; __syncthreads();
                    if (t < 32) { float a = 0.f; for (int n = 0; n < 127; ++n) { int lo = max(16 * n, 64 * t), hi2 = min(16 * n + 32, 64 * t + 64); int ov = hi2 - lo; if (ov > 0) a += pc[n] * ((float)ov / 32.f); } imp[t] += a; }
                    if (hd == h6 && t < 128) { float o = 0.f; for (int n = 0; n < 127; ++n) o += pc[n] * bf2f(vc[(size_t)n * 128 + t]); oacc[t] += g0 * o; }
                    __syncthreads();
                }
                if (t == 0) { const int blk = tt >> 6; float* sc = sbuf + 2200; for (int j = 0; j < 32; ++j) { const bool forced = j == 0 || j == blk || j == blk - 1; sc[j] = (j <= blk) ? imp[j] + (forced ? 1e4f : 0.f) : -1e30f; }
                    unsigned m = 0; for (int it = 0; it < 8; ++it) { float best = -1e30f; int bi = -1; for (int j = 0; j < 32; ++j) if (!((m >> j) & 1u) && sc[j] > best) { best = sc[j]; bi = j; } if (bi >= 0 && best > -0.5e30f) m |= 1u << bi; }
                    sidx[0] = (int)m; }
                __syncthreads();
                const unsigned selm = (unsigned)sidx[0];
                for (int br = 0; br < 2; ++br) {
                    const bf16_t* q = proj + qrow * PROJ_LD + C_NQ + h6 * 128; const int kcol = (br == 0 ? C_NKS : C_NKW) + g * 128, vcol = (br == 0 ? C_NVS : C_NVW) + g * 128;
                    float mx = -1e30f;
                    for (int k = t; k <= tt; k += 256) { const bool ok = br == 0 ? ((selm >> (k >> 6)) & 1u) != 0u : (tt - k < 512); float s = -1e30f;
                        if (ok) { const bf16_t* kr = proj + (size_t)(b * SEQ + k) * PROJ_LD + kcol; s = 0.f; for (int d = 0; d < 128; ++d) s += bf2f(q[d]) * bf2f(kr[d]); s += p.rel_bias[t5_bucket_ref(tt - k) * 10 + 4 + h6] * LOG2E; }
                        sbuf[k] = s; mx = fmaxf(mx, s); }
                    mx = blk_max(mx, sh); float sum = 0.f;
                    for (int k = t; k <= tt; k += 256) { sbuf[k] = sbuf[k] > -1e29f ? exp2f(sbuf[k] - mx) : 0.f; sum += sbuf[k]; }
                    sum = blk_sum(sum, sh);
                    if (t < 128) { float o = 0.f; for (int k = 0; k <= tt; ++k) o += sbuf[k] * bf2f(proj[(size_t)(b * SEQ + k) * PROJ_LD + vcol + t]); oacc[t] += (br == 0 ? g1 : g2) * o / sum; }
                    __syncthreads();
                }
                if (t < 128) { const float fv = bf2f(mixed[qrow * DM + 1280 + h6 * 128 + t]); const float er = relerr(fv, oacc[t], 0.05f); diag_max(diag, 9, er);
                    if (!(er <= 0.08f)) diag_bits(diag, 9, (tt < 64 ? 1u : tt < 512 ? 2u : 4u) | ((fabsf(fv) < 1e-6f) ? 8u : 0u) | ((fabsf(fv) > 4.f * fabsf(oacc[t]) + 0.2f) ? 16u : 0u) | ((fv != fv) ? 32u : 0u)); }
                __syncthreads();
            }
        } else if (stage == 5) {
            const int row = h0 % MROWS, col = h1 % DM; float dot = 0.f, ss = 0.f;
            for (int k = t; k < DM; k += 256) { dot += bf2f(mixed[(size_t)row * DM + k]) * bfr(p.w_out[((size_t)l * DM + k) * DM + col]); const float hv = p.out[(size_t)row * DM + k]; ss += hv * hv; }
            dot = blk_sum(dot, sh); ss = blk_sum(ss, sh);
            if (t == 0) { const float ref = p.x[(size_t)row * DM + col] + dot; diag_max(diag, 10, relerr(p.out[(size_t)row * DM + col], ref, 0.05f));
                diag_max(diag, 10, relerr(bf2f(hb[(size_t)row * DM + col]), ref, 0.05f)); diag_max(diag, 10, relerr(rstd[row], 1.f / sqrtf(ss / DM + RMS_EPS), 1e-3f)); }
        } else if (stage == 6) {
            const int pm = h0 % 128, row = pm * 256 + DBG_RS[smp & 15], ch = h1 % DFF, s = row % SEQ;
            float yg = p.conv_b[l * NUP + ch], yu = p.conv_b[l * NUP + DFF + ch];
            for (int tap = 0; tap < 3; ++tap) { const int sp = s - 2 + tap; float dg = 0.f, du = 0.f;
                if (sp >= 0) { const int r2 = row - 2 + tap;
                    for (int k = t; k < DM; k += 256) { const float a = bf2f(hb[(size_t)r2 * DM + k]); const float gk = p.ffn_norm_g[l * DM + k];
                        dg += a * bfr(p.w_up[((size_t)l * DM + k) * NUP + ch] * gk); du += a * bfr(p.w_up[((size_t)l * DM + k) * NUP + DFF + ch] * gk); }
                    dg = blk_sum(dg, sh) * rstd[r2]; du = blk_sum(du, sh) * rstd[r2]; }
                yg += p.conv_w[((size_t)l * 3 + tap) * NUP + ch] * dg; yu += p.conv_w[((size_t)l * 3 + tap) * NUP + DFF + ch] * du; }
            if (t == 0) { const float ref = yg / (1.f + expf(-yg)) * yu; diag_max(diag, 11, relerr(bf2f(proj[(size_t)row * DFF + ch]), ref, 0.05f)); }
        } else if (stage == 7) {
            const int row = h0 % MROWS, col = h1 % DM; float dot = 0.f, ss = 0.f;
            for (int k = t; k < DFF; k += 256) dot += bf2f(proj[(size_t)row * DFF + k]) * bfr(p.w_down[((size_t)l * DFF + k) * DM + col]);
            for (int k = t; k < DM; k += 256) { const float hv = p.out[(size_t)row * DM + k]; ss += hv * hv; }
            dot = blk_sum(dot, sh); ss = blk_sum(ss, sh);
            if (t == 0) { const float ref = out_prev[(size_t)row * DM + col] + dot; diag_max(diag, 12, relerr(p.out[(size_t)row * DM + col], ref, 0.05f));
                diag_max(diag, 12, relerr(bf2f(hb[(size_t)row * DM + col]), ref, 0.05f)); (void)ss; }
        }
    }
}
__global__ void report_kernel(float* out, const unsigned* diag, int n) {
    __shared__ float code, mag;
    if (threadIdx.x == 0) {
        int c = 0; float e = 0.f;
        for (int i = 1; i < 13; ++i) { if ((DBG_SKIP >> i) & 1) continue; const float v = __builtin_bit_cast(float, diag[i]); if (!(v <= DBG_TOL[i])) { c = i; e = v; break; } }
        if (!c || c > 3) { const unsigned n13 = diag[13]; if (n13 && !((DBG_SKIP >> 13) & 1)) { c = 13; e = 0.f; code = 13.f; mag = 100.f * (10.f + fminf(63.f, floorf(log2f((float)n13)) + 1.f)); } }
        if (c != 13 && (!c || c > 6)) { const unsigned n14 = diag[14]; if ((n14 || diag[15]) && !((DBG_SKIP >> 14) & 1)) { c = 14; code = 14.f; const unsigned nk = n14, nv = diag[15]; mag = 100.f * (10.f + (nk ? 32.f : 0.f) + fminf(31.f, (nv ? floorf(log2f((float)nv)) + 1.f : 0.f))); } }
        if (c == 13 || c == 14) { } else {
        code = (float)c; float info = 0.f;
        if (c) { const unsigned bits = diag[16 + c] & 63u; if (bits) info = (float)bits; else if (e != e) info = 89.f; else { info = 64.f + rintf(3.f * (log10f(fmaxf(e, 1e-6f)) + 6.f)); info = fminf(fmaxf(info, 64.f), 88.f); } }
        mag = c ? 100.f * (10.f + info) : 0.f; }
    }
    __syncthreads();
    for (int i = blockIdx.x * blockDim.x + threadIdx.x; i < n; i += gridDim.x * blockDim.x) out[i] = (i == 0) ? mag : code;
}
static void debug_launches(Params p, int grid, hipStream_t stream) {
    float* out_prev = (float*)(p.ws + WS_END);
    (void)hipMemsetAsync(p.ws + WS_DIAG, 0, 256, stream);
    p.l_begin = 0; p.l_end = 1; p.do_final = 0;
    const int masks[7] = {0, 1, 2, 4, 8, 16, 32};
    for (int s = 0; s < 7; ++s) {
        p.do_prologue = (s == 0); p.ph_mask = masks[s]; p.bar_region = s;
        if (s == 6) (void)hipMemcpyAsync(out_prev, p.out, (size_t)MROWS * DM * 4, hipMemcpyDeviceToDevice, stream);
        hipLaunchKernelGGL(mk_fwd, dim3(grid), dim3(512), LDS_BYTES, stream, p);
        hipLaunchKernelGGL(chk_kernel, dim3(64), dim3(256), 0, stream, p, s + 1, (const float*)out_prev);
    }
    hipLaunchKernelGGL(report_kernel, dim3(1024), dim3(256), 0, stream, p.out, (const unsigned*)(p.ws + WS_DIAG), MROWS * DM);
}
#endif

static void fill_params(Params& p, void* const* d_in, void* d_out, void* d_ws) {
    p.x = (const float*)d_in[0]; p.attn_norm_g = (const float*)d_in[1]; p.w_in = (const float*)d_in[2]; p.fox_f_bias = (const float*)d_in[3];
    p.lq1 = (const float*)d_in[4]; p.lk1 = (const float*)d_in[5]; p.lq2 = (const float*)d_in[6]; p.lk2 = (const float*)d_in[7];
    p.subln_g = (const float*)d_in[8]; p.cmp_pos = (const float*)d_in[9]; p.wk1 = (const float*)d_in[10]; p.wk2 = (const float*)d_in[11];
    p.wv1 = (const float*)d_in[12]; p.wv2 = (const float*)d_in[13]; p.w_out = (const float*)d_in[14]; p.ffn_norm_g = (const float*)d_in[15];
    p.w_up = (const float*)d_in[16]; p.conv_w = (const float*)d_in[17]; p.conv_b = (const float*)d_in[18]; p.w_down = (const float*)d_in[19];
    p.rel_bias = (const float*)d_in[20]; p.final_g = (const float*)d_in[21];
    p.out = (float*)d_out; p.ws = (unsigned char*)d_ws;
}
extern "C" void kernel_launch(void* const* d_in, const int* in_sizes, int n_in, void* d_out, int out_size, void* d_ws, size_t ws_size, hipStream_t stream) {
    static int grid = 0;
    if (grid == 0) {
        if (n_in != 22 || out_size != MROWS * DM || ws_size < WS_END) { fprintf(stderr, "kernel_launch: unexpected problem (n_in %d, out %d, ws %zu < %zu)\n", n_in, out_size, ws_size, (size_t)WS_END); grid = -1; return; }
        int dev = 0, cus = 0;
        if (hipGetDevice(&dev) != hipSuccess || hipDeviceGetAttribute(&cus, hipDeviceAttributeMultiprocessorCount, dev) != hipSuccess || cus <= 0) { grid = -1; return; }
        if (hipFuncSetAttribute((const void*)mk_fwd, hipFuncAttributeMaxDynamicSharedMemorySize, LDS_BYTES) != hipSuccess) { fprintf(stderr, "kernel_launch: hipFuncSetAttribute failed\n"); grid = -1; return; }
        int per_cu = 0;
        if (hipOccupancyMaxActiveBlocksPerMultiprocessor(&per_cu, (const void*)mk_fwd, 512, LDS_BYTES) != hipSuccess || per_cu < 1) fprintf(stderr, "kernel_launch: occupancy query says %d\n", per_cu);
        (void)hipGetLastError();
        grid = cus;
    }
    if (grid < 0) return;
    (void)hipMemsetAsync((char*)d_ws + WS_CTL, 0, CTL_ZERO_BYTES, stream);
    Params p{};
    fill_params(p, d_in, d_out, d_ws);
#if !MK_DEBUG
    p.l_begin = 0; p.l_end = DEPTH; p.do_prologue = 1; p.do_final = 1; p.bar_region = 0; p.ph_mask = 63;
    hipLaunchKernelGGL(mk_fwd, dim3(grid), dim3(512), LDS_BYTES, stream, p);
#else
    debug_launches(p, grid, stream);
#endif
}
```

```cpp
#include <hip/hip_runtime.h>
#include <cstdio>
#include <cstdint>

#ifndef MK_DEBUG
#define MK_DEBUG 0
#endif

namespace pg8 {
#define PG8_LAS __attribute__((address_space(3)))
typedef unsigned short bf16_t;
typedef short bf16x8 __attribute__((ext_vector_type(8)));
typedef float f32x4 __attribute__((ext_vector_type(4)));
typedef unsigned u32x4 __attribute__((ext_vector_type(4)));
constexpr int BM = 256, BK = 64, HALF = 128, HTB = HALF * BK * 2  , STAGE_BYTES = 8 * HTB, NXCD = 8, WGM = 8;

__host__ __device__ __forceinline__ int lds_byte(int r, int c) { const int st = (r >> 4) * 2 + (c >> 5), rr = r & 15, cc = c & 31, ob = rr * 64 + cc * 2; return st * 1024 + (ob ^ (((ob >> 9) & 1) << 5)); }
__host__ __device__ __forceinline__ void stage_rc(int b, int& R, int& C) { const int st = b / 1024, sb = b % 1024, swz = sb ^ (((sb >> 9) & 1) << 5); R = (st >> 1) * 16 + swz / 64; C = (st & 1) * 32 + (swz % 64) / 2; }
__host__ __device__ __forceinline__ int perm32(int rho) { const int n = rho >> 4, i = rho & 15; return 8 * (i >> 2) + 4 * n + (i & 3); }

struct Unit { int pm, pn; };
struct Gemm { const bf16_t* A; const bf16_t* Bt; int M, N, K; };

struct StaticOrder {
    int nM, nN, nwg, G, c;
    __host__ __device__ void init(int M, int N, int G_, int c_) { nM = M / BM; nN = N / BM; nwg = nM * nN; G = G_; c = c_; }
    __host__ __device__ bool next(int i, Unit& u) const {
        const long L = (long)i * G + c; if (L >= nwg) return false;
        int wgid = (int)L; { const int q = nwg / NXCD, r = nwg % NXCD, xcd = wgid % NXCD, off = wgid / NXCD; wgid = (xcd < r ? xcd * (q + 1) : r * (q + 1) + (xcd - r) * q) + off; }
        const int nig = WGM * nN, gid = wgid / nig, fm = gid * WGM, gsz = (nM - fm) < WGM ? (nM - fm) : WGM;
        u.pm = fm + ((wgid % nig) % gsz); u.pn = (wgid % nig) / gsz; return true;
    }
    __device__ __forceinline__ void a_ready(const Unit&) const {}
    __device__ __forceinline__ void done(const Unit&) const {}
};
__device__ __forceinline__ unsigned cvt_pk_bf16(float lo, float hi) { unsigned r; asm volatile("v_cvt_pk_bf16_f32 %0, %1, %2" : "=v"(r) : "v"(lo), "v"(hi)); return r; }
typedef float f32x2 __attribute__((ext_vector_type(2)));
template <class Epi, class Sched, bool ALIGN_EPI = false, bool SP2 = false>
__device__ __forceinline__ void gemm_phase(PG8_LAS unsigned char* lds, const Gemm g, const Sched& S, const Epi& E) {
    int tid_l = threadIdx.x; asm volatile("" : "+v"(tid_l));
    const int tid = tid_l, wid = __builtin_amdgcn_readfirstlane(tid >> 6), lane = tid & 63, wr = wid >> 2, wc = wid & 3, fr = lane & 15, fq = lane >> 4;
    const int K = g.K, nt = K / BK;
    unsigned voffA[2], voffB[2]; int aoff, boff;
#define PG8_LANESET() do { int t_ = tid_l; asm volatile("" : "+v"(t_)); const int l_ = t_ & 63, fr_ = l_ & 15, fq_ = l_ >> 4; \
        _Pragma("unroll") for (int i = 0; i < 2; ++i) { int R, C; stage_rc(t_ * 16 + i * 8192, R, C); const int Rb = Epi::PERM ? ((R & ~31) + perm32(R & 31)) : R; \
            const int Ra = Epi::PERMA ? ((R & ~63) + 4 * (R & 15) + ((R >> 4) & 3)) : R; \
            voffA[i] = (unsigned)(Ra * K + C) * 2u; voffB[i] = (unsigned)(Rb * K + C) * 2u; } \
        aoff = lds_byte(wr * 64 + fr_, fq_ * 8); boff = lds_byte(wc * 32 + fr_, fq_ * 8); } while (0)
    PG8_LANESET();
    const size_t kstep = (size_t)(BK * 2);
    const size_t hstep = (size_t)HALF * K * 2;
    const size_t tstep = 2 * hstep;
    const unsigned ldsw = (unsigned)wid * 1024u;
#define PG8_SA(b, h) (((b) * 2 + (h)) * HTB)
#define PG8_SB(b, h) ((4 + (b) * 2 + (h)) * HTB)
#define PG8_STAGE(bufoff, gbase, voff) do { _Pragma("unroll") for (int _i = 0; _i < 2; ++_i) \
        __builtin_amdgcn_global_load_lds((const unsigned*)((const char*)(gbase) + (voff)[_i]), (PG8_LAS unsigned*)(lds + (bufoff) + ldsw + _i * 8192), 16, 0, 0); } while (0)
#define PG8_LDA(dst, b, h) do { _Pragma("unroll") for (int m = 0; m < 4; ++m) _Pragma("unroll") for (int k = 0; k < 2; ++k) dst[m][k] = *(const PG8_LAS bf16x8*)(lds + PG8_SA(b, h) + aoff + m * 2048 + k * 1024); } while (0)
#define PG8_LDB(dst, b, h) do { _Pragma("unroll") for (int n = 0; n < 2; ++n) _Pragma("unroll") for (int k = 0; k < 2; ++k) dst[n][k] = *(const PG8_LAS bf16x8*)(lds + PG8_SB(b, h) + boff + n * 2048 + k * 1024); } while (0)
#define PG8_MMA(ai, bj, At, Bt) do { __builtin_amdgcn_s_setprio(1); _Pragma("unroll") for (int m = 0; m < 4; ++m) _Pragma("unroll") for (int n = 0; n < 2; ++n) _Pragma("unroll") for (int k = 0; k < 2; ++k) \
        acc[ai][bj][m][n] = __builtin_amdgcn_mfma_f32_16x16x32_bf16(Bt[n][k], At[m][k], acc[ai][bj][m][n], 0, 0, 0); __builtin_amdgcn_s_setprio(0); } while (0)
#define PG8_WAIT_V(n) asm volatile("s_waitcnt vmcnt(" #n ")" ::: "memory")
#define PG8_WAIT_L(n) asm volatile("s_waitcnt lgkmcnt(" #n ")" ::: "memory")
#define PG8_BAR __builtin_amdgcn_s_barrier()
#define PG8_SCHED __builtin_amdgcn_sched_barrier(0)
    Unit cur, nxt; int ui = 0;
    if (!S.next(0, cur)) return;
    f32x4 acc[2][2][4][2];
#pragma unroll
    for (int a = 0; a < 2; ++a)
#pragma unroll
        for (int b = 0; b < 2; ++b)
#pragma unroll
            for (int m = 0; m < 4; ++m)
#pragma unroll
                for (int n = 0; n < 2; ++n) acc[a][b][m][n] = (f32x4){0.f, 0.f, 0.f, 0.f};
    bf16x8 At[4][2], B0[2][2], B1[2][2];
    const char* cA = (const char*)g.A + (size_t)cur.pm * tstep; const char* cB = (const char*)g.Bt + (size_t)cur.pn * tstep;
    S.a_ready(cur);
    if constexpr (SP2) {
        PG8_STAGE(PG8_SB(0, 0), cB, voffB); PG8_STAGE(PG8_SB(0, 1), cB + hstep, voffB); PG8_STAGE(PG8_SA(0, 0), cA, voffA); PG8_STAGE(PG8_SA(0, 1), cA + hstep, voffA);
        if (wr == 1) PG8_BAR;
        PG8_WAIT_V(2); PG8_BAR;
        PG8_STAGE(PG8_SB(1, 0), cB + kstep, voffB); PG8_STAGE(PG8_SA(1, 0), cA + kstep, voffA); PG8_STAGE(PG8_SB(1, 1), cB + hstep + kstep, voffB);
        PG8_WAIT_V(6); PG8_BAR;
    } else {
        PG8_STAGE(PG8_SB(0, 0), cB, voffB); PG8_STAGE(PG8_SA(0, 0), cA, voffA); PG8_STAGE(PG8_SB(0, 1), cB + hstep, voffB); PG8_STAGE(PG8_SA(0, 1), cA + hstep, voffA);
        if (wr == 1) PG8_BAR;
        PG8_WAIT_V(4); PG8_BAR;
        PG8_STAGE(PG8_SB(1, 0), cB + kstep, voffB); PG8_STAGE(PG8_SA(1, 0), cA + kstep, voffA); PG8_STAGE(PG8_SB(1, 1), cB + hstep + kstep, voffB);
        PG8_WAIT_V(6); PG8_BAR;
    }
    for (;;) {
        PG8_LANESET();
        const bool has_next = S.next(ui + 1, nxt);
        const char* nA = has_next ? (const char*)g.A + (size_t)nxt.pm * tstep : cA; const char* nB = has_next ? (const char*)g.Bt + (size_t)nxt.pn * tstep : cB;
        for (int t = 0; t < nt; t += 2) {
            const bool last = (t == nt - 2);
            const char* a1 = cA + (size_t)(t + 1) * kstep;
            const char* a2 = last ? nA : cA + (size_t)(t + 2) * kstep; const char* b2 = last ? nB : cB + (size_t)(t + 2) * kstep;
            const char* a3 = a2 + kstep; const char* b3 = b2 + kstep;
            if (last && has_next) S.a_ready(nxt);
            if constexpr (SP2) {
            PG8_LDB(B0, 0, 0); PG8_LDB(B1, 0, 1); PG8_SCHED; PG8_LDA(At, 0, 0); PG8_STAGE(PG8_SA(1, 1), a1 + hstep, voffA);
            PG8_WAIT_V(8); PG8_WAIT_L(0); PG8_BAR; PG8_MMA(0, 0, At, B0); PG8_MMA(0, 1, At, B1); PG8_BAR; PG8_SCHED;
            PG8_LDA(At, 0, 1); PG8_STAGE(PG8_SB(0, 0), b2, voffB); PG8_STAGE(PG8_SB(0, 1), b2 + hstep, voffB); PG8_STAGE(PG8_SA(0, 0), a2, voffA);
            PG8_WAIT_V(8); PG8_WAIT_L(0); PG8_BAR; PG8_MMA(1, 0, At, B0); PG8_MMA(1, 1, At, B1); PG8_BAR; PG8_SCHED;
            PG8_LDB(B0, 1, 0); PG8_LDB(B1, 1, 1); PG8_SCHED; PG8_LDA(At, 1, 0); PG8_STAGE(PG8_SA(0, 1), a2 + hstep, voffA);
            PG8_WAIT_V(8); PG8_WAIT_L(0); PG8_BAR; PG8_MMA(0, 0, At, B0); PG8_MMA(0, 1, At, B1); PG8_BAR; PG8_SCHED;
            PG8_LDA(At, 1, 1); PG8_STAGE(PG8_SB(1, 0), b3, voffB); PG8_STAGE(PG8_SB(1, 1), b3 + hstep, voffB); PG8_STAGE(PG8_SA(1, 0), a3, voffA);
            PG8_WAIT_V(8); PG8_WAIT_L(0); PG8_BAR; PG8_MMA(1, 0, At, B0); PG8_MMA(1, 1, At, B1); PG8_BAR; PG8_SCHED;
            } else {
            PG8_LDB(B0, 0, 0); PG8_SCHED; PG8_LDA(At, 0, 0); PG8_STAGE(PG8_SA(1, 1), a1 + hstep, voffA);
            PG8_WAIT_L(8); PG8_BAR; PG8_WAIT_L(0); PG8_MMA(0, 0, At, B0); PG8_BAR; PG8_SCHED;
            PG8_LDB(B1, 0, 1); PG8_STAGE(PG8_SB(0, 0), b2, voffB);
            PG8_BAR; PG8_WAIT_L(0); PG8_MMA(0, 1, At, B1); PG8_BAR;
            PG8_LDA(At, 0, 1); PG8_STAGE(PG8_SA(0, 0), a2, voffA);
            PG8_BAR; PG8_WAIT_L(0); PG8_MMA(1, 0, At, B0); PG8_BAR; PG8_SCHED;
            PG8_STAGE(PG8_SB(0, 1), b2 + hstep, voffB);
            PG8_WAIT_V(6); PG8_BAR; PG8_MMA(1, 1, At, B1); PG8_BAR;
            PG8_LDB(B0, 1, 0); PG8_SCHED; PG8_LDA(At, 1, 0); PG8_STAGE(PG8_SA(0, 1), a2 + hstep, voffA);
            PG8_WAIT_L(8); PG8_BAR; PG8_WAIT_L(0); PG8_MMA(0, 0, At, B0); PG8_BAR; PG8_SCHED;
            PG8_LDB(B1, 1, 1); PG8_STAGE(PG8_SB(1, 0), b3, voffB);
            PG8_BAR; PG8_WAIT_L(0); PG8_MMA(0, 1, At, B1); PG8_BAR;
            PG8_LDA(At, 1, 1); PG8_STAGE(PG8_SA(1, 0), a3, voffA);
            PG8_BAR; PG8_WAIT_L(0); PG8_MMA(1, 0, At, B0); PG8_BAR; PG8_SCHED;
            PG8_STAGE(PG8_SB(1, 1), b3 + hstep, voffB);
            PG8_WAIT_V(6); PG8_BAR; PG8_MMA(1, 1, At, B1); PG8_BAR;
            }
        }
        if constexpr (ALIGN_EPI) { if (wr == 0) PG8_BAR; }
        if constexpr (!Epi::AFTER_DRAIN) { E(acc, cur, wr, wc, fr, fq); S.done(cur); }
        if (!has_next) break;
#pragma unroll
        for (int a = 0; a < 2; ++a)
#pragma unroll
            for (int b = 0; b < 2; ++b)
#pragma unroll
                for (int m = 0; m < 4; ++m)
#pragma unroll
                    for (int n = 0; n < 2; ++n) acc[a][b][m][n] = (f32x4){0.f, 0.f, 0.f, 0.f};
        cur = nxt; cA = nA; cB = nB; ++ui;
        if constexpr (ALIGN_EPI) { if (wr == 1) PG8_BAR; }
    }
    PG8_WAIT_V(0);
    if constexpr (!ALIGN_EPI) { if (wr == 0) PG8_BAR; }
    PG8_BAR;
    if constexpr (Epi::AFTER_DRAIN) { E.fused(acc, cur, wr, wc, fr, fq, lds, wid, lane); S.done(cur); }
#undef PG8_LANESET
#undef PG8_SA
#undef PG8_SB
#undef PG8_STAGE
#undef PG8_LDA
#undef PG8_LDB
#undef PG8_MMA
#undef PG8_WAIT_V
#undef PG8_WAIT_L
#undef PG8_BAR
#undef PG8_SCHED
}
}
#define GAS __attribute__((address_space(1)))
#define LAS __attribute__((address_space(3)))

constexpr int DM = 2048, NBATCH = 16, SEQ = 2048, DEPTH = 4, MROWS = NBATCH * SEQ;
constexpr int NIN = 6168, NINP = 6176, PROJ_LD = 6144;
constexpr int DFF = 5632, NUP = 2 * DFF;
constexpr float RMS_EPS = 1e-6f;
constexpr float LOG2E = 1.4426950408889634f;
constexpr int C_FQ = 0, C_FK = 768, C_FV = 1536, C_DQ = 2304, C_DK = 2816, C_DV = 3328, C_NQ = 3840, C_NKC = 4608, C_NVC = 4864, C_NKS = 5120, C_NVS = 5376, C_NKW = 5632, C_NVW = 5888;
constexpr int GATE_LD = 32;
__device__ __forceinline__ int win_colmap(int c) {
    if (c < 2304) return c; if (c < 6144) return c + 6; if (c < 6150) return 2304 + (c - 6144); if (c < 6168) return c; return -1;
}
__device__ __forceinline__ int wup_colmap(int c) { const int pn = c >> 8, w = c & 255; return (w < 128) ? (pn * 128 + w) : (DFF + pn * 128 + (w - 128)); }

__constant__ unsigned char T5B[128] = {0, 1, 2, 3, 4, 5, 6, 7, 8, 9, 10, 11, 12, 13, 14, 15, 16, 16, 16, 17, 17, 18, 18, 18, 19, 19, 19, 20, 20, 20, 20, 21, 21, 21, 21, 22, 22, 22, 22, 22, 23, 23, 23, 23, 23, 23, 24, 24, 24, 24, 24, 24, 25, 25, 25, 25, 25, 25, 25, 26, 26, 26, 26, 26, 26, 26, 26, 27, 27, 27, 27, 27, 27, 27, 27, 27, 27, 28, 28, 28, 28, 28, 28, 28, 28, 28, 28, 29, 29, 29, 29, 29, 29, 29, 29, 29, 29, 29, 29, 30, 30, 30, 30, 30, 30, 30, 30, 30, 30, 30, 30, 30, 30, 31, 31, 31, 31, 31, 31, 31, 31, 31, 31, 31, 31, 31, 31, 31};

constexpr size_t al256(size_t x) { return (x + 255) & ~(size_t)255; }
constexpr size_t WS_CTL = 0, CTL_ZERO_BYTES = 1u << 20;
constexpr size_t WS_WIN = CTL_ZERO_BYTES;
constexpr size_t WS_WOUT = WS_WIN + (size_t)DEPTH * NINP * DM * 2;
constexpr size_t WS_WUP = WS_WOUT + (size_t)DEPTH * DM * DM * 2;
constexpr size_t WS_WDN = WS_WUP + (size_t)DEPTH * NUP * DM * 2;
constexpr size_t WS_W1T = WS_WDN + (size_t)DEPTH * DM * DFF * 2;
constexpr size_t WS_W2T = WS_W1T + (size_t)DEPTH * 2 * 128 * 4096 * 2;
constexpr size_t WS_POSC = WS_W2T + (size_t)DEPTH * 2 * 128 * 128 * 2;
constexpr size_t WS_HB = al256(WS_POSC + (size_t)DEPTH * 2 * 128 * 4);
constexpr size_t WS_MIXED = WS_HB + (size_t)MROWS * DM * 2;
constexpr size_t WS_PROJ = WS_MIXED + (size_t)MROWS * DM * 2;
constexpr size_t WS_GATES = WS_PROJ + (size_t)MROWS * PROJ_LD * 2;
constexpr size_t WS_SSQP = WS_GATES + (size_t)MROWS * GATE_LD * 4;
constexpr size_t WS_RSTD = WS_SSQP + (size_t)MROWS * 32 * 4;
constexpr size_t WS_HALO = WS_RSTD + (size_t)MROWS * 4;
constexpr size_t WS_KCMP = WS_HALO + (size_t)128 * 4 * NUP * 4;
constexpr size_t WS_VCMP = WS_KCMP + (size_t)NBATCH * 2 * 128 * 128 * 2;
constexpr size_t WS_CUM = WS_VCMP + (size_t)NBATCH * 2 * 128 * 128 * 2;
constexpr size_t WS_SCR = WS_CUM + (size_t)NBATCH * 6 * SEQ * 4;
constexpr size_t WS_DIAG = WS_SCR + (size_t)256 * 131072;
constexpr size_t WS_END = WS_DIAG + 65536;
static_assert(WS_END + (size_t)MROWS * DM * 4 <= (size_t)4 * DEPTH * DM * NUP * 4, "workspace map (+ the debug build's copy of h) must fit 4x the largest tensor");
constexpr int CW_BAR = 4096;
constexpr int CW_QUEUE = 65536;
constexpr int CW_CONV = 131072;
constexpr int CW_CMPDONE = 98304;

constexpr int RING_BYTES = 131072;
constexpr int LX_CONV = RING_BYTES;
constexpr int LX_MISC = RING_BYTES + 8192;
constexpr int LX_CW = LX_MISC + 256 + 2048;
constexpr int LX_RSTAB = LX_MISC + 256;
static_assert(LX_MISC + 256 + 2048 + 4096 <= 147456, "LDS map");
constexpr int LDS_BYTES = 147456;

typedef unsigned short bf16_t;
typedef short bf16x8 __attribute__((ext_vector_type(8)));
typedef short s16x4 __attribute__((ext_vector_type(4)));
typedef float f32x4 __attribute__((ext_vector_type(4)));
typedef float f32x2 __attribute__((ext_vector_type(2)));
typedef float f32x16 __attribute__((ext_vector_type(16)));
typedef unsigned u32x4 __attribute__((ext_vector_type(4)));
typedef unsigned u32x2 __attribute__((ext_vector_type(2)));

__device__ __forceinline__ int ltid() { int t = threadIdx.x; asm volatile("" : "+v"(t)); return t; }
typedef __bf16 bf16x2_t __attribute__((ext_vector_type(2)));
__device__ __forceinline__ unsigned cvtpk(float lo, float hi) { const f32x2 v = {lo, hi}; const bf16x2_t b = __builtin_convertvector(v, bf16x2_t); return __builtin_bit_cast(unsigned, b); }
__device__ __forceinline__ float bf2f(bf16_t v) { return __builtin_bit_cast(float, (unsigned)v << 16); }
__device__ __forceinline__ float fast_exp2(float x) { return __builtin_amdgcn_exp2f(x); }
__device__ __forceinline__ float fast_rcp(float x) { return __builtin_amdgcn_rcpf(x); }
__device__ __forceinline__ float shx(float v, int o) { return __builtin_bit_cast(float, __builtin_amdgcn_ds_bpermute(((ltid() & 63) ^ o) << 2, __builtin_bit_cast(int, v))); }
__device__ __forceinline__ float wave_sum(float v) {
    const int a = (ltid() & 63) << 2;
#pragma unroll
    for (int o = 1; o < 64; o <<= 1) v += __builtin_bit_cast(float, __builtin_amdgcn_ds_bpermute(a ^ (o << 2), __builtin_bit_cast(int, v)));
    return v;
}
template <int CTRL> __device__ __forceinline__ float dppf(float v) { return __builtin_bit_cast(float, __builtin_amdgcn_mov_dpp(__builtin_bit_cast(int, v), CTRL, 0xF, 0xF, false)); }
template <int CTRL> __device__ __forceinline__ float dppfo(float o, float v) { return __builtin_bit_cast(float, __builtin_amdgcn_update_dpp(__builtin_bit_cast(int, o), __builtin_bit_cast(int, v), CTRL, 0xF, 0xF, false)); }
template <int CTRL> __device__ __forceinline__ f32x4 dpp4o(f32x4 o, f32x4 v) { f32x4 r; r.x = dppfo<CTRL>(o.x, v.x); r.y = dppfo<CTRL>(o.y, v.y); r.z = dppfo<CTRL>(o.z, v.z); r.w = dppfo<CTRL>(o.w, v.w); return r; }
template <int CTRL> __device__ __forceinline__ f32x4 dpp4(f32x4 v) { f32x4 r; r.x = dppf<CTRL>(v.x); r.y = dppf<CTRL>(v.y); r.z = dppf<CTRL>(v.z); r.w = dppf<CTRL>(v.w); return r; }

namespace epi {
using pg8::Unit;

struct InProj {
    static constexpr bool PERM = true, PERMA = true, AFTER_DRAIN = false;
    bf16_t* proj; const __attribute__((address_space(3))) float* rstab;
    __device__ __forceinline__ void operator()(const f32x4 (&acc)[2][2][4][2], const Unit& u, int wr, int wc, int fr, int fq) const {
        { const int ln = ltid() & 63; fr = ln & 15; fq = ln >> 4; }
        const int row0 = u.pm * 256 + wr * 64 + 4 * fr;
        float cs = 1.f;
        if (u.pn < 3) cs = 0.08838834764831845f * LOG2E;
        else if (u.pn == 9 || u.pn == 10) cs = 0.125f * LOG2E;
        else if (u.pn >= 15 && u.pn <= 17) cs = 0.08838834764831845f * LOG2E;
        {
#pragma unroll
            for (int ai = 0; ai < 2; ++ai)
#pragma unroll
                for (int m = 0; m < 4; ++m) {
                    const int row = row0 + ai * 128 + m; const float s = rstab[((u.pm >> 3) & 1) * 256 + (row & 255)] * cs;
                    bf16_t* rp = proj + (size_t)row * PROJ_LD + u.pn * 256 + wc * 32 + 8 * fq;
#pragma unroll
                    for (int bj = 0; bj < 2; ++bj) { const f32x4 v0 = acc[ai][bj][m][0] * s, v1 = acc[ai][bj][m][1] * s;
                        u32x4 w; w.x = cvtpk(v0[0], v0[1]); w.y = cvtpk(v0[2], v0[3]); w.z = cvtpk(v1[0], v1[1]); w.w = cvtpk(v1[2], v1[3]);
                        *(u32x4*)(rp + bj * 128) = w; }
                }
        }
    }
};

struct Resid {
    static constexpr bool PERM = true, PERMA = true, AFTER_DRAIN = false;
    bf16_t* hb; float* ssqp;
    __device__ __forceinline__ void operator()(const f32x4 (&acc)[2][2][4][2], const Unit& u, int wr, int wc, int fr, int fq) const {
        { const int ln = ltid() & 63; fr = ln & 15; fq = ln >> 4; }
        const int row0 = u.pm * 256 + wr * 64 + 4 * fr, col0 = u.pn * 256 + wc * 32 + 8 * fq;
        u32x4 hv[2][4][2];
#pragma unroll
        for (int ai = 0; ai < 2; ++ai)
#pragma unroll
            for (int m = 0; m < 4; ++m)
#pragma unroll
                for (int bj = 0; bj < 2; ++bj) hv[ai][m][bj] = *(const u32x4*)(hb + (size_t)(row0 + ai * 128 + m) * DM + col0 + bj * 128);
#pragma unroll
        for (int ai = 0; ai < 2; ++ai)
#pragma unroll
            for (int m = 0; m < 4; ++m) {
                const int row = row0 + ai * 128 + m; float ss = 0.f;
#pragma unroll
                for (int bj = 0; bj < 2; ++bj) {
                    const size_t off = (size_t)row * DM + col0 + bj * 128;
                    const u32x4 h = hv[ai][m][bj];
                    f32x4 v0, v1;
                    v0[0] = __builtin_bit_cast(float, h.x << 16) + acc[ai][bj][m][0][0]; v0[1] = __builtin_bit_cast(float, h.x & 0xFFFF0000u) + acc[ai][bj][m][0][1];
                    v0[2] = __builtin_bit_cast(float, h.y << 16) + acc[ai][bj][m][0][2]; v0[3] = __builtin_bit_cast(float, h.y & 0xFFFF0000u) + acc[ai][bj][m][0][3];
                    v1[0] = __builtin_bit_cast(float, h.z << 16) + acc[ai][bj][m][1][0]; v1[1] = __builtin_bit_cast(float, h.z & 0xFFFF0000u) + acc[ai][bj][m][1][1];
                    v1[2] = __builtin_bit_cast(float, h.w << 16) + acc[ai][bj][m][1][2]; v1[3] = __builtin_bit_cast(float, h.w & 0xFFFF0000u) + acc[ai][bj][m][1][3];
                    u32x4 w; w.x = cvtpk(v0[0], v0[1]); w.y = cvtpk(v0[2], v0[3]); w.z = cvtpk(v1[0], v1[1]); w.w = cvtpk(v1[2], v1[3]);
                    *(u32x4*)(hb + off) = w;
                    ss += (v0[0] * v0[0] + v0[1] * v0[1]) + (v0[2] * v0[2] + v0[3] * v0[3]) + (v1[0] * v1[0] + v1[1] * v1[1]) + (v1[2] * v1[2] + v1[3] * v1[3]);
                }
                ss += shx(ss, 16); ss += shx(ss, 32);
                if (fq == 0) ssqp[(size_t)row * 32 + u.pn * 4 + wc] = ss;
            }
    }
};

struct UpConv {
    static constexpr bool PERM = true, PERMA = true, AFTER_DRAIN = false;
    bf16_t* act; const __attribute__((address_space(3))) float* rstab; const float* cw; const float* cb; float* halo; __attribute__((address_space(3))) float* ex;
    __device__ __forceinline__ void operator()(const f32x4 (&acc)[2][2][4][2], const Unit& u, int wr, int wc, int fr, int fq) const {
        { const int ln = ltid() & 63; fr = ln & 15; fq = ln >> 4; }
        const int tcol = wc * 32 + 8 * fq, ch0 = u.pn * 128 + tcol;
        const int row0 = u.pm * 256 + wr * 64 + 4 * fr;
        float rs[2][4];
#pragma unroll
        for (int ai = 0; ai < 2; ++ai)
#pragma unroll
            for (int m = 0; m < 4; ++m) rs[ai][m] = rstab[((u.pm >> 3) & 1) * 256 + ((row0 + ai * 128 + m) & 255)];
        __attribute__((address_space(3))) float* cwl = ex + (LX_CW - LX_CONV) / 4;
        { const int t = ltid();
#pragma unroll
          for (int k = 0; k < 2; ++k) { const int i = t + 512 * k, q = i >> 7, cc = i & 127, tap = q >> 1, bjj = q & 1;
              cwl[i] = (tap < 3 ? cw + tap * NUP : cb)[bjj * DFF + u.pn * 128 + cc]; } }
        if (fr == 15) {
#pragma unroll
            for (int ai = 0; ai < 2; ++ai)
#pragma unroll
                for (int bj = 0; bj < 2; ++bj)
#pragma unroll
                    for (int n = 0; n < 2; ++n)
#pragma unroll
                        for (int q = 0; q < 2; ++q) {
                            const f32x4 v = acc[ai][bj][2 + q][n] * rs[ai][2 + q];
                            *(__attribute__((address_space(3))) f32x4*)(ex + ((ai * 2 + wr) * 2 + q) * 256 + bj * 128 + tcol + 4 * n) = v;
                            if (ai == 1 && wr == 1) *(f32x4*)(halo + ((size_t)(u.pm * 4 + 2 + q) * NUP) + u.pn * 256 + bj * 128 + tcol + 4 * n) = v;
                        }
        }
        if (fr == 0 && wr == 0) {
#pragma unroll
            for (int bj = 0; bj < 2; ++bj)
#pragma unroll
                for (int n = 0; n < 2; ++n)
#pragma unroll
                    for (int q = 0; q < 2; ++q)
                        *(f32x4*)(halo + ((size_t)(u.pm * 4 + q) * NUP) + u.pn * 256 + bj * 128 + tcol + 4 * n) = acc[0][bj][q][n] * rs[0][q];
        }
        asm volatile("s_waitcnt lgkmcnt(0)" ::: "memory");
        __builtin_amdgcn_s_barrier();
#pragma unroll
        for (int ai = 0; ai < 2; ++ai) {
            const bool top = (ai == 0 && wr == 0);
            const int pb = (wr ? ai * 2 : (ai * 2 - 1));
#pragma unroll
            for (int n = 0; n < 2; ++n) {
                f32x4 yg[4];
#pragma unroll
                for (int bj = 0; bj < 2; ++bj) {
                    asm volatile("" ::: "memory"); __builtin_amdgcn_sched_barrier(0);
                    const __attribute__((address_space(3))) float* wl = cwl + bj * 128 + tcol + 4 * n;
                    const f32x4 w0 = *(const __attribute__((address_space(3))) f32x4*)wl, w1 = *(const __attribute__((address_space(3))) f32x4*)(wl + 256), w2 = *(const __attribute__((address_space(3))) f32x4*)(wl + 512), bb = *(const __attribute__((address_space(3))) f32x4*)(wl + 768);
                    f32x4 e62 = {0.f, 0.f, 0.f, 0.f}, e63 = {0.f, 0.f, 0.f, 0.f};
                    if (!top) {
                        e62 = *(const __attribute__((address_space(3))) f32x4*)(ex + (pb * 2 + 0) * 256 + bj * 128 + tcol + 4 * n);
                        e63 = *(const __attribute__((address_space(3))) f32x4*)(ex + (pb * 2 + 1) * 256 + bj * 128 + tcol + 4 * n);
                    }
                    f32x4 v[4];
#pragma unroll
                    for (int m = 0; m < 4; ++m) v[m] = acc[ai][bj][m][n] * rs[ai][m];
                    const f32x4 s3 = dpp4o<0x111>(e63, v[3]), s2 = dpp4o<0x111>(e62, v[2]);
                    f32x4 y[4];
                    y[0] = ((bb + w2 * v[0]) + w1 * s3) + w0 * s2;
                    y[1] = ((bb + w2 * v[1]) + w1 * v[0]) + w0 * s3;
                    y[2] = ((bb + w2 * v[2]) + w1 * v[1]) + w0 * v[0];
                    y[3] = ((bb + w2 * v[3]) + w1 * v[2]) + w0 * v[1];
#pragma unroll
                    for (int m = 0; m < 4; ++m) {
                        if (bj == 0) yg[m] = y[m];
                        else {
                            f32x4 o;
#pragma unroll
                            for (int i = 0; i < 4; ++i) o[i] = yg[m][i] * fast_rcp(1.f + fast_exp2(-yg[m][i] * LOG2E)) * y[m][i];
                            if (!(top && fr == 0 && m < 2)) {
                                u32x2 w; w.x = cvtpk(o[0], o[1]); w.y = cvtpk(o[2], o[3]);
                                *(u32x2*)(act + (size_t)(row0 + ai * 128 + m) * DFF + ch0 + 4 * n) = w;
                            }
                        }
                    }
                }
            }
        }
    }
};
}
#define XB_TMO      128
#define XB_XCNT(j)  (256  + 64 * (j))
#define XB_XSUB(j)  (1280 + 64 * (j))
#define XB_XGEN(j)  (2304 + 64 * (j))
#define XB_TOP      3328
#define XB_TOPGEN   3392
#define XCD_BAR_WORDS 3456
#define XB_SPIN_CAP (1u << 18)

__device__ __forceinline__ unsigned xb_ld(unsigned* p)              { return __hip_atomic_load(p, __ATOMIC_RELAXED, __HIP_MEMORY_SCOPE_AGENT); }
__device__ __forceinline__ unsigned xb_add(unsigned* p, unsigned v) { return __hip_atomic_fetch_add(p, v, __ATOMIC_RELAXED, __HIP_MEMORY_SCOPE_AGENT); }
__device__ __forceinline__ unsigned xb_xcc_id() { return (unsigned)__builtin_amdgcn_s_getreg((3 << 11) | 20) & 0xFu; }
#define XB_SPIN(cond, bar) do { unsigned _sp = 0; while (cond) { __builtin_amdgcn_s_sleep(1); \
    if ((++_sp & 255u) == 0u) { if (xb_ld(&(bar)[XB_TMO])) break; if (_sp > XB_SPIN_CAP) { atomicAdd(&(bar)[XB_TMO], 1u); break; } } } } while (0)

struct XcdBarrier {
    unsigned* bar; unsigned x;
    volatile LAS unsigned* st;
};

__device__ __forceinline__ XcdBarrier xcd_barrier_post(unsigned* bar, volatile LAS unsigned* st) {
    XcdBarrier b; b.bar = bar; b.x = xb_xcc_id(); b.st = st;
    if (threadIdx.x == 0) (void)xb_add(&bar[XB_XCNT(b.x)], 1u);
    return b;
}
__device__ __forceinline__ void xcd_barrier_complete(unsigned* bar, unsigned x, unsigned& nloc, unsigned& nx) {
    const unsigned G = gridDim.x * gridDim.y * gridDim.z;
    unsigned sum, cnt, mine, sp = 0u;
    for (;;) {
        sum = 0u; cnt = 0u; mine = 0u;
#pragma unroll
        for (unsigned j = 0; j < 16; ++j) { const unsigned c = xb_ld(&bar[XB_XCNT(j)]); sum += c; cnt += (c > 0u) ? 1u : 0u; mine = (j == x) ? c : mine; }
        if (sum == G) break;
        __builtin_amdgcn_s_sleep(1);
        if ((++sp & 255u) == 0u) { if (xb_ld(&bar[XB_TMO])) break; if (sp > XB_SPIN_CAP) { atomicAdd(&bar[XB_TMO], 1u); break; } }
    }
    nloc = mine > 0u ? mine : 1u; nx = cnt > 0u ? cnt : 1u;
}

__device__ __forceinline__ void xcd_barrier(const XcdBarrier& b) {
    asm volatile("s_waitcnt vmcnt(0)" ::: "memory");
    __syncthreads();
    if (threadIdx.x == 0) {
        unsigned* bar = b.bar; asm volatile("" : "+s"(bar));
        __builtin_amdgcn_s_waitcnt(0);
        unsigned nloc = b.st[0], nx = b.st[1];
        if (nloc == 0u) { xcd_barrier_complete(bar, b.x, nloc, nx); b.st[0] = nloc; b.st[1] = nx; }
        const unsigned old = xb_add(&bar[XB_XSUB(b.x)], 1u);
        const unsigned gen = old / nloc;
        if (old + 1u == (gen + 1u) * nloc) {
            __builtin_amdgcn_fence(__ATOMIC_RELEASE, "agent");
            asm volatile("s_waitcnt vmcnt(0)" ::: "memory");
            const unsigned og = xb_add(&bar[XB_TOP], 1u);
            const unsigned tg = og / nx;
            if (og + 1u == (tg + 1u) * nx) xb_add(&bar[XB_TOPGEN], 1u);
            else XB_SPIN(xb_ld(&bar[XB_TOPGEN]) == tg, bar);
            __builtin_amdgcn_fence(__ATOMIC_ACQUIRE, "agent");
            xb_add(&bar[XB_XGEN(b.x)], 1u);
            asm volatile("s_waitcnt vmcnt(0)" ::: "memory");
        } else {
            XB_SPIN(xb_ld(&bar[XB_XGEN(b.x)]) == gen, bar);
            __builtin_amdgcn_fence(__ATOMIC_ACQUIRE, "agent");
            asm volatile("s_waitcnt vmcnt(0)" ::: "memory");
        }
    }
    __syncthreads();
}

namespace att {
constexpr int SHM = 16384;
constexpr int L_V = 0, L_K = 2 * SHM, L_WS = 4 * SHM, L_CUM = L_WS + 2048, L_LUT = L_CUM + 8192, L_IMP = L_LUT + 5120, L_SEL = L_IMP + 256 * 33 * 4, L_UNI = L_SEL + 1024, L_END = L_UNI + 64;
static_assert(L_END <= RING_BYTES, "attention scratch inside the ring region");
constexpr float THR2 = 11.5f;
enum { K_FOX = 0, K_DIFF = 1, K_SEL = 2, K_WIN = 3, K_CMP = 4 };

#define KSWZ(row, colB) ((row) * 256 + ((colB) ^ (((row) & 7) << 4)))
#define SBAR() __builtin_amdgcn_sched_barrier(0)
__device__ __forceinline__ int v_st(int k, int c) { const int kk = (k & ~0xC) | ((k & 4) << 1) | ((k & 8) >> 1); return ((kk >> 3) * 4 + (c >> 5)) * 512 + ((kk & 7) * 32 + (c & 31)) * 2; }
__device__ __forceinline__ int v_rd_base(int lane) { return ((lane & 3) << 3) | (((lane >> 2) & 3) << 6) | (((lane >> 4) & 1) << 5) | (((lane >> 5) & 1) << 8); }
constexpr int v_rd_off(int d0, int ks, int half) { return d0 * 512 + ks * 4096 + half * 2048; }
__device__ __forceinline__ int crow(int r, int hi) { return (r & 3) + 8 * (r >> 2) + 4 * hi; }
constexpr int ccol(int r) { return (r & 3) + 8 * (r >> 2); }

typedef LAS char* lptr;

template <int NQ>
__device__ __forceinline__ void qkt(f32x16& p0, f32x16& p1, lptr kbuf, int kf0, int r32, int hi, const bf16x8 (&qr)[8]) {
    p0 = f32x16{}; p1 = f32x16{};
    const int kb0 = (int)(uintptr_t)kbuf + (kf0 >> 2) * 128;
    const int ka0 = kb0 + KSWZ(r32, (0 * 16 + hi * 8) * 2), ka1 = kb0 + KSWZ(r32, (1 * 16 + hi * 8) * 2), ka2 = kb0 + KSWZ(r32, (2 * 16 + hi * 8) * 2), ka3 = kb0 + KSWZ(r32, (3 * 16 + hi * 8) * 2);
#define KRD(dst, addr, off) asm volatile("ds_read_b128 %0, %1 offset:%2" : "=&v"(dst) : "v"(addr), "i"(off) : "memory")
#define KRD4(S, aA, aB, off) do { KRD(S[0], aA, off); KRD(S[1], aA, (off) + 8192); KRD(S[2], aB, off); KRD(S[3], aB, (off) + 8192); } while (0)
#define KMM4(S, d) do { p0 = __builtin_amdgcn_mfma_f32_32x32x16_bf16(S[0], qr[d], p0, 0, 0, 0); p1 = __builtin_amdgcn_mfma_f32_32x32x16_bf16(S[1], qr[d], p1, 0, 0, 0); \
                        p0 = __builtin_amdgcn_mfma_f32_32x32x16_bf16(S[2], qr[(d) + 1], p0, 0, 0, 0); p1 = __builtin_amdgcn_mfma_f32_32x32x16_bf16(S[3], qr[(d) + 1], p1, 0, 0, 0); } while (0)
#define LGK(n) asm volatile("s_waitcnt lgkmcnt(" #n ")" ::: "memory")
    bf16x8 A[4], B[4];
    LGK(0); SBAR();
    if (NQ == 8) {
        KRD4(A, ka0, ka1, 0); KRD4(B, ka2, ka3, 0);
        LGK(4); SBAR(); KMM4(A, 0); SBAR(); KRD4(A, ka0, ka1, 128);
        LGK(4); SBAR(); KMM4(B, 2); SBAR(); KRD4(B, ka2, ka3, 128);
        LGK(4); SBAR(); KMM4(A, 4); SBAR();
        LGK(0); SBAR(); KMM4(B, 6);
    } else {
        KRD4(A, ka0, ka1, 0); KRD4(B, ka2, ka3, 0);
        LGK(4); SBAR(); KMM4(A, 0); SBAR();
        LGK(0); SBAR(); KMM4(B, 2);
    }
#undef KRD
#undef KRD4
#undef KMM4
#undef LGK
}
__device__ __forceinline__ void pv_tile(f32x16 (&o)[4], int vb0, bf16x8 pa0, bf16x8 pa1, bf16x8 pa2, bf16x8 pa3) {
#define TRRD(dst, off) asm volatile("ds_read_b64_tr_b16 %0, %1 offset:%2" : "=&v"(dst) : "v"(vb0), "i"(off) : "memory")
#define PV_RD(S, d0) do { constexpr int b_ = v_rd_off(d0, 0, 0); TRRD(S[0], b_); TRRD(S[1], b_ + 2048); TRRD(S[2], b_ + 4096); TRRD(S[3], b_ + 6144); \
                          TRRD(S[4], b_ + 8192); TRRD(S[5], b_ + 10240); TRRD(S[6], b_ + 12288); TRRD(S[7], b_ + 14336); } while (0)
#define PV_MM(S, d0) do { \
        o[d0] = __builtin_amdgcn_mfma_f32_32x32x16_bf16(pa0, (bf16x8){S[0][0], S[0][1], S[0][2], S[0][3], S[1][0], S[1][1], S[1][2], S[1][3]}, o[d0], 0, 0, 0);   \
        o[d0] = __builtin_amdgcn_mfma_f32_32x32x16_bf16(pa1, (bf16x8){S[2][0], S[2][1], S[2][2], S[2][3], S[3][0], S[3][1], S[3][2], S[3][3]}, o[d0], 0, 0, 0);   \
        o[d0] = __builtin_amdgcn_mfma_f32_32x32x16_bf16(pa2, (bf16x8){S[4][0], S[4][1], S[4][2], S[4][3], S[5][0], S[5][1], S[5][2], S[5][3]}, o[d0], 0, 0, 0);   \
        o[d0] = __builtin_amdgcn_mfma_f32_32x32x16_bf16(pa3, (bf16x8){S[6][0], S[6][1], S[6][2], S[6][3], S[7][0], S[7][1], S[7][2], S[7][3]}, o[d0], 0, 0, 0); } while (0)
#define LGK(n) asm volatile("s_waitcnt lgkmcnt(" #n ")" ::: "memory")
    s16x4 A[8], B[8];
    LGK(0); SBAR();
    PV_RD(A, 0); PV_RD(B, 1);
    LGK(8); SBAR(); PV_MM(A, 0); SBAR(); PV_RD(A, 2);
    LGK(8); SBAR(); PV_MM(B, 1); SBAR(); PV_RD(B, 3);
    LGK(8); SBAR(); PV_MM(A, 2); SBAR();
    LGK(0); SBAR(); PV_MM(B, 3);
#undef TRRD
#undef PV_RD
#undef PV_MM
#undef LGK
}
__device__ __forceinline__ void softmax_tile(f32x16& p0, f32x16& p1, float& m_reg, float& l_reg, float& alpha, bf16x8& pa0, bf16x8& pa1, bf16x8& pa2, bf16x8& pa3) {
    float pmax = p0[0];
#pragma unroll
    for (int r = 1; r < 16; ++r) pmax = fmaxf(pmax, p0[r]);
#pragma unroll
    for (int r = 0; r < 16; ++r) pmax = fmaxf(pmax, p1[r]);
    { auto rr = __builtin_amdgcn_permlane32_swap(__float_as_uint(pmax), __float_as_uint(pmax), false, false);
      pmax = fmaxf(__uint_as_float(rr[0]), __uint_as_float(rr[1])); }
    float mn;
    if (__builtin_expect(__all((pmax - m_reg) <= THR2), 1)) { mn = m_reg; alpha = 1.f; }
    else { mn = fmaxf(m_reg, pmax); alpha = fast_exp2(m_reg - mn); m_reg = mn; }
    float ps = 0.f;
#pragma unroll
    for (int r = 0; r < 16; ++r) { p0[r] = fast_exp2(p0[r] - mn); ps += p0[r]; }
#pragma unroll
    for (int r = 0; r < 16; ++r) { p1[r] = fast_exp2(p1[r] - mn); ps += p1[r]; }
    { auto rr = __builtin_amdgcn_permlane32_swap(__float_as_uint(ps), __float_as_uint(ps), false, false);
      ps = __uint_as_float(rr[0]) + __uint_as_float(rr[1]); }
    l_reg = l_reg * alpha + ps;
#define PK4(P, B_, OUT) do { unsigned a0 = cvtpk(P[B_+0], P[B_+1]), a1 = cvtpk(P[B_+2], P[B_+3]);                          \
        unsigned b0 = cvtpk(P[B_+4], P[B_+5]), b1 = cvtpk(P[B_+6], P[B_+7]);                                             \
        auto r0 = __builtin_amdgcn_permlane32_swap(a0, b0, false, false); auto r1 = __builtin_amdgcn_permlane32_swap(a1, b1, false, false); \
        u32x4 w = {r0[0], r1[0], r0[1], r1[1]}; OUT = __builtin_bit_cast(bf16x8, w); } while (0)
    PK4(p0, 0, pa0); PK4(p0, 8, pa1); PK4(p1, 0, pa2); PK4(p1, 8, pa3);
#undef PK4
}
__device__ __forceinline__ void rowbcast(LAS float* wsl, float v, int r32, int hi, float (&out)[16]) {
    if (hi == 0) wsl[r32] = v;
    asm volatile("s_waitcnt lgkmcnt(0)" ::: "memory");
#pragma unroll
    for (int r = 0; r < 16; ++r) out[r] = wsl[crow(r, hi)];
    asm volatile("s_waitcnt lgkmcnt(0)" ::: "memory");
}

template <int KIND>
__device__ __forceinline__ bool wave_act(int j, int qlo, unsigned selm) {
    const int kb = j * 64;
    if (KIND == K_FOX || KIND == K_DIFF) return kb <= qlo + 31;
    if (KIND == K_WIN) return (kb <= qlo + 31) && (kb + 63 >= qlo - 511);
    if (KIND == K_SEL) return (kb <= qlo + 31) && __any((int)((selm >> j) & 1u));
    return true;
}
template <int KIND>
__device__ __forceinline__ void score_fix(f32x16& p0, f32x16& p1, int j, int qlo, int qpos, int hi, const LAS float* lut, const LAS float* cum, unsigned selm) {
    const float NEG = -__builtin_inff();
    const int kb = j * 64, dq = qpos - kb - 4 * hi;
    if (KIND == K_FOX) {
        const LAS float* cb = cum + kb + 4 * hi;
#pragma unroll
        for (int r = 0; r < 16; ++r) { p0[r] += cb[ccol(r)]; p1[r] += cb[ccol(r) + 32]; }
        if (kb + 63 > qlo) {
#pragma unroll
            for (int r = 0; r < 16; ++r) { if (dq - ccol(r) < 0) p0[r] = NEG; if (dq - ccol(r) - 32 < 0) p1[r] = NEG; }
        }
    } else if (KIND == K_CMP) {
        const int dc = qpos - 31 - 16 * (kb + 4 * hi);
#pragma unroll
        for (int r = 0; r < 16; ++r) {
            const int rel0 = dc - 16 * ccol(r), rel1 = rel0 - 512;
            p0[r] += lut[min(max(rel0, 0), 127)]; p1[r] += lut[min(max(rel1, 0), 127)];
            if (rel0 < 0) p0[r] = NEG;
            if (rel1 < 0 || (kb + 4 * hi + ccol(r) + 32 >= 127)) p1[r] = NEG;
        }
    } else {
        if (qlo - (kb + 63) >= 113) {
            const float c31 = lut[127];
#pragma unroll
            for (int r = 0; r < 16; ++r) { p0[r] += c31; p1[r] += c31; }
        } else {
#pragma unroll
            for (int r = 0; r < 16; ++r) { const int rel0 = dq - ccol(r), rel1 = rel0 - 32;
                p0[r] += lut[min(max(rel0, 0), 127)]; p1[r] += lut[min(max(rel1, 0), 127)];
                if (rel0 < 0) p0[r] = NEG; if (rel1 < 0) p1[r] = NEG; }
        }
        if (KIND == K_WIN) {
            if (qlo + 31 - kb >= 512) {
#pragma unroll
                for (int r = 0; r < 16; ++r) { if (dq - ccol(r) >= 512) p0[r] = NEG; if (dq - ccol(r) - 32 >= 512) p1[r] = NEG; }
            }
        }
        if (KIND == K_SEL) {
            if (((selm >> j) & 1u) == 0u) {
#pragma unroll
                for (int r = 0; r < 16; ++r) { p0[r] = NEG; p1[r] = NEG; }
            }
        }
    }
}

template <int KIND, int NQ, int EXPM = 0>
__device__ __forceinline__ void attn_pass(lptr lds, const bf16_t* __restrict__ Kg, const bf16_t* __restrict__ Vg, int kp, int vp, unsigned tilemask,
                                          const bf16x8 (&qr)[8], int kf0, int P0, const LAS float* lut, const LAS float* cum, unsigned selm,
                                          f32x16 (&o)[4], float& m_reg, float& l_reg) {
    const int tid = ltid(), wid = __builtin_amdgcn_readfirstlane(tid >> 6), lane = tid & 63, r32 = lane & 31, hi = lane >> 5;
    const int sr = tid >> 4, sc = (tid & 15) * 8;
    const int kws = KSWZ(sr, sc * 2), vst0 = v_st(sr, sc), vst1 = v_st(32 + sr, sc);
    const int qlo = P0 + wid * 32, qpos = qlo + r32;
    LAS float* wsl = (LAS float*)(lds + L_WS) + wid * 64;
    const int vbase = (int)(uintptr_t)(lds + L_V) + v_rd_base(lane);
    if (tilemask == 0u) return;
    const int kr_ = wid * 4 + (lane >> 4);
    const int kcol_ = (((lane & 15) ^ (kr_ & 7)) * 8);
    const int vsub_ = wid * 2 + (lane >> 5);
    const int vkk_ = ((vsub_ >> 2) << 3) | ((lane & 31) >> 2);
    const int vkey_ = (vkk_ & ~0xC) | ((vkk_ & 4) << 1) | ((vkk_ & 8) >> 1);
    const int vcol_ = (vsub_ & 3) * 32 + (lane & 3) * 8;
    const unsigned dma_w = (unsigned)wid * 1024u;
#define DMA_TILE(jj, bf) do { \
        const bf16_t* kp0_ = Kg + (size_t)((jj) * 64 + kr_) * kp + kcol_; const bf16_t* vp0_ = Vg + (size_t)((jj) * 64 + vkey_) * vp + vcol_; \
        __builtin_amdgcn_global_load_lds((const unsigned*)kp0_, (LAS unsigned*)(lds + L_K + (bf) * SHM + dma_w), 16, 0, 0); \
        __builtin_amdgcn_global_load_lds((const unsigned*)(kp0_ + (size_t)32 * kp), (LAS unsigned*)(lds + L_K + (bf) * SHM + 8192 + dma_w), 16, 0, 0); \
        __builtin_amdgcn_global_load_lds((const unsigned*)vp0_, (LAS unsigned*)(lds + L_V + (bf) * SHM + dma_w), 16, 0, 0); \
        __builtin_amdgcn_global_load_lds((const unsigned*)(vp0_ + (size_t)32 * vp), (LAS unsigned*)(lds + L_V + (bf) * SHM + 8192 + dma_w), 16, 0, 0); } while (0)
#define NEXT_TILE(jv) do { if (tilemask) { jv = __builtin_ctz(tilemask); tilemask &= tilemask - 1u; } else jv = -1; } while (0)
    int j0, j1;
    NEXT_TILE(j0); NEXT_TILE(j1);
    DMA_TILE(j0, 0);
    asm volatile("s_waitcnt vmcnt(0)" ::: "memory");
    __syncthreads();
    int buf = 0;
    for (;;) {
        if (j1 >= 0) DMA_TILE(j1, buf ^ 1);
        if (wave_act<KIND>(j0, qlo, selm)) {
            f32x16 p0, p1;
            qkt<NQ>(p0, p1, lds + L_K + buf * SHM, kf0, r32, hi, qr);
            score_fix<KIND>(p0, p1, j0, qlo, qpos, hi, lut, cum, selm);
            float alpha; bf16x8 pa0, pa1, pa2, pa3;
            softmax_tile(p0, p1, m_reg, l_reg, alpha, pa0, pa1, pa2, pa3);
            if (__any(alpha < 1.f)) {
                float al[16]; rowbcast(wsl, alpha, r32, hi, al);
#pragma unroll
                for (int d = 0; d < 4; ++d)
#pragma unroll
                    for (int r = 0; r < 16; ++r) o[d][r] *= al[r];
            }
            pv_tile(o, vbase + buf * SHM, pa0, pa1, pa2, pa3);
        }
        asm volatile("s_waitcnt vmcnt(0)" ::: "memory");
        __syncthreads();
        if (j1 < 0) break;
        j0 = j1; NEXT_TILE(j1); buf ^= 1;
    }
#undef DMA_TILE
#undef NEXT_TILE
}

__device__ __forceinline__ void fox_pass(lptr lds, const bf16_t* __restrict__ Kg, const bf16_t* __restrict__ Vg, int ntiles, const bf16x8 (&qr)[8], int P0,
                                         const LAS float* cum, f32x16 (&o)[4], float& m_reg, float& l_reg) {
    const int tid = ltid(), wid = __builtin_amdgcn_readfirstlane(tid >> 6), lane = tid & 63, r32 = lane & 31, hi = lane >> 5;
    const int sr = tid >> 4, sc = (tid & 15) * 8;
    const int kws = KSWZ(sr, sc * 2), vst0 = v_st(sr, sc), vst1 = v_st(32 + sr, sc);
    const int qlo = P0 + wid * 32, qpos = qlo + r32;
    LAS float* wsl = (LAS float*)(lds + L_WS) + wid * 64;
    const int vbase = (int)(uintptr_t)(lds + L_V) + v_rd_base(lane);
    const int kbase = (int)(uintptr_t)(lds + L_K);
    const int ko0 = KSWZ(r32, (0 * 16 + hi * 8) * 2), ko1 = KSWZ(r32, (1 * 16 + hi * 8) * 2), ko2 = KSWZ(r32, (2 * 16 + hi * 8) * 2), ko3 = KSWZ(r32, (3 * 16 + hi * 8) * 2);
    const int PITCH = PROJ_LD;
    bf16x8 st_k0, st_k1, st_v0, st_v1;
#define LOADK(jj) do { const size_t kr = (size_t)((jj) * 64 + sr); st_k0 = *(const bf16x8*)(Kg + kr * PITCH + sc); st_k1 = *(const bf16x8*)(Kg + (kr + 32) * PITCH + sc); } while (0)
#define LOADV(jj) do { const size_t kr = (size_t)((jj) * 64 + sr); st_v0 = *(const bf16x8*)(Vg + kr * PITCH + sc); st_v1 = *(const bf16x8*)(Vg + (kr + 32) * PITCH + sc); } while (0)
#define WRITEK(bf) do { *(LAS bf16x8*)(lds + L_K + (bf) * SHM + kws) = st_k0; *(LAS bf16x8*)(lds + L_K + (bf) * SHM + kws + 32 * 256) = st_k1; } while (0)
#define WRITEV(bf) do { *(LAS bf16x8*)(lds + L_V + (bf) * SHM + vst0) = st_v0; *(LAS bf16x8*)(lds + L_V + (bf) * SHM + vst1) = st_v1; } while (0)
#define KRD(dst, addr, off) asm volatile("ds_read_b128 %0, %1 offset:%2" : "=&v"(dst) : "v"(addr), "i"(off) : "memory")
#define KRD4(S, aA, aB, off) do { KRD(S[0], aA, off); KRD(S[1], aA, (off) + 8192); KRD(S[2], aB, off); KRD(S[3], aB, (off) + 8192); } while (0)
#define KMM4(S, d) do { sn0 = __builtin_amdgcn_mfma_f32_32x32x16_bf16(S[0], qr[d], sn0, 0, 0, 0); sn1 = __builtin_amdgcn_mfma_f32_32x32x16_bf16(S[1], qr[d], sn1, 0, 0, 0); \
                        sn0 = __builtin_amdgcn_mfma_f32_32x32x16_bf16(S[2], qr[(d) + 1], sn0, 0, 0, 0); sn1 = __builtin_amdgcn_mfma_f32_32x32x16_bf16(S[3], qr[(d) + 1], sn1, 0, 0, 0); } while (0)
#define LGK(n) asm volatile("s_waitcnt lgkmcnt(" #n ")" ::: "memory")
    LOADK(0); LOADV(0); WRITEK(0); WRITEV(0);
    if (ntiles > 1) { LOADK(1); WRITEK(1); }
    __syncthreads();
    f32x16 sc0, sc1;
    bool actc = 0 <= qlo + 31;
    if (actc) { qkt<8>(sc0, sc1, lds + L_K, 0, r32, hi, qr); score_fix<K_FOX>(sc0, sc1, 0, qlo, qpos, hi, nullptr, cum, 0u); }
    for (int t = 0; t < ntiles; ++t) {
        const int buf = t & 1; const bool has1 = t + 1 < ntiles, has2 = t + 2 < ntiles;
        if (has1) LOADV(t + 1);
        if (has2) LOADK(t + 2);
        const bool actn = has1 && ((t + 1) * 64 <= qlo + 31);
        f32x16 sn0, sn1;
        if (actc && actn && ((t + 1) * 64 + 63 <= qlo)) {
            const int ka = kbase + (buf ^ 1) * SHM;
            const int ka0 = ka + ko0, ka1 = ka + ko1, ka2 = ka + ko2, ka3 = ka + ko3;
            bf16x8 A[4], B[4];
            SBAR(); LGK(0);
            KRD4(A, ka0, ka1, 0); KRD4(B, ka2, ka3, 0);
            SBAR();
            float pmax = sc0[0];
#pragma unroll
            for (int r = 1; r < 16; ++r) pmax = fmaxf(pmax, sc0[r]);
            sn0 = f32x16{}; sn1 = f32x16{};
            SBAR(); LGK(4); SBAR(); KMM4(A, 0); SBAR(); KRD4(A, ka0, ka1, 128); SBAR();
#pragma unroll
            for (int r = 0; r < 16; ++r) pmax = fmaxf(pmax, sc1[r]);
            { auto rr = __builtin_amdgcn_permlane32_swap(__float_as_uint(pmax), __float_as_uint(pmax), false, false);
              pmax = fmaxf(__uint_as_float(rr[0]), __uint_as_float(rr[1])); }
            const bool keep = __all((pmax - m_reg) <= THR2);
            const float mn = keep ? m_reg : fmaxf(m_reg, pmax);
            const float alpha = fast_exp2(m_reg - mn); m_reg = mn;
            SBAR(); LGK(4); SBAR(); KMM4(B, 2); SBAR(); KRD4(B, ka2, ka3, 128); SBAR();
            float ps = 0.f;
#pragma unroll
            for (int r = 0; r < 16; ++r) { sc0[r] = fast_exp2(sc0[r] - mn); ps += sc0[r]; }
            SBAR(); LGK(4); SBAR(); KMM4(A, 4); SBAR();
#pragma unroll
            for (int r = 0; r < 16; ++r) { sc1[r] = fast_exp2(sc1[r] - mn); ps += sc1[r]; }
            SBAR(); LGK(0); SBAR(); KMM4(B, 6); SBAR();
            { auto rr = __builtin_amdgcn_permlane32_swap(__float_as_uint(ps), __float_as_uint(ps), false, false);
              ps = __uint_as_float(rr[0]) + __uint_as_float(rr[1]); }
            l_reg = l_reg * alpha + ps;
            bf16x8 pa0, pa1, pa2, pa3;
#define PK4(P, B_, OUT) do { unsigned a0 = cvtpk(P[B_+0], P[B_+1]), a1 = cvtpk(P[B_+2], P[B_+3]);                          \
        unsigned b0 = cvtpk(P[B_+4], P[B_+5]), b1 = cvtpk(P[B_+6], P[B_+7]);                                             \
        auto r0 = __builtin_amdgcn_permlane32_swap(a0, b0, false, false); auto r1 = __builtin_amdgcn_permlane32_swap(a1, b1, false, false); \
        u32x4 w = {r0[0], r1[0], r0[1], r1[1]}; OUT = __builtin_bit_cast(bf16x8, w); } while (0)
            PK4(sc0, 0, pa0); PK4(sc0, 8, pa1); PK4(sc1, 0, pa2); PK4(sc1, 8, pa3);
#undef PK4
            SBAR();
            if (__any(alpha < 1.f)) {
                float al[16]; rowbcast(wsl, alpha, r32, hi, al);
#pragma unroll
                for (int d = 0; d < 4; ++d)
#pragma unroll
                    for (int r = 0; r < 16; ++r) o[d][r] *= al[r];
            }
            pv_tile(o, vbase + buf * SHM, pa0, pa1, pa2, pa3);
            { const LAS float* cbp = cum + (t + 1) * 64 + 4 * hi;
#pragma unroll
              for (int r = 0; r < 16; ++r) { sn0[r] += cbp[ccol(r)]; sn1[r] += cbp[ccol(r) + 32]; } }
        } else {
            if (actn) qkt<8>(sn0, sn1, lds + L_K + (buf ^ 1) * SHM, 0, r32, hi, qr);
            if (actc) {
                float alpha; bf16x8 pa0, pa1, pa2, pa3;
                softmax_tile(sc0, sc1, m_reg, l_reg, alpha, pa0, pa1, pa2, pa3);
                if (__any(alpha < 1.f)) {
                    float al[16]; rowbcast(wsl, alpha, r32, hi, al);
#pragma unroll
                    for (int d = 0; d < 4; ++d)
#pragma unroll
                        for (int r = 0; r < 16; ++r) o[d][r] *= al[r];
                }
                pv_tile(o, vbase + buf * SHM, pa0, pa1, pa2, pa3);
            }
            if (actn) score_fix<K_FOX>(sn0, sn1, t + 1, qlo, qpos, hi, nullptr, cum, 0u);
        }
        if (has1) WRITEV(buf ^ 1);
        if (has2) WRITEK(buf);
        __syncthreads();
        sc0 = sn0; sc1 = sn1; actc = actn;
    }
#undef LOADK
#undef LOADV
#undef WRITEK
#undef WRITEV
#undef KRD
#undef KRD4
#undef KMM4
#undef LGK
}

template <int NQ>
__device__ __forceinline__ void load_q(bf16x8 (&qr)[8], const bf16_t* proj, int row_first, int col0) {
    const int lane = ltid() & 63, r32 = lane & 31, hi = lane >> 5, wid = ltid() >> 6;
    const bf16_t* q = proj + (size_t)(row_first + wid * 32 + r32) * PROJ_LD + col0 + hi * 8;
#pragma unroll
    for (int d = 0; d < NQ; ++d) qr[d] = *(const bf16x8*)(q + d * 16);
}
__device__ __forceinline__ void store_o(const f32x16 (&o)[4], bf16_t* mixed, int row_first, int col0) {
    const int lane = ltid() & 63, r32 = lane & 31, hi = lane >> 5, wid = ltid() >> 6;
    const bool odd = (r32 & 1) != 0;
    bf16_t* base = mixed + (size_t)(row_first + wid * 32) * DM + col0 + (r32 & ~1);
#pragma unroll
    for (int rp = 0; rp < 8; ++rp) { const int orow = crow(2 * rp + (odd ? 1 : 0), hi);
#pragma unroll
        for (int d = 0; d < 4; ++d) { const float va = o[d][2 * rp], vb = o[d][2 * rp + 1];
            const float y = dppf<0xB1>(odd ? va : vb);
            *(unsigned*)(base + (size_t)orow * DM + d * 32) = odd ? cvtpk(y, vb) : cvtpk(va, y); } }
}
__device__ __forceinline__ void scr_acc(float* scr, const f32x16 (&o)[4], const float (&f)[16], bool add) {
    f32x4* s = (f32x4*)(scr + (ltid() >> 6) * 4096) + (ltid() & 63);
#pragma unroll
    for (int d = 0; d < 4; ++d)
#pragma unroll
        for (int q = 0; q < 4; ++q) { f32x4 v; v.x = o[d][4 * q] * f[4 * q]; v.y = o[d][4 * q + 1] * f[4 * q + 1]; v.z = o[d][4 * q + 2] * f[4 * q + 2]; v.w = o[d][4 * q + 3] * f[4 * q + 3];
            if (add) v += s[(d * 4 + q) * 64]; s[(d * 4 + q) * 64] = v; }
}
__device__ __forceinline__ void scr_load(const float* scr, f32x16 (&o)[4]) {
    const f32x4* s = (const f32x4*)(scr + (ltid() >> 6) * 4096) + (ltid() & 63);
#pragma unroll
    for (int d = 0; d < 4; ++d)
#pragma unroll
        for (int q = 0; q < 4; ++q) { const f32x4 v = s[(d * 4 + q) * 64]; o[d][4 * q] = v.x; o[d][4 * q + 1] = v.y; o[d][4 * q + 2] = v.z; o[d][4 * q + 3] = v.w; }
}

template <int EXPM = 0>
__device__ __forceinline__ void fox_unit(lptr lds, const bf16_t* proj, const float* gates, float fbias, bf16_t* mixed, int b, int h, int qb) {
    const int tid = ltid(), wid = tid >> 6, lane = tid & 63, r32 = lane & 31, hi = lane >> 5;
    const int P0 = qb * 256, rowb = b * SEQ;
    LAS float* cum = (LAS float*)(lds + L_CUM);
    { const int nk = P0 + 256; float run = 0.f; const bool on = 4 * tid < nk;
      float xs[4];
#pragma unroll
      for (int i = 0; i < 4; ++i) xs[i] = gates[(size_t)(rowb + 4 * tid + i) * GATE_LD + h] + fbias;
      if (on) {
#pragma unroll
          for (int i = 0; i < 4; ++i) { const float xx = xs[i];
              run += fminf(xx, 0.f) - __logf(1.f + __expf(-fabsf(xx))); cum[4 * tid + i] = run; }
      }
      float inc = run;
#pragma unroll
      for (int o = 1; o < 64; o <<= 1) { const float t = __builtin_bit_cast(float, __builtin_amdgcn_ds_bpermute(((lane - o) & 63) << 2, __builtin_bit_cast(int, inc))); if (lane >= o) inc += t; }
      LAS float* wsum = (LAS float*)(lds + L_WS);
      if (lane == 63) wsum[wid] = inc;
      __syncthreads();
      float base = 0.f;
#pragma unroll
      for (int w = 0; w < 8; ++w) if (w < wid) base += wsum[w];
      const float ex = base + inc - run;
      if (on) {
#pragma unroll 1
          for (int i = 0; i < 4; ++i) cum[4 * tid + i] = (ex + cum[4 * tid + i]) * LOG2E; }
      __syncthreads();
      const float cref = cum[P0];
      __syncthreads();
      if (on) {
#pragma unroll 1
          for (int i = 0; i < 4; ++i) cum[4 * tid + i] = cref - cum[4 * tid + i]; }
    }
    bf16x8 qr[8]; load_q<8>(qr, proj, rowb + P0, C_FQ + h * 128);
    __syncthreads();
    f32x16 o[4] = {}; float m_reg = -1e30f, l_reg = 0.f;
    const unsigned tm = (qb == 7) ? 0xFFFFFFFFu : ((1u << (4 * (qb + 1))) - 1u);
    if (false) fox_pass(lds, proj + (size_t)rowb * PROJ_LD + C_FK + h * 128, proj + (size_t)rowb * PROJ_LD + C_FV + h * 128, 4 * (qb + 1), qr, P0, cum, o, m_reg, l_reg);
    else attn_pass<K_FOX, 8, EXPM>(lds, proj + (size_t)rowb * PROJ_LD + C_FK + h * 128, proj + (size_t)rowb * PROJ_LD + C_FV + h * 128, PROJ_LD, PROJ_LD, tm, qr, 0, P0, nullptr, cum, 0u, o, m_reg, l_reg);
    float f[16]; rowbcast((LAS float*)(lds + L_WS) + wid * 64, fast_rcp(l_reg), r32, hi, f);
#pragma unroll
    for (int d = 0; d < 4; ++d)
#pragma unroll
        for (int r = 0; r < 16; ++r) o[d][r] *= f[r];
    store_o(o, mixed, rowb + P0, h * 128);
    __syncthreads();
}
__device__ __forceinline__ void diff_unit(lptr lds, const bf16_t* proj, bf16_t* mixed, float* scr, int b, int h, int qb, float lam, float out_scale, const float* subln_g) {
    const int tid = ltid(), wid = tid >> 6, lane = tid & 63, r32 = lane & 31, hi = lane >> 5;
    const int P0 = qb * 256, rowb = b * SEQ;
    const LAS float* lut = (const LAS float*)(lds + L_LUT) + h * 128;
    LAS float* wsl = (LAS float*)(lds + L_WS) + wid * 64;
    const unsigned tm = (qb == 7) ? 0xFFFFFFFFu : ((1u << (4 * (qb + 1))) - 1u);
    const bf16_t* Kg = proj + (size_t)rowb * PROJ_LD + C_DK + h * 128; const bf16_t* Vg = proj + (size_t)rowb * PROJ_LD + C_DV + h * 128;
#pragma unroll 1
    for (int mp = 0; mp < 2; ++mp) {
        bf16x8 qr[8]; load_q<4>(qr, proj, rowb + P0, C_DQ + h * 128 + mp * 64);
        f32x16 o[4] = {}; float m_reg = -1e30f, l_reg = 0.f;
        attn_pass<K_DIFF, 4>(lds, Kg, Vg, PROJ_LD, PROJ_LD, tm, qr, mp * 4, P0, lut, nullptr, 0u, o, m_reg, l_reg);
        float f[16]; rowbcast(wsl, (mp == 0 ? 1.f : -lam) * fast_rcp(l_reg), r32, hi, f);
        scr_acc(scr, o, f, mp != 0);
    }
    f32x16 ot[4]; scr_load(scr, ot);
    float gcol[4];
#pragma unroll
    for (int d = 0; d < 4; ++d) gcol[d] = subln_g[d * 32 + r32] * out_scale;
#pragma unroll
    for (int r = 0; r < 16; ++r) {
        float ss = ot[0][r] * ot[0][r] + ot[1][r] * ot[1][r] + ot[2][r] * ot[2][r] + ot[3][r] * ot[3][r];
        ss += shx(ss, 1); ss += shx(ss, 2); ss += shx(ss, 4); ss += shx(ss, 8); ss += shx(ss, 16);
        const float rn = __builtin_amdgcn_rsqf(ss * (1.f / 128.f) + RMS_EPS);
#pragma unroll
        for (int d = 0; d < 4; ++d) ot[d][r] *= rn * gcol[d];
    }
    store_o(ot, mixed, rowb + P0, 768 + h * 128);
    __syncthreads();
}
__device__ __forceinline__ void nsa_unit(lptr lds, const bf16_t* proj, const float* gates, const bf16_t* kcmp, const bf16_t* vcmp, bf16_t* mixed, float* scr, int b, int g, int qb) {
    const int tid = ltid(), wid = tid >> 6, lane = tid & 63, r32 = lane & 31, hi = lane >> 5;
    const int P0 = qb * 256, rowb = b * SEQ;
    const int qlo = P0 + wid * 32, qpos = qlo + r32;
    LAS float* wsl = (LAS float*)(lds + L_WS) + wid * 64;
    LAS float* imp = (LAS float*)(lds + L_IMP);
    LAS unsigned* sel = (LAS unsigned*)(lds + L_SEL);
    LAS unsigned* uni = (LAS unsigned*)(lds + L_UNI);
    const float NEG = -__builtin_inff();
    const bf16_t* kc = kcmp + (size_t)(b * 2 + g) * 128 * 128; const bf16_t* vc = vcmp + (size_t)(b * 2 + g) * 128 * 128;
    { const int sr = tid >> 4, sc = (tid & 15) * 8, kws = KSWZ(sr, sc * 2);
#pragma unroll
      for (int t = 0; t < 2; ++t) { const bf16x8 a = *(const bf16x8*)(kc + (size_t)(t * 64 + sr) * 128 + sc), c = *(const bf16x8*)(kc + (size_t)(t * 64 + 32 + sr) * 128 + sc);
          *(LAS bf16x8*)(lds + L_K + t * SHM + kws) = a; *(LAS bf16x8*)(lds + L_K + t * SHM + kws + 32 * 256) = c; }
      if (tid == 0) uni[0] = 0u; }
    __syncthreads();
    float ia[16], ic[16];
#pragma unroll
    for (int i = 0; i < 16; ++i) { ia[i] = 0.f; ic[i] = 0.f; }
#pragma unroll 1
    for (int hh = 0; hh < 3; ++hh) {
        const int hd = g * 3 + hh; const LAS float* lut = (const LAS float*)(lds + L_LUT) + (4 + hd) * 128;
        bf16x8 qr[8]; load_q<8>(qr, proj, rowb + P0, C_NQ + hd * 128);
        f32x16 p[4];
        qkt<8>(p[0], p[1], lds + L_K, 0, r32, hi, qr); qkt<8>(p[2], p[3], lds + L_K + SHM, 0, r32, hi, qr);
        float mx = -1e30f;
#pragma unroll
        for (int q4 = 0; q4 < 4; ++q4)
#pragma unroll
            for (int r = 0; r < 16; ++r) { const int n = q4 * 32 + 4 * hi + ccol(r); const int rel = qpos - 31 - 16 * n;
                float s = p[q4][r] + lut[min(max(rel, 0), 127)]; if (rel < 0 || n >= 127) s = NEG; p[q4][r] = s; mx = fmaxf(mx, s); }
        mx = fmaxf(mx, shx(mx, 32));
        float ps = 0.f;
#pragma unroll
        for (int q4 = 0; q4 < 4; ++q4)
#pragma unroll
            for (int r = 0; r < 16; ++r) { p[q4][r] = fast_exp2(p[q4][r] - mx); ps += p[q4][r]; }
        ps += shx(ps, 32);
        const float inv = ps > 0.f ? 1.f / ps : 0.f;
#pragma unroll
        for (int q4 = 0; q4 < 4; ++q4)
#pragma unroll
            for (int i = 0; i < 4; ++i) { const float x0 = p[q4][4 * i] * inv, x1 = p[q4][4 * i + 1] * inv, x2 = p[q4][4 * i + 2] * inv, x3 = p[q4][4 * i + 3] * inv;
                ia[q4 * 4 + i] += x0 + x1 + x2 + 0.5f * x3; ic[q4 * 4 + i] += 0.5f * x3; }
    }
#pragma unroll
    for (int gi = 0; gi < 16; ++gi) {
        const float cp = shx(ic[gi], 32);
        const float cpm = (gi > 0) ? shx(ic[gi > 0 ? gi - 1 : 0], 32) : 0.f;
        const float v = ia[gi] + (hi ? cp : cpm);
        imp[(wid * 32 + r32) * 33 + 2 * gi + hi] = v;
    }
    __syncthreads();
    if (tid < 256) {
        const int t = P0 + tid, blk = t >> 6;
        float sc[32];
#pragma unroll
        for (int j2 = 0; j2 < 32; ++j2) { const bool forced = (j2 == 0) || (j2 == blk) || (j2 == blk - 1);
            sc[j2] = (j2 <= blk) ? (imp[tid * 33 + j2] + (forced ? 1e4f : 0.f)) : -1e30f; }
        unsigned mask = 0u;
#pragma unroll 1
        for (int it = 0; it < 8; ++it) { float best = -1e30f; int bi = -1;
#pragma unroll
            for (int j2 = 0; j2 < 32; ++j2) { const bool free_ = ((mask >> j2) & 1u) == 0u; if (free_ && sc[j2] > best) { best = sc[j2]; bi = j2; } }
            if (bi >= 0 && best > -0.5e30f) mask |= 1u << bi; }
        sel[tid] = mask;
        atomicOr((unsigned*)uni, mask);
    }
    __syncthreads();
    const unsigned selm = sel[wid * 32 + r32];
    const unsigned um = uni[0];
#pragma unroll 1
    for (int hp = 0; hp < 3; ++hp) {
    const int h6 = g * 3 + hp;
    const float* gp = gates + (size_t)(rowb + qpos) * GATE_LD + 6 + h6 * 3;
    const float g0 = 1.f / (1.f + __expf(-gp[0])), g1 = 1.f / (1.f + __expf(-gp[1])), g2 = 1.f / (1.f + __expf(-gp[2]));
    const LAS float* lut = (const LAS float*)(lds + L_LUT) + (4 + h6) * 128;
    bf16x8 qr[8]; load_q<8>(qr, proj, rowb + P0, C_NQ + h6 * 128);
    {
        f32x16 o[4] = {}; float m_reg = -1e30f, l_reg = 0.f;
        attn_pass<K_CMP, 8>(lds, kc, vc, 128, 128, 3u, qr, 0, P0, lut, nullptr, 0u, o, m_reg, l_reg);
        float f[16]; rowbcast(wsl, l_reg > 0.f ? g0 / l_reg : 0.f, r32, hi, f);
        scr_acc(scr, o, f, false);
    }
    {
        f32x16 o[4] = {}; float m_reg = -1e30f, l_reg = 0.f;
        const unsigned cm = (qb == 7) ? 0xFFFFFFFFu : ((1u << (4 * (qb + 1))) - 1u);
        attn_pass<K_SEL, 8>(lds, proj + (size_t)rowb * PROJ_LD + C_NKS + g * 128, proj + (size_t)rowb * PROJ_LD + C_NVS + g * 128, PROJ_LD, PROJ_LD, um & cm, qr, 0, P0, lut, nullptr, selm, o, m_reg, l_reg);
        float f[16]; rowbcast(wsl, l_reg > 0.f ? g1 / l_reg : 0.f, r32, hi, f);
        scr_acc(scr, o, f, true);
    }
    {
        f32x16 o[4] = {}; float m_reg = -1e30f, l_reg = 0.f;
        const int jlo = (P0 - 511) > 0 ? (P0 - 511) >> 6 : 0, jhi = (P0 + 255) >> 6;
        const unsigned hiM = (jhi == 31) ? 0xFFFFFFFFu : ((1u << (jhi + 1)) - 1u);
        const unsigned wm = hiM & ~((1u << jlo) - 1u);
        attn_pass<K_WIN, 8>(lds, proj + (size_t)rowb * PROJ_LD + C_NKW + g * 128, proj + (size_t)rowb * PROJ_LD + C_NVW + g * 128, PROJ_LD, PROJ_LD, wm, qr, 0, P0, lut, nullptr, 0u, o, m_reg, l_reg);
        float f[16]; rowbcast(wsl, l_reg > 0.f ? g2 / l_reg : 0.f, r32, hi, f);
        f32x16 ot[4]; scr_load(scr, ot);
#pragma unroll
        for (int d = 0; d < 4; ++d)
#pragma unroll
            for (int r = 0; r < 16; ++r) ot[d][r] += o[d][r] * f[r];
        store_o(ot, mixed, rowb + P0, 1280 + h6 * 128);
    }
    __syncthreads();
    }
}
#undef KSWZ
}

struct Params {
    const float* x; const float* attn_norm_g; const float* w_in; const float* fox_f_bias; const float* lq1; const float* lk1; const float* lq2; const float* lk2;
    const float* subln_g; const float* cmp_pos; const float* wk1; const float* wk2; const float* wv1; const float* wv2; const float* w_out; const float* ffn_norm_g;
    const float* w_up; const float* conv_w; const float* conv_b; const float* w_down; const float* rel_bias; const float* final_g;
    float* out; unsigned char* ws;
    int l_begin, l_end, do_prologue, do_final, bar_region, ph_mask;
};

typedef const __attribute__((address_space(4))) Params* KP;
__device__ __forceinline__ KP kparams() { unsigned long long a = (unsigned long long)__builtin_amdgcn_kernarg_segment_ptr(); asm volatile("" : "+s"(a)); return (KP)a; }

template <int MAPK>
__device__ __forceinline__ void transpose_item(const float* __restrict__ src, int ldsrc, const float* __restrict__ kscale, bf16_t* __restrict__ dst, int K, int k0, int n0, LAS float* scr, int lane) {
    const int c = n0 + (lane & 31);
    const int oc = (MAPK == 1) ? win_colmap(c) : (MAPK == 2) ? wup_colmap(c) : c;
    const float* sp = src + (size_t)(k0 + (lane >> 5)) * ldsrc + (oc >= 0 ? oc : 0);
    float v[32];
#pragma unroll
    for (int i = 0; i < 32; ++i) v[i] = sp[(size_t)(2 * i) * ldsrc];
    if (kscale) {
#pragma unroll
        for (int i = 0; i < 32; ++i) v[i] *= kscale[k0 + 2 * i + (lane >> 5)];
    }
#pragma unroll
    for (int i = 0; i < 32; ++i) scr[(2 * i + (lane >> 5)) * 33 + (lane & 31)] = (oc < 0) ? 0.f : v[i];
    asm volatile("s_waitcnt lgkmcnt(0)" ::: "memory");
    const int cc = lane & 7;
#pragma unroll
    for (int j = 0; j < 4; ++j) { const int n = (lane >> 3) + 8 * j; const LAS float* s = scr + (8 * cc) * 33 + n;
        u32x4 o; o.x = cvtpk(s[0], s[33]); o.y = cvtpk(s[2 * 33], s[3 * 33]); o.z = cvtpk(s[4 * 33], s[5 * 33]); o.w = cvtpk(s[6 * 33], s[7 * 33]);
        *(u32x4*)(dst + (size_t)(n0 + n) * K + k0 + 8 * cc) = o; }
    asm volatile("s_waitcnt lgkmcnt(0)" ::: "memory");
}

constexpr int T_IN = (DM / 64) * (NINP / 32), T_OUT = (DM / 64) * (DM / 32), T_UP = (DM / 64) * (NUP / 32), T_DN = (DFF / 64) * (DM / 32), T_W1 = (4096 / 64) * 4, T_W2 = 2 * 4;
constexpr int T_LAYER = T_IN + T_OUT + T_UP + T_DN + 2 * T_W1 + 2 * T_W2;
__device__ __forceinline__ void convert_item(KP p, int l, int r, LAS float* scr, int lane) {
    unsigned char* ws = p->ws;
    if (r < T_IN) { const int nb = NINP / 32; transpose_item<1>(p->w_in + (size_t)l * DM * NIN, NIN, p->attn_norm_g + l * DM, (bf16_t*)(ws + WS_WIN) + (size_t)l * NINP * DM, DM, (r / nb) * 64, (r % nb) * 32, scr, lane); return; } r -= T_IN;
    if (r < T_OUT) { const int nb = DM / 32; transpose_item<0>(p->w_out + (size_t)l * DM * DM, DM, nullptr, (bf16_t*)(ws + WS_WOUT) + (size_t)l * DM * DM, DM, (r / nb) * 64, (r % nb) * 32, scr, lane); return; } r -= T_OUT;
    if (r < T_UP) { const int nb = NUP / 32; transpose_item<2>(p->w_up + (size_t)l * DM * NUP, NUP, p->ffn_norm_g + l * DM, (bf16_t*)(ws + WS_WUP) + (size_t)l * NUP * DM, DM, (r / nb) * 64, (r % nb) * 32, scr, lane); return; } r -= T_UP;
    if (r < T_DN) { const int nb = DM / 32; transpose_item<0>(p->w_down + (size_t)l * DFF * DM, DM, nullptr, (bf16_t*)(ws + WS_WDN) + (size_t)l * DM * DFF, DFF, (r / nb) * 64, (r % nb) * 32, scr, lane); return; } r -= T_DN;
    if (r < 2 * T_W1) { const int kv = r / T_W1, rr = r % T_W1; const float* src = (kv ? p->wv1 : p->wk1) + (size_t)l * 4096 * 128;
        transpose_item<0>(src, 128, nullptr, (bf16_t*)(ws + WS_W1T) + (size_t)(l * 2 + kv) * 128 * 4096, 4096, (rr / 4) * 64, (rr % 4) * 32, scr, lane); return; } r -= 2 * T_W1;
    { const int kv = r / T_W2, rr = r % T_W2; const float* src = (kv ? p->wv2 : p->wk2) + (size_t)l * 128 * 128;
        transpose_item<0>(src, 128, nullptr, (bf16_t*)(ws + WS_W2T) + (size_t)(l * 2 + kv) * 128 * 128, 128, (rr / 4) * 64, (rr % 4) * 32, scr, lane); }
}
__device__ __forceinline__ void prologue_phase(KP p, LAS unsigned char* lds) {
    const int tid = ltid(), lane = tid & 63, wave = tid >> 6;
    LAS float* scr = (LAS float*)lds + wave * (64 * 33);
    const int G = gridDim.x, bx = blockIdx.x;
    unsigned char* ws = p->ws;
    for (int it = bx * 8 + wave; it < T_LAYER; it += G * 8) convert_item(p, 0, it, scr, lane);
    __syncthreads();
    { LAS float* scr = (LAS float*)lds;
    for (int it = bx; it < DEPTH * 2 * 8; it += G) {
        const int l = it >> 4, kv = (it >> 3) & 1, c0 = (it & 7) * 16; const float* w1 = (kv ? p->wv1 : p->wk1) + (size_t)l * 4096 * 128; const float* pos = p->cmp_pos + (size_t)l * 4096;
        const int col = c0 + (tid & 15), ks = tid >> 4; float s = 0.f;
#pragma unroll 8
        for (int k = ks * 128; k < ks * 128 + 128; ++k) s += pos[k] * w1[(size_t)k * 128 + col];
        scr[tid] = s; __syncthreads();
        if (tid < 16) { float a = 0.f; for (int j = 0; j < 32; ++j) a += scr[j * 16 + tid]; ((float*)(ws + WS_POSC))[(l * 2 + kv) * 128 + c0 + tid] = a; }
        __syncthreads();
    }
    }
    { const int gw = bx * 8 + wave, NGW = G * 8; bf16_t* hb = (bf16_t*)(ws + WS_HB);
      for (int row = gw; row < MROWS; row += NGW) {
          const f32x4* xr = (const f32x4*)(p->x + (size_t)row * DM) + lane; f32x4 v[8]; float ss = 0.f;
#pragma unroll
          for (int j = 0; j < 8; ++j) { v[j] = xr[64 * j]; ss += (v[j].x * v[j].x + v[j].y * v[j].y) + (v[j].z * v[j].z + v[j].w * v[j].w); }
          ss = wave_sum(ss);
          if (lane < 32) ((float*)(ws + WS_SSQP))[(size_t)row * 32 + lane] = (lane == 0) ? ss : 0.f;
          u32x2* o = (u32x2*)(hb + (size_t)row * DM) + lane;
#pragma unroll
          for (int j = 0; j < 8; ++j) { u32x2 w; w.x = cvtpk(v[j].x, v[j].y); w.y = cvtpk(v[j].z, v[j].w); o[64 * j] = w; }
      } }
}

__device__ __forceinline__ int panel_a() { return 16 * ((int)blockIdx.x & 7) + (((int)blockIdx.x >> 3) & 7); }
__device__ __forceinline__ void rstd_prefix(KP p, LAS unsigned char* lds) {
    const int tid = ltid(); const float* ssqp = (const float*)(p->ws + WS_SSQP); LAS float* rstab = (LAS float*)(lds + LX_RSTAB);
    const int row = (panel_a() + 8 * (tid >> 8)) * 256 + (tid & 255);
    const f32x4* q = (const f32x4*)(ssqp + (size_t)row * 32); float s = 0.f;
#pragma unroll
    for (int j = 0; j < 8; ++j) { const f32x4 v = q[j]; s += (v.x + v.y) + (v.z + v.w); }
    rstab[tid] = __builtin_amdgcn_rsqf(s * (1.f / DM) + RMS_EPS);
    __syncthreads();
}
__device__ __forceinline__ void gate_prefix(KP p, int l, LAS unsigned char* lds) {
    const int tid = ltid(), lane = tid & 63, wave = tid >> 6, r32 = lane & 31, hi = lane >> 5;
    const bf16_t* hb = (const bf16_t*)(p->ws + WS_HB); const bf16_t* wg = (const bf16_t*)(p->ws + WS_WIN) + ((size_t)l * NINP + 6144) * DM;
    float* gates = (float*)(p->ws + WS_GATES); const LAS float* rstab = (const LAS float*)(lds + LX_RSTAB);
    constexpr int WPITCH = DM * 2 + 16;
    for (int i = tid; i < 32 * (DM / 8); i += 512) { const int r = i >> 8, c8 = i & 255; *(LAS bf16x8*)(lds + r * WPITCH + c8 * 16) = *(const bf16x8*)(wg + (size_t)r * DM + c8 * 8); }
    __syncthreads();
    if (wave < 4) {
        const int slot = wave >> 1, prow = ((int)blockIdx.x >> 6) * 64 + (wave & 1) * 32;
        const int row0 = (panel_a() + 8 * slot) * 256 + prow;
        const float rs = rstab[slot * 256 + prow + r32];
        const bf16_t* ap = hb + (size_t)(row0 + r32) * DM + hi * 8; const LAS unsigned char* bp = lds + r32 * WPITCH + hi * 16;
        f32x16 acc = {};
#pragma unroll 1
        for (int k32 = 0; k32 < 4; ++k32) { bf16x8 a[32];
#pragma unroll
            for (int j = 0; j < 32; ++j) a[j] = *(const bf16x8*)(ap + (k32 * 32 + j) * 16);
#pragma unroll
            for (int j = 0; j < 32; ++j) { const bf16x8 b = *(const LAS bf16x8*)(bp + (k32 * 32 + j) * 32); acc = __builtin_amdgcn_mfma_f32_32x32x16_bf16(a[j], b, acc, 0, 0, 0); } }
#pragma unroll
        for (int r = 0; r < 16; ++r) { const int rr = att::crow(r, hi);
            const float rsr = __builtin_bit_cast(float, __builtin_amdgcn_ds_bpermute(rr << 2, __builtin_bit_cast(int, rs)));
            if (r32 < 24) gates[(size_t)(row0 + rr) * GATE_LD + r32] = acc[r] * rsr; }
    }
    __syncthreads();
}
__device__ __forceinline__ void fixup_prefix(KP p, int l) {
    const float* halo = (const float*)(p->ws + WS_HALO); bf16_t* act = (bf16_t*)(p->ws + WS_PROJ);
    const float* cw = p->conv_w + (size_t)l * 3 * NUP; const float* cb = p->conv_b + (size_t)l * NUP;
    const int pa = panel_a();
#pragma unroll 2
    for (int i = ltid(); i < 2 * (DFF / 4); i += 512) {
        const int c4 = i % (DFF / 4), pm = pa + 8 * (i / (DFF / 4)), ch = c4 * 4;
        const int tg = (ch >> 7) * 256 + (ch & 127), tu = tg + 128;
        const bool has_prev = (pm & 7) != 0;
        const float* hc = halo + (size_t)(pm * 4) * NUP; const float* hp = halo + (size_t)((has_prev ? pm - 1 : pm) * 4) * NUP;
        const f32x4 c0g = *(const f32x4*)(hc + tg), c0u = *(const f32x4*)(hc + tu), c1g = *(const f32x4*)(hc + NUP + tg), c1u = *(const f32x4*)(hc + NUP + tu);
        f32x4 p3g = *(const f32x4*)(hp + 3 * NUP + tg), p3u = *(const f32x4*)(hp + 3 * NUP + tu), p2g = *(const f32x4*)(hp + 2 * NUP + tg), p2u = *(const f32x4*)(hp + 2 * NUP + tu);
        const f32x4 w0g = *(const f32x4*)(cw + ch), w1g = *(const f32x4*)(cw + NUP + ch), w2g = *(const f32x4*)(cw + 2 * NUP + ch), bg = *(const f32x4*)(cb + ch);
        const f32x4 w0u = *(const f32x4*)(cw + DFF + ch), w1u = *(const f32x4*)(cw + NUP + DFF + ch), w2u = *(const f32x4*)(cw + 2 * NUP + DFF + ch), bu = *(const f32x4*)(cb + DFF + ch);
        if (!has_prev) { p3g = f32x4{0.f, 0.f, 0.f, 0.f}; p3u = p3g; p2g = p3g; p2u = p3g; }
        float o0[4], o1[4];
#pragma unroll
        for (int e = 0; e < 4; ++e) {
            const float yg0 = w0g[e] * p2g[e] + w1g[e] * p3g[e] + w2g[e] * c0g[e] + bg[e], yu0 = w0u[e] * p2u[e] + w1u[e] * p3u[e] + w2u[e] * c0u[e] + bu[e];
            const float yg1 = w0g[e] * p3g[e] + w1g[e] * c0g[e] + w2g[e] * c1g[e] + bg[e], yu1 = w0u[e] * p3u[e] + w1u[e] * c0u[e] + w2u[e] * c1u[e] + bu[e];
            o0[e] = yg0 * fast_rcp(1.f + fast_exp2(-yg0 * LOG2E)) * yu0; o1[e] = yg1 * fast_rcp(1.f + fast_exp2(-yg1 * LOG2E)) * yu1;
        }
        u32x2 s0, s1; s0.x = cvtpk(o0[0], o0[1]); s0.y = cvtpk(o0[2], o0[3]); s1.x = cvtpk(o1[0], o1[1]); s1.y = cvtpk(o1[2], o1[3]);
        *(u32x2*)(act + (size_t)(pm * 256) * DFF + ch) = s0; *(u32x2*)(act + (size_t)(pm * 256 + 1) * DFF + ch) = s1;
    }
    asm volatile("s_waitcnt vmcnt(0)" ::: "memory");
    __syncthreads();
}
__device__ __forceinline__ void final_phase(KP p) {
    const int lane = ltid() & 63, wave = ltid() >> 6; const float* ssqp = (const float*)(p->ws + WS_SSQP);
    for (int row = blockIdx.x * 8 + wave; row < MROWS; row += gridDim.x * 8) {
        float s = (lane < 32) ? ssqp[(size_t)row * 32 + lane] : 0.f; s = wave_sum(s);
        const float rs = __builtin_amdgcn_rsqf(s * (1.f / DM) + RMS_EPS);
        f32x4* o = (f32x4*)(p->out + (size_t)row * DM) + lane; const f32x4* gq = (const f32x4*)p->final_g + lane;
        const u32x2* hq = (const u32x2*)((const bf16_t*)(p->ws + WS_HB) + (size_t)row * DM) + lane;
#pragma unroll
        for (int j = 0; j < 8; ++j) { const u32x2 hv = hq[64 * j]; const f32x4 gg = gq[64 * j]; f32x4 v;
            v.x = __builtin_bit_cast(float, hv.x << 16); v.y = __builtin_bit_cast(float, hv.x & 0xFFFF0000u); v.z = __builtin_bit_cast(float, hv.y << 16); v.w = __builtin_bit_cast(float, hv.y & 0xFFFF0000u);
            o[64 * j] = v * rs * gg; }
    }
}
__device__ __forceinline__ float gelu_tanh(float x) { const float u = 0.7978845608028654f * (x + 0.044715f * x * x * x); const float e = __expf(2.f * u); const float th = 1.f - 2.f / (e + 1.f); return 0.5f * x * (1.f + th); }
__device__ __forceinline__ void compress_unit(KP p, int l, LAS unsigned char* lds, int upair) {
    const int tid = ltid(), wid = tid >> 6, lane = tid & 63, fr = lane & 15, fq = lane >> 4;
    const int nblk = wid & 3, grp = wid >> 2;
    const int unit = upair * 2 + grp;
    const int mc = unit & 3, kv = (unit >> 2) & 1, g = (unit >> 3) & 1, b = unit >> 4;
    const bf16_t* proj = (const bf16_t*)(p->ws + WS_PROJ);
    const bf16_t* w1t = (const bf16_t*)(p->ws + WS_W1T) + (size_t)(l * 2 + kv) * 128 * 4096;
    const bf16_t* w2t = (const bf16_t*)(p->ws + WS_W2T) + (size_t)(l * 2 + kv) * 128 * 128;
    const float* posc = (const float*)(p->ws + WS_POSC) + (l * 2 + kv) * 128;
    bf16_t* outp = (bf16_t*)(p->ws + (kv ? WS_VCMP : WS_KCMP)) + (size_t)(b * 2 + g) * 128 * 128;
    const bf16_t* arow[2]; const bf16_t* brow[2];
#pragma unroll
    for (int i = 0; i < 2; ++i) { const int n = mc * 32 + i * 16 + fr, nc = n < 127 ? n : 126;
        arow[i] = proj + (size_t)(b * SEQ + 16 * nc) * PROJ_LD + (kv ? C_NVC : C_NKC) + g * 128 + fq * 8;
        brow[i] = w1t + (size_t)(nblk * 32 + i * 16 + fr) * 4096 + fq * 8; }
    f32x4 acc[2][2] = {};
#define CMP_LOAD(A_, B_, LL) do { _Pragma("unroll") for (int i = 0; i < 2; ++i) _Pragma("unroll") for (int j = 0; j < 4; ++j) { \
        A_[i][j] = *(const bf16x8*)(arow[i] + (size_t)(LL) * PROJ_LD + j * 32); B_[i][j] = *(const bf16x8*)(brow[i] + (LL) * 128 + j * 32); } } while (0)
#define CMP_MMA(A_, B_) do { _Pragma("unroll") for (int j = 0; j < 4; ++j) _Pragma("unroll") for (int mi = 0; mi < 2; ++mi) _Pragma("unroll") for (int ni = 0; ni < 2; ++ni) \
        acc[mi][ni] = __builtin_amdgcn_mfma_f32_16x16x32_bf16(A_[mi][j], B_[ni][j], acc[mi][ni], 0, 0, 0); } while (0)
    bf16x8 a0[2][4], b0[2][4], a1[2][4], b1[2][4];
    CMP_LOAD(a0, b0, 0);
#pragma unroll 1
    for (int ll = 0; ll < 32; ll += 2) {
        CMP_LOAD(a1, b1, ll + 1);
        CMP_MMA(a0, b0);
        if (ll + 2 < 32) CMP_LOAD(a0, b0, ll + 2);
        CMP_MMA(a1, b1);
    }
#undef CMP_LOAD
#undef CMP_MMA
    LAS bf16_t* hid = (LAS bf16_t*)(lds + grp * 16384);
#pragma unroll
    for (int ni = 0; ni < 2; ++ni) { const int col = nblk * 32 + ni * 16 + fr; const float pc = posc[col];
#pragma unroll
        for (int mi = 0; mi < 2; ++mi)
#pragma unroll
            for (int i = 0; i < 4; ++i) hid[(mi * 16 + 4 * fq + i) * 136 + col] = (bf16_t)(cvtpk(gelu_tanh(acc[mi][ni][i] + pc), 0.f) & 0xFFFFu); }
    __syncthreads();
    {
        f32x4 acc2[2][2] = {};
#pragma unroll
        for (int j = 0; j < 4; ++j) { bf16x8 a2[2], b2[2];
#pragma unroll
            for (int i = 0; i < 2; ++i) { a2[i] = *(const LAS bf16x8*)(hid + (i * 16 + fr) * 136 + j * 32 + fq * 8); b2[i] = *(const bf16x8*)(w2t + (size_t)(nblk * 32 + i * 16 + fr) * 128 + j * 32 + fq * 8); }
#pragma unroll
            for (int mi = 0; mi < 2; ++mi)
#pragma unroll
                for (int ni = 0; ni < 2; ++ni) acc2[mi][ni] = __builtin_amdgcn_mfma_f32_16x16x32_bf16(a2[mi], b2[ni], acc2[mi][ni], 0, 0, 0); }
#pragma unroll
        for (int mi = 0; mi < 2; ++mi)
#pragma unroll
            for (int ni = 0; ni < 2; ++ni)
#pragma unroll
                for (int i = 0; i < 4; ++i) { const int nr = mc * 32 + mi * 16 + 4 * fq + i; const float v = (nr < 127) ? acc2[mi][ni][i] : 0.f;
                    outp[(size_t)nr * 128 + nblk * 32 + ni * 16 + fr] = (bf16_t)(cvtpk(v, 0.f) & 0xFFFFu); }
    }
    __syncthreads();
}
__device__ __forceinline__ void cumsum_unit(KP p, int l, LAS unsigned char* lds, int unit) {
    const int tid = ltid(), lane = tid & 63, wid = tid >> 6; const int b = unit / 6, h = unit % 6;
    const float* gates = (const float*)(p->ws + WS_GATES); float* c2 = (float*)(p->ws + WS_CUM) + (size_t)unit * SEQ;
    const float fb = p->fox_f_bias[l * 6 + h];
    float v[4], run = 0.f;
#pragma unroll
    for (int i = 0; i < 4; ++i) { const float xx = gates[(size_t)(b * SEQ + 4 * tid + i) * GATE_LD + h] + fb;
        const float ls = fminf(xx, 0.f) - log1pf(__expf(-fabsf(xx))); run += ls; v[i] = run; }
    float inc = run;
#pragma unroll
    for (int o = 1; o < 64; o <<= 1) { const float t = __builtin_bit_cast(float, __builtin_amdgcn_ds_bpermute(((lane - o) & 63) << 2, __builtin_bit_cast(int, inc))); if (lane >= o) inc += t; }
    LAS float* wsum = (LAS float*)lds;
    if (lane == 63) wsum[wid] = inc;
    __syncthreads();
    float base = 0.f;
#pragma unroll
    for (int w = 0; w < 8; ++w) if (w < wid) base += wsum[w];
    const float ex = base + inc - run;
#pragma unroll
    for (int i = 0; i < 4; ++i) c2[4 * tid + i] = (ex + v[i]) * LOG2E;
    __syncthreads();
}

#ifndef ATT_EN
#define ATT_EN 7
#endif
__device__ __forceinline__ void attention_phase(KP p, int lq, LAS unsigned char* lds_u, volatile LAS unsigned* misc) {
#ifdef ATT_DUPK
    const int att_en = (lq >= 4) ? (ATT_DUPK) : (ATT_EN);
#else
    constexpr int att_en = ATT_EN;
#endif
    const int l = lq & 3;
    att::lptr lds = (att::lptr)lds_u;
    const int tid = ltid();
    unsigned* ctl = (unsigned*)(p->ws + WS_CTL);
    const bf16_t* proj = (const bf16_t*)(p->ws + WS_PROJ); bf16_t* mixed = (bf16_t*)(p->ws + WS_MIXED);
    const float* gates = (const float*)(p->ws + WS_GATES);
    float* scr = (float*)(p->ws + WS_SCR) + (size_t)blockIdx.x * 32768;
    const bf16_t* kcmp = (const bf16_t*)(p->ws + WS_KCMP); const bf16_t* vcmp = (const bf16_t*)(p->ws + WS_VCMP);
    { LAS float* lut = (LAS float*)(lds + att::L_LUT);
      for (int i = tid; i < 1280; i += 512) { const int hh = i >> 7, rel = i & 127; lut[i] = p->rel_bias[(int)T5B[rel] * 10 + hh] * LOG2E; } }
    const int lane = tid & 63;
    const float s1 = wave_sum(p->lq1[l * 64 + lane] * p->lk1[l * 64 + lane]), s2 = wave_sum(p->lq2[l * 64 + lane] * p->lk2[l * 64 + lane]);
    const float lam_init = 0.8f - 0.6f * __expf(-0.3f * (float)l);
    const float lam = __expf(s1) - __expf(s2) + lam_init;
    constexpr int QN_CMP = 16, QN_DIFF = 64, QN_NSA = 32, QN_FOX = 96, QN = QN_CMP + QN_DIFF + QN_NSA + QN_FOX;
    if ((tid >> 6) >= 4) __builtin_amdgcn_s_setprio(1); else __builtin_amdgcn_s_setprio(0);
    const int home = (int)(xb_xcc_id() & 7u);
    unsigned cmp_seen = 0u;
    int qx = home;
    __syncthreads();
    for (;;) {
        if (tid == 0) {
            unsigned* qh = ctl + CW_QUEUE + (lq * 8) * 64;
            unsigned iv = __hip_atomic_fetch_add(qh + qx * 64, 1u, __ATOMIC_RELAXED, __HIP_MEMORY_SCOPE_AGENT); int q = qx;
            if (iv >= (unsigned)QN) {
                unsigned hv[7];
#pragma unroll
                for (int k = 1; k < 8; ++k) hv[k - 1] = __hip_atomic_load(qh + ((qx + k) & 7) * 64, __ATOMIC_RELAXED, __HIP_MEMORY_SCOPE_AGENT);
#pragma unroll
                for (int k = 1; k < 8; ++k) if (iv >= (unsigned)QN && hv[k - 1] < (unsigned)QN) {
                    const unsigned t = __hip_atomic_fetch_add(qh + ((qx + k) & 7) * 64, 1u, __ATOMIC_RELAXED, __HIP_MEMORY_SCOPE_AGENT);
                    if (t < (unsigned)QN) { iv = t; q = (qx + k) & 7; } }
            }
            misc[4] = iv; misc[5] = (unsigned)q;
        }
        __syncthreads();
        const int idx = (int)misc[4]; qx = (int)misc[5];
        __syncthreads();
        if (idx >= QN) break;
        unsigned* cdone = ctl + CW_CMPDONE + (lq * 8 + qx) * 64;
        if (idx < QN_CMP) {
            const int gi = qx * 4 + (idx >> 2), pr = idx & 3;
            compress_unit(p, l, lds_u, gi * 4 + pr);
            asm volatile("s_waitcnt vmcnt(0)" ::: "memory");
            __syncthreads();
            if (tid == 0) { __builtin_amdgcn_fence(__ATOMIC_RELEASE, "agent"); asm volatile("s_waitcnt vmcnt(0)" ::: "memory");
                __hip_atomic_fetch_add(cdone, 1u, __ATOMIC_RELAXED, __HIP_MEMORY_SCOPE_AGENT); }
            continue;
        }
        int j = idx - QN_CMP;
        if (j < QN_DIFF) { const int di = qx * 8 + (j & 7), qb = 7 - (j >> 3);
            if (att_en & 2) att::diff_unit(lds, proj, mixed, scr, di >> 2, di & 3, qb, lam, 1.f - lam_init, p->subln_g + l * 128); continue; }
        j -= QN_DIFF;
        if (j < QN_NSA) { const int gi = qx * 4 + (j & 3), qb = 7 - (j >> 2);
            if (!((cmp_seen >> qx) & 1u)) {
                if (tid == 0) { unsigned sp = 0; while (__hip_atomic_load(cdone, __ATOMIC_RELAXED, __HIP_MEMORY_SCOPE_AGENT) < (unsigned)QN_CMP) { __builtin_amdgcn_s_sleep(2); if (++sp > (1u << 22)) break; }
                    __builtin_amdgcn_fence(__ATOMIC_ACQUIRE, "agent"); asm volatile("s_waitcnt vmcnt(0)" ::: "memory"); }
                __syncthreads(); cmp_seen |= 1u << qx; }
            if (att_en & 1) att::nsa_unit(lds, proj, gates, kcmp, vcmp, mixed, scr, gi >> 1, gi & 1, qb); continue; }
        j -= QN_NSA;
        { const int fi = qx * 12 + j % 12, qb = 7 - j / 12;
            if (att_en & 4) att::fox_unit(lds, proj, gates, p->fox_f_bias[l * 6 + fi % 6], mixed, fi / 6, fi % 6, qb); }
    }
    __builtin_amdgcn_s_setprio(0);
    if (l + 1 < DEPTH && lq < 4) {
        const int tid = ltid(); KP p = kparams();
                unsigned* chead = (unsigned*)(p->ws + WS_CTL) + CW_CONV + l * 64;
        LAS float* scrw = (LAS float*)lds_u + (tid >> 6) * (64 * 33);
        constexpr int NCH = (T_LAYER + 63) / 64;
        __syncthreads();
        for (;;) {
            if (tid == 0) misc[4] = __hip_atomic_fetch_add(chead, 1u, __ATOMIC_RELAXED, __HIP_MEMORY_SCOPE_AGENT);
            __syncthreads();
            const int ch = (int)misc[4];
            __syncthreads();
            if (ch >= NCH) break;
#pragma unroll 1
            for (int k = 0; k < 8; ++k) { const int it = ch * 64 + k * 8 + (tid >> 6); if (it < T_LAYER) convert_item(p, l + 1, it, scrw, tid & 63); }
        }
    }
}

#ifndef ATT_EN
#define ATT_EN 7
#endif
#ifndef PH_EN
#define PH_EN 255
#endif
#ifndef DUP
#define DUP 0
#endif
#define DUPLOOP(k) _Pragma("unroll 1") for (int rep_ = 0; rep_ < (((DUP) & (k)) ? 2 : 1); ++rep_)
__global__ void __launch_bounds__(512, 2) mk_fwd(Params p_unused) {
    extern __shared__ __attribute__((aligned(16))) unsigned char lds_raw[];
    LAS unsigned char* lds = (LAS unsigned char*)lds_raw;
    volatile LAS unsigned* misc = (volatile LAS unsigned*)(lds + LX_MISC);
    const int G = gridDim.x;
    if (ltid() < 16) misc[ltid()] = 0u;
    __syncthreads();
    XcdBarrier bar;
    { KP p = kparams(); bar = xcd_barrier_post((unsigned*)(p->ws + WS_CTL) + CW_BAR + p->bar_region * XCD_BAR_WORDS, misc); }
    DUPLOOP(64) { KP p = kparams(); if ((PH_EN & 64) && p->do_prologue) { prologue_phase(p, lds); xcd_barrier(bar); } }

    const int l_begin = kparams()->l_begin, l_end = kparams()->l_end, ph_mask = kparams()->ph_mask;
    for (int l = l_begin; l < l_end; ++l) {
        if ((PH_EN & 1) && (ph_mask & 1)) DUPLOOP(1) {
            KP p = kparams(); unsigned char* ws = p->ws;
            rstd_prefix(p, lds); if (rep_ == 0) gate_prefix(p, l, lds);
            pg8::Gemm g{(const bf16_t*)(ws + WS_HB), (const bf16_t*)(ws + WS_WIN) + (size_t)l * NINP * DM, MROWS, PROJ_LD, DM}; pg8::StaticOrder S; S.init(MROWS, PROJ_LD, G, (int)blockIdx.x);
            epi::InProj E{(bf16_t*)(ws + WS_PROJ), (const LAS float*)(lds + LX_RSTAB)};
            pg8::gemm_phase<epi::InProj, pg8::StaticOrder, true, true>(lds, g, S, E);
            xcd_barrier(bar);
        }
        if ((PH_EN & 4) && (ph_mask & 6)) DUPLOOP(4) {
            attention_phase(kparams(), l + 4 * rep_, lds, misc);
            xcd_barrier(bar);
        }
        if ((PH_EN & 8) && (ph_mask & 8)) DUPLOOP(8) {
            { KP p = kparams(); unsigned char* ws = p->ws;
              pg8::Gemm g{(const bf16_t*)(ws + WS_MIXED), (const bf16_t*)(ws + WS_WOUT) + (size_t)l * DM * DM, MROWS, DM, DM}; pg8::StaticOrder S; S.init(MROWS, DM, G, (int)blockIdx.x);
              epi::Resid E{(bf16_t*)(ws + (rep_ ? WS_END : WS_HB)), (float*)(ws + (rep_ ? WS_END + (size_t)MROWS * DM * 2 : WS_SSQP))};
              pg8::gemm_phase<epi::Resid, pg8::StaticOrder, true, true>(lds, g, S, E); }
            xcd_barrier(bar);
        }
        if ((PH_EN & 16) && (ph_mask & 16)) DUPLOOP(16) {
            { KP p = kparams(); unsigned char* ws = p->ws;
              rstd_prefix(p, lds);
              pg8::Gemm g{(const bf16_t*)(ws + WS_HB), (const bf16_t*)(ws + WS_WUP) + (size_t)l * NUP * DM, MROWS, NUP, DM}; pg8::StaticOrder S; S.init(MROWS, NUP, G, (int)blockIdx.x);
              epi::UpConv E{(bf16_t*)(ws + WS_PROJ), (const LAS float*)(lds + LX_RSTAB), p->conv_w + (size_t)l * 3 * NUP, p->conv_b + (size_t)l * NUP, (float*)(ws + WS_HALO), (LAS float*)(lds + LX_CONV)};
              pg8::gemm_phase<epi::UpConv, pg8::StaticOrder, true, true>(lds, g, S, E); }
            xcd_barrier(bar);
        }
        if ((PH_EN & 32) && (ph_mask & 32)) DUPLOOP(32) {
            { KP p = kparams(); unsigned char* ws = p->ws;
              fixup_prefix(p, l);
              pg8::Gemm g{(const bf16_t*)(ws + WS_PROJ), (const bf16_t*)(ws + WS_WDN) + (size_t)l * DM * DFF, MROWS, DM, DFF}; pg8::StaticOrder S; S.init(MROWS, DM, G, (int)blockIdx.x);
              epi::Resid E{(bf16_t*)(ws + (rep_ ? WS_END : WS_HB)), (float*)(ws + (rep_ ? WS_END + (size_t)MROWS * DM * 2 : WS_SSQP))};
              pg8::gemm_phase<epi::Resid, pg8::StaticOrder, true, true>(lds, g, S, E); }
            xcd_barrier(bar);
        }
    }
    { KP p = kparams(); if ((PH_EN & 128) && p->do_final) final_phase(p); }
}

#if MK_DEBUG
constexpr int NCHK = 16;
#ifndef DBG_SKIP
#define DBG_SKIP 0
#endif
__constant__ int DBG_TS[8] = {0, 1, 255, 256, 700, 1023, 1500, 2047};
__constant__ int DBG_RS[16] = {0, 1, 2, 3, 62, 63, 64, 65, 126, 127, 128, 129, 191, 192, 254, 255};
__constant__ float DBG_TOL[NCHK] = {0, 1e-6f, 1e-3f, 0.03f, 0.03f, 1e-3f, 0.05f, 0.05f, 0.05f, 0.08f, 0.03f, 0.05f, 0.03f, 0, 0, 0};
__device__ __forceinline__ void diag_max(unsigned* diag, int c, float err) { unsigned b = __builtin_bit_cast(unsigned, fabsf(err)); if (err != err) b = 0x7FC00000u; atomicMax(diag + c, b); }
__device__ __forceinline__ void diag_bits(unsigned* diag, int c, unsigned bits) { atomicOr(diag + 16 + c, bits); }
__device__ __forceinline__ unsigned hash_u(unsigned x) { x ^= x >> 16; x *= 0x7feb352du; x ^= x >> 15; x *= 0x846ca68bu; x ^= x >> 16; return x; }
__device__ __forceinline__ float bfr(float v) { return bf2f((bf16_t)(cvtpk(v, 0.f) & 0xFFFFu)); }
__device__ __forceinline__ float blk_sum(float v, float* sh) {
    const int t = threadIdx.x; sh[t] = v; __syncthreads();
    for (int o = 128; o > 0; o >>= 1) { if (t < o) sh[t] += sh[t + o]; __syncthreads(); }
    const float r = sh[0]; __syncthreads(); return r;
}
__device__ __forceinline__ float blk_max(float v, float* sh) {
    const int t = threadIdx.x; sh[t] = v; __syncthreads();
    for (int o = 128; o > 0; o >>= 1) { if (t < o) sh[t] = fmaxf(sh[t], sh[t + o]); __syncthreads(); }
    const float r = sh[0]; __syncthreads(); return r;
}
__device__ __forceinline__ int t5_bucket_ref(int rel) {
    const int n = rel > 0 ? rel : 0; if (n < 16) return n;
    const float nf = (float)n; int large = 16 + (int)(logf(nf / 16.f) / logf(8.f) * 16.f); if (large > 31) large = 31; return large;
}
__device__ __forceinline__ float relerr(float fast, float ref, float scale) { return fabsf(fast - ref) / (fabsf(ref) + scale); }

__global__ void __launch_bounds__(256) chk_kernel(Params p, int stage, const float* out_prev) {
    __shared__ float sh[256];
    __shared__ float sbuf[2304];
    __shared__ float sq[384];
    __shared__ int sidx[16];
    unsigned* diag = (unsigned*)(p.ws + WS_DIAG);
    unsigned char* ws = p.ws;
    const int t = threadIdx.x;
    const bf16_t* hb = (const bf16_t*)(ws + WS_HB); const float* rstd = (const float*)(ws + WS_RSTD);
    const bf16_t* proj = (const bf16_t*)(ws + WS_PROJ); const float* gates = (const float*)(ws + WS_GATES);
    const bf16_t* mixed = (const bf16_t*)(ws + WS_MIXED); const float* c2 = (const float*)(ws + WS_CUM);
    const bf16_t* kcmp = (const bf16_t*)(ws + WS_KCMP); const bf16_t* vcmp = (const bf16_t*)(ws + WS_VCMP);
    const int l = 0;
    if (stage == 2) {
        unsigned bad = 0; const size_t nvec = (size_t)MROWS * PROJ_LD / 8;
        for (size_t i = (size_t)blockIdx.x * 256 + t; i < nvec; i += (size_t)gridDim.x * 256) { const bf16x8 v = ((const bf16x8*)proj)[i];
#pragma unroll
            for (int e = 0; e < 8; ++e) { const float x = bf2f((bf16_t)v[e]); if (!(fabsf(x) < 1000.f)) ++bad; } }
        if (bad) atomicAdd(diag + 13, bad);
    }
    if (stage == 3) {
        unsigned bad = 0;
        for (int i = blockIdx.x * 256 + t; i < NBATCH * 2 * 128 * 128; i += gridDim.x * 256) { const float a = bf2f(kcmp[i]), c = bf2f(vcmp[i]); if (!(fabsf(a) < 1000.f)) ++bad; if (!(fabsf(c) < 1000.f)) bad += 65536u; }
        if (bad & 0xFFFFu) atomicAdd(diag + 14, bad & 0xFFFFu); if (bad >> 16) atomicAdd(diag + 15, bad >> 16);
    }
    for (int smp = blockIdx.x; smp < (stage == 2 ? 512 : 64); smp += gridDim.x) {
        const unsigned h0 = hash_u(smp * 2654435761u + stage * 97u + 12345u), h1 = hash_u(h0 + 1u), h2 = hash_u(h1 + 7u);
        if (stage == 1) {
            const unsigned r0 = hash_u(h0 + t * 31u), r1 = hash_u(r0 + 5u), r2 = hash_u(r1 + 3u);
            { const int ll = r0 & 3, c = r1 % NINP, k = r2 % DM; const int oc = win_colmap(c);
              const float ref = oc >= 0 ? bfr(p.w_in[((size_t)ll * DM + k) * NIN + oc] * p.attn_norm_g[ll * DM + k]) : 0.f;
              diag_max(diag, 1, bf2f(((const bf16_t*)(ws + WS_WIN))[((size_t)ll * NINP + c) * DM + k]) - ref); }
            { const int ll = r0 & 3, c = r1 % DM, k = r2 % DM; const float ref = bfr(p.w_out[((size_t)ll * DM + k) * DM + c]);
              diag_max(diag, 1, bf2f(((const bf16_t*)(ws + WS_WOUT))[((size_t)ll * DM + c) * DM + k]) - ref); }
            { const int ll = r0 & 3, c = r1 % NUP, k = r2 % DM; const int oc = wup_colmap(c); const float ref = bfr(p.w_up[((size_t)ll * DM + k) * NUP + oc] * p.ffn_norm_g[ll * DM + k]);
              diag_max(diag, 1, bf2f(((const bf16_t*)(ws + WS_WUP))[((size_t)ll * NUP + c) * DM + k]) - ref); }
            { const int ll = r0 & 3, c = r1 % DM, k = r2 % DFF; const float ref = bfr(p.w_down[((size_t)ll * DFF + k) * DM + c]);
              diag_max(diag, 1, bf2f(((const bf16_t*)(ws + WS_WDN))[((size_t)ll * DM + c) * DFF + k]) - ref); }
            { const int ll = r0 & 3, kv = (r0 >> 2) & 1, c = r1 % 128, k = r2 % 4096; const float ref = bfr((kv ? p.wv1 : p.wk1)[((size_t)ll * 4096 + k) * 128 + c]);
              diag_max(diag, 1, bf2f(((const bf16_t*)(ws + WS_W1T))[((size_t)(ll * 2 + kv) * 128 + c) * 4096 + k]) - ref); }
            { const int ll = r0 & 3, kv = (r0 >> 2) & 1, c = r1 % 128, k = r2 % 128; const float ref = bfr((kv ? p.wv2 : p.wk2)[((size_t)ll * 128 + k) * 128 + c]);
              diag_max(diag, 1, bf2f(((const bf16_t*)(ws + WS_W2T))[((size_t)(ll * 2 + kv) * 128 + c) * 128 + k]) - ref); }
            { const int row = h0 % MROWS; float ss = 0.f; for (int k = t; k < DM; k += 256) { const float xv = p.x[(size_t)row * DM + k]; ss += xv * xv; diag_max(diag, 2, bf2f(hb[(size_t)row * DM + k]) - bfr(xv)); }
              ss = blk_sum(ss, sh); if (t == 0) diag_max(diag, 2, relerr(rstd[row], 1.f / sqrtf(ss / DM + RMS_EPS), 1e-6f)); }
            { const int ll = h1 & 3, kv = (h1 >> 2) & 1, c = h2 % 128; float s = 0.f; for (int k = t; k < 4096; k += 256) s += p.cmp_pos[(size_t)ll * 4096 + k] * (kv ? p.wv1 : p.wk1)[((size_t)ll * 4096 + k) * 128 + c];
              s = blk_sum(s, sh); if (t == 0) diag_max(diag, 2, relerr(((const float*)(ws + WS_POSC))[(ll * 2 + kv) * 128 + c], s, 1e-3f)); }
        } else if (stage == 2) {
            const int pnn = smp % 25; const int row = h0 % MROWS, c = pnn == 24 ? 6144 + (h1 % 24) : pnn * 256 + (h1 % 256); const int oc = win_colmap(c);
            float ss = 0.f, dot = 0.f;
            for (int k = t; k < DM; k += 256) { const float xv = p.x[(size_t)row * DM + k]; ss += xv * xv; dot += bfr(xv) * bfr(p.w_in[((size_t)l * DM + k) * NIN + oc] * p.attn_norm_g[l * DM + k]); }
            ss = blk_sum(ss, sh); dot = blk_sum(dot, sh);
            if (t == 0) { const float rs = 1.f / sqrtf(ss / DM + RMS_EPS); const int pn = c >> 8;
                float cs = 1.f; if (pn < 3 || (pn >= 15 && pn <= 17)) cs = 0.08838834764831845f * LOG2E; else if (pn == 9 || pn == 10) cs = 0.125f * LOG2E;
                if (c < 6144) { const float fv = bf2f(proj[(size_t)row * PROJ_LD + c]); const float er = relerr(fv, dot * rs * cs, 0.05f); diag_max(diag, 3, er);
                    if (!(er <= 0.03f)) diag_bits(diag, 3, (pn < 9 ? 1u : pn < 15 ? 2u : pn < 18 ? 4u : 8u) | ((row % SEQ) >= 512 ? 16u : 0u) | (fabsf(fv) < 1e-6f ? 32u : 0u)); }
                else diag_max(diag, 4, relerr(gates[(size_t)row * GATE_LD + (c - 6144)], dot * rs, 0.05f)); }
        } else if (stage == 3) {
            if (smp < 24) { if (t == 0) { const int bh = (h0 % 96), b = bh / 6, h = bh % 6; float run = 0.f, worst = 0.f;
                    for (int s = 0; s < SEQ; ++s) { const float xx = gates[(size_t)(b * SEQ + s) * GATE_LD + h] + p.fox_f_bias[l * 6 + h]; run += fminf(xx, 0.f) - log1pf(expf(-fabsf(xx)));
                        worst = fmaxf(worst, relerr(c2[(size_t)bh * SEQ + s], run * LOG2E, 1.f)); float cv = c2[(size_t)bh * SEQ + s]; if (cv != cv) worst = cv; }
                    diag_max(diag, 5, worst); } }
            else { const int b = h0 % NBATCH, g = h1 & 1, kv = (h1 >> 1) & 1, n = (smp & 7) == 7 ? 127 : (smp & 7) == 6 ? 126 : h2 % 127;
                const float* w1 = (kv ? p.wv1 : p.wk1) + (size_t)l * 4096 * 128; const float* w2 = (kv ? p.wv2 : p.wk2) + (size_t)l * 128 * 128;
                if (t < 128) { float s = 0.f; if (n < 127) { for (int ll = 0; ll < 32; ++ll) for (int d = 0; d < 128; ++d)
                        s += bf2f(proj[(size_t)(b * SEQ + 16 * n + ll) * PROJ_LD + (kv ? C_NVC : C_NKC) + g * 128 + d]) * bfr(w1[(size_t)(ll * 128 + d) * 128 + t]);
                        s += ((const float*)(ws + WS_POSC))[(l * 2 + kv) * 128 + t]; const float u = 0.7978845608028654f * (s + 0.044715f * s * s * s); s = 0.5f * s * (1.f + tanhf(u)); }
                    sbuf[t] = bfr(s);
                    if (n < 127) { const int unit = (n >> 5) + 4 * kv + 8 * g + 16 * b; const float hv = ((const float*)(ws + WS_SCR))[(size_t)unit * 4096 + (n & 31) * 128 + t];
                        const float er = relerr(hv, s, 0.05f); if (!(er <= 0.05f)) diag_bits(diag, 6, 1u | (fabsf(hv) > 100.f ? 2u : 0u) | (hv != hv ? 4u : 0u)); } }
                __syncthreads();
                if (t < 128) { float s = 0.f; if (n < 127) for (int j = 0; j < 128; ++j) s += sbuf[j] * bfr(w2[(size_t)j * 128 + t]);
                    const float fv = bf2f((kv ? vcmp : kcmp)[((size_t)(b * 2 + g) * 128 + n) * 128 + t]); const float er = relerr(fv, s, 0.05f);
                    diag_max(diag, 6, er);
                    if (!(er <= 0.05f)) diag_bits(diag, 6, 8u | (kv ? 16u : 0u) | ((n >= 96 && n < 112) ? 32u : 0u)); }
                __syncthreads(); }
        } else if (stage == 4) {
            const int b = h0 % NBATCH, tt = (smp & 1) ? DBG_TS[(smp >> 1) & 7] : (int)(h1 % SEQ);
            const size_t qrow = (size_t)(b * SEQ + tt);
            if (smp < 24) {
                const int h = h2 % 6; const bf16_t* q = proj + qrow * PROJ_LD + C_FQ + h * 128; const float* cc = c2 + (size_t)(b * 6 + h) * SEQ;
                float mx = -1e30f;
                for (int k = t; k <= tt; k += 256) { const bf16_t* kr = proj + (size_t)(b * SEQ + k) * PROJ_LD + C_FK + h * 128; float s = 0.f; for (int d = 0; d < 128; ++d) s += bf2f(q[d]) * bf2f(kr[d]);
                    s += cc[tt] - cc[k]; sbuf[k] = s; mx = fmaxf(mx, s); }
                mx = blk_max(mx, sh); float sum = 0.f;
                for (int k = t; k <= tt; k += 256) { sbuf[k] = exp2f(sbuf[k] - mx); sum += sbuf[k]; }
                sum = blk_sum(sum, sh);
                if (t < 128) { float o = 0.f; for (int k = 0; k <= tt; ++k) o += sbuf[k] * bf2f(proj[(size_t)(b * SEQ + k) * PROJ_LD + C_FV + h * 128 + t]); o /= sum;
                    const float fv = bf2f(mixed[qrow * DM + h * 128 + t]); const float er = relerr(fv, o, 0.05f); diag_max(diag, 7, er);
                    if (!(er <= 0.05f)) diag_bits(diag, 7, (tt < 64 ? 1u : tt < 512 ? 2u : 4u) | ((fabsf(fv) < 1e-6f) ? 8u : 0u) | ((fabsf(fv) > 4.f * fabsf(o) + 0.2f) ? 16u : 0u) | ((fv != fv) ? 32u : 0u)); }
                __syncthreads();
            } else if (smp < 40) {
                const int h = h2 & 3; float* o2 = sq;
                const float lam_init = 0.8f - 0.6f * expf(-0.3f * (float)l);
                float s1 = 0.f, s2 = 0.f; for (int i = 0; i < 64; ++i) { s1 += p.lq1[l * 64 + i] * p.lk1[l * 64 + i]; s2 += p.lq2[l * 64 + i] * p.lk2[l * 64 + i]; }
                const float lam = expf(s1) - expf(s2) + lam_init;
                if (t < 128) o2[t] = 0.f; __syncthreads();
                for (int mp = 0; mp < 2; ++mp) {
                    const bf16_t* q = proj + qrow * PROJ_LD + C_DQ + h * 128 + mp * 64; float mx = -1e30f;
                    for (int k = t; k <= tt; k += 256) { const bf16_t* kr = proj + (size_t)(b * SEQ + k) * PROJ_LD + C_DK + h * 128 + mp * 64; float s = 0.f; for (int d = 0; d < 64; ++d) s += bf2f(q[d]) * bf2f(kr[d]);
                        s += p.rel_bias[t5_bucket_ref(tt - k) * 10 + h] * LOG2E; sbuf[k] = s; mx = fmaxf(mx, s); }
                    mx = blk_max(mx, sh); float sum = 0.f;
                    for (int k = t; k <= tt; k += 256) { sbuf[k] = exp2f(sbuf[k] - mx); sum += sbuf[k]; }
                    sum = blk_sum(sum, sh);
                    if (t < 128) { float o = 0.f; for (int k = 0; k <= tt; ++k) o += sbuf[k] * bf2f(proj[(size_t)(b * SEQ + k) * PROJ_LD + C_DV + h * 128 + t]); o /= sum; o2[t] += (mp == 0 ? o : -lam * o); }
                    __syncthreads();
                }
                float ssq = (t < 128) ? o2[t] * o2[t] : 0.f; ssq = blk_sum(ssq, sh);
                if (t < 128) { const float y = o2[t] * (1.f / sqrtf(ssq / 128.f + RMS_EPS)) * p.subln_g[l * 128 + t] * (1.f - lam_init);
                    const float fv = bf2f(mixed[qrow * DM + 768 + h * 128 + t]); const float er = relerr(fv, y, 0.5f); diag_max(diag, 8, er);
                    if (!(er <= 0.05f)) diag_bits(diag, 8, (tt < 64 ? 1u : tt < 512 ? 2u : 4u) | ((fabsf(fv) < 1e-6f) ? 8u : 0u) | ((fabsf(fv) > 4.f * fabsf(y) + 0.2f) ? 16u : 0u) | ((fv != fv) ? 32u : 0u)); }
                __syncthreads();
            } else {
                const int h6 = h2 % 6, g = h6 / 3; float* pc = sbuf + 2048;
                float* imp = sq + 128; float* oacc = sq + 192;
                if (t < 32) imp[t] = 0.f; if (t < 128) oacc[t] = 0.f; __syncthreads();
                const bf16_t* kc = kcmp + (size_t)(b * 2 + g) * 128 * 128; const bf16_t* vc = vcmp + (size_t)(b * 2 + g) * 128 * 128;
                const float* gp = gates + qrow * GATE_LD + 6 + h6 * 3;
                const float g0 = 1.f / (1.f + expf(-gp[0])), g1 = 1.f / (1.f + expf(-gp[1])), g2 = 1.f / (1.f + expf(-gp[2]));
                for (int hh = 0; hh < 3; ++hh) {
                    const int hd = g * 3 + hh; const bf16_t* q = proj + qrow * PROJ_LD + C_NQ + hd * 128;
                    float s = -1e30f; bool ok = false;
                    if (t < 127) { ok = (16 * t + 31) <= tt; if (ok) { s = 0.f; for (int d = 0; d < 128; ++d) s += bf2f(q[d]) * bf2f(kc[(size_t)t * 128 + d]); s += p.rel_bias[t5_bucket_ref(tt - (16 * t + 31)) * 10 + 4 + hd] * LOG2E; } }
                    const float mx = blk_max(ok ? s : -1e30f, sh); const float e = ok ? exp2f(s - mx) : 0.f; const float sum = blk_sum(e, sh);
                    const float pr = sum > 0.f ? e / sum : 0.f;
                    if (t < 128) pc[t] = pr; __syncthreads();
                    if (t < 32) { float a = 0.f; for (int n = 0; n < 127; ++n) { int lo = max(16 * n, 64 * t), hi2 = min(16 * n + 32, 64 * t + 64); int ov = hi2 - lo; if (ov > 0) a += pc[n] * ((float)ov / 32.f); } imp[t] += a; }
                    if (hd == h6 && t < 128) { float o = 0.f; for (int n = 0; n < 127; ++n) o += pc[n] * bf2f(vc[(size_t)n * 128 + t]); oacc[t] += g0 * o; }
                    __syncthreads();
                }
                if (t == 0) { const int blk = tt >> 6; float* sc = sbuf + 2200; for (int j = 0; j < 32; ++j) { const bool forced = j == 0 || j == blk || j == blk - 1; sc[j] = (j <= blk) ? imp[j] + (forced ? 1e4f : 0.f) : -1e30f; }
                    unsigned m = 0; for (int it = 0; it < 8; ++it) { float best = -1e30f; int bi = -1; for (int j = 0; j < 32; ++j) if (!((m >> j) & 1u) && sc[j] > best) { best = sc[j]; bi = j; } if (bi >= 0 && best > -0.5e30f) m |= 1u << bi; }
                    sidx[0] = (int)m; }
                __syncthreads();
                const unsigned selm = (unsigned)sidx[0];
                for (int br = 0; br < 2; ++br) {
                    const bf16_t* q = proj + qrow * PROJ_LD + C_NQ + h6 * 128; const int kcol = (br == 0 ? C_NKS : C_NKW) + g * 128, vcol = (br == 0 ? C_NVS : C_NVW) + g * 128;
                    float mx = -1e30f;
                    for (int k = t; k <= tt; k += 256) { const bool ok = br == 0 ? ((selm >> (k >> 6)) & 1u) != 0u : (tt - k < 512); float s = -1e30f;
                        if (ok) { const bf16_t* kr = proj + (size_t)(b * SEQ + k) * PROJ_LD + kcol; s = 0.f; for (int d = 0; d < 128; ++d) s += bf2f(q[d]) * bf2f(kr[d]); s += p.rel_bias[t5_bucket_ref(tt - k) * 10 + 4 + h6] * LOG2E; }
                        sbuf[k] = s; mx = fmaxf(mx, s); }
                    mx = blk_max(mx, sh); float sum = 0.f;
                    for (int k = t; k <= tt; k += 256) { sbuf[k] = sbuf[k] > -1e29f ? exp2f(sbuf[k] - mx) : 0.f; sum += sbuf[k]; }
                    sum = blk_sum(sum, sh);
                    if (t < 128) { float o = 0.f; for (int k = 0; k <= tt; ++k) o += sbuf[k] * bf2f(proj[(size_t)(b * SEQ + k) * PROJ_LD + vcol + t]); oacc[t] += (br == 0 ? g1 : g2) * o / sum; }
                    __syncthreads();
                }
                if (t < 128) { const float fv = bf2f(mixed[qrow * DM + 1280 + h6 * 128 + t]); const float er = relerr(fv, oacc[t], 0.05f); diag_max(diag, 9, er);
                    if (!(er <= 0.08f)) diag_bits(diag, 9, (tt < 64 ? 1u : tt < 512 ? 2u : 4u) | ((fabsf(fv) < 1e-6f) ? 8u : 0u) | ((fabsf(fv) > 4.f * fabsf(oacc[t]) + 0.2f) ? 16u : 0u) | ((fv != fv) ? 32u : 0u)); }
                __syncthreads();
            }
        } else if (stage == 5) {
            const int row = h0 % MROWS, col = h1 % DM; float dot = 0.f, ss = 0.f;
            for (int k = t; k < DM; k += 256) { dot += bf2f(mixed[(size_t)row * DM + k]) * bfr(p.w_out[((size_t)l * DM + k) * DM + col]); const float hv = p.out[(size_t)row * DM + k]; ss += hv * hv; }
            dot = blk_sum(dot, sh); ss = blk_sum(ss, sh);
            if (t == 0) { const float ref = p.x[(size_t)row * DM + col] + dot; diag_max(diag, 10, relerr(p.out[(size_t)row * DM + col], ref, 0.05f));
                diag_max(diag, 10, relerr(bf2f(hb[(size_t)row * DM + col]), ref, 0.05f)); diag_max(diag, 10, relerr(rstd[row], 1.f / sqrtf(ss / DM + RMS_EPS), 1e-3f)); }
        } else if (stage == 6) {
            const int pm = h0 % 128, row = pm * 256 + DBG_RS[smp & 15], ch = h1 % DFF, s = row % SEQ;
            float yg = p.conv_b[l * NUP + ch], yu = p.conv_b[l * NUP + DFF + ch];
            for (int tap = 0; tap < 3; ++tap) { const int sp = s - 2 + tap; float dg = 0.f, du = 0.f;
                if (sp >= 0) { const int r2 = row - 2 + tap;
                    for (int k = t; k < DM; k += 256) { const float a = bf2f(hb[(size_t)r2 * DM + k]); const float gk = p.ffn_norm_g[l * DM + k];
                        dg += a * bfr(p.w_up[((size_t)l * DM + k) * NUP + ch] * gk); du += a * bfr(p.w_up[((size_t)l * DM + k) * NUP + DFF + ch] * gk); }
                    dg = blk_sum(dg, sh) * rstd[r2]; du = blk_sum(du, sh) * rstd[r2]; }
                yg += p.conv_w[((size_t)l * 3 + tap) * NUP + ch] * dg; yu += p.conv_w[((size_t)l * 3 + tap) * NUP + DFF + ch] * du; }
            if (t == 0) { const float ref = yg / (1.f + expf(-yg)) * yu; diag_max(diag, 11, relerr(bf2f(proj[(size_t)row * DFF + ch]), ref, 0.05f)); }
        } else if (stage == 7) {
            const int row = h0 % MROWS, col = h1 % DM; float dot = 0.f, ss = 0.f;
            for (int k = t; k < DFF; k += 256) dot += bf2f(proj[(size_t)row * DFF + k]) * bfr(p.w_down[((size_t)l * DFF + k) * DM + col]);
            for (int k = t; k < DM; k += 256) { const float hv = p.out[(size_t)row * DM + k]; ss += hv * hv; }
            dot = blk_sum(dot, sh); ss = blk_sum(ss, sh);
            if (t == 0) { const float ref = out_prev[(size_t)row * DM + col] + dot; diag_max(diag, 12, relerr(p.out[(size_t)row * DM + col], ref, 0.05f));
                diag_max(diag, 12, relerr(bf2f(hb[(size_t)row * DM + col]), ref, 0.05f)); (void)ss; }
        }
    }
}
__global__ void report_kernel(float* out, const unsigned* diag, int n) {
    __shared__ float code, mag;
    if (threadIdx.x == 0) {
        int c = 0; float e = 0.f;
        for (int i = 1; i < 13; ++i) { if ((DBG_SKIP >> i) & 1) continue; const float v = __builtin_bit_cast(float, diag[i]); if (!(v <= DBG_TOL[i])) { c = i; e = v; break; } }
        if (!c || c > 3) { const unsigned n13 = diag[13]; if (n13 && !((DBG_SKIP >> 13) & 1)) { c = 13; e = 0.f; code = 13.f; mag = 100.f * (10.f + fminf(63.f, floorf(log2f((float)n13)) + 1.f)); } }
        if (c != 13 && (!c || c > 6)) { const unsigned n14 = diag[14]; if ((n14 || diag[15]) && !((DBG_SKIP >> 14) & 1)) { c = 14; code = 14.f; const unsigned nk = n14, nv = diag[15]; mag = 100.f * (10.f + (nk ? 32.f : 0.f) + fminf(31.f, (nv ? floorf(log2f((float)nv)) + 1.f : 0.f))); } }
        if (c == 13 || c == 14) { } else {
        code = (float)c; float info = 0.f;
        if (c) { const unsigned bits = diag[16 + c] & 63u; if (bits) info = (float)bits; else if (e != e) info = 89.f; else { info = 64.f + rintf(3.f * (log10f(fmaxf(e, 1e-6f)) + 6.f)); info = fminf(fmaxf(info, 64.f), 88.f); } }
        mag = c ? 100.f * (10.f + info) : 0.f; }
    }
    __syncthreads();
    for (int i = blockIdx.x * blockDim.x + threadIdx.x; i < n; i += gridDim.x * blockDim.x) out[i] = (i == 0) ? mag : code;
}
static void debug_launches(Params p, int grid, hipStream_t stream) {
    float* out_prev = (float*)(p.ws + WS_END);
    (void)hipMemsetAsync(p.ws + WS_DIAG, 0, 256, stream);
    p.l_begin = 0; p.l_end = 1; p.do_final = 0;
    const int masks[7] = {0, 1, 2, 4, 8, 16, 32};
    for (int s = 0; s < 7; ++s) {
        p.do_prologue = (s == 0); p.ph_mask = masks[s]; p.bar_region = s;
        if (s == 6) (void)hipMemcpyAsync(out_prev, p.out, (size_t)MROWS * DM * 4, hipMemcpyDeviceToDevice, stream);
        hipLaunchKernelGGL(mk_fwd, dim3(grid), dim3(512), LDS_BYTES, stream, p);
        hipLaunchKernelGGL(chk_kernel, dim3(64), dim3(256), 0, stream, p, s + 1, (const float*)out_prev);
    }
    hipLaunchKernelGGL(report_kernel, dim3(1024), dim3(256), 0, stream, p.out, (const unsigned*)(p.ws + WS_DIAG), MROWS * DM);
}
#endif

static void fill_params(Params& p, void* const* d_in, void* d_out, void* d_ws) {
    p.x = (const float*)d_in[0]; p.attn_norm_g = (const float*)d_in[1]; p.w_in = (const float*)d_in[2]; p.fox_f_bias = (const float*)d_in[3];
    p.lq1 = (const float*)d_in[4]; p.lk1 = (const float*)d_in[5]; p.lq2 = (const float*)d_in[6]; p.lk2 = (const float*)d_in[7];
    p.subln_g = (const float*)d_in[8]; p.cmp_pos = (const float*)d_in[9]; p.wk1 = (const float*)d_in[10]; p.wk2 = (const float*)d_in[11];
    p.wv1 = (const float*)d_in[12]; p.wv2 = (const float*)d_in[13]; p.w_out = (const float*)d_in[14]; p.ffn_norm_g = (const float*)d_in[15];
    p.w_up = (const float*)d_in[16]; p.conv_w = (const float*)d_in[17]; p.conv_b = (const float*)d_in[18]; p.w_down = (const float*)d_in[19];
    p.rel_bias = (const float*)d_in[20]; p.final_g = (const float*)d_in[21];
    p.out = (float*)d_out; p.ws = (unsigned char*)d_ws;
}
extern "C" void kernel_launch(void* const* d_in, const int* in_sizes, int n_in, void* d_out, int out_size, void* d_ws, size_t ws_size, hipStream_t stream) {
    static int grid = 0;
    if (grid == 0) {
        if (n_in != 22 || out_size != MROWS * DM || ws_size < WS_END) { fprintf(stderr, "kernel_launch: unexpected problem (n_in %d, out %d, ws %zu < %zu)\n", n_in, out_size, ws_size, (size_t)WS_END); grid = -1; return; }
        int dev = 0, cus = 0;
        if (hipGetDevice(&dev) != hipSuccess || hipDeviceGetAttribute(&cus, hipDeviceAttributeMultiprocessorCount, dev) != hipSuccess || cus <= 0) { grid = -1; return; }
        if (hipFuncSetAttribute((const void*)mk_fwd, hipFuncAttributeMaxDynamicSharedMemorySize, LDS_BYTES) != hipSuccess) { fprintf(stderr, "kernel_launch: hipFuncSetAttribute failed\n"); grid = -1; return; }
        int per_cu = 0;
        if (hipOccupancyMaxActiveBlocksPerMultiprocessor(&per_cu, (const void*)mk_fwd, 512, LDS_BYTES) != hipSuccess || per_cu < 1) fprintf(stderr, "kernel_launch: occupancy query says %d\n", per_cu);
        (void)hipGetLastError();
        grid = cus;
    }
    if (grid < 0) return;
    (void)hipMemsetAsync((char*)d_ws + WS_CTL, 0, CTL_ZERO_BYTES, stream);
    Params p{};
    fill_params(p, d_in, d_out, d_ws);
#if !MK_DEBUG
    p.l_begin = 0; p.l_end = DEPTH; p.do_prologue = 1; p.do_final = 1; p.bar_region = 0; p.ph_mask = 63;
    hipLaunchKernelGGL(mk_fwd, dim3(grid), dim3(512), LDS_BYTES, stream, p);
#else
    debug_launches(p, grid, stream);
#endif
}
```

```cpp
#include <hip/hip_runtime.h>
#include <cstdio>
#include <cstdint>

#ifndef MK_DEBUG
#define MK_DEBUG 0
#endif

namespace pg8 {
#define PG8_LAS __attribute__((address_space(3)))
typedef unsigned short bf16_t;
typedef short bf16x8 __attribute__((ext_vector_type(8)));
typedef float f32x4 __attribute__((ext_vector_type(4)));
typedef unsigned u32x4 __attribute__((ext_vector_type(4)));
constexpr int BM = 256, BK = 64, HALF = 128, HTB = HALF * BK * 2  , STAGE_BYTES = 8 * HTB, NXCD = 8, WGM = 8;

__host__ __device__ __forceinline__ int lds_byte(int r, int c) { const int st = (r >> 4) * 2 + (c >> 5), rr = r & 15, cc = c & 31, ob = rr * 64 + cc * 2; return st * 1024 + (ob ^ (((ob >> 9) & 1) << 5)); }
__host__ __device__ __forceinline__ void stage_rc(int b, int& R, int& C) { const int st = b / 1024, sb = b % 1024, swz = sb ^ (((sb >> 9) & 1) << 5); R = (st >> 1) * 16 + swz / 64; C = (st & 1) * 32 + (swz % 64) / 2; }
__host__ __device__ __forceinline__ int perm32(int rho) { const int n = rho >> 4, i = rho & 15; return 8 * (i >> 2) + 4 * n + (i & 3); }

struct Unit { int pm, pn; };
struct Gemm { const bf16_t* A; const bf16_t* Bt; int M, N, K; };

struct StaticOrder {
    int nM, nN, nwg, G, c;
    __host__ __device__ void init(int M, int N, int G_, int c_) { nM = M / BM; nN = N / BM; nwg = nM * nN; G = G_; c = c_; }
    __host__ __device__ bool next(int i, Unit& u) const {
        const long L = (long)i * G + c; if (L >= nwg) return false;
        int wgid = (int)L; { const int q = nwg / NXCD, r = nwg % NXCD, xcd = wgid % NXCD, off = wgid / NXCD; wgid = (xcd < r ? xcd * (q + 1) : r * (q + 1) + (xcd - r) * q) + off; }
        const int nig = WGM * nN, gid = wgid / nig, fm = gid * WGM, gsz = (nM - fm) < WGM ? (nM - fm) : WGM;
        u.pm = fm + ((wgid % nig) % gsz); u.pn = (wgid % nig) / gsz; return true;
    }
    __device__ __forceinline__ void a_ready(const Unit&) const {}
    __device__ __forceinline__ void done(const Unit&) const {}
};
__device__ __forceinline__ unsigned cvt_pk_bf16(float lo, float hi) { unsigned r; asm volatile("v_cvt_pk_bf16_f32 %0, %1, %2" : "=v"(r) : "v"(lo), "v"(hi)); return r; }
typedef float f32x2 __attribute__((ext_vector_type(2)));
template <class Epi, class Sched, bool ALIGN_EPI = false, bool SP2 = false>
__device__ __forceinline__ void gemm_phase(PG8_LAS unsigned char* lds, const Gemm g, const Sched& S, const Epi& E) {
    int tid_l = threadIdx.x; asm volatile("" : "+v"(tid_l));
    const int tid = tid_l, wid = __builtin_amdgcn_readfirstlane(tid >> 6), lane = tid & 63, wr = wid >> 2, wc = wid & 3, fr = lane & 15, fq = lane >> 4;
    const int K = g.K, nt = K / BK;
    unsigned voffA[2], voffB[2]; int aoff, boff;
#define PG8_LANESET() do { int t_ = tid_l; asm volatile("" : "+v"(t_)); const int l_ = t_ & 63, fr_ = l_ & 15, fq_ = l_ >> 4; \
        _Pragma("unroll") for (int i = 0; i < 2; ++i) { int R, C; stage_rc(t_ * 16 + i * 8192, R, C); const int Rb = Epi::PERM ? ((R & ~31) + perm32(R & 31)) : R; \
            const int Ra = Epi::PERMA ? ((R & ~63) + 4 * (R & 15) + ((R >> 4) & 3)) : R; \
            voffA[i] = (unsigned)(Ra * K + C) * 2u; voffB[i] = (unsigned)(Rb * K + C) * 2u; } \
        aoff = lds_byte(wr * 64 + fr_, fq_ * 8); boff = lds_byte(wc * 32 + fr_, fq_ * 8); } while (0)
    PG8_LANESET();
    const size_t kstep = (size_t)(BK * 2);
    const size_t hstep = (size_t)HALF * K * 2;
    const size_t tstep = 2 * hstep;
    const unsigned ldsw = (unsigned)wid * 1024u;
#define PG8_SA(b, h) (((b) * 2 + (h)) * HTB)
#define PG8_SB(b, h) ((4 + (b) * 2 + (h)) * HTB)
#define PG8_STAGE(bufoff, gbase, voff) do { _Pragma("unroll") for (int _i = 0; _i < 2; ++_i) \
        __builtin_amdgcn_global_load_lds((const unsigned*)((const char*)(gbase) + (voff)[_i]), (PG8_LAS unsigned*)(lds + (bufoff) + ldsw + _i * 8192), 16, 0, 0); } while (0)
#define PG8_LDA(dst, b, h) do { _Pragma("unroll") for (int m = 0; m < 4; ++m) _Pragma("unroll") for (int k = 0; k < 2; ++k) dst[m][k] = *(const PG8_LAS bf16x8*)(lds + PG8_SA(b, h) + aoff + m * 2048 + k * 1024); } while (0)
#define PG8_LDB(dst, b, h) do { _Pragma("unroll") for (int n = 0; n < 2; ++n) _Pragma("unroll") for (int k = 0; k < 2; ++k) dst[n][k] = *(const PG8_LAS bf16x8*)(lds + PG8_SB(b, h) + boff + n * 2048 + k * 1024); } while (0)
#define PG8_MMA(ai, bj, At, Bt) do { __builtin_amdgcn_s_setprio(1); _Pragma("unroll") for (int m = 0; m < 4; ++m) _Pragma("unroll") for (int n = 0; n < 2; ++n) _Pragma("unroll") for (int k = 0; k < 2; ++k) \
        acc[ai][bj][m][n] = __builtin_amdgcn_mfma_f32_16x16x32_bf16(Bt[n][k], At[m][k], acc[ai][bj][m][n], 0, 0, 0); __builtin_amdgcn_s_setprio(0); } while (0)
#define PG8_WAIT_V(n) asm volatile("s_waitcnt vmcnt(" #n ")" ::: "memory")
#define PG8_WAIT_L(n) asm volatile("s_waitcnt lgkmcnt(" #n ")" ::: "memory")
#define PG8_BAR __builtin_amdgcn_s_barrier()
#define PG8_SCHED __builtin_amdgcn_sched_barrier(0)
    Unit cur, nxt; int ui = 0;
    if (!S.next(0, cur)) return;
    f32x4 acc[2][2][4][2];
#pragma unroll
    for (int a = 0; a < 2; ++a)
#pragma unroll
        for (int b = 0; b < 2; ++b)
#pragma unroll
            for (int m = 0; m < 4; ++m)
#pragma unroll
                for (int n = 0; n < 2; ++n) acc[a][b][m][n] = (f32x4){0.f, 0.f, 0.f, 0.f};
    bf16x8 At[4][2], B0[2][2], B1[2][2];
    const char* cA = (const char*)g.A + (size_t)cur.pm * tstep; const char* cB = (const char*)g.Bt + (size_t)cur.pn * tstep;
    S.a_ready(cur);
    if constexpr (SP2) {
        PG8_STAGE(PG8_SB(0, 0), cB, voffB); PG8_STAGE(PG8_SB(0, 1), cB + hstep, voffB); PG8_STAGE(PG8_SA(0, 0), cA, voffA); PG8_STAGE(PG8_SA(0, 1), cA + hstep, voffA);
        if (wr == 1) PG8_BAR;
        PG8_WAIT_V(2); PG8_BAR;
        PG8_STAGE(PG8_SB(1, 0), cB + kstep, voffB); PG8_STAGE(PG8_SA(1, 0), cA + kstep, voffA); PG8_STAGE(PG8_SB(1, 1), cB + hstep + kstep, voffB);
        PG8_WAIT_V(6); PG8_BAR;
    } else {
        PG8_STAGE(PG8_SB(0, 0), cB, voffB); PG8_STAGE(PG8_SA(0, 0), cA, voffA); PG8_STAGE(PG8_SB(0, 1), cB + hstep, voffB); PG8_STAGE(PG8_SA(0, 1), cA + hstep, voffA);
        if (wr == 1) PG8_BAR;
        PG8_WAIT_V(4); PG8_BAR;
        PG8_STAGE(PG8_SB(1, 0), cB + kstep, voffB); PG8_STAGE(PG8_SA(1, 0), cA + kstep, voffA); PG8_STAGE(PG8_SB(1, 1), cB + hstep + kstep, voffB);
        PG8_WAIT_V(6); PG8_BAR;
    }
    for (;;) {
        PG8_LANESET();
        const bool has_next = S.next(ui + 1, nxt);
        const char* nA = has_next ? (const char*)g.A + (size_t)nxt.pm * tstep : cA; const char* nB = has_next ? (const char*)g.Bt + (size_t)nxt.pn * tstep : cB;
        for (int t = 0; t < nt; t += 2) {
            const bool last = (t == nt - 2);
            const char* a1 = cA + (size_t)(t + 1) * kstep;
            const char* a2 = last ? nA : cA + (size_t)(t + 2) * kstep; const char* b2 = last ? nB : cB + (size_t)(t + 2) * kstep;
            const char* a3 = a2 + kstep; const char* b3 = b2 + kstep;
            if (last && has_next) S.a_ready(nxt);
            if constexpr (SP2) {
            PG8_LDB(B0, 0, 0); PG8_LDB(B1, 0, 1); PG8_SCHED; PG8_LDA(At, 0, 0); PG8_STAGE(PG8_SA(1, 1), a1 + hstep, voffA);
            PG8_WAIT_V(8); PG8_WAIT_L(0); PG8_BAR; PG8_MMA(0, 0, At, B0); PG8_MMA(0, 1, At, B1); PG8_BAR; PG8_SCHED;
            PG8_LDA(At, 0, 1); PG8_STAGE(PG8_SB(0, 0), b2, voffB); PG8_STAGE(PG8_SB(0, 1), b2 + hstep, voffB); PG8_STAGE(PG8_SA(0, 0), a2, voffA);
            PG8_WAIT_V(8); PG8_WAIT_L(0); PG8_BAR; PG8_MMA(1, 0, At, B0); PG8_MMA(1, 1, At, B1); PG8_BAR; PG8_SCHED;
            PG8_LDB(B0, 1, 0); PG8_LDB(B1, 1, 1); PG8_SCHED; PG8_LDA(At, 1, 0); PG8_STAGE(PG8_SA(0, 1), a2 + hstep, voffA);
            PG8_WAIT_V(8); PG8_WAIT_L(0); PG8_BAR; PG8_MMA(0, 0, At, B0); PG8_MMA(0, 1, At, B1); PG8_BAR; PG8_SCHED;
            PG8_LDA(At, 1, 1); PG8_STAGE(PG8_SB(1, 0), b3, voffB); PG8_STAGE(PG8_SB(1, 1), b3 + hstep, voffB); PG8_STAGE(PG8_SA(1, 0), a3, voffA);
            PG8_WAIT_V(8); PG8_WAIT_L(0); PG8_BAR; PG8_MMA(1, 0, At, B0); PG8_MMA(1, 1, At, B1); PG8_BAR; PG8_SCHED;
            } else {
            PG8_LDB(B0, 0, 0); PG8_SCHED; PG8_LDA(At, 0, 0); PG8_STAGE(PG8_SA(1, 1), a1 + hstep, voffA);
            PG8_WAIT_L(8); PG8_BAR; PG8_WAIT_L(0); PG8_MMA(0, 0, At, B0); PG8_BAR; PG8_SCHED;
            PG8_LDB(B1, 0, 1); PG8_STAGE(PG8_SB(0, 0), b2, voffB);
            PG8_BAR; PG8_WAIT_L(0); PG8_MMA(0, 1, At, B1); PG8_BAR;
            PG8_LDA(At, 0, 1); PG8_STAGE(PG8_SA(0, 0), a2, voffA);
            PG8_BAR; PG8_WAIT_L(0); PG8_MMA(1, 0, At, B0); PG8_BAR; PG8_SCHED;
            PG8_STAGE(PG8_SB(0, 1), b2 + hstep, voffB);
            PG8_WAIT_V(6); PG8_BAR; PG8_MMA(1, 1, At, B1); PG8_BAR;
            PG8_LDB(B0, 1, 0); PG8_SCHED; PG8_LDA(At, 1, 0); PG8_STAGE(PG8_SA(0, 1), a2 + hstep, voffA);
            PG8_WAIT_L(8); PG8_BAR; PG8_WAIT_L(0); PG8_MMA(0, 0, At, B0); PG8_BAR; PG8_SCHED;
            PG8_LDB(B1, 1, 1); PG8_STAGE(PG8_SB(1, 0), b3, voffB);
            PG8_BAR; PG8_WAIT_L(0); PG8_MMA(0, 1, At, B1); PG8_BAR;
            PG8_LDA(At, 1, 1); PG8_STAGE(PG8_SA(1, 0), a3, voffA);
            PG8_BAR; PG8_WAIT_L(0); PG8_MMA(1, 0, At, B0); PG8_BAR; PG8_SCHED;
            PG8_STAGE(PG8_SB(1, 1), b3 + hstep, voffB);
            PG8_WAIT_V(6); PG8_BAR; PG8_MMA(1, 1, At, B1); PG8_BAR;
            }
        }
        if constexpr (ALIGN_EPI) { if (wr == 0) PG8_BAR; }
        if constexpr (!Epi::AFTER_DRAIN) { E(acc, cur, wr, wc, fr, fq); S.done(cur); }
        if (!has_next) break;
#pragma unroll
        for (int a = 0; a < 2; ++a)
#pragma unroll
            for (int b = 0; b < 2; ++b)
#pragma unroll
                for (int m = 0; m < 4; ++m)
#pragma unroll
                    for (int n = 0; n < 2; ++n) acc[a][b][m][n] = (f32x4){0.f, 0.f, 0.f, 0.f};
        cur = nxt; cA = nA; cB = nB; ++ui;
        if constexpr (ALIGN_EPI) { if (wr == 1) PG8_BAR; }
    }
    PG8_WAIT_V(0);
    if constexpr (!ALIGN_EPI) { if (wr == 0) PG8_BAR; }
    PG8_BAR;
    if constexpr (Epi::AFTER_DRAIN) { E.fused(acc, cur, wr, wc, fr, fq, lds, wid, lane); S.done(cur); }
#undef PG8_LANESET
#undef PG8_SA
#undef PG8_SB
#undef PG8_STAGE
#undef PG8_LDA
#undef PG8_LDB
#undef PG8_MMA
#undef PG8_WAIT_V
#undef PG8_WAIT_L
#undef PG8_BAR
#undef PG8_SCHED
}
}
#define GAS __attribute__((address_space(1)))
#define LAS __attribute__((address_space(3)))

constexpr int DM = 2048, NBATCH = 16, SEQ = 2048, DEPTH = 4, MROWS = NBATCH * SEQ;
constexpr int NIN = 6168, NINP = 6176, PROJ_LD = 6144;
constexpr int DFF = 5632, NUP = 2 * DFF;
constexpr float RMS_EPS = 1e-6f;
constexpr float LOG2E = 1.4426950408889634f;
constexpr int C_FQ = 0, C_FK = 768, C_FV = 1536, C_DQ = 2304, C_DK = 2816, C_DV = 3328, C_NQ = 3840, C_NKC = 4608, C_NVC = 4864, C_NKS = 5120, C_NVS = 5376, C_NKW = 5632, C_NVW = 5888;
constexpr int GATE_LD = 32;
__device__ __forceinline__ int win_colmap(int c) {
    if (c < 2304) return c; if (c < 6144) return c + 6; if (c < 6150) return 2304 + (c - 6144); if (c < 6168) return c; return -1;
}
__device__ __forceinline__ int wup_colmap(int c) { const int pn = c >> 8, w = c & 255; return (w < 128) ? (pn * 128 + w) : (DFF + pn * 128 + (w - 128)); }

__constant__ unsigned char T5B[128] = {0, 1, 2, 3, 4, 5, 6, 7, 8, 9, 10, 11, 12, 13, 14, 15, 16, 16, 16, 17, 17, 18, 18, 18, 19, 19, 19, 20, 20, 20, 20, 21, 21, 21, 21, 22, 22, 22, 22, 22, 23, 23, 23, 23, 23, 23, 24, 24, 24, 24, 24, 24, 25, 25, 25, 25, 25, 25, 25, 26, 26, 26, 26, 26, 26, 26, 26, 27, 27, 27, 27, 27, 27, 27, 27, 27, 27, 28, 28, 28, 28, 28, 28, 28, 28, 28, 28, 29, 29, 29, 29, 29, 29, 29, 29, 29, 29, 29, 29, 30, 30, 30, 30, 30, 30, 30, 30, 30, 30, 30, 30, 30, 30, 31, 31, 31, 31, 31, 31, 31, 31, 31, 31, 31, 31, 31, 31, 31};

constexpr size_t al256(size_t x) { return (x + 255) & ~(size_t)255; }
constexpr size_t WS_CTL = 0, CTL_ZERO_BYTES = 1u << 20;
constexpr size_t WS_WIN = CTL_ZERO_BYTES;
constexpr size_t WS_WOUT = WS_WIN + (size_t)DEPTH * NINP * DM * 2;
constexpr size_t WS_WUP = WS_WOUT + (size_t)DEPTH * DM * DM * 2;
constexpr size_t WS_WDN = WS_WUP + (size_t)DEPTH * NUP * DM * 2;
constexpr size_t WS_W1T = WS_WDN + (size_t)DEPTH * DM * DFF * 2;
constexpr size_t WS_W2T = WS_W1T + (size_t)DEPTH * 2 * 128 * 4096 * 2;
constexpr size_t WS_POSC = WS_W2T + (size_t)DEPTH * 2 * 128 * 128 * 2;
constexpr size_t WS_HB = al256(WS_POSC + (size_t)DEPTH * 2 * 128 * 4);
constexpr size_t WS_MIXED = WS_HB + (size_t)MROWS * DM * 2;
constexpr size_t WS_PROJ = WS_MIXED + (size_t)MROWS * DM * 2;
constexpr size_t WS_GATES = WS_PROJ + (size_t)MROWS * PROJ_LD * 2;
constexpr size_t WS_SSQP = WS_GATES + (size_t)MROWS * GATE_LD * 4;
constexpr size_t WS_RSTD = WS_SSQP + (size_t)MROWS * 32 * 4;
constexpr size_t WS_HALO = WS_RSTD + (size_t)MROWS * 4;
constexpr size_t WS_KCMP = WS_HALO + (size_t)128 * 4 * NUP * 4;
constexpr size_t WS_VCMP = WS_KCMP + (size_t)NBATCH * 2 * 128 * 128 * 2;
constexpr size_t WS_CUM = WS_VCMP + (size_t)NBATCH * 2 * 128 * 128 * 2;
constexpr size_t WS_SCR = WS_CUM + (size_t)NBATCH * 6 * SEQ * 4;
constexpr size_t WS_DIAG = WS_SCR + (size_t)256 * 131072;
constexpr size_t WS_END = WS_DIAG + 65536;
static_assert(WS_END + (size_t)MROWS * DM * 4 <= (size_t)4 * DEPTH * DM * NUP * 4, "workspace map (+ the debug build's copy of h) must fit 4x the largest tensor");
constexpr int CW_BAR = 4096;
constexpr int CW_QUEUE = 65536;
constexpr int CW_CONV = 131072;
constexpr int CW_CMPDONE = 98304;

constexpr int RING_BYTES = 131072;
constexpr int LX_CONV = RING_BYTES;
constexpr int LX_MISC = RING_BYTES + 8192;
constexpr int LX_CW = LX_MISC + 256 + 2048;
constexpr int LX_RSTAB = LX_MISC + 256;
static_assert(LX_MISC + 256 + 2048 + 4096 <= 147456, "LDS map");
constexpr int LDS_BYTES = 147456;

typedef unsigned short bf16_t;
typedef short bf16x8 __attribute__((ext_vector_type(8)));
typedef short s16x4 __attribute__((ext_vector_type(4)));
typedef float f32x4 __attribute__((ext_vector_type(4)));
typedef float f32x2 __attribute__((ext_vector_type(2)));
typedef float f32x16 __attribute__((ext_vector_type(16)));
typedef unsigned u32x4 __attribute__((ext_vector_type(4)));
typedef unsigned u32x2 __attribute__((ext_vector_type(2)));

__device__ __forceinline__ int ltid() { int t = threadIdx.x; asm volatile("" : "+v"(t)); return t; }
typedef __bf16 bf16x2_t __attribute__((ext_vector_type(2)));
__device__ __forceinline__ unsigned cvtpk(float lo, float hi) { const f32x2 v = {lo, hi}; const bf16x2_t b = __builtin_convertvector(v, bf16x2_t); return __builtin_bit_cast(unsigned, b); }
__device__ __forceinline__ float bf2f(bf16_t v) { return __builtin_bit_cast(float, (unsigned)v << 16); }
__device__ __forceinline__ float fast_exp2(float x) { return __builtin_amdgcn_exp2f(x); }
__device__ __forceinline__ float fast_rcp(float x) { return __builtin_amdgcn_rcpf(x); }
__device__ __forceinline__ float shx(float v, int o) { return __builtin_bit_cast(float, __builtin_amdgcn_ds_bpermute(((ltid() & 63) ^ o) << 2, __builtin_bit_cast(int, v))); }
__device__ __forceinline__ float wave_sum(float v) {
    const int a = (ltid() & 63) << 2;
#pragma unroll
    for (int o = 1; o < 64; o <<= 1) v += __builtin_bit_cast(float, __builtin_amdgcn_ds_bpermute(a ^ (o << 2), __builtin_bit_cast(int, v)));
    return v;
}
template <int CTRL> __device__ __forceinline__ float dppf(float v) { return __builtin_bit_cast(float, __builtin_amdgcn_mov_dpp(__builtin_bit_cast(int, v), CTRL, 0xF, 0xF, false)); }
template <int CTRL> __device__ __forceinline__ float dppfo(float o, float v) { return __builtin_bit_cast(float, __builtin_amdgcn_update_dpp(__builtin_bit_cast(int, o), __builtin_bit_cast(int, v), CTRL, 0xF, 0xF, false)); }
template <int CTRL> __device__ __forceinline__ f32x4 dpp4o(f32x4 o, f32x4 v) { f32x4 r; r.x = dppfo<CTRL>(o.x, v.x); r.y = dppfo<CTRL>(o.y, v.y); r.z = dppfo<CTRL>(o.z, v.z); r.w = dppfo<CTRL>(o.w, v.w); return r; }
template <int CTRL> __device__ __forceinline__ f32x4 dpp4(f32x4 v) { f32x4 r; r.x = dppf<CTRL>(v.x); r.y = dppf<CTRL>(v.y); r.z = dppf<CTRL>(v.z); r.w = dppf<CTRL>(v.w); return r; }

namespace epi {
using pg8::Unit;

struct InProj {
    static constexpr bool PERM = true, PERMA = true, AFTER_DRAIN = false;
    bf16_t* proj; const __attribute__((address_space(3))) float* rstab;
    __device__ __forceinline__ void operator()(const f32x4 (&acc)[2][2][4][2], const Unit& u, int wr, int wc, int fr, int fq) const {
        { const int ln = ltid() & 63; fr = ln & 15; fq = ln >> 4; }
        const int row0 = u.pm * 256 + wr * 64 + 4 * fr;
        float cs = 1.f;
        if (u.pn < 3) cs = 0.08838834764831845f * LOG2E;
        else if (u.pn == 9 || u.pn == 10) cs = 0.125f * LOG2E;
        else if (u.pn >= 15 && u.pn <= 17) cs = 0.08838834764831845f * LOG2E;
        {
#pragma unroll
            for (int ai = 0; ai < 2; ++ai)
#pragma unroll
                for (int m = 0; m < 4; ++m) {
                    const int row = row0 + ai * 128 + m; const float s = rstab[((u.pm >> 3) & 1) * 256 + (row & 255)] * cs;
                    bf16_t* rp = proj + (size_t)row * PROJ_LD + u.pn * 256 + wc * 32 + 8 * fq;
#pragma unroll
                    for (int bj = 0; bj < 2; ++bj) { const f32x4 v0 = acc[ai][bj][m][0] * s, v1 = acc[ai][bj][m][1] * s;
                        u32x4 w; w.x = cvtpk(v0[0], v0[1]); w.y = cvtpk(v0[2], v0[3]); w.z = cvtpk(v1[0], v1[1]); w.w = cvtpk(v1[2], v1[3]);
                        *(u32x4*)(rp + bj * 128) = w; }
                }
        }
    }
};

struct Resid {
    static constexpr bool PERM = true, PERMA = true, AFTER_DRAIN = false;
    bf16_t* hb; float* ssqp;
    __device__ __forceinline__ void operator()(const f32x4 (&acc)[2][2][4][2], const Unit& u, int wr, int wc, int fr, int fq) const {
        { const int ln = ltid() & 63; fr = ln & 15; fq = ln >> 4; }
        const int row0 = u.pm * 256 + wr * 64 + 4 * fr, col0 = u.pn * 256 + wc * 32 + 8 * fq;
        u32x4 hv[2][4][2];
#pragma unroll
        for (int ai = 0; ai < 2; ++ai)
#pragma unroll
            for (int m = 0; m < 4; ++m)
#pragma unroll
                for (int bj = 0; bj < 2; ++bj) hv[ai][m][bj] = *(const u32x4*)(hb + (size_t)(row0 + ai * 128 + m) * DM + col0 + bj * 128);
#pragma unroll
        for (int ai = 0; ai < 2; ++ai)
#pragma unroll
            for (int m = 0; m < 4; ++m) {
                const int row = row0 + ai * 128 + m; float ss = 0.f;
#pragma unroll
                for (int bj = 0; bj < 2; ++bj) {
                    const size_t off = (size_t)row * DM + col0 + bj * 128;
                    const u32x4 h = hv[ai][m][bj];
                    f32x4 v0, v1;
                    v0[0] = __builtin_bit_cast(float, h.x << 16) + acc[ai][bj][m][0][0]; v0[1] = __builtin_bit_cast(float, h.x & 0xFFFF0000u) + acc[ai][bj][m][0][1];
                    v0[2] = __builtin_bit_cast(float, h.y << 16) + acc[ai][bj][m][0][2]; v0[3] = __builtin_bit_cast(float, h.y & 0xFFFF0000u) + acc[ai][bj][m][0][3];
                    v1[0] = __builtin_bit_cast(float, h.z << 16) + acc[ai][bj][m][1][0]; v1[1] = __builtin_bit_cast(float, h.z & 0xFFFF0000u) + acc[ai][bj][m][1][1];
                    v1[2] = __builtin_bit_cast(float, h.w << 16) + acc[ai][bj][m][1][2]; v1[3] = __builtin_bit_cast(float, h.w & 0xFFFF0000u) + acc[ai][bj][m][1][3];
                    u32x4 w; w.x = cvtpk(v0[0], v0[1]); w.y = cvtpk(v0[2], v0[3]); w.z = cvtpk(v1[0], v1[1]); w.w = cvtpk(v1[2], v1[3]);
                    *(u32x4*)(hb + off) = w;
                    ss += (v0[0] * v0[0] + v0[1] * v0[1]) + (v0[2] * v0[2] + v0[3] * v0[3]) + (v1[0] * v1[0] + v1[1] * v1[1]) + (v1[2] * v1[2] + v1[3] * v1[3]);
                }
                ss += shx(ss, 16); ss += shx(ss, 32);
                if (fq == 0) ssqp[(size_t)row * 32 + u.pn * 4 + wc] = ss;
            }
    }
};

struct UpConv {
    static constexpr bool PERM = true, PERMA = true, AFTER_DRAIN = false;
    bf16_t* act; const __attribute__((address_space(3))) float* rstab; const float* cw; const float* cb; float* halo; __attribute__((address_space(3))) float* ex;
    __device__ __forceinline__ void operator()(const f32x4 (&acc)[2][2][4][2], const Unit& u, int wr, int wc, int fr, int fq) const {
        { const int ln = ltid() & 63; fr = ln & 15; fq = ln >> 4; }
        const int tcol = wc * 32 + 8 * fq, ch0 = u.pn * 128 + tcol;
        const int row0 = u.pm * 256 + wr * 64 + 4 * fr;
        float rs[2][4];
#pragma unroll
        for (int ai = 0; ai < 2; ++ai)
#pragma unroll
            for (int m = 0; m < 4; ++m) rs[ai][m] = rstab[((u.pm >> 3) & 1) * 256 + ((row0 + ai * 128 + m) & 255)];
        __attribute__((address_space(3))) float* cwl = ex + (LX_CW - LX_CONV) / 4;
        { const int t = ltid();
#pragma unroll
          for (int k = 0; k < 2; ++k) { const int i = t + 512 * k, q = i >> 7, cc = i & 127, tap = q >> 1, bjj = q & 1;
              cwl[i] = (tap < 3 ? cw + tap * NUP : cb)[bjj * DFF + u.pn * 128 + cc]; } }
        if (fr == 15) {
#pragma unroll
            for (int ai = 0; ai < 2; ++ai)
#pragma unroll
                for (int bj = 0; bj < 2; ++bj)
#pragma unroll
                    for (int n = 0; n < 2; ++n)
#pragma unroll
                        for (int q = 0; q < 2; ++q) {
                            const f32x4 v = acc[ai][bj][2 + q][n] * rs[ai][2 + q];
                            *(__attribute__((address_space(3))) f32x4*)(ex + ((ai * 2 + wr) * 2 + q) * 256 + bj * 128 + tcol + 4 * n) = v;
                            if (ai == 1 && wr == 1) *(f32x4*)(halo + ((size_t)(u.pm * 4 + 2 + q) * NUP) + u.pn * 256 + bj * 128 + tcol + 4 * n) = v;
                        }
        }
        if (fr == 0 && wr == 0) {
#pragma unroll
            for (int bj = 0; bj < 2; ++bj)
#pragma unroll
                for (int n = 0; n < 2; ++n)
#pragma unroll
                    for (int q = 0; q < 2; ++q)
                        *(f32x4*)(halo + ((size_t)(u.pm * 4 + q) * NUP) + u.pn * 256 + bj * 128 + tcol + 4 * n) = acc[0][bj][q][n] * rs[0][q];
        }
        asm volatile("s_waitcnt lgkmcnt(0)" ::: "memory");
        __builtin_amdgcn_s_barrier();
#pragma unroll
        for (int ai = 0; ai < 2; ++ai) {
            const bool top = (ai == 0 && wr == 0);
            const int pb = (wr ? ai * 2 : (ai * 2 - 1));
#pragma unroll
            for (int n = 0; n < 2; ++n) {
                f32x4 yg[4];
#pragma unroll
                for (int bj = 0; bj < 2; ++bj) {
                    asm volatile("" ::: "memory"); __builtin_amdgcn_sched_barrier(0);
                    const __attribute__((address_space(3))) float* wl = cwl + bj * 128 + tcol + 4 * n;
                    const f32x4 w0 = *(const __attribute__((address_space(3))) f32x4*)wl, w1 = *(const __attribute__((address_space(3))) f32x4*)(wl + 256), w2 = *(const __attribute__((address_space(3))) f32x4*)(wl + 512), bb = *(const __attribute__((address_space(3))) f32x4*)(wl + 768);
                    f32x4 e62 = {0.f, 0.f, 0.f, 0.f}, e63 = {0.f, 0.f, 0.f, 0.f};
                    if (!top) {
                        e62 = *(const __attribute__((address_space(3))) f32x4*)(ex + (pb * 2 + 0) * 256 + bj * 128 + tcol + 4 * n);
                        e63 = *(const __attribute__((address_space(3))) f32x4*)(ex + (pb * 2 + 1) * 256 + bj * 128 + tcol + 4 * n);
                    }
                    f32x4 v[4];
#pragma unroll
                    for (int m = 0; m < 4; ++m) v[m] = acc[ai][bj][m][n] * rs[ai][m];
                    const f32x4 s3 = dpp4o<0x111>(e63, v[3]), s2 = dpp4o<0x111>(e62, v[2]);
                    f32x4 y[4];
                    y[0] = ((bb + w2 * v[0]) + w1 * s3) + w0 * s2;
                    y[1] = ((bb + w2 * v[1]) + w1 * v[0]) + w0 * s3;
                    y[2] = ((bb + w2 * v[2]) + w1 * v[1]) + w0 * v[0];
                    y[3] = ((bb + w2 * v[3]) + w1 * v[2]) + w0 * v[1];
#pragma unroll
                    for (int m = 0; m < 4; ++m) {
                        if (bj == 0) yg[m] = y[m];
                        else {
                            f32x4 o;
#pragma unroll
                            for (int i = 0; i < 4; ++i) o[i] = yg[m][i] * fast_rcp(1.f + fast_exp2(-yg[m][i] * LOG2E)) * y[m][i];
                            if (!(top && fr == 0 && m < 2)) {
                                u32x2 w; w.x = cvtpk(o[0], o[1]); w.y = cvtpk(o[2], o[3]);
                                *(u32x2*)(act + (size_t)(row0 + ai * 128 + m) * DFF + ch0 + 4 * n) = w;
                            }
                        }
                    }
                }
            }
        }
    }
};
}
#define XB_TMO      128
#define XB_XCNT(j)  (256  + 64 * (j))
#define XB_XSUB(j)  (1280 + 64 * (j))
#define XB_XGEN(j)  (2304 + 64 * (j))
#define XB_TOP      3328
#define XB_TOPGEN   3392
#define XCD_BAR_WORDS 3456
#define XB_SPIN_CAP (1u << 18)

__device__ __forceinline__ unsigned xb_ld(unsigned* p)              { return __hip_atomic_load(p, __ATOMIC_RELAXED, __HIP_MEMORY_SCOPE_AGENT); }
__device__ __forceinline__ unsigned xb_add(unsigned* p, unsigned v) { return __hip_atomic_fetch_add(p, v, __ATOMIC_RELAXED, __HIP_MEMORY_SCOPE_AGENT); }
__device__ __forceinline__ unsigned xb_xcc_id() { return (unsigned)__builtin_amdgcn_s_getreg((3 << 11) | 20) & 0xFu; }
#define XB_SPIN(cond, bar) do { unsigned _sp = 0; while (cond) { __builtin_amdgcn_s_sleep(1); \
    if ((++_sp & 255u) == 0u) { if (xb_ld(&(bar)[XB_TMO])) break; if (_sp > XB_SPIN_CAP) { atomicAdd(&(bar)[XB_TMO], 1u); break; } } } } while (0)

struct XcdBarrier {
    unsigned* bar; unsigned x;
    volatile LAS unsigned* st;
};

__device__ __forceinline__ XcdBarrier xcd_barrier_post(unsigned* bar, volatile LAS unsigned* st) {
    XcdBarrier b; b.bar = bar; b.x = xb_xcc_id(); b.st = st;
    if (threadIdx.x == 0) (void)xb_add(&bar[XB_XCNT(b.x)], 1u);
    return b;
}
__device__ __forceinline__ void xcd_barrier_complete(unsigned* bar, unsigned x, unsigned& nloc, unsigned& nx) {
    const unsigned G = gridDim.x * gridDim.y * gridDim.z;
    unsigned sum, cnt, mine, sp = 0u;
    for (;;) {
        sum = 0u; cnt = 0u; mine = 0u;
#pragma unroll
        for (unsigned j = 0; j < 16; ++j) { const unsigned c = xb_ld(&bar[XB_XCNT(j)]); sum += c; cnt += (c > 0u) ? 1u : 0u; mine = (j == x) ? c : mine; }
        if (sum == G) break;
        __builtin_amdgcn_s_sleep(1);
        if ((++sp & 255u) == 0u) { if (xb_ld(&bar[XB_TMO])) break; if (sp > XB_SPIN_CAP) { atomicAdd(&bar[XB_TMO], 1u); break; } }
    }
    nloc = mine > 0u ? mine : 1u; nx = cnt > 0u ? cnt : 1u;
}

__device__ __forceinline__ void xcd_barrier(const XcdBarrier& b) {
    asm volatile("s_waitcnt vmcnt(0)" ::: "memory");
    __syncthreads();
    if (threadIdx.x == 0) {
        unsigned* bar = b.bar; asm volatile("" : "+s"(bar));
        __builtin_amdgcn_s_waitcnt(0);
        unsigned nloc = b.st[0], nx = b.st[1];
        if (nloc == 0u) { xcd_barrier_complete(bar, b.x, nloc, nx); b.st[0] = nloc; b.st[1] = nx; }
        const unsigned old = xb_add(&bar[XB_XSUB(b.x)], 1u);
        const unsigned gen = old / nloc;
        if (old + 1u == (gen + 1u) * nloc) {
            __builtin_amdgcn_fence(__ATOMIC_RELEASE, "agent");
            asm volatile("s_waitcnt vmcnt(0)" ::: "memory");
            const unsigned og = xb_add(&bar[XB_TOP], 1u);
            const unsigned tg = og / nx;
            if (og + 1u == (tg + 1u) * nx) xb_add(&bar[XB_TOPGEN], 1u);
            else XB_SPIN(xb_ld(&bar[XB_TOPGEN]) == tg, bar);
            __builtin_amdgcn_fence(__ATOMIC_ACQUIRE, "agent");
            xb_add(&bar[XB_XGEN(b.x)], 1u);
            asm volatile("s_waitcnt vmcnt(0)" ::: "memory");
        } else {
            XB_SPIN(xb_ld(&bar[XB_XGEN(b.x)]) == gen, bar);
            __builtin_amdgcn_fence(__ATOMIC_ACQUIRE, "agent");
            asm volatile("s_waitcnt vmcnt(0)" ::: "memory");
        }
    }
    __syncthreads();
}

namespace att {
constexpr int SHM = 16384;
constexpr int L_V = 0, L_K = 2 * SHM, L_WS = 4 * SHM, L_CUM = L_WS + 2048, L_LUT = L_CUM + 8192, L_IMP = L_LUT + 5120, L_SEL = L_IMP + 256 * 33 * 4, L_UNI = L_SEL + 1024, L_END = L_UNI + 64;
static_assert(L_END <= RING_BYTES, "attention scratch inside the ring region");
constexpr float THR2 = 11.5f;
enum { K_FOX = 0, K_DIFF = 1, K_SEL = 2, K_WIN = 3, K_CMP = 4 };

#define KSWZ(row, colB) ((row) * 256 + ((colB) ^ (((row) & 7) << 4)))
#define SBAR() __builtin_amdgcn_sched_barrier(0)
__device__ __forceinline__ int v_st(int k, int c) { const int kk = (k & ~0xC) | ((k & 4) << 1) | ((k & 8) >> 1); return ((kk >> 3) * 4 + (c >> 5)) * 512 + ((kk & 7) * 32 + (c & 31)) * 2; }
__device__ __forceinline__ int v_rd_base(int lane) { return ((lane & 3) << 3) | (((lane >> 2) & 3) << 6) | (((lane >> 4) & 1) << 5) | (((lane >> 5) & 1) << 8); }
constexpr int v_rd_off(int d0, int ks, int half) { return d0 * 512 + ks * 4096 + half * 2048; }
__device__ __forceinline__ int crow(int r, int hi) { return (r & 3) + 8 * (r >> 2) + 4 * hi; }
constexpr int ccol(int r) { return (r & 3) + 8 * (r >> 2); }

typedef LAS char* lptr;

template <int NQ>
__device__ __forceinline__ void qkt(f32x16& p0, f32x16& p1, lptr kbuf, int kf0, int r32, int hi, const bf16x8 (&qr)[8]) {
    p0 = f32x16{}; p1 = f32x16{};
    const int kb0 = (int)(uintptr_t)kbuf + (kf0 >> 2) * 128;
    const int ka0 = kb0 + KSWZ(r32, (0 * 16 + hi * 8) * 2), ka1 = kb0 + KSWZ(r32, (1 * 16 + hi * 8) * 2), ka2 = kb0 + KSWZ(r32, (2 * 16 + hi * 8) * 2), ka3 = kb0 + KSWZ(r32, (3 * 16 + hi * 8) * 2);
#define KRD(dst, addr, off) asm volatile("ds_read_b128 %0, %1 offset:%2" : "=&v"(dst) : "v"(addr), "i"(off) : "memory")
#define KRD4(S, aA, aB, off) do { KRD(S[0], aA, off); KRD(S[1], aA, (off) + 8192); KRD(S[2], aB, off); KRD(S[3], aB, (off) + 8192); } while (0)
#define KMM4(S, d) do { p0 = __builtin_amdgcn_mfma_f32_32x32x16_bf16(S[0], qr[d], p0, 0, 0, 0); p1 = __builtin_amdgcn_mfma_f32_32x32x16_bf16(S[1], qr[d], p1, 0, 0, 0); \
                        p0 = __builtin_amdgcn_mfma_f32_32x32x16_bf16(S[2], qr[(d) + 1], p0, 0, 0, 0); p1 = __builtin_amdgcn_mfma_f32_32x32x16_bf16(S[3], qr[(d) + 1], p1, 0, 0, 0); } while (0)
#define LGK(n) asm volatile("s_waitcnt lgkmcnt(" #n ")" ::: "memory")
    bf16x8 A[4], B[4];
    LGK(0); SBAR();
    if (NQ == 8) {
        KRD4(A, ka0, ka1, 0); KRD4(B, ka2, ka3, 0);
        LGK(4); SBAR(); KMM4(A, 0); SBAR(); KRD4(A, ka0, ka1, 128);
        LGK(4); SBAR(); KMM4(B, 2); SBAR(); KRD4(B, ka2, ka3, 128);
        LGK(4); SBAR(); KMM4(A, 4); SBAR();
        LGK(0); SBAR(); KMM4(B, 6);
    } else {
        KRD4(A, ka0, ka1, 0); KRD4(B, ka2, ka3, 0);
        LGK(4); SBAR(); KMM4(A, 0); SBAR();
        LGK(0); SBAR(); KMM4(B, 2);
    }
#undef KRD
#undef KRD4
#undef KMM4
#undef LGK
}
__device__ __forceinline__ void pv_tile(f32x16 (&o)[4], int vb0, bf16x8 pa0, bf16x8 pa1, bf16x8 pa2, bf16x8 pa3) {
#define TRRD(dst, off) asm volatile("ds_read_b64_tr_b16 %0, %1 offset:%2" : "=&v"(dst) : "v"(vb0), "i"(off) : "memory")
#define PV_RD(S, d0) do { constexpr int b_ = v_rd_off(d0, 0, 0); TRRD(S[0], b_); TRRD(S[1], b_ + 2048); TRRD(S[2], b_ + 4096); TRRD(S[3], b_ + 6144); \
                          TRRD(S[4], b_ + 8192); TRRD(S[5], b_ + 10240); TRRD(S[6], b_ + 12288); TRRD(S[7], b_ + 14336); } while (0)
#define PV_MM(S, d0) do { \
        o[d0] = __builtin_amdgcn_mfma_f32_32x32x16_bf16(pa0, (bf16x8){S[0][0], S[0][1], S[0][2], S[0][3], S[1][0], S[1][1], S[1][2], S[1][3]}, o[d0], 0, 0, 0);   \
        o[d0] = __builtin_amdgcn_mfma_f32_32x32x16_bf16(pa1, (bf16x8){S[2][0], S[2][1], S[2][2], S[2][3], S[3][0], S[3][1], S[3][2], S[3][3]}, o[d0], 0, 0, 0);   \
        o[d0] = __builtin_amdgcn_mfma_f32_32x32x16_bf16(pa2, (bf16x8){S[4][0], S[4][1], S[4][2], S[4][3], S[5][0], S[5][1], S[5][2], S[5][3]}, o[d0], 0, 0, 0);   \
        o[d0] = __builtin_amdgcn_mfma_f32_32x32x16_bf16(pa3, (bf16x8){S[6][0], S[6][1], S[6][2], S[6][3], S[7][0], S[7][1], S[7][2], S[7][3]}, o[d0], 0, 0, 0); } while (0)
#define LGK(n) asm volatile("s_waitcnt lgkmcnt(" #n ")" ::: "memory")
    s16x4 A[8], B[8];
    LGK(0); SBAR();
    PV_RD(A, 0); PV_RD(B, 1);
    LGK(8); SBAR(); PV_MM(A, 0); SBAR(); PV_RD(A, 2);
    LGK(8); SBAR(); PV_MM(B, 1); SBAR(); PV_RD(B, 3);
    LGK(8); SBAR(); PV_MM(A, 2); SBAR();
    LGK(0); SBAR(); PV_MM(B, 3);
#undef TRRD
#undef PV_RD
#undef PV_MM
#undef LGK
}
__device__ __forceinline__ void softmax_tile(f32x16& p0, f32x16& p1, float& m_reg, float& l_reg, float& alpha, bf16x8& pa0, bf16x8& pa1, bf16x8& pa2, bf16x8& pa3) {
    float pmax = p0[0];
#pragma unroll
    for (int r = 1; r < 16; ++r) pmax = fmaxf(pmax, p0[r]);
#pragma unroll
    for (int r = 0; r < 16; ++r) pmax = fmaxf(pmax, p1[r]);
    { auto rr = __builtin_amdgcn_permlane32_swap(__float_as_uint(pmax), __float_as_uint(pmax), false, false);
      pmax = fmaxf(__uint_as_float(rr[0]), __uint_as_float(rr[1])); }
    float mn;
    if (__builtin_expect(__all((pmax - m_reg) <= THR2), 1)) { mn = m_reg; alpha = 1.f; }
    else { mn = fmaxf(m_reg, pmax); alpha = fast_exp2(m_reg - mn); m_reg = mn; }
    float ps = 0.f;
#pragma unroll
    for (int r = 0; r < 16; ++r) { p0[r] = fast_exp2(p0[r] - mn); ps += p0[r]; }
#pragma unroll
    for (int r = 0; r < 16; ++r) { p1[r] = fast_exp2(p1[r] - mn); ps += p1[r]; }
    { auto rr = __builtin_amdgcn_permlane32_swap(__float_as_uint(ps), __float_as_uint(ps), false, false);
      ps = __uint_as_float(rr[0]) + __uint_as_float(rr[1]); }
    l_reg = l_reg * alpha + ps;
#define PK4(P, B_, OUT) do { unsigned a0 = cvtpk(P[B_+0], P[B_+1]), a1 = cvtpk(P[B_+2], P[B_+3]);                          \
        unsigned b0 = cvtpk(P[B_+4], P[B_+5]), b1 = cvtpk(P[B_+6], P[B_+7]);                                             \
        auto r0 = __builtin_amdgcn_permlane32_swap(a0, b0, false, false); auto r1 = __builtin_amdgcn_permlane32_swap(a1, b1, false, false); \
        u32x4 w = {r0[0], r1[0], r0[1], r1[1]}; OUT = __builtin_bit_cast(bf16x8, w); } while (0)
    PK4(p0, 0, pa0); PK4(p0, 8, pa1); PK4(p1, 0, pa2); PK4(p1, 8, pa3);
#undef PK4
}
__device__ __forceinline__ void rowbcast(LAS float* wsl, float v, int r32, int hi, float (&out)[16]) {
    if (hi == 0) wsl[r32] = v;
    asm volatile("s_waitcnt lgkmcnt(0)" ::: "memory");
#pragma unroll
    for (int r = 0; r < 16; ++r) out[r] = wsl[crow(r, hi)];
    asm volatile("s_waitcnt lgkmcnt(0)" ::: "memory");
}

template <int KIND>
__device__ __forceinline__ bool wave_act(int j, int qlo, unsigned selm) {
    const int kb = j * 64;
    if (KIND == K_FOX || KIND == K_DIFF) return kb <= qlo + 31;
    if (KIND == K_WIN) return (kb <= qlo + 31) && (kb + 63 >= qlo - 511);
    if (KIND == K_SEL) return (kb <= qlo + 31) && __any((int)((selm >> j) & 1u));
    return true;
}
template <int KIND>
__device__ __forceinline__ void score_fix(f32x16& p0, f32x16& p1, int j, int qlo, int qpos, int hi, const LAS float* lut, const LAS float* cum, unsigned selm) {
    const float NEG = -__builtin_inff();
    const int kb = j * 64, dq = qpos - kb - 4 * hi;
    if (KIND == K_FOX) {
        const LAS float* cb = cum + kb + 4 * hi;
#pragma unroll
        for (int r = 0; r < 16; ++r) { p0[r] += cb[ccol(r)]; p1[r] += cb[ccol(r) + 32]; }
        if (kb + 63 > qlo) {
#pragma unroll
            for (int r = 0; r < 16; ++r) { if (dq - ccol(r) < 0) p0[r] = NEG; if (dq - ccol(r) - 32 < 0) p1[r] = NEG; }
        }
    } else if (KIND == K_CMP) {
        const int dc = qpos - 31 - 16 * (kb + 4 * hi);
#pragma unroll
        for (int r = 0; r < 16; ++r) {
            const int rel0 = dc - 16 * ccol(r), rel1 = rel0 - 512;
            p0[r] += lut[min(max(rel0, 0), 127)]; p1[r] += lut[min(max(rel1, 0), 127)];
            if (rel0 < 0) p0[r] = NEG;
            if (rel1 < 0 || (kb + 4 * hi + ccol(r) + 32 >= 127)) p1[r] = NEG;
        }
    } else {
        if (qlo - (kb + 63) >= 113) {
        } else {
#pragma unroll
            for (int r = 0; r < 16; ++r) { const int rel0 = dq - ccol(r), rel1 = rel0 - 32;
                p0[r] += lut[min(max(rel0, 0), 127)]; p1[r] += lut[min(max(rel1, 0), 127)];
                if (rel0 < 0) p0[r] = NEG; if (rel1 < 0) p1[r] = NEG; }
        }
        if (KIND == K_WIN) {
            if (qlo + 31 - kb >= 512) {
#pragma unroll
                for (int r = 0; r < 16; ++r) { if (dq - ccol(r) >= 512) p0[r] = NEG; if (dq - ccol(r) - 32 >= 512) p1[r] = NEG; }
            }
        }
        if (KIND == K_SEL) {
            if (((selm >> j) & 1u) == 0u) {
#pragma unroll
                for (int r = 0; r < 16; ++r) { p0[r] = NEG; p1[r] = NEG; }
            }
        }
    }
}

template <int KIND, int NQ, int EXPM = 0>
__device__ __forceinline__ void attn_pass(lptr lds, const bf16_t* __restrict__ Kg, const bf16_t* __restrict__ Vg, int kp, int vp, unsigned tilemask,
                                          const bf16x8 (&qr)[8], int kf0, int P0, const LAS float* lut, const LAS float* cum, unsigned selm,
                                          f32x16 (&o)[4], float& m_reg, float& l_reg) {
    const int tid = ltid(), wid = __builtin_amdgcn_readfirstlane(tid >> 6), lane = tid & 63, r32 = lane & 31, hi = lane >> 5;
    const int sr = tid >> 4, sc = (tid & 15) * 8;
    const int kws = KSWZ(sr, sc * 2), vst0 = v_st(sr, sc), vst1 = v_st(32 + sr, sc);
    const int qlo = P0 + wid * 32, qpos = qlo + r32;
    LAS float* wsl = (LAS float*)(lds + L_WS) + wid * 64;
    const int vbase = (int)(uintptr_t)(lds + L_V) + v_rd_base(lane);
    if (tilemask == 0u) return;
    const int kr_ = wid * 4 + (lane >> 4);
    const int kcol_ = (((lane & 15) ^ (kr_ & 7)) * 8);
    const int vsub_ = wid * 2 + (lane >> 5);
    const int vkk_ = ((vsub_ >> 2) << 3) | ((lane & 31) >> 2);
    const int vkey_ = (vkk_ & ~0xC) | ((vkk_ & 4) << 1) | ((vkk_ & 8) >> 1);
    const int vcol_ = (vsub_ & 3) * 32 + (lane & 3) * 8;
    const unsigned dma_w = (unsigned)wid * 1024u;
#define DMA_TILE(jj, bf) do { \
        const bf16_t* kp0_ = Kg + (size_t)((jj) * 64 + kr_) * kp + kcol_; const bf16_t* vp0_ = Vg + (size_t)((jj) * 64 + vkey_) * vp + vcol_; \
        __builtin_amdgcn_global_load_lds((const unsigned*)kp0_, (LAS unsigned*)(lds + L_K + (bf) * SHM + dma_w), 16, 0, 0); \
        __builtin_amdgcn_global_load_lds((const unsigned*)(kp0_ + (size_t)32 * kp), (LAS unsigned*)(lds + L_K + (bf) * SHM + 8192 + dma_w), 16, 0, 0); \
        __builtin_amdgcn_global_load_lds((const unsigned*)vp0_, (LAS unsigned*)(lds + L_V + (bf) * SHM + dma_w), 16, 0, 0); \
        __builtin_amdgcn_global_load_lds((const unsigned*)(vp0_ + (size_t)32 * vp), (LAS unsigned*)(lds + L_V + (bf) * SHM + 8192 + dma_w), 16, 0, 0); } while (0)
#define NEXT_TILE(jv) do { if (tilemask) { jv = __builtin_ctz(tilemask); tilemask &= tilemask - 1u; } else jv = -1; } while (0)
    int j0, j1;
    NEXT_TILE(j0); NEXT_TILE(j1);
    DMA_TILE(j0, 0);
    asm volatile("s_waitcnt vmcnt(0)" ::: "memory");
    __syncthreads();
    int buf = 0;
    for (;;) {
        if (j1 >= 0) DMA_TILE(j1, buf ^ 1);
        if (wave_act<KIND>(j0, qlo, selm)) {
            f32x16 p0, p1;
            qkt<NQ>(p0, p1, lds + L_K + buf * SHM, kf0, r32, hi, qr);
            score_fix<KIND>(p0, p1, j0, qlo, qpos, hi, lut, cum, selm);
            float alpha; bf16x8 pa0, pa1, pa2, pa3;
            softmax_tile(p0, p1, m_reg, l_reg, alpha, pa0, pa1, pa2, pa3);
            if (__any(alpha < 1.f)) {
                float al[16]; rowbcast(wsl, alpha, r32, hi, al);
#pragma unroll
                for (int d = 0; d < 4; ++d)
#pragma unroll
                    for (int r = 0; r < 16; ++r) o[d][r] *= al[r];
            }
            pv_tile(o, vbase + buf * SHM, pa0, pa1, pa2, pa3);
        }
        asm volatile("s_waitcnt vmcnt(0)" ::: "memory");
        __syncthreads();
        if (j1 < 0) break;
        j0 = j1; NEXT_TILE(j1); buf ^= 1;
    }
#undef DMA_TILE
#undef NEXT_TILE
}

__device__ __forceinline__ void fox_pass(lptr lds, const bf16_t* __restrict__ Kg, const bf16_t* __restrict__ Vg, int ntiles, const bf16x8 (&qr)[8], int P0,
                                         const LAS float* cum, f32x16 (&o)[4], float& m_reg, float& l_reg) {
    const int tid = ltid(), wid = __builtin_amdgcn_readfirstlane(tid >> 6), lane = tid & 63, r32 = lane & 31, hi = lane >> 5;
    const int sr = tid >> 4, sc = (tid & 15) * 8;
    const int kws = KSWZ(sr, sc * 2), vst0 = v_st(sr, sc), vst1 = v_st(32 + sr, sc);
    const int qlo = P0 + wid * 32, qpos = qlo + r32;
    LAS float* wsl = (LAS float*)(lds + L_WS) + wid * 64;
    const int vbase = (int)(uintptr_t)(lds + L_V) + v_rd_base(lane);
    const int kbase = (int)(uintptr_t)(lds + L_K);
    const int ko0 = KSWZ(r32, (0 * 16 + hi * 8) * 2), ko1 = KSWZ(r32, (1 * 16 + hi * 8) * 2), ko2 = KSWZ(r32, (2 * 16 + hi * 8) * 2), ko3 = KSWZ(r32, (3 * 16 + hi * 8) * 2);
    const int PITCH = PROJ_LD;
    bf16x8 st_k0, st_k1, st_v0, st_v1;
#define LOADK(jj) do { const size_t kr = (size_t)((jj) * 64 + sr); st_k0 = *(const bf16x8*)(Kg + kr * PITCH + sc); st_k1 = *(const bf16x8*)(Kg + (kr + 32) * PITCH + sc); } while (0)
#define LOADV(jj) do { const size_t kr = (size_t)((jj) * 64 + sr); st_v0 = *(const bf16x8*)(Vg + kr * PITCH + sc); st_v1 = *(const bf16x8*)(Vg + (kr + 32) * PITCH + sc); } while (0)
#define WRITEK(bf) do { *(LAS bf16x8*)(lds + L_K + (bf) * SHM + kws) = st_k0; *(LAS bf16x8*)(lds + L_K + (bf) * SHM + kws + 32 * 256) = st_k1; } while (0)
#define WRITEV(bf) do { *(LAS bf16x8*)(lds + L_V + (bf) * SHM + vst0) = st_v0; *(LAS bf16x8*)(lds + L_V + (bf) * SHM + vst1) = st_v1; } while (0)
#define KRD(dst, addr, off) asm volatile("ds_read_b128 %0, %1 offset:%2" : "=&v"(dst) : "v"(addr), "i"(off) : "memory")
#define KRD4(S, aA, aB, off) do { KRD(S[0], aA, off); KRD(S[1], aA, (off) + 8192); KRD(S[2], aB, off); KRD(S[3], aB, (off) + 8192); } while (0)
#define KMM4(S, d) do { sn0 = __builtin_amdgcn_mfma_f32_32x32x16_bf16(S[0], qr[d], sn0, 0, 0, 0); sn1 = __builtin_amdgcn_mfma_f32_32x32x16_bf16(S[1], qr[d], sn1, 0, 0, 0); \
                        sn0 = __builtin_amdgcn_mfma_f32_32x32x16_bf16(S[2], qr[(d) + 1], sn0, 0, 0, 0); sn1 = __builtin_amdgcn_mfma_f32_32x32x16_bf16(S[3], qr[(d) + 1], sn1, 0, 0, 0); } while (0)
#define LGK(n) asm volatile("s_waitcnt lgkmcnt(" #n ")" ::: "memory")
    LOADK(0); LOADV(0); WRITEK(0); WRITEV(0);
    if (ntiles > 1) { LOADK(1); WRITEK(1); }
    __syncthreads();
    f32x16 sc0, sc1;
    bool actc = 0 <= qlo + 31;
    if (actc) { qkt<8>(sc0, sc1, lds + L_K, 0, r32, hi, qr); score_fix<K_FOX>(sc0, sc1, 0, qlo, qpos, hi, nullptr, cum, 0u); }
    for (int t = 0; t < ntiles; ++t) {
        const int buf = t & 1; const bool has1 = t + 1 < ntiles, has2 = t + 2 < ntiles;
        if (has1) LOADV(t + 1);
        if (has2) LOADK(t + 2);
        const bool actn = has1 && ((t + 1) * 64 <= qlo + 31);
        f32x16 sn0, sn1;
        if (actc && actn && ((t + 1) * 64 + 63 <= qlo)) {
            const int ka = kbase + (buf ^ 1) * SHM;
            const int ka0 = ka + ko0, ka1 = ka + ko1, ka2 = ka + ko2, ka3 = ka + ko3;
            bf16x8 A[4], B[4];
            SBAR(); LGK(0);
            KRD4(A, ka0, ka1, 0); KRD4(B, ka2, ka3, 0);
            SBAR();
            float pmax = sc0[0];
#pragma unroll
            for (int r = 1; r < 16; ++r) pmax = fmaxf(pmax, sc0[r]);
            sn0 = f32x16{}; sn1 = f32x16{};
            SBAR(); LGK(4); SBAR(); KMM4(A, 0); SBAR(); KRD4(A, ka0, ka1, 128); SBAR();
#pragma unroll
            for (int r = 0; r < 16; ++r) pmax = fmaxf(pmax, sc1[r]);
            { auto rr = __builtin_amdgcn_permlane32_swap(__float_as_uint(pmax), __float_as_uint(pmax), false, false);
              pmax = fmaxf(__uint_as_float(rr[0]), __uint_as_float(rr[1])); }
            const bool keep = __all((pmax - m_reg) <= THR2);
            const float mn = keep ? m_reg : fmaxf(m_reg, pmax);
            const float alpha = fast_exp2(m_reg - mn); m_reg = mn;
            SBAR(); LGK(4); SBAR(); KMM4(B, 2); SBAR(); KRD4(B, ka2, ka3, 128); SBAR();
            float ps = 0.f;
#pragma unroll
            for (int r = 0; r < 16; ++r) { sc0[r] = fast_exp2(sc0[r] - mn); ps += sc0[r]; }
            SBAR(); LGK(4); SBAR(); KMM4(A, 4); SBAR();
#pragma unroll
            for (int r = 0; r < 16; ++r) { sc1[r] = fast_exp2(sc1[r] - mn); ps += sc1[r]; }
            SBAR(); LGK(0); SBAR(); KMM4(B, 6); SBAR();
            { auto rr = __builtin_amdgcn_permlane32_swap(__float_as_uint(ps), __float_as_uint(ps), false, false);
              ps = __uint_as_float(rr[0]) + __uint_as_float(rr[1]); }
            l_reg = l_reg * alpha + ps;
            bf16x8 pa0, pa1, pa2, pa3;
#define PK4(P, B_, OUT) do { unsigned a0 = cvtpk(P[B_+0], P[B_+1]), a1 = cvtpk(P[B_+2], P[B_+3]);                          \
        unsigned b0 = cvtpk(P[B_+4], P[B_+5]), b1 = cvtpk(P[B_+6], P[B_+7]);                                             \
        auto r0 = __builtin_amdgcn_permlane32_swap(a0, b0, false, false); auto r1 = __builtin_amdgcn_permlane32_swap(a1, b1, false, false); \
        u32x4 w = {r0[0], r1[0], r0[1], r1[1]}; OUT = __builtin_bit_cast(bf16x8, w); } while (0)
            PK4(sc0, 0, pa0); PK4(sc0, 8, pa1); PK4(sc1, 0, pa2); PK4(sc1, 8, pa3);
#undef PK4
            SBAR();
            if (__any(alpha < 1.f)) {
                float al[16]; rowbcast(wsl, alpha, r32, hi, al);
#pragma unroll
                for (int d = 0; d < 4; ++d)
#pragma unroll
                    for (int r = 0; r < 16; ++r) o[d][r] *= al[r];
            }
            pv_tile(o, vbase + buf * SHM, pa0, pa1, pa2, pa3);
            { const LAS float* cbp = cum + (t + 1) * 64 + 4 * hi;
#pragma unroll
              for (int r = 0; r < 16; ++r) { sn0[r] += cbp[ccol(r)]; sn1[r] += cbp[ccol(r) + 32]; } }
        } else {
            if (actn) qkt<8>(sn0, sn1, lds + L_K + (buf ^ 1) * SHM, 0, r32, hi, qr);
            if (actc) {
                float alpha; bf16x8 pa0, pa1, pa2, pa3;
                softmax_tile(sc0, sc1, m_reg, l_reg, alpha, pa0, pa1, pa2, pa3);
                if (__any(alpha < 1.f)) {
                    float al[16]; rowbcast(wsl, alpha, r32, hi, al);
#pragma unroll
                    for (int d = 0; d < 4; ++d)
#pragma unroll
                        for (int r = 0; r < 16; ++r) o[d][r] *= al[r];
                }
                pv_tile(o, vbase + buf * SHM, pa0, pa1, pa2, pa3);
            }
            if (actn) score_fix<K_FOX>(sn0, sn1, t + 1, qlo, qpos, hi, nullptr, cum, 0u);
        }
        if (has1) WRITEV(buf ^ 1);
        if (has2) WRITEK(buf);
        __syncthreads();
        sc0 = sn0; sc1 = sn1; actc = actn;
    }
#undef LOADK
#undef LOADV
#undef WRITEK
#undef WRITEV
#undef KRD
#undef KRD4
#undef KMM4
#undef LGK
}

template <int NQ>
__device__ __forceinline__ void load_q(bf16x8 (&qr)[8], const bf16_t* proj, int row_first, int col0) {
    const int lane = ltid() & 63, r32 = lane & 31, hi = lane >> 5, wid = ltid() >> 6;
    const bf16_t* q = proj + (size_t)(row_first + wid * 32 + r32) * PROJ_LD + col0 + hi * 8;
#pragma unroll
    for (int d = 0; d < NQ; ++d) qr[d] = *(const bf16x8*)(q + d * 16);
}
__device__ __forceinline__ void store_o(const f32x16 (&o)[4], bf16_t* mixed, int row_first, int col0) {
    const int lane = ltid() & 63, r32 = lane & 31, hi = lane >> 5, wid = ltid() >> 6;
    const bool odd = (r32 & 1) != 0;
    bf16_t* base = mixed + (size_t)(row_first + wid * 32) * DM + col0 + (r32 & ~1);
#pragma unroll
    for (int rp = 0; rp < 8; ++rp) { const int orow = crow(2 * rp + (odd ? 1 : 0), hi);
#pragma unroll
        for (int d = 0; d < 4; ++d) { const float va = o[d][2 * rp], vb = o[d][2 * rp + 1];
            const float y = dppf<0xB1>(odd ? va : vb);
            *(unsigned*)(base + (size_t)orow * DM + d * 32) = odd ? cvtpk(y, vb) : cvtpk(va, y); } }
}
__device__ __forceinline__ void scr_acc(float* scr, const f32x16 (&o)[4], const float (&f)[16], bool add) {
    f32x4* s = (f32x4*)(scr + (ltid() >> 6) * 4096) + (ltid() & 63);
#pragma unroll
    for (int d = 0; d < 4; ++d)
#pragma unroll
        for (int q = 0; q < 4; ++q) { f32x4 v; v.x = o[d][4 * q] * f[4 * q]; v.y = o[d][4 * q + 1] * f[4 * q + 1]; v.z = o[d][4 * q + 2] * f[4 * q + 2]; v.w = o[d][4 * q + 3] * f[4 * q + 3];
            if (add) v += s[(d * 4 + q) * 64]; s[(d * 4 + q) * 64] = v; }
}
__device__ __forceinline__ void scr_load(const float* scr, f32x16 (&o)[4]) {
    const f32x4* s = (const f32x4*)(scr + (ltid() >> 6) * 4096) + (ltid() & 63);
#pragma unroll
    for (int d = 0; d < 4; ++d)
#pragma unroll
        for (int q = 0; q < 4; ++q) { const f32x4 v = s[(d * 4 + q) * 64]; o[d][4 * q] = v.x; o[d][4 * q + 1] = v.y; o[d][4 * q + 2] = v.z; o[d][4 * q + 3] = v.w; }
}

template <int EXPM = 0>
__device__ __forceinline__ void fox_unit(lptr lds, const bf16_t* proj, const float* gates, float fbias, bf16_t* mixed, int b, int h, int qb) {
    const int tid = ltid(), wid = tid >> 6, lane = tid & 63, r32 = lane & 31, hi = lane >> 5;
    const int P0 = qb * 256, rowb = b * SEQ;
    LAS float* cum = (LAS float*)(lds + L_CUM);
    { const int nk = P0 + 256; float run = 0.f; const bool on = 4 * tid < nk;
      float xs[4];
#pragma unroll
      for (int i = 0; i < 4; ++i) xs[i] = gates[(size_t)(rowb + 4 * tid + i) * GATE_LD + h] + fbias;
      if (on) {
#pragma unroll
          for (int i = 0; i < 4; ++i) { const float xx = xs[i];
              run += fminf(xx, 0.f) - __logf(1.f + __expf(-fabsf(xx))); cum[4 * tid + i] = run; }
      }
      float inc = run;
#pragma unroll
      for (int o = 1; o < 64; o <<= 1) { const float t = __builtin_bit_cast(float, __builtin_amdgcn_ds_bpermute(((lane - o) & 63) << 2, __builtin_bit_cast(int, inc))); if (lane >= o) inc += t; }
      LAS float* wsum = (LAS float*)(lds + L_WS);
      if (lane == 63) wsum[wid] = inc;
      __syncthreads();
      float base = 0.f;
#pragma unroll
      for (int w = 0; w < 8; ++w) if (w < wid) base += wsum[w];
      const float ex = base + inc - run;
      if (on) {
#pragma unroll 1
          for (int i = 0; i < 4; ++i) cum[4 * tid + i] = (ex + cum[4 * tid + i]) * LOG2E; }
      __syncthreads();
      const float cref = cum[P0];
      __syncthreads();
      if (on) {
#pragma unroll 1
          for (int i = 0; i < 4; ++i) cum[4 * tid + i] = cref - cum[4 * tid + i]; }
    }
    bf16x8 qr[8]; load_q<8>(qr, proj, rowb + P0, C_FQ + h * 128);
    __syncthreads();
    f32x16 o[4] = {}; float m_reg = -1e30f, l_reg = 0.f;
    const unsigned tm = (qb == 7) ? 0xFFFFFFFFu : ((1u << (4 * (qb + 1))) - 1u);
    if (false) fox_pass(lds, proj + (size_t)rowb * PROJ_LD + C_FK + h * 128, proj + (size_t)rowb * PROJ_LD + C_FV + h * 128, 4 * (qb + 1), qr, P0, cum, o, m_reg, l_reg);
    else attn_pass<K_FOX, 8, EXPM>(lds, proj + (size_t)rowb * PROJ_LD + C_FK + h * 128, proj + (size_t)rowb * PROJ_LD + C_FV + h * 128, PROJ_LD, PROJ_LD, tm, qr, 0, P0, nullptr, cum, 0u, o, m_reg, l_reg);
    float f[16]; rowbcast((LAS float*)(lds + L_WS) + wid * 64, fast_rcp(l_reg), r32, hi, f);
#pragma unroll
    for (int d = 0; d < 4; ++d)
#pragma unroll
        for (int r = 0; r < 16; ++r) o[d][r] *= f[r];
    store_o(o, mixed, rowb + P0, h * 128);
    __syncthreads();
}
__device__ __forceinline__ void diff_unit(lptr lds, const bf16_t* proj, bf16_t* mixed, float* scr, int b, int h, int qb, float lam, float out_scale, const float* subln_g) {
    const int tid = ltid(), wid = tid >> 6, lane = tid & 63, r32 = lane & 31, hi = lane >> 5;
    const int P0 = qb * 256, rowb = b * SEQ;
    const LAS float* lut = (const LAS float*)(lds + L_LUT) + h * 128;
    LAS float* wsl = (LAS float*)(lds + L_WS) + wid * 64;
    const unsigned tm = (qb == 7) ? 0xFFFFFFFFu : ((1u << (4 * (qb + 1))) - 1u);
    const bf16_t* Kg = proj + (size_t)rowb * PROJ_LD + C_DK + h * 128; const bf16_t* Vg = proj + (size_t)rowb * PROJ_LD + C_DV + h * 128;
    f32x16 ot[4];
#pragma unroll 1
    for (int mp = 0; mp < 2; ++mp) {
        bf16x8 qr[8]; load_q<4>(qr, proj, rowb + P0, C_DQ + h * 128 + mp * 64);
        f32x16 o[4] = {}; float m_reg = -1e30f, l_reg = 0.f;
        attn_pass<K_DIFF, 4>(lds, Kg, Vg, PROJ_LD, PROJ_LD, tm, qr, mp * 4, P0, lut, nullptr, 0u, o, m_reg, l_reg);
        float f[16]; rowbcast(wsl, (mp == 0 ? 1.f : -lam) * fast_rcp(l_reg), r32, hi, f);
        if (mp == 0) scr_acc(scr, o, f, false);
        else {
            scr_load(scr, ot);
#pragma unroll
            for (int d = 0; d < 4; ++d)
#pragma unroll
                for (int r = 0; r < 16; ++r) ot[d][r] += o[d][r] * f[r];
        }
    }
    float gcol[4];
#pragma unroll
    for (int d = 0; d < 4; ++d) gcol[d] = subln_g[d * 32 + r32] * out_scale;
#pragma unroll
    for (int r = 0; r < 16; ++r) {
        float ss = ot[0][r] * ot[0][r] + ot[1][r] * ot[1][r] + ot[2][r] * ot[2][r] + ot[3][r] * ot[3][r];
        ss += dppf<0x128>(ss); ss += dppf<0x124>(ss); ss += dppf<0x122>(ss); ss += dppf<0x121>(ss); ss += shx(ss, 16);
        const float rn = __builtin_amdgcn_rsqf(ss * (1.f / 128.f) + RMS_EPS);
#pragma unroll
        for (int d = 0; d < 4; ++d) ot[d][r] *= rn * gcol[d];
    }
    store_o(ot, mixed, rowb + P0, 768 + h * 128);
    __syncthreads();
}
__device__ __forceinline__ void nsa_unit(lptr lds, const bf16_t* proj, const float* gates, const bf16_t* kcmp, const bf16_t* vcmp, bf16_t* mixed, float* scr, int b, int g, int qb) {
    const int tid = ltid(), wid = tid >> 6, lane = tid & 63, r32 = lane & 31, hi = lane >> 5;
    const int P0 = qb * 256, rowb = b * SEQ;
    const int qlo = P0 + wid * 32, qpos = qlo + r32;
    LAS float* wsl = (LAS float*)(lds + L_WS) + wid * 64;
    LAS float* imp = (LAS float*)(lds + L_IMP);
    LAS unsigned* sel = (LAS unsigned*)(lds + L_SEL);
    LAS unsigned* uni = (LAS unsigned*)(lds + L_UNI);
    const float NEG = -__builtin_inff();
    const bf16_t* kc = kcmp + (size_t)(b * 2 + g) * 128 * 128; const bf16_t* vc = vcmp + (size_t)(b * 2 + g) * 128 * 128;
    { const int sr = tid >> 4, sc = (tid & 15) * 8, kws = KSWZ(sr, sc * 2);
#pragma unroll
      for (int t = 0; t < 2; ++t) { const bf16x8 a = *(const bf16x8*)(kc + (size_t)(t * 64 + sr) * 128 + sc), c = *(const bf16x8*)(kc + (size_t)(t * 64 + 32 + sr) * 128 + sc);
          *(LAS bf16x8*)(lds + L_K + t * SHM + kws) = a; *(LAS bf16x8*)(lds + L_K + t * SHM + kws + 32 * 256) = c; }
      if (tid == 0) uni[0] = 0u; }
    __syncthreads();
    float ia[16], ic[16];
#pragma unroll
    for (int i = 0; i < 16; ++i) { ia[i] = 0.f; ic[i] = 0.f; }
#pragma unroll 1
    for (int hh = 0; hh < 3; ++hh) {
        const int hd = g * 3 + hh; const LAS float* lut = (const LAS float*)(lds + L_LUT) + (4 + hd) * 128;
        bf16x8 qr[8]; load_q<8>(qr, proj, rowb + P0, C_NQ + hd * 128);
        f32x16 p[4];
        qkt<8>(p[0], p[1], lds + L_K, 0, r32, hi, qr); qkt<8>(p[2], p[3], lds + L_K + SHM, 0, r32, hi, qr);
        float mx = -1e30f;
#pragma unroll
        for (int q4 = 0; q4 < 4; ++q4)
#pragma unroll
            for (int r = 0; r < 16; ++r) { const int n = q4 * 32 + 4 * hi + ccol(r); const int rel = qpos - 31 - 16 * n;
                float s = p[q4][r] + lut[min(max(rel, 0), 127)]; if (rel < 0 || n >= 127) s = NEG; p[q4][r] = s; mx = fmaxf(mx, s); }
        mx = fmaxf(mx, shx(mx, 32));
        float ps = 0.f;
#pragma unroll
        for (int q4 = 0; q4 < 4; ++q4)
#pragma unroll
            for (int r = 0; r < 16; ++r) { p[q4][r] = fast_exp2(p[q4][r] - mx); ps += p[q4][r]; }
        ps += shx(ps, 32);
        const float inv = ps > 0.f ? 1.f / ps : 0.f;
#pragma unroll
        for (int q4 = 0; q4 < 4; ++q4)
#pragma unroll
            for (int i = 0; i < 4; ++i) { const float x0 = p[q4][4 * i] * inv, x1 = p[q4][4 * i + 1] * inv, x2 = p[q4][4 * i + 2] * inv, x3 = p[q4][4 * i + 3] * inv;
                ia[q4 * 4 + i] += x0 + x1 + x2 + 0.5f * x3; ic[q4 * 4 + i] += 0.5f * x3; }
    }
#pragma unroll
    for (int gi = 0; gi < 16; ++gi) {
        const float cp = shx(ic[gi], 32);
        const float cpm = (gi > 0) ? shx(ic[gi > 0 ? gi - 1 : 0], 32) : 0.f;
        const float v = ia[gi] + (hi ? cp : cpm);
        imp[(wid * 32 + r32) * 33 + 2 * gi + hi] = v;
    }
    __syncthreads();
    if (tid < 256) {
        const int t = P0 + tid, blk = t >> 6;
        float sc[32];
#pragma unroll
        for (int j2 = 0; j2 < 32; ++j2) { const bool forced = (j2 == 0) || (j2 == blk) || (j2 == blk - 1);
            sc[j2] = (j2 <= blk) ? (imp[tid * 33 + j2] + (forced ? 1e4f : 0.f)) : -1e30f; }
        unsigned mask = 0u;
#pragma unroll 1
        for (int it = 0; it < 8; ++it) { float best = -1e30f; int bi = -1;
#pragma unroll
            for (int j2 = 0; j2 < 32; ++j2) { const bool free_ = ((mask >> j2) & 1u) == 0u; if (free_ && sc[j2] > best) { best = sc[j2]; bi = j2; } }
            if (bi >= 0 && best > -0.5e30f) mask |= 1u << bi; }
        sel[tid] = mask;
        atomicOr((unsigned*)uni, mask);
    }
    __syncthreads();
    const unsigned selm = sel[wid * 32 + r32];
    const unsigned um = uni[0];
#pragma unroll 1
    for (int hp = 0; hp < 3; ++hp) {
    const int h6 = g * 3 + hp;
    const float* gp = gates + (size_t)(rowb + qpos) * GATE_LD + 6 + h6 * 3;
    const float g0 = 1.f / (1.f + __expf(-gp[0])), g1 = 1.f / (1.f + __expf(-gp[1])), g2 = 1.f / (1.f + __expf(-gp[2]));
    const LAS float* lut = (const LAS float*)(lds + L_LUT) + (4 + h6) * 128;
    bf16x8 qr[8]; load_q<8>(qr, proj, rowb + P0, C_NQ + h6 * 128);
    {
        f32x16 o[4] = {}; float m_reg = -1e30f, l_reg = 0.f;
        attn_pass<K_CMP, 8>(lds, kc, vc, 128, 128, 3u, qr, 0, P0, lut, nullptr, 0u, o, m_reg, l_reg);
        float f[16]; rowbcast(wsl, l_reg > 0.f ? g0 / l_reg : 0.f, r32, hi, f);
        scr_acc(scr, o, f, false);
    }
    {
        f32x16 o[4] = {}; float m_reg = -1e30f, l_reg = 0.f;
        const unsigned cm = (qb == 7) ? 0xFFFFFFFFu : ((1u << (4 * (qb + 1))) - 1u);
        attn_pass<K_SEL, 8>(lds, proj + (size_t)rowb * PROJ_LD + C_NKS + g * 128, proj + (size_t)rowb * PROJ_LD + C_NVS + g * 128, PROJ_LD, PROJ_LD, um & cm, qr, 0, P0, lut, nullptr, selm, o, m_reg, l_reg);
        float f[16]; rowbcast(wsl, l_reg > 0.f ? g1 / l_reg : 0.f, r32, hi, f);
        scr_acc(scr, o, f, true);
    }
    {
        f32x16 o[4] = {}; float m_reg = -1e30f, l_reg = 0.f;
        const int jlo = (P0 - 511) > 0 ? (P0 - 511) >> 6 : 0, jhi = (P0 + 255) >> 6;
        const unsigned hiM = (jhi == 31) ? 0xFFFFFFFFu : ((1u << (jhi + 1)) - 1u);
        const unsigned wm = hiM & ~((1u << jlo) - 1u);
        attn_pass<K_WIN, 8>(lds, proj + (size_t)rowb * PROJ_LD + C_NKW + g * 128, proj + (size_t)rowb * PROJ_LD + C_NVW + g * 128, PROJ_LD, PROJ_LD, wm, qr, 0, P0, lut, nullptr, 0u, o, m_reg, l_reg);
        float f[16]; rowbcast(wsl, l_reg > 0.f ? g2 / l_reg : 0.f, r32, hi, f);
        f32x16 ot[4]; scr_load(scr, ot);
#pragma unroll
        for (int d = 0; d < 4; ++d)
#pragma unroll
            for (int r = 0; r < 16; ++r) ot[d][r] += o[d][r] * f[r];
        store_o(ot, mixed, rowb + P0, 1280 + h6 * 128);
    }
    __syncthreads();
    }
}
#undef KSWZ
}

struct Params {
    const float* x; const float* attn_norm_g; const float* w_in; const float* fox_f_bias; const float* lq1; const float* lk1; const float* lq2; const float* lk2;
    const float* subln_g; const float* cmp_pos; const float* wk1; const float* wk2; const float* wv1; const float* wv2; const float* w_out; const float* ffn_norm_g;
    const float* w_up; const float* conv_w; const float* conv_b; const float* w_down; const float* rel_bias; const float* final_g;
    float* out; unsigned char* ws;
    int l_begin, l_end, do_prologue, do_final, bar_region, ph_mask;
};

typedef const __attribute__((address_space(4))) Params* KP;
__device__ __forceinline__ KP kparams() { unsigned long long a = (unsigned long long)__builtin_amdgcn_kernarg_segment_ptr(); asm volatile("" : "+s"(a)); return (KP)a; }

template <int MAPK>
__device__ __forceinline__ void transpose_item(const float* __restrict__ src, int ldsrc, const float* __restrict__ kscale, bf16_t* __restrict__ dst, int K, int k0, int n0, LAS float* scr, int lane) {
    const int c = n0 + (lane & 31);
    const int oc = (MAPK == 1) ? win_colmap(c) : (MAPK == 2) ? wup_colmap(c) : c;
    const float* sp = src + (size_t)(k0 + (lane >> 5)) * ldsrc + (oc >= 0 ? oc : 0);
    float v[32];
#pragma unroll
    for (int i = 0; i < 32; ++i) v[i] = sp[(size_t)(2 * i) * ldsrc];
    if (kscale) {
#pragma unroll
        for (int i = 0; i < 32; ++i) v[i] *= kscale[k0 + 2 * i + (lane >> 5)];
    }
#pragma unroll
    for (int i = 0; i < 32; ++i) scr[(2 * i + (lane >> 5)) * 33 + (lane & 31)] = (oc < 0) ? 0.f : v[i];
    asm volatile("s_waitcnt lgkmcnt(0)" ::: "memory");
    const int cc = lane & 7;
#pragma unroll
    for (int j = 0; j < 4; ++j) { const int n = (lane >> 3) + 8 * j; const LAS float* s = scr + (8 * cc) * 33 + n;
        u32x4 o; o.x = cvtpk(s[0], s[33]); o.y = cvtpk(s[2 * 33], s[3 * 33]); o.z = cvtpk(s[4 * 33], s[5 * 33]); o.w = cvtpk(s[6 * 33], s[7 * 33]);
        *(u32x4*)(dst + (size_t)(n0 + n) * K + k0 + 8 * cc) = o; }
    asm volatile("s_waitcnt lgkmcnt(0)" ::: "memory");
}

constexpr int T_IN = (DM / 64) * (NINP / 32), T_OUT = (DM / 64) * (DM / 32), T_UP = (DM / 64) * (NUP / 32), T_DN = (DFF / 64) * (DM / 32), T_W1 = (4096 / 64) * 4, T_W2 = 2 * 4;
constexpr int T_LAYER = T_IN + T_OUT + T_UP + T_DN + 2 * T_W1 + 2 * T_W2;
__device__ __forceinline__ void convert_item(KP p, int l, int r, LAS float* scr, int lane) {
    unsigned char* ws = p->ws;
    if (r < T_IN) { const int nb = NINP / 32; transpose_item<1>(p->w_in + (size_t)l * DM * NIN, NIN, p->attn_norm_g + l * DM, (bf16_t*)(ws + WS_WIN) + (size_t)l * NINP * DM, DM, (r / nb) * 64, (r % nb) * 32, scr, lane); return; } r -= T_IN;
    if (r < T_OUT) { const int nb = DM / 32; transpose_item<0>(p->w_out + (size_t)l * DM * DM, DM, nullptr, (bf16_t*)(ws + WS_WOUT) + (size_t)l * DM * DM, DM, (r / nb) * 64, (r % nb) * 32, scr, lane); return; } r -= T_OUT;
    if (r < T_UP) { const int nb = NUP / 32; transpose_item<2>(p->w_up + (size_t)l * DM * NUP, NUP, p->ffn_norm_g + l * DM, (bf16_t*)(ws + WS_WUP) + (size_t)l * NUP * DM, DM, (r / nb) * 64, (r % nb) * 32, scr, lane); return; } r -= T_UP;
    if (r < T_DN) { const int nb = DM / 32; transpose_item<0>(p->w_down + (size_t)l * DFF * DM, DM, nullptr, (bf16_t*)(ws + WS_WDN) + (size_t)l * DM * DFF, DFF, (r / nb) * 64, (r % nb) * 32, scr, lane); return; } r -= T_DN;
    if (r < 2 * T_W1) { const int kv = r / T_W1, rr = r % T_W1; const float* src = (kv ? p->wv1 : p->wk1) + (size_t)l * 4096 * 128;
        transpose_item<0>(src, 128, nullptr, (bf16_t*)(ws + WS_W1T) + (size_t)(l * 2 + kv) * 128 * 4096, 4096, (rr / 4) * 64, (rr % 4) * 32, scr, lane); return; } r -= 2 * T_W1;
    { const int kv = r / T_W2, rr = r % T_W2; const float* src = (kv ? p->wv2 : p->wk2) + (size_t)l * 128 * 128;
        transpose_item<0>(src, 128, nullptr, (bf16_t*)(ws + WS_W2T) + (size_t)(l * 2 + kv) * 128 * 128, 128, (rr / 4) * 64, (rr % 4) * 32, scr, lane); }
}
__device__ __forceinline__ void prologue_phase(KP p, LAS unsigned char* lds) {
    const int tid = ltid(), lane = tid & 63, wave = tid >> 6;
    LAS float* scr = (LAS float*)lds + wave * (64 * 33);
    const int G = gridDim.x, bx = blockIdx.x;
    unsigned char* ws = p->ws;
    for (int it = bx * 8 + wave; it < T_LAYER; it += G * 8) convert_item(p, 0, it, scr, lane);
    __syncthreads();
    { LAS float* scr = (LAS float*)lds;
    for (int it = bx; it < DEPTH * 2 * 8; it += G) {
        const int l = it >> 4, kv = (it >> 3) & 1, c0 = (it & 7) * 16; const float* w1 = (kv ? p->wv1 : p->wk1) + (size_t)l * 4096 * 128; const float* pos = p->cmp_pos + (size_t)l * 4096;
        const int col = c0 + (tid & 15), ks = tid >> 4; float s = 0.f;
#pragma unroll 8
        for (int k = ks * 128; k < ks * 128 + 128; ++k) s += pos[k] * w1[(size_t)k * 128 + col];
        scr[tid] = s; __syncthreads();
        if (tid < 16) { float a = 0.f; for (int j = 0; j < 32; ++j) a += scr[j * 16 + tid]; ((float*)(ws + WS_POSC))[(l * 2 + kv) * 128 + c0 + tid] = a; }
        __syncthreads();
    }
    }
    { const int gw = bx * 8 + wave, NGW = G * 8; bf16_t* hb = (bf16_t*)(ws + WS_HB);
      for (int row = gw; row < MROWS; row += NGW) {
          const f32x4* xr = (const f32x4*)(p->x + (size_t)row * DM) + lane; f32x4 v[8]; float ss = 0.f;
#pragma unroll
          for (int j = 0; j < 8; ++j) { v[j] = xr[64 * j]; ss += (v[j].x * v[j].x + v[j].y * v[j].y) + (v[j].z * v[j].z + v[j].w * v[j].w); }
          ss = wave_sum(ss);
          if (lane < 32) ((float*)(ws + WS_SSQP))[(size_t)row * 32 + lane] = (lane == 0) ? ss : 0.f;
          u32x2* o = (u32x2*)(hb + (size_t)row * DM) + lane;
#pragma unroll
          for (int j = 0; j < 8; ++j) { u32x2 w; w.x = cvtpk(v[j].x, v[j].y); w.y = cvtpk(v[j].z, v[j].w); o[64 * j] = w; }
      } }
}

__device__ __forceinline__ int panel_a() { return 16 * ((int)blockIdx.x & 7) + (((int)blockIdx.x >> 3) & 7); }
__device__ __forceinline__ void rstd_prefix(KP p, LAS unsigned char* lds) {
    const int tid = ltid(); const float* ssqp = (const float*)(p->ws + WS_SSQP); LAS float* rstab = (LAS float*)(lds + LX_RSTAB);
    const int row = (panel_a() + 8 * (tid >> 8)) * 256 + (tid & 255);
    const f32x4* q = (const f32x4*)(ssqp + (size_t)row * 32); float s = 0.f;
#pragma unroll
    for (int j = 0; j < 8; ++j) { const f32x4 v = q[j]; s += (v.x + v.y) + (v.z + v.w); }
    rstab[tid] = __builtin_amdgcn_rsqf(s * (1.f / DM) + RMS_EPS);
    __syncthreads();
}
__device__ __forceinline__ void gate_prefix(KP p, int l, LAS unsigned char* lds) {
    const int tid = ltid(), lane = tid & 63, wave = tid >> 6, r32 = lane & 31, hi = lane >> 5;
    const bf16_t* hb = (const bf16_t*)(p->ws + WS_HB); const bf16_t* wg = (const bf16_t*)(p->ws + WS_WIN) + ((size_t)l * NINP + 6144) * DM;
    float* gates = (float*)(p->ws + WS_GATES); const LAS float* rstab = (const LAS float*)(lds + LX_RSTAB);
    constexpr int WPITCH = DM * 2 + 16;
    for (int i = tid; i < 32 * (DM / 8); i += 512) { const int r = i >> 8, c8 = i & 255; *(LAS bf16x8*)(lds + r * WPITCH + c8 * 16) = *(const bf16x8*)(wg + (size_t)r * DM + c8 * 8); }
    __syncthreads();
    if (wave < 4) {
        const int slot = wave >> 1, prow = ((int)blockIdx.x >> 6) * 64 + (wave & 1) * 32;
        const int row0 = (panel_a() + 8 * slot) * 256 + prow;
        const float rs = rstab[slot * 256 + prow + r32];
        const bf16_t* ap = hb + (size_t)(row0 + r32) * DM + hi * 8; const LAS unsigned char* bp = lds + r32 * WPITCH + hi * 16;
        f32x16 acc = {};
#pragma unroll 1
        for (int k32 = 0; k32 < 4; ++k32) { bf16x8 a[32];
#pragma unroll
            for (int j = 0; j < 32; ++j) a[j] = *(const bf16x8*)(ap + (k32 * 32 + j) * 16);
#pragma unroll
            for (int j = 0; j < 32; ++j) { const bf16x8 b = *(const LAS bf16x8*)(bp + (k32 * 32 + j) * 32); acc = __builtin_amdgcn_mfma_f32_32x32x16_bf16(a[j], b, acc, 0, 0, 0); } }
#pragma unroll
        for (int r = 0; r < 16; ++r) { const int rr = att::crow(r, hi);
            const float rsr = __builtin_bit_cast(float, __builtin_amdgcn_ds_bpermute(rr << 2, __builtin_bit_cast(int, rs)));
            if (r32 < 24) gates[(size_t)(row0 + rr) * GATE_LD + r32] = acc[r] * rsr; }
    }
    __syncthreads();
}
__device__ __forceinline__ void fixup_prefix(KP p, int l) {
    const float* halo = (const float*)(p->ws + WS_HALO); bf16_t* act = (bf16_t*)(p->ws + WS_PROJ);
    const float* cw = p->conv_w + (size_t)l * 3 * NUP; const float* cb = p->conv_b + (size_t)l * NUP;
    const int pa = panel_a();
#pragma unroll 2
    for (int i = ltid(); i < 2 * (DFF / 4); i += 512) {
        const int c4 = i % (DFF / 4), pm = pa + 8 * (i / (DFF / 4)), ch = c4 * 4;
        const int tg = (ch >> 7) * 256 + (ch & 127), tu = tg + 128;
        const bool has_prev = (pm & 7) != 0;
        const float* hc = halo + (size_t)(pm * 4) * NUP; const float* hp = halo + (size_t)((has_prev ? pm - 1 : pm) * 4) * NUP;
        const f32x4 c0g = *(const f32x4*)(hc + tg), c0u = *(const f32x4*)(hc + tu), c1g = *(const f32x4*)(hc + NUP + tg), c1u = *(const f32x4*)(hc + NUP + tu);
        f32x4 p3g = *(const f32x4*)(hp + 3 * NUP + tg), p3u = *(const f32x4*)(hp + 3 * NUP + tu), p2g = *(const f32x4*)(hp + 2 * NUP + tg), p2u = *(const f32x4*)(hp + 2 * NUP + tu);
        const f32x4 w0g = *(const f32x4*)(cw + ch), w1g = *(const f32x4*)(cw + NUP + ch), w2g = *(const f32x4*)(cw + 2 * NUP + ch), bg = *(const f32x4*)(cb + ch);
        const f32x4 w0u = *(const f32x4*)(cw + DFF + ch), w1u = *(const f32x4*)(cw + NUP + DFF + ch), w2u = *(const f32x4*)(cw + 2 * NUP + DFF + ch), bu = *(const f32x4*)(cb + DFF + ch);
        if (!has_prev) { p3g = f32x4{0.f, 0.f, 0.f, 0.f}; p3u = p3g; p2g = p3g; p2u = p3g; }
        float o0[4], o1[4];
#pragma unroll
        for (int e = 0; e < 4; ++e) {
            const float yg0 = w0g[e] * p2g[e] + w1g[e] * p3g[e] + w2g[e] * c0g[e] + bg[e], yu0 = w0u[e] * p2u[e] + w1u[e] * p3u[e] + w2u[e] * c0u[e] + bu[e];
            const float yg1 = w0g[e] * p3g[e] + w1g[e] * c0g[e] + w2g[e] * c1g[e] + bg[e], yu1 = w0u[e] * p3u[e] + w1u[e] * c0u[e] + w2u[e] * c1u[e] + bu[e];
            o0[e] = yg0 * fast_rcp(1.f + fast_exp2(-yg0 * LOG2E)) * yu0; o1[e] = yg1 * fast_rcp(1.f + fast_exp2(-yg1 * LOG2E)) * yu1;
        }
        u32x2 s0, s1; s0.x = cvtpk(o0[0], o0[1]); s0.y = cvtpk(o0[2], o0[3]); s1.x = cvtpk(o1[0], o1[1]); s1.y = cvtpk(o1[2], o1[3]);
        *(u32x2*)(act + (size_t)(pm * 256) * DFF + ch) = s0; *(u32x2*)(act + (size_t)(pm * 256 + 1) * DFF + ch) = s1;
    }
    asm volatile("s_waitcnt vmcnt(0)" ::: "memory");
    __syncthreads();
}
__device__ __forceinline__ void final_phase(KP p) {
    const int lane = ltid() & 63, wave = ltid() >> 6; const float* ssqp = (const float*)(p->ws + WS_SSQP);
    for (int row = blockIdx.x * 8 + wave; row < MROWS; row += gridDim.x * 8) {
        float s = (lane < 32) ? ssqp[(size_t)row * 32 + lane] : 0.f; s = wave_sum(s);
        const float rs = __builtin_amdgcn_rsqf(s * (1.f / DM) + RMS_EPS);
        f32x4* o = (f32x4*)(p->out + (size_t)row * DM) + lane; const f32x4* gq = (const f32x4*)p->final_g + lane;
        const u32x2* hq = (const u32x2*)((const bf16_t*)(p->ws + WS_HB) + (size_t)row * DM) + lane;
#pragma unroll
        for (int j = 0; j < 8; ++j) { const u32x2 hv = hq[64 * j]; const f32x4 gg = gq[64 * j]; f32x4 v;
            v.x = __builtin_bit_cast(float, hv.x << 16); v.y = __builtin_bit_cast(float, hv.x & 0xFFFF0000u); v.z = __builtin_bit_cast(float, hv.y << 16); v.w = __builtin_bit_cast(float, hv.y & 0xFFFF0000u);
            o[64 * j] = v * rs * gg; }
    }
}
__device__ __forceinline__ float gelu_tanh(float x) { const float u = 0.7978845608028654f * (x + 0.044715f * x * x * x); const float e = __expf(2.f * u); const float th = 1.f - 2.f / (e + 1.f); return 0.5f * x * (1.f + th); }
__device__ __forceinline__ void compress_unit(KP p, int l, LAS unsigned char* lds, int upair) {
    const int tid = ltid(), wid = tid >> 6, lane = tid & 63, fr = lane & 15, fq = lane >> 4;
    const int nblk = wid & 3, grp = wid >> 2;
    const int unit = upair * 2 + grp;
    const int mc = unit & 3, kv = (unit >> 2) & 1, g = (unit >> 3) & 1, b = unit >> 4;
    const bf16_t* proj = (const bf16_t*)(p->ws + WS_PROJ);
    const bf16_t* w1t = (const bf16_t*)(p->ws + WS_W1T) + (size_t)(l * 2 + kv) * 128 * 4096;
    const bf16_t* w2t = (const bf16_t*)(p->ws + WS_W2T) + (size_t)(l * 2 + kv) * 128 * 128;
    const float* posc = (const float*)(p->ws + WS_POSC) + (l * 2 + kv) * 128;
    bf16_t* outp = (bf16_t*)(p->ws + (kv ? WS_VCMP : WS_KCMP)) + (size_t)(b * 2 + g) * 128 * 128;
    const bf16_t* arow[2]; const bf16_t* brow[2];
#pragma unroll
    for (int i = 0; i < 2; ++i) { const int n = mc * 32 + i * 16 + fr, nc = n < 127 ? n : 126;
        arow[i] = proj + (size_t)(b * SEQ + 16 * nc) * PROJ_LD + (kv ? C_NVC : C_NKC) + g * 128 + fq * 8;
        brow[i] = w1t + (size_t)(nblk * 32 + i * 16 + fr) * 4096 + fq * 8; }
    f32x4 acc[2][2] = {};
#define CMP_LOAD(A_, B_, LL) do { _Pragma("unroll") for (int i = 0; i < 2; ++i) _Pragma("unroll") for (int j = 0; j < 4; ++j) { \
        A_[i][j] = *(const bf16x8*)(arow[i] + (size_t)(LL) * PROJ_LD + j * 32); B_[i][j] = *(const bf16x8*)(brow[i] + (LL) * 128 + j * 32); } } while (0)
#define CMP_MMA(A_, B_) do { _Pragma("unroll") for (int j = 0; j < 4; ++j) _Pragma("unroll") for (int mi = 0; mi < 2; ++mi) _Pragma("unroll") for (int ni = 0; ni < 2; ++ni) \
        acc[mi][ni] = __builtin_amdgcn_mfma_f32_16x16x32_bf16(A_[mi][j], B_[ni][j], acc[mi][ni], 0, 0, 0); } while (0)
    bf16x8 a0[2][4], b0[2][4], a1[2][4], b1[2][4];
    CMP_LOAD(a0, b0, 0);
#pragma unroll 1
    for (int ll = 0; ll < 32; ll += 2) {
        CMP_LOAD(a1, b1, ll + 1);
        CMP_MMA(a0, b0);
        if (ll + 2 < 32) CMP_LOAD(a0, b0, ll + 2);
        CMP_MMA(a1, b1);
    }
#undef CMP_LOAD
#undef CMP_MMA
    LAS bf16_t* hid = (LAS bf16_t*)(lds + grp * 16384);
#pragma unroll
    for (int ni = 0; ni < 2; ++ni) { const int col = nblk * 32 + ni * 16 + fr; const float pc = posc[col];
#pragma unroll
        for (int mi = 0; mi < 2; ++mi)
#pragma unroll
            for (int i = 0; i < 4; ++i) hid[(mi * 16 + 4 * fq + i) * 136 + col] = (bf16_t)(cvtpk(gelu_tanh(acc[mi][ni][i] + pc), 0.f) & 0xFFFFu); }
    __syncthreads();
    {
        f32x4 acc2[2][2] = {};
#pragma unroll
        for (int j = 0; j < 4; ++j) { bf16x8 a2[2], b2[2];
#pragma unroll
            for (int i = 0; i < 2; ++i) { a2[i] = *(const LAS bf16x8*)(hid + (i * 16 + fr) * 136 + j * 32 + fq * 8); b2[i] = *(const bf16x8*)(w2t + (size_t)(nblk * 32 + i * 16 + fr) * 128 + j * 32 + fq * 8); }
#pragma unroll
            for (int mi = 0; mi < 2; ++mi)
#pragma unroll
                for (int ni = 0; ni < 2; ++ni) acc2[mi][ni] = __builtin_amdgcn_mfma_f32_16x16x32_bf16(a2[mi], b2[ni], acc2[mi][ni], 0, 0, 0); }
#pragma unroll
        for (int mi = 0; mi < 2; ++mi)
#pragma unroll
            for (int ni = 0; ni < 2; ++ni)
#pragma unroll
                for (int i = 0; i < 4; ++i) { const int nr = mc * 32 + mi * 16 + 4 * fq + i; const float v = (nr < 127) ? acc2[mi][ni][i] : 0.f;
                    outp[(size_t)nr * 128 + nblk * 32 + ni * 16 + fr] = (bf16_t)(cvtpk(v, 0.f) & 0xFFFFu); }
    }
    __syncthreads();
}
__device__ __forceinline__ void cumsum_unit(KP p, int l, LAS unsigned char* lds, int unit) {
    const int tid = ltid(), lane = tid & 63, wid = tid >> 6; const int b = unit / 6, h = unit % 6;
    const float* gates = (const float*)(p->ws + WS_GATES); float* c2 = (float*)(p->ws + WS_CUM) + (size_t)unit * SEQ;
    const float fb = p->fox_f_bias[l * 6 + h];
    float v[4], run = 0.f;
#pragma unroll
    for (int i = 0; i < 4; ++i) { const float xx = gates[(size_t)(b * SEQ + 4 * tid + i) * GATE_LD + h] + fb;
        const float ls = fminf(xx, 0.f) - log1pf(__expf(-fabsf(xx))); run += ls; v[i] = run; }
    float inc = run;
#pragma unroll
    for (int o = 1; o < 64; o <<= 1) { const float t = __builtin_bit_cast(float, __builtin_amdgcn_ds_bpermute(((lane - o) & 63) << 2, __builtin_bit_cast(int, inc))); if (lane >= o) inc += t; }
    LAS float* wsum = (LAS float*)lds;
    if (lane == 63) wsum[wid] = inc;
    __syncthreads();
    float base = 0.f;
#pragma unroll
    for (int w = 0; w < 8; ++w) if (w < wid) base += wsum[w];
    const float ex = base + inc - run;
#pragma unroll
    for (int i = 0; i < 4; ++i) c2[4 * tid + i] = (ex + v[i]) * LOG2E;
    __syncthreads();
}

#ifndef ATT_EN
#define ATT_EN 7
#endif
__device__ __forceinline__ void attention_phase(KP p, int lq, LAS unsigned char* lds_u, volatile LAS unsigned* misc) {
#ifdef ATT_DUPK
    const int att_en = (lq >= 4) ? (ATT_DUPK) : (ATT_EN);
#else
    constexpr int att_en = ATT_EN;
#endif
    const int l = lq & 3;
    att::lptr lds = (att::lptr)lds_u;
    const int tid = ltid();
    unsigned* ctl = (unsigned*)(p->ws + WS_CTL);
    const bf16_t* proj = (const bf16_t*)(p->ws + WS_PROJ); bf16_t* mixed = (bf16_t*)(p->ws + WS_MIXED);
    const float* gates = (const float*)(p->ws + WS_GATES);
    float* scr = (float*)(p->ws + WS_SCR) + (size_t)blockIdx.x * 32768;
    const bf16_t* kcmp = (const bf16_t*)(p->ws + WS_KCMP); const bf16_t* vcmp = (const bf16_t*)(p->ws + WS_VCMP);
    { LAS float* lut = (LAS float*)(lds + att::L_LUT);
      for (int i = tid; i < 1280; i += 512) { const int hh = i >> 7, rel = i & 127; lut[i] = (p->rel_bias[(int)T5B[rel] * 10 + hh] - p->rel_bias[31 * 10 + hh]) * LOG2E; } }
    const int lane = tid & 63;
    const float s1 = wave_sum(p->lq1[l * 64 + lane] * p->lk1[l * 64 + lane]), s2 = wave_sum(p->lq2[l * 64 + lane] * p->lk2[l * 64 + lane]);
    const float lam_init = 0.8f - 0.6f * __expf(-0.3f * (float)l);
    const float lam = __expf(s1) - __expf(s2) + lam_init;
    constexpr int QN_CMP = 16, QN_DIFF = 64, QN_NSA = 32, QN_FOX = 96, QN = QN_CMP + QN_DIFF + QN_NSA + QN_FOX;
    if ((tid >> 6) >= 4) __builtin_amdgcn_s_setprio(1); else __builtin_amdgcn_s_setprio(0);
    const int home = (int)(xb_xcc_id() & 7u);
    unsigned cmp_seen = 0u;
    int qx = home;
    __syncthreads();
    for (;;) {
        if (tid == 0) {
            unsigned* qh = ctl + CW_QUEUE + (lq * 8) * 64;
            unsigned iv = __hip_atomic_fetch_add(qh + qx * 64, 1u, __ATOMIC_RELAXED, __HIP_MEMORY_SCOPE_AGENT); int q = qx;
            if (iv >= (unsigned)QN) {
                unsigned hv[7];
#pragma unroll
                for (int k = 1; k < 8; ++k) hv[k - 1] = __hip_atomic_load(qh + ((qx + k) & 7) * 64, __ATOMIC_RELAXED, __HIP_MEMORY_SCOPE_AGENT);
#pragma unroll
                for (int k = 1; k < 8; ++k) if (iv >= (unsigned)QN && hv[k - 1] < (unsigned)QN) {
                    const unsigned t = __hip_atomic_fetch_add(qh + ((qx + k) & 7) * 64, 1u, __ATOMIC_RELAXED, __HIP_MEMORY_SCOPE_AGENT);
                    if (t < (unsigned)QN) { iv = t; q = (qx + k) & 7; } }
            }
            misc[4] = iv; misc[5] = (unsigned)q;
        }
        __syncthreads();
        const int idx = (int)misc[4]; qx = (int)misc[5];
        __syncthreads();
        if (idx >= QN) break;
        unsigned* cdone = ctl + CW_CMPDONE + (lq * 8 + qx) * 64;
        if (idx < QN_CMP) {
            const int gi = qx * 4 + (idx >> 2), pr = idx & 3;
            compress_unit(p, l, lds_u, gi * 4 + pr);
            asm volatile("s_waitcnt vmcnt(0)" ::: "memory");
            __syncthreads();
            if (tid == 0) { __builtin_amdgcn_fence(__ATOMIC_RELEASE, "agent"); asm volatile("s_waitcnt vmcnt(0)" ::: "memory");
                __hip_atomic_fetch_add(cdone, 1u, __ATOMIC_RELAXED, __HIP_MEMORY_SCOPE_AGENT); }
            continue;
        }
        int j = idx - QN_CMP;
        if (j < QN_DIFF) { const int di = qx * 8 + (j & 7), qb = 7 - (j >> 3);
            if (att_en & 2) att::diff_unit(lds, proj, mixed, scr, di >> 2, di & 3, qb, lam, 1.f - lam_init, p->subln_g + l * 128); continue; }
        j -= QN_DIFF;
        if (j < QN_NSA) { const int gi = qx * 4 + (j & 3), qb = 7 - (j >> 2);
            if (!((cmp_seen >> qx) & 1u)) {
                if (tid == 0) { unsigned sp = 0; while (__hip_atomic_load(cdone, __ATOMIC_RELAXED, __HIP_MEMORY_SCOPE_AGENT) < (unsigned)QN_CMP) { __builtin_amdgcn_s_sleep(2); if (++sp > (1u << 22)) break; }
                    __builtin_amdgcn_fence(__ATOMIC_ACQUIRE, "agent"); asm volatile("s_waitcnt vmcnt(0)" ::: "memory"); }
                __syncthreads(); cmp_seen |= 1u << qx; }
            if (att_en & 1) att::nsa_unit(lds, proj, gates, kcmp, vcmp, mixed, scr, gi >> 1, gi & 1, qb); continue; }
        j -= QN_NSA;
        { const int fi = qx * 12 + j % 12, qb = 7 - j / 12;
            if (att_en & 4) att::fox_unit(lds, proj, gates, p->fox_f_bias[l * 6 + fi % 6], mixed, fi / 6, fi % 6, qb); }
    }
    __builtin_amdgcn_s_setprio(0);
    if (l + 1 < DEPTH && lq < 4) {
        const int tid = ltid(); KP p = kparams();
                unsigned* chead = (unsigned*)(p->ws + WS_CTL) + CW_CONV + l * 64;
        LAS float* scrw = (LAS float*)lds_u + (tid >> 6) * (64 * 33);
        constexpr int NCH = (T_LAYER + 63) / 64;
        __syncthreads();
        for (;;) {
            if (tid == 0) misc[4] = __hip_atomic_fetch_add(chead, 1u, __ATOMIC_RELAXED, __HIP_MEMORY_SCOPE_AGENT);
            __syncthreads();
            const int ch = (int)misc[4];
            __syncthreads();
            if (ch >= NCH) break;
#pragma unroll 1
            for (int k = 0; k < 8; ++k) { const int it = ch * 64 + k * 8 + (tid >> 6); if (it < T_LAYER) convert_item(p, l + 1, it, scrw, tid & 63); }
        }
    }
}

#ifndef ATT_EN
#define ATT_EN 7
#endif
#ifndef PH_EN
#define PH_EN 255
#endif
#ifndef DUP
#define DUP 0
#endif
#define DUPLOOP(k) _Pragma("unroll 1") for (int rep_ = 0; rep_ < (((DUP) & (k)) ? 2 : 1); ++rep_)
__global__ void __launch_bounds__(512, 2) mk_fwd(Params p_unused) {
    extern __shared__ __attribute__((aligned(16))) unsigned char lds_raw[];
    LAS unsigned char* lds = (LAS unsigned char*)lds_raw;
    volatile LAS unsigned* misc = (volatile LAS unsigned*)(lds + LX_MISC);
    const int G = gridDim.x;
    if (ltid() < 16) misc[ltid()] = 0u;
    __syncthreads();
    XcdBarrier bar;
    { KP p = kparams(); bar = xcd_barrier_post((unsigned*)(p->ws + WS_CTL) + CW_BAR + p->bar_region * XCD_BAR_WORDS, misc); }
    DUPLOOP(64) { KP p = kparams(); if ((PH_EN & 64) && p->do_prologue) { prologue_phase(p, lds); xcd_barrier(bar); } }

    const int l_begin = kparams()->l_begin, l_end = kparams()->l_end, ph_mask = kparams()->ph_mask;
    for (int l = l_begin; l < l_end; ++l) {
        if ((PH_EN & 1) && (ph_mask & 1)) DUPLOOP(1) {
            KP p = kparams(); unsigned char* ws = p->ws;
            rstd_prefix(p, lds); if (rep_ == 0) gate_prefix(p, l, lds);
            pg8::Gemm g{(const bf16_t*)(ws + WS_HB), (const bf16_t*)(ws + WS_WIN) + (size_t)l * NINP * DM, MROWS, PROJ_LD, DM}; pg8::StaticOrder S; S.init(MROWS, PROJ_LD, G, (int)blockIdx.x);
            epi::InProj E{(bf16_t*)(ws + WS_PROJ), (const LAS float*)(lds + LX_RSTAB)};
            pg8::gemm_phase<epi::InProj, pg8::StaticOrder, true, true>(lds, g, S, E);
            xcd_barrier(bar);
        }
        if ((PH_EN & 4) && (ph_mask & 6)) DUPLOOP(4) {
            attention_phase(kparams(), l + 4 * rep_, lds, misc);
            xcd_barrier(bar);
        }
        if ((PH_EN & 8) && (ph_mask & 8)) DUPLOOP(8) {
            { KP p = kparams(); unsigned char* ws = p->ws;
              pg8::Gemm g{(const bf16_t*)(ws + WS_MIXED), (const bf16_t*)(ws + WS_WOUT) + (size_t)l * DM * DM, MROWS, DM, DM}; pg8::StaticOrder S; S.init(MROWS, DM, G, (int)blockIdx.x);
              epi::Resid E{(bf16_t*)(ws + (rep_ ? WS_END : WS_HB)), (float*)(ws + (rep_ ? WS_END + (size_t)MROWS * DM * 2 : WS_SSQP))};
              pg8::gemm_phase<epi::Resid, pg8::StaticOrder, true, true>(lds, g, S, E); }
            xcd_barrier(bar);
        }
        if ((PH_EN & 16) && (ph_mask & 16)) DUPLOOP(16) {
            { KP p = kparams(); unsigned char* ws = p->ws;
              rstd_prefix(p, lds);
              pg8::Gemm g{(const bf16_t*)(ws + WS_HB), (const bf16_t*)(ws + WS_WUP) + (size_t)l * NUP * DM, MROWS, NUP, DM}; pg8::StaticOrder S; S.init(MROWS, NUP, G, (int)blockIdx.x);
              epi::UpConv E{(bf16_t*)(ws + WS_PROJ), (const LAS float*)(lds + LX_RSTAB), p->conv_w + (size_t)l * 3 * NUP, p->conv_b + (size_t)l * NUP, (float*)(ws + WS_HALO), (LAS float*)(lds + LX_CONV)};
              pg8::gemm_phase<epi::UpConv, pg8::StaticOrder, true, true>(lds, g, S, E); }
            xcd_barrier(bar);
        }
        if ((PH_EN & 32) && (ph_mask & 32)) DUPLOOP(32) {
            { KP p = kparams(); unsigned char* ws = p->ws;
              fixup_prefix(p, l);
              pg8::Gemm g{(const bf16_t*)(ws + WS_PROJ), (const bf16_t*)(ws + WS_WDN) + (size_t)l * DM * DFF, MROWS, DM, DFF}; pg8::StaticOrder S; S.init(MROWS, DM, G, (int)blockIdx.x);
              epi::Resid E{(bf16_t*)(ws + (rep_ ? WS_END : WS_HB)), (float*)(ws + (rep_ ? WS_END + (size_t)MROWS * DM * 2 : WS_SSQP))};
              pg8::gemm_phase<epi::Resid, pg8::StaticOrder, true, true>(lds, g, S, E); }
            xcd_barrier(bar);
        }
    }
    { KP p = kparams(); if ((PH_EN & 128) && p->do_final) final_phase(p); }
}

#if MK_DEBUG
constexpr int NCHK = 16;
#ifndef DBG_SKIP
#define DBG_SKIP 0
#endif
__constant__ int DBG_TS[8] = {0, 1, 255, 256, 700, 1023, 1500, 2047};
__constant__ int DBG_RS[16] = {0, 1, 2, 3, 62, 63, 64, 65, 126, 127, 128, 129, 191, 192, 254, 255};
__constant__ float DBG_TOL[NCHK] = {0, 1e-6f, 1e-3f, 0.03f, 0.03f, 1e-3f, 0.05f, 0.05f, 0.05f, 0.08f, 0.03f, 0.05f, 0.03f, 0, 0, 0};
__device__ __forceinline__ void diag_max(unsigned* diag, int c, float err) { unsigned b = __builtin_bit_cast(unsigned, fabsf(err)); if (err != err) b = 0x7FC00000u; atomicMax(diag + c, b); }
__device__ __forceinline__ void diag_bits(unsigned* diag, int c, unsigned bits) { atomicOr(diag + 16 + c, bits); }
__device__ __forceinline__ unsigned hash_u(unsigned x) { x ^= x >> 16; x *= 0x7feb352du; x ^= x >> 15; x *= 0x846ca68bu; x ^= x >> 16; return x; }
__device__ __forceinline__ float bfr(float v) { return bf2f((bf16_t)(cvtpk(v, 0.f) & 0xFFFFu)); }
__device__ __forceinline__ float blk_sum(float v, float* sh) {
    const int t = threadIdx.x; sh[t] = v; __syncthreads();
    for (int o = 128; o > 0; o >>= 1) { if (t < o) sh[t] += sh[t + o]; __syncthreads(); }
    const float r = sh[0]; __syncthreads(); return r;
}
__device__ __forceinline__ float blk_max(float v, float* sh) {
    const int t = threadIdx.x; sh[t] = v; __syncthreads();
    for (int o = 128; o > 0; o >>= 1) { if (t < o) sh[t] = fmaxf(sh[t], sh[t + o]); __syncthreads(); }
    const float r = sh[0]; __syncthreads(); return r;
}
__device__ __forceinline__ int t5_bucket_ref(int rel) {
    const int n = rel > 0 ? rel : 0; if (n < 16) return n;
    const float nf = (float)n; int large = 16 + (int)(logf(nf / 16.f) / logf(8.f) * 16.f); if (large > 31) large = 31; return large;
}
__device__ __forceinline__ float relerr(float fast, float ref, float scale) { return fabsf(fast - ref) / (fabsf(ref) + scale); }

__global__ void __launch_bounds__(256) chk_kernel(Params p, int stage, const float* out_prev) {
    __shared__ float sh[256];
    __shared__ float sbuf[2304];
    __shared__ float sq[384];
    __shared__ int sidx[16];
    unsigned* diag = (unsigned*)(p.ws + WS_DIAG);
    unsigned char* ws = p.ws;
    const int t = threadIdx.x;
    const bf16_t* hb = (const bf16_t*)(ws + WS_HB); const float* rstd = (const float*)(ws + WS_RSTD);
    const bf16_t* proj = (const bf16_t*)(ws + WS_PROJ); const float* gates = (const float*)(ws + WS_GATES);
    const bf16_t* mixed = (const bf16_t*)(ws + WS_MIXED); const float* c2 = (const float*)(ws + WS_CUM);
    const bf16_t* kcmp = (const bf16_t*)(ws + WS_KCMP); const bf16_t* vcmp = (const bf16_t*)(ws + WS_VCMP);
    const int l = 0;
    if (stage == 2) {
        unsigned bad = 0; const size_t nvec = (size_t)MROWS * PROJ_LD / 8;
        for (size_t i = (size_t)blockIdx.x * 256 + t; i < nvec; i += (size_t)gridDim.x * 256) { const bf16x8 v = ((const bf16x8*)proj)[i];
#pragma unroll
            for (int e = 0; e < 8; ++e) { const float x = bf2f((bf16_t)v[e]); if (!(fabsf(x) < 1000.f)) ++bad; } }
        if (bad) atomicAdd(diag + 13, bad);
    }
    if (stage == 3) {
        unsigned bad = 0;
        for (int i = blockIdx.x * 256 + t; i < NBATCH * 2 * 128 * 128; i += gridDim.x * 256) { const float a = bf2f(kcmp[i]), c = bf2f(vcmp[i]); if (!(fabsf(a) < 1000.f)) ++bad; if (!(fabsf(c) < 1000.f)) bad += 65536u; }
        if (bad & 0xFFFFu) atomicAdd(diag + 14, bad & 0xFFFFu); if (bad >> 16) atomicAdd(diag + 15, bad >> 16);
    }
    for (int smp = blockIdx.x; smp < (stage == 2 ? 512 : 64); smp += gridDim.x) {
        const unsigned h0 = hash_u(smp * 2654435761u + stage * 97u + 12345u), h1 = hash_u(h0 + 1u), h2 = hash_u(h1 + 7u);
        if (stage == 1) {
            const unsigned r0 = hash_u(h0 + t * 31u), r1 = hash_u(r0 + 5u), r2 = hash_u(r1 + 3u);
            { const int ll = r0 & 3, c = r1 % NINP, k = r2 % DM; const int oc = win_colmap(c);
              const float ref = oc >= 0 ? bfr(p.w_in[((size_t)ll * DM + k) * NIN + oc] * p.attn_norm_g[ll * DM + k]) : 0.f;
              diag_max(diag, 1, bf2f(((const bf16_t*)(ws + WS_WIN))[((size_t)ll * NINP + c) * DM + k]) - ref); }
            { const int ll = r0 & 3, c = r1 % DM, k = r2 % DM; const float ref = bfr(p.w_out[((size_t)ll * DM + k) * DM + c]);
              diag_max(diag, 1, bf2f(((const bf16_t*)(ws + WS_WOUT))[((size_t)ll * DM + c) * DM + k]) - ref); }
            { const int ll = r0 & 3, c = r1 % NUP, k = r2 % DM; const int oc = wup_colmap(c); const float ref = bfr(p.w_up[((size_t)ll * DM + k) * NUP + oc] * p.ffn_norm_g[ll * DM + k]);
              diag_max(diag, 1, bf2f(((const bf16_t*)(ws + WS_WUP))[((size_t)ll * NUP + c) * DM + k]) - ref); }
            { const int ll = r0 & 3, c = r1 % DM, k = r2 % DFF; const float ref = bfr(p.w_down[((size_t)ll * DFF + k) * DM + c]);
              diag_max(diag, 1, bf2f(((const bf16_t*)(ws + WS_WDN))[((size_t)ll * DM + c) * DFF + k]) - ref); }
            { const int ll = r0 & 3, kv = (r0 >> 2) & 1, c = r1 % 128, k = r2 % 4096; const float ref = bfr((kv ? p.wv1 : p.wk1)[((size_t)ll * 4096 + k) * 128 + c]);
              diag_max(diag, 1, bf2f(((const bf16_t*)(ws + WS_W1T))[((size_t)(ll * 2 + kv) * 128 + c) * 4096 + k]) - ref); }
            { const int ll = r0 & 3, kv = (r0 >> 2) & 1, c = r1 % 128, k = r2 % 128; const float ref = bfr((kv ? p.wv2 : p.wk2)[((size_t)ll * 128 + k) * 128 + c]);
              diag_max(diag, 1, bf2f(((const bf16_t*)(ws + WS_W2T))[((size_t)(ll * 2 + kv) * 128 + c) * 128 + k]) - ref); }
            { const int row = h0 % MROWS; float ss = 0.f; for (int k = t; k < DM; k += 256) { const float xv = p.x[(size_t)row * DM + k]; ss += xv * xv; diag_max(diag, 2, bf2f(hb[(size_t)row * DM + k]) - bfr(xv)); }
              ss = blk_sum(ss, sh); if (t == 0) diag_max(diag, 2, relerr(rstd[row], 1.f / sqrtf(ss / DM + RMS_EPS), 1e-6f)); }
            { const int ll = h1 & 3, kv = (h1 >> 2) & 1, c = h2 % 128; float s = 0.f; for (int k = t; k < 4096; k += 256) s += p.cmp_pos[(size_t)ll * 4096 + k] * (kv ? p.wv1 : p.wk1)[((size_t)ll * 4096 + k) * 128 + c];
              s = blk_sum(s, sh); if (t == 0) diag_max(diag, 2, relerr(((const float*)(ws + WS_POSC))[(ll * 2 + kv) * 128 + c], s, 1e-3f)); }
        } else if (stage == 2) {
            const int pnn = smp % 25; const int row = h0 % MROWS, c = pnn == 24 ? 6144 + (h1 % 24) : pnn * 256 + (h1 % 256); const int oc = win_colmap(c);
            float ss = 0.f, dot = 0.f;
            for (int k = t; k < DM; k += 256) { const float xv = p.x[(size_t)row * DM + k]; ss += xv * xv; dot += bfr(xv) * bfr(p.w_in[((size_t)l * DM + k) * NIN + oc] * p.attn_norm_g[l * DM + k]); }
            ss = blk_sum(ss, sh); dot = blk_sum(dot, sh);
            if (t == 0) { const float rs = 1.f / sqrtf(ss / DM + RMS_EPS); const int pn = c >> 8;
                float cs = 1.f; if (pn < 3 || (pn >= 15 && pn <= 17)) cs = 0.08838834764831845f * LOG2E; else if (pn == 9 || pn == 10) cs = 0.125f * LOG2E;
                if (c < 6144) { const float fv = bf2f(proj[(size_t)row * PROJ_LD + c]); const float er = relerr(fv, dot * rs * cs, 0.05f); diag_max(diag, 3, er);
                    if (!(er <= 0.03f)) diag_bits(diag, 3, (pn < 9 ? 1u : pn < 15 ? 2u : pn < 18 ? 4u : 8u) | ((row % SEQ) >= 512 ? 16u : 0u) | (fabsf(fv) < 1e-6f ? 32u : 0u)); }
                else diag_max(diag, 4, relerr(gates[(size_t)row * GATE_LD + (c - 6144)], dot * rs, 0.05f)); }
        } else if (stage == 3) {
            if (smp < 24) { if (t == 0) { const int bh = (h0 % 96), b = bh / 6, h = bh % 6; float run = 0.f, worst = 0.f;
                    for (int s = 0; s < SEQ; ++s) { const float xx = gates[(size_t)(b * SEQ + s) * GATE_LD + h] + p.fox_f_bias[l * 6 + h]; run += fminf(xx, 0.f) - log1pf(expf(-fabsf(xx)));
                        worst = fmaxf(worst, relerr(c2[(size_t)bh * SEQ + s], run * LOG2E, 1.f)); float cv = c2[(size_t)bh * SEQ + s]; if (cv != cv) worst = cv; }
                    diag_max(diag, 5, worst); } }
            else { const int b = h0 % NBATCH, g = h1 & 1, kv = (h1 >> 1) & 1, n = (smp & 7) == 7 ? 127 : (smp & 7) == 6 ? 126 : h2 % 127;
                const float* w1 = (kv ? p.wv1 : p.wk1) + (size_t)l * 4096 * 128; const float* w2 = (kv ? p.wv2 : p.wk2) + (size_t)l * 128 * 128;
                if (t < 128) { float s = 0.f; if (n < 127) { for (int ll = 0; ll < 32; ++ll) for (int d = 0; d < 128; ++d)
                        s += bf2f(proj[(size_t)(b * SEQ + 16 * n + ll) * PROJ_LD + (kv ? C_NVC : C_NKC) + g * 128 + d]) * bfr(w1[(size_t)(ll * 128 + d) * 128 + t]);
                        s += ((const float*)(ws + WS_POSC))[(l * 2 + kv) * 128 + t]; const float u = 0.7978845608028654f * (s + 0.044715f * s * s * s); s = 0.5f * s * (1.f + tanhf(u)); }
                    sbuf[t] = bfr(s);
                    if (n < 127) { const int unit = (n >> 5) + 4 * kv + 8 * g + 16 * b; const float hv = ((const float*)(ws + WS_SCR))[(size_t)unit * 4096 + (n & 31) * 128 + t];
                        const float er = relerr(hv, s, 0.05f); if (!(er <= 0.05f)) diag_bits(diag, 6, 1u | (fabsf(hv) > 100.f ? 2u : 0u) | (hv != hv ? 4u : 0u)); } }
                __syncthreads();
                if (t < 128) { float s = 0.f; if (n < 127) for (int j = 0; j < 128; ++j) s += sbuf[j] * bfr(w2[(size_t)j * 128 + t]);
                    const float fv = bf2f((kv ? vcmp : kcmp)[((size_t)(b * 2 + g) * 128 + n) * 128 + t]); const float er = relerr(fv, s, 0.05f);
                    diag_max(diag, 6, er);
                    if (!(er <= 0.05f)) diag_bits(diag, 6, 8u | (kv ? 16u : 0u) | ((n >= 96 && n < 112) ? 32u : 0u)); }
                __syncthreads(); }
        } else if (stage == 4) {
            const int b = h0 % NBATCH, tt = (smp & 1) ? DBG_TS[(smp >> 1) & 7] : (int)(h1 % SEQ);
            const size_t qrow = (size_t)(b * SEQ + tt);
            if (smp < 24) {
                const int h = h2 % 6; const bf16_t* q = proj + qrow * PROJ_LD + C_FQ + h * 128; const float* cc = c2 + (size_t)(b * 6 + h) * SEQ;
                float mx = -1e30f;
                for (int k = t; k <= tt; k += 256) { const bf16_t* kr = proj + (size_t)(b * SEQ + k) * PROJ_LD + C_FK + h * 128; float s = 0.f; for (int d = 0; d < 128; ++d) s += bf2f(q[d]) * bf2f(kr[d]);
                    s += cc[tt] - cc[k]; sbuf[k] = s; mx = fmaxf(mx, s); }
                mx = blk_max(mx, sh); float sum = 0.f;
                for (int k = t; k <= tt; k += 256) { sbuf[k] = exp2f(sbuf[k] - mx); sum += sbuf[k]; }
                sum = blk_sum(sum, sh);
                if (t < 128) { float o = 0.f; for (int k = 0; k <= tt; ++k) o += sbuf[k] * bf2f(proj[(size_t)(b * SEQ + k) * PROJ_LD + C_FV + h * 128 + t]); o /= sum;
                    const float fv = bf2f(mixed[qrow * DM + h * 128 + t]); const float er = relerr(fv, o, 0.05f); diag_max(diag, 7, er);
                    if (!(er <= 0.05f)) diag_bits(diag, 7, (tt < 64 ? 1u : tt < 512 ? 2u : 4u) | ((fabsf(fv) < 1e-6f) ? 8u : 0u) | ((fabsf(fv) > 4.f * fabsf(o) + 0.2f) ? 16u : 0u) | ((fv != fv) ? 32u : 0u)); }
                __syncthreads();
            } else if (smp < 40) {
                const int h = h2 & 3; float* o2 = sq;
                const float lam_init = 0.8f - 0.6f * expf(-0.3f * (float)l);
                float s1 = 0.f, s2 = 0.f; for (int i = 0; i < 64; ++i) { s1 += p.lq1[l * 64 + i] * p.lk1[l * 64 + i]; s2 += p.lq2[l * 64 + i] * p.lk2[l * 64 + i]; }
                const float lam = expf(s1) - expf(s2) + lam_init;
                if (t < 128) o2[t] = 0.f; __syncthreads();
                for (int mp = 0; mp < 2; ++mp) {
                    const bf16_t* q = proj + qrow * PROJ_LD + C_DQ + h * 128 + mp * 64; float mx = -1e30f;
                    for (int k = t; k <= tt; k += 256) { const bf16_t* kr = proj + (size_t)(b * SEQ + k) * PROJ_LD + C_DK + h * 128 + mp * 64; float s = 0.f; for (int d = 0; d < 64; ++d) s += bf2f(q[d]) * bf2f(kr[d]);
                        s += p.rel_bias[t5_bucket_ref(tt - k) * 10 + h] * LOG2E; sbuf[k] = s; mx = fmaxf(mx, s); }
                    mx = blk_max(mx, sh); float sum = 0.f;
                    for (int k = t; k <= tt; k += 256) { sbuf[k] = exp2f(sbuf[k] - mx); sum += sbuf[k]; }
                    sum = blk_sum(sum, sh);
                    if (t < 128) { float o = 0.f; for (int k = 0; k <= tt; ++k) o += sbuf[k] * bf2f(proj[(size_t)(b * SEQ + k) * PROJ_LD + C_DV + h * 128 + t]); o /= sum; o2[t] += (mp == 0 ? o : -lam * o); }
                    __syncthreads();
                }
                float ssq = (t < 128) ? o2[t] * o2[t] : 0.f; ssq = blk_sum(ssq, sh);
                if (t < 128) { const float y = o2[t] * (1.f / sqrtf(ssq / 128.f + RMS_EPS)) * p.subln_g[l * 128 + t] * (1.f - lam_init);
                    const float fv = bf2f(mixed[qrow * DM + 768 + h * 128 + t]); const float er = relerr(fv, y, 0.5f); diag_max(diag, 8, er);
                    if (!(er <= 0.05f)) diag_bits(diag, 8, (tt < 64 ? 1u : tt < 512 ? 2u : 4u) | ((fabsf(fv) < 1e-6f) ? 8u : 0u) | ((fabsf(fv) > 4.f * fabsf(y) + 0.2f) ? 16u : 0u) | ((fv != fv) ? 32u : 0u)); }
                __syncthreads();
            } else {
                const int h6 = h2 % 6, g = h6 / 3; float* pc = sbuf + 2048;
                float* imp = sq + 128; float* oacc = sq + 192;
                if (t < 32) imp[t] = 0.f; if (t < 128) oacc[t] = 0.f; __syncthreads();
                const bf16_t* kc = kcmp + (size_t)(b * 2 + g) * 128 * 128; const bf16_t* vc = vcmp + (size_t)(b * 2 + g) * 128 * 128;
                const float* gp = gates + qrow * GATE_LD + 6 + h6 * 3;
                const float g0 = 1.f / (1.f + expf(-gp[0])), g1 = 1.f / (1.f + expf(-gp[1])), g2 = 1.f / (1.f + expf(-gp[2]));
                for (int hh = 0; hh < 3; ++hh) {
                    const int hd = g * 3 + hh; const bf16_t* q = proj + qrow * PROJ_LD + C_NQ + hd * 128;
                    float s = -1e30f; bool ok = false;
                    if (t < 127) { ok = (16 * t + 31) <= tt; if (ok) { s = 0.f; for (int d = 0; d < 128; ++d) s += bf2f(q[d]) * bf2f(kc[(size_t)t * 128 + d]); s += p.rel_bias[t5_bucket_ref(tt - (16 * t + 31)) * 10 + 4 + hd] * LOG2E; } }
                    const float mx = blk_max(ok ? s : -1e30f, sh); const float e = ok ? exp2f(s - mx) : 0.f; const float sum = blk_sum(e, sh);
                    const float pr = sum > 0.f ? e / sum : 0.f;
                    if (t < 128) pc[t] = pr; __syncthreads();
                    if (t < 32) { float a = 0.f; for (int n = 0; n < 127; ++n) { int lo = max(16 * n, 64 * t), hi2 = min(16 * n + 32, 64 * t + 64); int ov = hi2 - lo; if (ov > 0) a += pc[n] * ((float)ov / 32.f); } imp[t] += a; }
                    if (hd == h6 && t < 128) { float o = 0.f; for (int n = 0; n < 127; ++n) o += pc[n] * bf2f(vc[(size_t)n * 128 + t]); oacc[t] += g0 * o; }
                    __syncthreads();
                }
                if (t == 0) { const int blk = tt >> 6; float* sc = sbuf + 2200; for (int j = 0; j < 32; ++j) { const bool forced = j == 0 || j == blk || j == blk - 1; sc[j] = (j <= blk) ? imp[j] + (forced ? 1e4f : 0.f) : -1e30f; }
                    unsigned m = 0; for (int it = 0; it < 8; ++it) { float best = -1e30f; int bi = -1; for (int j = 0; j < 32; ++j) if (!((m >> j) & 1u) && sc[j] > best) { best = sc[j]; bi = j; } if (bi >= 0 && best > -0.5e30f) m |= 1u << bi; }
                    sidx[0] = (int)m; }
                __syncthreads();
                const unsigned selm = (unsigned)sidx[0];
                for (int br = 0; br < 2; ++br) {
                    const bf16_t* q = proj + qrow * PROJ_LD + C_NQ + h6 * 128; const int kcol = (br == 0 ? C_NKS : C_NKW) + g * 128, vcol = (br == 0 ? C_NVS : C_NVW) + g * 128;
                    float mx = -1e30f;
                    for (int k = t; k <= tt; k += 256) { const bool ok = br == 0 ? ((selm >> (k >> 6)) & 1u) != 0u : (tt - k < 512); float s = -1e30f;
                        if (ok) { const bf16_t* kr = proj + (size_t)(b * SEQ + k) * PROJ_LD + kcol; s = 0.f; for (int d = 0; d < 128; ++d) s += bf2f(q[d]) * bf2f(kr[d]); s += p.rel_bias[t5_bucket_ref(tt - k) * 10 + 4 + h6] * LOG2E; }
                        sbuf[k] = s; mx = fmaxf(mx, s); }
                    mx = blk_max(mx, sh); float sum = 0.f;
                    for (int k = t; k <= tt; k += 256) { sbuf[k] = sbuf[k] > -1e29f ? exp2f(sbuf[k] - mx) : 0.f; sum += sbuf[k]; }
                    sum = blk_sum(sum, sh);
                    if (t < 128) { float o = 0.f; for (int k = 0; k <= tt; ++k) o += sbuf[k] * bf2f(proj[(size_t)(b * SEQ + k) * PROJ_LD + vcol + t]); oacc[t] += (br == 0 ? g1 : g2) * o / sum; }
                    __syncthreads();
                }
                if (t < 128) { const float fv = bf2f(mixed[qrow * DM + 1280 + h6 * 128 + t]); const float er = relerr(fv, oacc[t], 0.05f); diag_max(diag, 9, er);
                    if (!(er <= 0.08f)) diag_bits(diag, 9, (tt < 64 ? 1u : tt < 512 ? 2u : 4u) | ((fabsf(fv) < 1e-6f) ? 8u : 0u) | ((fabsf(fv) > 4.f * fabsf(oacc[t]) + 0.2f) ? 16u : 0u) | ((fv != fv) ? 32u : 0u)); }
                __syncthreads();
            }
        } else if (stage == 5) {
            const int row = h0 % MROWS, col = h1 % DM; float dot = 0.f, ss = 0.f;
            for (int k = t; k < DM; k += 256) { dot += bf2f(mixed[(size_t)row * DM + k]) * bfr(p.w_out[((size_t)l * DM + k) * DM + col]); const float hv = p.out[(size_t)row * DM + k]; ss += hv * hv; }
            dot = blk_sum(dot, sh); ss = blk_sum(ss, sh);
            if (t == 0) { const float ref = p.x[(size_t)row * DM + col] + dot; diag_max(diag, 10, relerr(p.out[(size_t)row * DM + col], ref, 0.05f));
                diag_max(diag, 10, relerr(bf2f(hb[(size_t)row * DM + col]), ref, 0.05f)); diag_max(diag, 10, relerr(rstd[row], 1.f / sqrtf(ss / DM + RMS_EPS), 1e-3f)); }
        } else if (stage == 6) {
            const int pm = h0 % 128, row = pm * 256 + DBG_RS[smp & 15], ch = h1 % DFF, s = row % SEQ;
            float yg = p.conv_b[l * NUP + ch], yu = p.conv_b[l * NUP + DFF + ch];
            for (int tap = 0; tap < 3; ++tap) { const int sp = s - 2 + tap; float dg = 0.f, du = 0.f;
                if (sp >= 0) { const int r2 = row - 2 + tap;
                    for (int k = t; k < DM; k += 256) { const float a = bf2f(hb[(size_t)r2 * DM + k]); const float gk = p.ffn_norm_g[l * DM + k];
                        dg += a * bfr(p.w_up[((size_t)l * DM + k) * NUP + ch] * gk); du += a * bfr(p.w_up[((size_t)l * DM + k) * NUP + DFF + ch] * gk); }
                    dg = blk_sum(dg, sh) * rstd[r2]; du = blk_sum(du, sh) * rstd[r2]; }
                yg += p.conv_w[((size_t)l * 3 + tap) * NUP + ch] * dg; yu += p.conv_w[((size_t)l * 3 + tap) * NUP + DFF + ch] * du; }
            if (t == 0) { const float ref = yg / (1.f + expf(-yg)) * yu; diag_max(diag, 11, relerr(bf2f(proj[(size_t)row * DFF + ch]), ref, 0.05f)); }
        } else if (stage == 7) {
            const int row = h0 % MROWS, col = h1 % DM; float dot = 0.f, ss = 0.f;
            for (int k = t; k < DFF; k += 256) dot += bf2f(proj[(size_t)row * DFF + k]) * bfr(p.w_down[((size_t)l * DFF + k) * DM + col]);
            for (int k = t; k < DM; k += 256) { const float hv = p.out[(size_t)row * DM + k]; ss += hv * hv; }
            dot = blk_sum(dot, sh); ss = blk_sum(ss, sh);
            if (t == 0) { const float ref = out_prev[(size_t)row * DM + col] + dot; diag_max(diag, 12, relerr(p.out[(size_t)row * DM + col], ref, 0.05f));
                diag_max(diag, 12, relerr(bf2f(hb[(size_t)row * DM + col]), ref, 0.05f)); (void)ss; }
        }
    }
}
__global__ void report_kernel(float* out, const unsigned* diag, int n) {
    __shared__ float code, mag;
    if (threadIdx.x == 0) {
        int c = 0; float e = 0.f;
        for (int i = 1; i < 13; ++i) { if ((DBG_SKIP >> i) & 1) continue; const float v = __builtin_bit_cast(float, diag[i]); if (!(v <= DBG_TOL[i])) { c = i; e = v; break; } }
        if (!c || c > 3) { const unsigned n13 = diag[13]; if (n13 && !((DBG_SKIP >> 13) & 1)) { c = 13; e = 0.f; code = 13.f; mag = 100.f * (10.f + fminf(63.f, floorf(log2f((float)n13)) + 1.f)); } }
        if (c != 13 && (!c || c > 6)) { const unsigned n14 = diag[14]; if ((n14 || diag[15]) && !((DBG_SKIP >> 14) & 1)) { c = 14; code = 14.f; const unsigned nk = n14, nv = diag[15]; mag = 100.f * (10.f + (nk ? 32.f : 0.f) + fminf(31.f, (nv ? floorf(log2f((float)nv)) + 1.f : 0.f))); } }
        if (c == 13 || c == 14) { } else {
        code = (float)c; float info = 0.f;
        if (c) { const unsigned bits = diag[16 + c] & 63u; if (bits) info = (float)bits; else if (e != e) info = 89.f; else { info = 64.f + rintf(3.f * (log10f(fmaxf(e, 1e-6f)) + 6.f)); info = fminf(fmaxf(info, 64.f), 88.f); } }
        mag = c ? 100.f * (10.f + info) : 0.f; }
    }
    __syncthreads();
    for (int i = blockIdx.x * blockDim.x + threadIdx.x; i < n; i += gridDim.x * blockDim.x) out[i] = (i == 0) ? mag : code;
}
static void debug_launches(Params p, int grid, hipStream_t stream) {
    float* out_prev = (float*)(p.ws + WS_END);
    (void)hipMemsetAsync(p.ws + WS_DIAG, 0, 256, stream);
    p.l_begin = 0; p.l_end = 1; p.do_final = 0;
    const int masks[7] = {0, 1, 2, 4, 8, 16, 32};
    for (int s = 0; s < 7; ++s) {
        p.do_prologue = (s == 0); p.ph_mask = masks[s]; p.bar_region = s;
        if (s == 6) (void)hipMemcpyAsync(out_prev, p.out, (size_t)MROWS * DM * 4, hipMemcpyDeviceToDevice, stream);
        hipLaunchKernelGGL(mk_fwd, dim3(grid), dim3(512), LDS_BYTES, stream, p);
        hipLaunchKernelGGL(chk_kernel, dim3(64), dim3(256), 0, stream, p, s + 1, (const float*)out_prev);
    }
    hipLaunchKernelGGL(report_kernel, dim3(1024), dim3(256), 0, stream, p.out, (const unsigned*)(p.ws + WS_DIAG), MROWS * DM);
}
#endif

static void fill_params(Params& p, void* const* d_in, void* d_out, void* d_ws) {
    p.x = (const float*)d_in[0]; p.attn_norm_g = (const float*)d_in[1]; p.w_in = (const float*)d_in[2]; p.fox_f_bias = (const float*)d_in[3];
    p.lq1 = (const float*)d_in[4]; p.lk1 = (const float*)d_in[5]; p.lq2 = (const float*)d_in[6]; p.lk2 = (const float*)d_in[7];
    p.subln_g = (const float*)d_in[8]; p.cmp_pos = (const float*)d_in[9]; p.wk1 = (const float*)d_in[10]; p.wk2 = (const float*)d_in[11];
    p.wv1 = (const float*)d_in[12]; p.wv2 = (const float*)d_in[13]; p.w_out = (const float*)d_in[14]; p.ffn_norm_g = (const float*)d_in[15];
    p.w_up = (const float*)d_in[16]; p.conv_w = (const float*)d_in[17]; p.conv_b = (const float*)d_in[18]; p.w_down = (const float*)d_in[19];
    p.rel_bias = (const float*)d_in[20]; p.final_g = (const float*)d_in[21];
    p.out = (float*)d_out; p.ws = (unsigned char*)d_ws;
}
extern "C" void kernel_launch(void* const* d_in, const int* in_sizes, int n_in, void* d_out, int out_size, void* d_ws, size_t ws_size, hipStream_t stream) {
    static int grid = 0;
    if (grid == 0) {
        if (n_in != 22 || out_size != MROWS * DM || ws_size < WS_END) { fprintf(stderr, "kernel_launch: unexpected problem (n_in %d, out %d, ws %zu < %zu)\n", n_in, out_size, ws_size, (size_t)WS_END); grid = -1; return; }
        int dev = 0, cus = 0;
        if (hipGetDevice(&dev) != hipSuccess || hipDeviceGetAttribute(&cus, hipDeviceAttributeMultiprocessorCount, dev) != hipSuccess || cus <= 0) { grid = -1; return; }
        if (hipFuncSetAttribute((const void*)mk_fwd, hipFuncAttributeMaxDynamicSharedMemorySize, LDS_BYTES) != hipSuccess) { fprintf(stderr, "kernel_launch: hipFuncSetAttribute failed\n"); grid = -1; return; }
        int per_cu = 0;
        if (hipOccupancyMaxActiveBlocksPerMultiprocessor(&per_cu, (const void*)mk_fwd, 512, LDS_BYTES) != hipSuccess || per_cu < 1) fprintf(stderr, "kernel_launch: occupancy query says %d\n", per_cu);
        (void)hipGetLastError();
        grid = cus;
    }
    if (grid < 0) return;
    (void)hipMemsetAsync((char*)d_ws + WS_CTL, 0, CTL_ZERO_BYTES, stream);
    Params p{};
    fill_params(p, d_in, d_out, d_ws);
#if !MK_DEBUG
    p.l_begin = 0; p.l_end = DEPTH; p.do_prologue = 1; p.do_final = 1; p.bar_region = 0; p.ph_mask = 63;
    hipLaunchKernelGGL(mk_fwd, dim3(grid), dim3(512), LDS_BYTES, stream, p);
#else
    debug_launches(p, grid, stream);
#endif
}
```

```cpp
#include <hip/hip_runtime.h>
#include <cstdio>
#include <cstdint>

#ifndef MK_DEBUG
#define MK_DEBUG 0
#endif

namespace pg8 {
#define PG8_LAS __attribute__((address_space(3)))
typedef unsigned short bf16_t;
typedef short bf16x8 __attribute__((ext_vector_type(8)));
typedef float f32x4 __attribute__((ext_vector_type(4)));
typedef unsigned u32x4 __attribute__((ext_vector_type(4)));
constexpr int BM = 256, BK = 64, HALF = 128, HTB = HALF * BK * 2  , STAGE_BYTES = 8 * HTB, NXCD = 8, WGM = 8;

__host__ __device__ __forceinline__ int lds_byte(int r, int c) { const int st = (r >> 4) * 2 + (c >> 5), rr = r & 15, cc = c & 31, ob = rr * 64 + cc * 2; return st * 1024 + (ob ^ (((ob >> 9) & 1) << 5)); }
__host__ __device__ __forceinline__ void stage_rc(int b, int& R, int& C) { const int st = b / 1024, sb = b % 1024, swz = sb ^ (((sb >> 9) & 1) << 5); R = (st >> 1) * 16 + swz / 64; C = (st & 1) * 32 + (swz % 64) / 2; }
__host__ __device__ __forceinline__ int perm32(int rho) { const int n = rho >> 4, i = rho & 15; return 8 * (i >> 2) + 4 * n + (i & 3); }

struct Unit { int pm, pn; };
struct Gemm { const bf16_t* A; const bf16_t* Bt; int M, N, K; };

struct StaticOrder {
    int nM, nN, nwg, G, c;
    __host__ __device__ void init(int M, int N, int G_, int c_) { nM = M / BM; nN = N / BM; nwg = nM * nN; G = G_; c = c_; }
    __host__ __device__ bool next(int i, Unit& u) const {
        const long L = (long)i * G + c; if (L >= nwg) return false;
        int wgid = (int)L; { const int q = nwg / NXCD, r = nwg % NXCD, xcd = wgid % NXCD, off = wgid / NXCD; wgid = (xcd < r ? xcd * (q + 1) : r * (q + 1) + (xcd - r) * q) + off; }
        const int nig = WGM * nN, gid = wgid / nig, fm = gid * WGM, gsz = (nM - fm) < WGM ? (nM - fm) : WGM;
        u.pm = fm + ((wgid % nig) % gsz); u.pn = (wgid % nig) / gsz; return true;
    }
    __device__ __forceinline__ void a_ready(const Unit&) const {}
    __device__ __forceinline__ void done(const Unit&) const {}
};
__device__ __forceinline__ unsigned cvt_pk_bf16(float lo, float hi) { unsigned r; asm volatile("v_cvt_pk_bf16_f32 %0, %1, %2" : "=v"(r) : "v"(lo), "v"(hi)); return r; }
typedef float f32x2 __attribute__((ext_vector_type(2)));
template <class Epi, class Sched, bool ALIGN_EPI = false, bool SP2 = false>
__device__ __forceinline__ void gemm_phase(PG8_LAS unsigned char* lds, const Gemm g, const Sched& S, const Epi& E) {
    int tid_l = threadIdx.x; asm volatile("" : "+v"(tid_l));
    const int tid = tid_l, wid = __builtin_amdgcn_readfirstlane(tid >> 6), lane = tid & 63, wr = wid >> 2, wc = wid & 3, fr = lane & 15, fq = lane >> 4;
    const int K = g.K, nt = K / BK;
    unsigned voffA[2], voffB[2]; int aoff, boff;
#define PG8_LANESET() do { int t_ = tid_l; asm volatile("" : "+v"(t_)); const int l_ = t_ & 63, fr_ = l_ & 15, fq_ = l_ >> 4; \
        _Pragma("unroll") for (int i = 0; i < 2; ++i) { int R, C; stage_rc(t_ * 16 + i * 8192, R, C); const int Rb = Epi::PERM ? ((R & ~31) + perm32(R & 31)) : R; \
            const int Ra = Epi::PERMA ? ((R & ~63) + 4 * (R & 15) + ((R >> 4) & 3)) : R; \
            voffA[i] = (unsigned)(Ra * K + C) * 2u; voffB[i] = (unsigned)(Rb * K + C) * 2u; } \
        aoff = lds_byte(wr * 64 + fr_, fq_ * 8); boff = lds_byte(wc * 32 + fr_, fq_ * 8); } while (0)
    PG8_LANESET();
    const size_t kstep = (size_t)(BK * 2);
    const size_t hstep = (size_t)HALF * K * 2;
    const size_t tstep = 2 * hstep;
    const unsigned ldsw = (unsigned)wid * 1024u;
#define PG8_SA(b, h) (((b) * 2 + (h)) * HTB)
#define PG8_SB(b, h) ((4 + (b) * 2 + (h)) * HTB)
#define PG8_STAGE(bufoff, gbase, voff) do { _Pragma("unroll") for (int _i = 0; _i < 2; ++_i) \
        __builtin_amdgcn_global_load_lds((const unsigned*)((const char*)(gbase) + (voff)[_i]), (PG8_LAS unsigned*)(lds + (bufoff) + ldsw + _i * 8192), 16, 0, 0); } while (0)
#define PG8_LDA(dst, b, h) do { _Pragma("unroll") for (int m = 0; m < 4; ++m) _Pragma("unroll") for (int k = 0; k < 2; ++k) dst[m][k] = *(const PG8_LAS bf16x8*)(lds + PG8_SA(b, h) + aoff + m * 2048 + k * 1024); } while (0)
#define PG8_LDB(dst, b, h) do { _Pragma("unroll") for (int n = 0; n < 2; ++n) _Pragma("unroll") for (int k = 0; k < 2; ++k) dst[n][k] = *(const PG8_LAS bf16x8*)(lds + PG8_SB(b, h) + boff + n * 2048 + k * 1024); } while (0)
#define PG8_MMA(ai, bj, At, Bt) do { __builtin_amdgcn_s_setprio(1); _Pragma("unroll") for (int m = 0; m < 4; ++m) _Pragma("unroll") for (int n = 0; n < 2; ++n) _Pragma("unroll") for (int k = 0; k < 2; ++k) \
        acc[ai][bj][m][n] = __builtin_amdgcn_mfma_f32_16x16x32_bf16(Bt[n][k], At[m][k], acc[ai][bj][m][n], 0, 0, 0); __builtin_amdgcn_s_setprio(0); } while (0)
#define PG8_WAIT_V(n) asm volatile("s_waitcnt vmcnt(" #n ")" ::: "memory")
#define PG8_WAIT_L(n) asm volatile("s_waitcnt lgkmcnt(" #n ")" ::: "memory")
#define PG8_BAR __builtin_amdgcn_s_barrier()
#define PG8_SCHED __builtin_amdgcn_sched_barrier(0)
    Unit cur, nxt; int ui = 0;
    if (!S.next(0, cur)) return;
    f32x4 acc[2][2][4][2];
#pragma unroll
    for (int a = 0; a < 2; ++a)
#pragma unroll
        for (int b = 0; b < 2; ++b)
#pragma unroll
            for (int m = 0; m < 4; ++m)
#pragma unroll
                for (int n = 0; n < 2; ++n) acc[a][b][m][n] = (f32x4){0.f, 0.f, 0.f, 0.f};
    bf16x8 At[4][2], B0[2][2], B1[2][2];
    const char* cA = (const char*)g.A + (size_t)cur.pm * tstep; const char* cB = (const char*)g.Bt + (size_t)cur.pn * tstep;
    S.a_ready(cur);
    if constexpr (SP2) {
        PG8_STAGE(PG8_SB(0, 0), cB, voffB); PG8_STAGE(PG8_SB(0, 1), cB + hstep, voffB); PG8_STAGE(PG8_SA(0, 0), cA, voffA); PG8_STAGE(PG8_SA(0, 1), cA + hstep, voffA);
        if (wr == 1) PG8_BAR;
        PG8_WAIT_V(2); PG8_BAR;
        PG8_STAGE(PG8_SB(1, 0), cB + kstep, voffB); PG8_STAGE(PG8_SA(1, 0), cA + kstep, voffA); PG8_STAGE(PG8_SB(1, 1), cB + hstep + kstep, voffB);
        PG8_WAIT_V(6); PG8_BAR;
    } else {
        PG8_STAGE(PG8_SB(0, 0), cB, voffB); PG8_STAGE(PG8_SA(0, 0), cA, voffA); PG8_STAGE(PG8_SB(0, 1), cB + hstep, voffB); PG8_STAGE(PG8_SA(0, 1), cA + hstep, voffA);
        if (wr == 1) PG8_BAR;
        PG8_WAIT_V(4); PG8_BAR;
        PG8_STAGE(PG8_SB(1, 0), cB + kstep, voffB); PG8_STAGE(PG8_SA(1, 0), cA + kstep, voffA); PG8_STAGE(PG8_SB(1, 1), cB + hstep + kstep, voffB);
        PG8_WAIT_V(6); PG8_BAR;
    }
    for (;;) {
        PG8_LANESET();
        const bool has_next = S.next(ui + 1, nxt);
        const char* nA = has_next ? (const char*)g.A + (size_t)nxt.pm * tstep : cA; const char* nB = has_next ? (const char*)g.Bt + (size_t)nxt.pn * tstep : cB;
        for (int t = 0; t < nt; t += 2) {
            const bool last = (t == nt - 2);
            const char* a1 = cA + (size_t)(t + 1) * kstep;
            const char* a2 = last ? nA : cA + (size_t)(t + 2) * kstep; const char* b2 = last ? nB : cB + (size_t)(t + 2) * kstep;
            const char* a3 = a2 + kstep; const char* b3 = b2 + kstep;
            if (last && has_next) S.a_ready(nxt);
            if constexpr (SP2) {
            PG8_LDB(B0, 0, 0); PG8_LDB(B1, 0, 1); PG8_SCHED; PG8_LDA(At, 0, 0); PG8_STAGE(PG8_SA(1, 1), a1 + hstep, voffA);
            PG8_WAIT_V(8); PG8_WAIT_L(0); PG8_BAR; PG8_MMA(0, 0, At, B0); PG8_MMA(0, 1, At, B1); PG8_BAR; PG8_SCHED;
            PG8_LDA(At, 0, 1); PG8_STAGE(PG8_SB(0, 0), b2, voffB); PG8_STAGE(PG8_SB(0, 1), b2 + hstep, voffB); PG8_STAGE(PG8_SA(0, 0), a2, voffA);
            PG8_WAIT_V(8); PG8_WAIT_L(0); PG8_BAR; PG8_MMA(1, 0, At, B0); PG8_MMA(1, 1, At, B1); PG8_BAR; PG8_SCHED;
            PG8_LDB(B0, 1, 0); PG8_LDB(B1, 1, 1); PG8_SCHED; PG8_LDA(At, 1, 0); PG8_STAGE(PG8_SA(0, 1), a2 + hstep, voffA);
            PG8_WAIT_V(8); PG8_WAIT_L(0); PG8_BAR; PG8_MMA(0, 0, At, B0); PG8_MMA(0, 1, At, B1); PG8_BAR; PG8_SCHED;
            PG8_LDA(At, 1, 1); PG8_STAGE(PG8_SB(1, 0), b3, voffB); PG8_STAGE(PG8_SB(1, 1), b3 + hstep, voffB); PG8_STAGE(PG8_SA(1, 0), a3, voffA);
            PG8_WAIT_V(8); PG8_WAIT_L(0); PG8_BAR; PG8_MMA(1, 0, At, B0); PG8_MMA(1, 1, At, B1); PG8_BAR; PG8_SCHED;
            } else {
            PG8_LDB(B0, 0, 0); PG8_SCHED; PG8_LDA(At, 0, 0); PG8_STAGE(PG8_SA(1, 1), a1 + hstep, voffA);
            PG8_WAIT_L(8); PG8_BAR; PG8_WAIT_L(0); PG8_MMA(0, 0, At, B0); PG8_BAR; PG8_SCHED;
            PG8_LDB(B1, 0, 1); PG8_STAGE(PG8_SB(0, 0), b2, voffB);
            PG8_BAR; PG8_WAIT_L(0); PG8_MMA(0, 1, At, B1); PG8_BAR;
            PG8_LDA(At, 0, 1); PG8_STAGE(PG8_SA(0, 0), a2, voffA);
            PG8_BAR; PG8_WAIT_L(0); PG8_MMA(1, 0, At, B0); PG8_BAR; PG8_SCHED;
            PG8_STAGE(PG8_SB(0, 1), b2 + hstep, voffB);
            PG8_WAIT_V(6); PG8_BAR; PG8_MMA(1, 1, At, B1); PG8_BAR;
            PG8_LDB(B0, 1, 0); PG8_SCHED; PG8_LDA(At, 1, 0); PG8_STAGE(PG8_SA(0, 1), a2 + hstep, voffA);
            PG8_WAIT_L(8); PG8_BAR; PG8_WAIT_L(0); PG8_MMA(0, 0, At, B0); PG8_BAR; PG8_SCHED;
            PG8_LDB(B1, 1, 1); PG8_STAGE(PG8_SB(1, 0), b3, voffB);
            PG8_BAR; PG8_WAIT_L(0); PG8_MMA(0, 1, At, B1); PG8_BAR;
            PG8_LDA(At, 1, 1); PG8_STAGE(PG8_SA(1, 0), a3, voffA);
            PG8_BAR; PG8_WAIT_L(0); PG8_MMA(1, 0, At, B0); PG8_BAR; PG8_SCHED;
            PG8_STAGE(PG8_SB(1, 1), b3 + hstep, voffB);
            PG8_WAIT_V(6); PG8_BAR; PG8_MMA(1, 1, At, B1); PG8_BAR;
            }
        }
        if constexpr (ALIGN_EPI) { if (wr == 0) PG8_BAR; }
        if constexpr (!Epi::AFTER_DRAIN) { E(acc, cur, wr, wc, fr, fq); S.done(cur); }
        if (!has_next) break;
#pragma unroll
        for (int a = 0; a < 2; ++a)
#pragma unroll
            for (int b = 0; b < 2; ++b)
#pragma unroll
                for (int m = 0; m < 4; ++m)
#pragma unroll
                    for (int n = 0; n < 2; ++n) acc[a][b][m][n] = (f32x4){0.f, 0.f, 0.f, 0.f};
        cur = nxt; cA = nA; cB = nB; ++ui;
        if constexpr (ALIGN_EPI) { if (wr == 1) PG8_BAR; }
    }
    PG8_WAIT_V(0);
    if constexpr (!ALIGN_EPI) { if (wr == 0) PG8_BAR; }
    PG8_BAR;
    if constexpr (Epi::AFTER_DRAIN) { E.fused(acc, cur, wr, wc, fr, fq, lds, wid, lane); S.done(cur); }
#undef PG8_LANESET
#undef PG8_SA
#undef PG8_SB
#undef PG8_STAGE
#undef PG8_LDA
#undef PG8_LDB
#undef PG8_MMA
#undef PG8_WAIT_V
#undef PG8_WAIT_L
#undef PG8_BAR
#undef PG8_SCHED
}
}
#define GAS __attribute__((address_space(1)))
#define LAS __attribute__((address_space(3)))

constexpr int DM = 2048, NBATCH = 16, SEQ = 2048, DEPTH = 4, MROWS = NBATCH * SEQ;
constexpr int NIN = 6168, NINP = 6176, PROJ_LD = 6144;
constexpr int DFF = 5632, NUP = 2 * DFF;
constexpr float RMS_EPS = 1e-6f;
constexpr float LOG2E = 1.4426950408889634f;
constexpr int C_FQ = 0, C_FK = 768, C_FV = 1536, C_DQ = 2304, C_DK = 2816, C_DV = 3328, C_NQ = 3840, C_NKC = 4608, C_NVC = 4864, C_NKS = 5120, C_NVS = 5376, C_NKW = 5632, C_NVW = 5888;
constexpr int GATE_LD = 32;
__device__ __forceinline__ int win_colmap(int c) {
    if (c < 2304) return c; if (c < 6144) return c + 6; if (c < 6150) return 2304 + (c - 6144); if (c < 6168) return c; return -1;
}
__device__ __forceinline__ int wup_colmap(int c) { const int pn = c >> 8, w = c & 255; return (w < 128) ? (pn * 128 + w) : (DFF + pn * 128 + (w - 128)); }

__constant__ unsigned char T5B[128] = {0, 1, 2, 3, 4, 5, 6, 7, 8, 9, 10, 11, 12, 13, 14, 15, 16, 16, 16, 17, 17, 18, 18, 18, 19, 19, 19, 20, 20, 20, 20, 21, 21, 21, 21, 22, 22, 22, 22, 22, 23, 23, 23, 23, 23, 23, 24, 24, 24, 24, 24, 24, 25, 25, 25, 25, 25, 25, 25, 26, 26, 26, 26, 26, 26, 26, 26, 27, 27, 27, 27, 27, 27, 27, 27, 27, 27, 28, 28, 28, 28, 28, 28, 28, 28, 28, 28, 29, 29, 29, 29, 29, 29, 29, 29, 29, 29, 29, 29, 30, 30, 30, 30, 30, 30, 30, 30, 30, 30, 30, 30, 30, 30, 31, 31, 31, 31, 31, 31, 31, 31, 31, 31, 31, 31, 31, 31, 31};

constexpr size_t al256(size_t x) { return (x + 255) & ~(size_t)255; }
constexpr size_t WS_CTL = 0, CTL_ZERO_BYTES = 1u << 20;
constexpr size_t WS_WIN = CTL_ZERO_BYTES;
constexpr size_t WS_WOUT = WS_WIN + (size_t)DEPTH * NINP * DM * 2;
constexpr size_t WS_WUP = WS_WOUT + (size_t)DEPTH * DM * DM * 2;
constexpr size_t WS_WDN = WS_WUP + (size_t)DEPTH * NUP * DM * 2;
constexpr size_t WS_W1T = WS_WDN + (size_t)DEPTH * DM * DFF * 2;
constexpr size_t WS_W2T = WS_W1T + (size_t)DEPTH * 2 * 128 * 4096 * 2;
constexpr size_t WS_POSC = WS_W2T + (size_t)DEPTH * 2 * 128 * 128 * 2;
constexpr size_t WS_HB = al256(WS_POSC + (size_t)DEPTH * 2 * 128 * 4);
constexpr size_t WS_MIXED = WS_HB + (size_t)MROWS * DM * 2;
constexpr size_t WS_PROJ = WS_MIXED + (size_t)MROWS * DM * 2;
constexpr size_t WS_GATES = WS_PROJ + (size_t)MROWS * PROJ_LD * 2;
constexpr size_t WS_SSQP = WS_GATES + (size_t)MROWS * GATE_LD * 4;
constexpr size_t WS_RSTD = WS_SSQP + (size_t)MROWS * 32 * 4;
constexpr size_t WS_HALO = WS_RSTD + (size_t)MROWS * 4;
constexpr size_t WS_KCMP = WS_HALO + (size_t)128 * 4 * NUP * 4;
constexpr size_t WS_VCMP = WS_KCMP + (size_t)NBATCH * 2 * 128 * 128 * 2;
constexpr size_t WS_CUM = WS_VCMP + (size_t)NBATCH * 2 * 128 * 128 * 2;
constexpr size_t WS_SCR = WS_CUM + (size_t)NBATCH * 6 * SEQ * 4;
constexpr size_t WS_DIAG = WS_SCR + (size_t)256 * 131072;
constexpr size_t WS_END = WS_DIAG + 65536;
static_assert(WS_END + (size_t)MROWS * DM * 4 <= (size_t)4 * DEPTH * DM * NUP * 4, "workspace map (+ the debug build's copy of h) must fit 4x the largest tensor");
constexpr int CW_BAR = 4096;
constexpr int CW_QUEUE = 65536;
constexpr int CW_CONV = 131072;
constexpr int CW_CMPDONE = 98304;

constexpr int RING_BYTES = 131072;
constexpr int LX_CONV = RING_BYTES;
constexpr int LX_MISC = RING_BYTES + 8192;
constexpr int LX_CW = LX_MISC + 256 + 2048;
constexpr int LX_RSTAB = LX_MISC + 256;
static_assert(LX_MISC + 256 + 2048 + 4096 <= 147456, "LDS map");
constexpr int LDS_BYTES = 147456;

typedef unsigned short bf16_t;
typedef short bf16x8 __attribute__((ext_vector_type(8)));
typedef short s16x4 __attribute__((ext_vector_type(4)));
typedef float f32x4 __attribute__((ext_vector_type(4)));
typedef float f32x2 __attribute__((ext_vector_type(2)));
typedef float f32x16 __attribute__((ext_vector_type(16)));
typedef unsigned u32x4 __attribute__((ext_vector_type(4)));
typedef unsigned u32x2 __attribute__((ext_vector_type(2)));

__device__ __forceinline__ int ltid() { int t = threadIdx.x; asm volatile("" : "+v"(t)); return t; }
typedef __bf16 bf16x2_t __attribute__((ext_vector_type(2)));
__device__ __forceinline__ unsigned cvtpk(float lo, float hi) { const f32x2 v = {lo, hi}; const bf16x2_t b = __builtin_convertvector(v, bf16x2_t); return __builtin_bit_cast(unsigned, b); }
__device__ __forceinline__ float bf2f(bf16_t v) { return __builtin_bit_cast(float, (unsigned)v << 16); }
__device__ __forceinline__ float fast_exp2(float x) { return __builtin_amdgcn_exp2f(x); }
__device__ __forceinline__ float fast_rcp(float x) { return __builtin_amdgcn_rcpf(x); }
__device__ __forceinline__ float shx(float v, int o) { return __builtin_bit_cast(float, __builtin_amdgcn_ds_bpermute(((ltid() & 63) ^ o) << 2, __builtin_bit_cast(int, v))); }
__device__ __forceinline__ float wave_sum(float v) {
    const int a = (ltid() & 63) << 2;
#pragma unroll
    for (int o = 1; o < 64; o <<= 1) v += __builtin_bit_cast(float, __builtin_amdgcn_ds_bpermute(a ^ (o << 2), __builtin_bit_cast(int, v)));
    return v;
}
template <int CTRL> __device__ __forceinline__ float dppf(float v) { return __builtin_bit_cast(float, __builtin_amdgcn_mov_dpp(__builtin_bit_cast(int, v), CTRL, 0xF, 0xF, false)); }
template <int CTRL> __device__ __forceinline__ float dppfo(float o, float v) { return __builtin_bit_cast(float, __builtin_amdgcn_update_dpp(__builtin_bit_cast(int, o), __builtin_bit_cast(int, v), CTRL, 0xF, 0xF, false)); }
template <int CTRL> __device__ __forceinline__ f32x4 dpp4o(f32x4 o, f32x4 v) { f32x4 r; r.x = dppfo<CTRL>(o.x, v.x); r.y = dppfo<CTRL>(o.y, v.y); r.z = dppfo<CTRL>(o.z, v.z); r.w = dppfo<CTRL>(o.w, v.w); return r; }
template <int CTRL> __device__ __forceinline__ f32x4 dpp4(f32x4 v) { f32x4 r; r.x = dppf<CTRL>(v.x); r.y = dppf<CTRL>(v.y); r.z = dppf<CTRL>(v.z); r.w = dppf<CTRL>(v.w); return r; }

namespace epi {
using pg8::Unit;

struct InProj {
    static constexpr bool PERM = true, PERMA = true, AFTER_DRAIN = false;
    bf16_t* proj; const __attribute__((address_space(3))) float* rstab;
    __device__ __forceinline__ void operator()(const f32x4 (&acc)[2][2][4][2], const Unit& u, int wr, int wc, int fr, int fq) const {
        { const int ln = ltid() & 63; fr = ln & 15; fq = ln >> 4; }
        const int row0 = u.pm * 256 + wr * 64 + 4 * fr;
        float cs = 1.f;
        if (u.pn < 3) cs = 0.08838834764831845f * LOG2E;
        else if (u.pn == 9 || u.pn == 10) cs = 0.125f * LOG2E;
        else if (u.pn >= 15 && u.pn <= 17) cs = 0.08838834764831845f * LOG2E;
        {
#pragma unroll
            for (int ai = 0; ai < 2; ++ai)
#pragma unroll
                for (int m = 0; m < 4; ++m) {
                    const int row = row0 + ai * 128 + m; const float s = rstab[((u.pm >> 3) & 1) * 256 + (row & 255)] * cs;
                    bf16_t* rp = proj + (size_t)row * PROJ_LD + u.pn * 256 + wc * 32 + 8 * fq;
#pragma unroll
                    for (int bj = 0; bj < 2; ++bj) { const f32x4 v0 = acc[ai][bj][m][0] * s, v1 = acc[ai][bj][m][1] * s;
                        u32x4 w; w.x = cvtpk(v0[0], v0[1]); w.y = cvtpk(v0[2], v0[3]); w.z = cvtpk(v1[0], v1[1]); w.w = cvtpk(v1[2], v1[3]);
                        *(u32x4*)(rp + bj * 128) = w; }
                }
        }
    }
};

struct Resid {
    static constexpr bool PERM = true, PERMA = true, AFTER_DRAIN = false;
    bf16_t* hb; float* ssqp;
    __device__ __forceinline__ void operator()(const f32x4 (&acc)[2][2][4][2], const Unit& u, int wr, int wc, int fr, int fq) const {
        { const int ln = ltid() & 63; fr = ln & 15; fq = ln >> 4; }
        const int row0 = u.pm * 256 + wr * 64 + 4 * fr, col0 = u.pn * 256 + wc * 32 + 8 * fq;
        u32x4 hv[2][4][2];
#pragma unroll
        for (int ai = 0; ai < 2; ++ai)
#pragma unroll
            for (int m = 0; m < 4; ++m)
#pragma unroll
                for (int bj = 0; bj < 2; ++bj) hv[ai][m][bj] = *(const u32x4*)(hb + (size_t)(row0 + ai * 128 + m) * DM + col0 + bj * 128);
#pragma unroll
        for (int ai = 0; ai < 2; ++ai)
#pragma unroll
            for (int m = 0; m < 4; ++m) {
                const int row = row0 + ai * 128 + m; float ss = 0.f;
#pragma unroll
                for (int bj = 0; bj < 2; ++bj) {
                    const size_t off = (size_t)row * DM + col0 + bj * 128;
                    const u32x4 h = hv[ai][m][bj];
                    f32x4 v0, v1;
                    v0[0] = __builtin_bit_cast(float, h.x << 16) + acc[ai][bj][m][0][0]; v0[1] = __builtin_bit_cast(float, h.x & 0xFFFF0000u) + acc[ai][bj][m][0][1];
                    v0[2] = __builtin_bit_cast(float, h.y << 16) + acc[ai][bj][m][0][2]; v0[3] = __builtin_bit_cast(float, h.y & 0xFFFF0000u) + acc[ai][bj][m][0][3];
                    v1[0] = __builtin_bit_cast(float, h.z << 16) + acc[ai][bj][m][1][0]; v1[1] = __builtin_bit_cast(float, h.z & 0xFFFF0000u) + acc[ai][bj][m][1][1];
                    v1[2] = __builtin_bit_cast(float, h.w << 16) + acc[ai][bj][m][1][2]; v1[3] = __builtin_bit_cast(float, h.w & 0xFFFF0000u) + acc[ai][bj][m][1][3];
                    u32x4 w; w.x = cvtpk(v0[0], v0[1]); w.y = cvtpk(v0[2], v0[3]); w.z = cvtpk(v1[0], v1[1]); w.w = cvtpk(v1[2], v1[3]);
                    *(u32x4*)(hb + off) = w;
                    ss += (v0[0] * v0[0] + v0[1] * v0[1]) + (v0[2] * v0[2] + v0[3] * v0[3]) + (v1[0] * v1[0] + v1[1] * v1[1]) + (v1[2] * v1[2] + v1[3] * v1[3]);
                }
                ss += shx(ss, 16); ss += shx(ss, 32);
                if (fq == 0) ssqp[(size_t)row * 32 + u.pn * 4 + wc] = ss;
            }
    }
};

struct UpConv {
    static constexpr bool PERM = true, PERMA = true, AFTER_DRAIN = false;
    bf16_t* act; const __attribute__((address_space(3))) float* rstab; const float* cw; const float* cb; float* halo; __attribute__((address_space(3))) float* ex;
    __device__ __forceinline__ void operator()(const f32x4 (&acc)[2][2][4][2], const Unit& u, int wr, int wc, int fr, int fq) const {
        { const int ln = ltid() & 63; fr = ln & 15; fq = ln >> 4; }
        const int tcol = wc * 32 + 8 * fq, ch0 = u.pn * 128 + tcol;
        const int row0 = u.pm * 256 + wr * 64 + 4 * fr;
        float rs[2][4];
#pragma unroll
        for (int ai = 0; ai < 2; ++ai)
#pragma unroll
            for (int m = 0; m < 4; ++m) rs[ai][m] = rstab[((u.pm >> 3) & 1) * 256 + ((row0 + ai * 128 + m) & 255)];
        __attribute__((address_space(3))) float* cwl = ex + (LX_CW - LX_CONV) / 4;
        { const int t = ltid();
#pragma unroll
          for (int k = 0; k < 2; ++k) { const int i = t + 512 * k, q = i >> 7, cc = i & 127, tap = q >> 1, bjj = q & 1;
              cwl[i] = (tap < 3 ? cw + tap * NUP : cb)[bjj * DFF + u.pn * 128 + cc]; } }
        if (fr == 15) {
#pragma unroll
            for (int ai = 0; ai < 2; ++ai)
#pragma unroll
                for (int bj = 0; bj < 2; ++bj)
#pragma unroll
                    for (int n = 0; n < 2; ++n)
#pragma unroll
                        for (int q = 0; q < 2; ++q) {
                            const f32x4 v = acc[ai][bj][2 + q][n] * rs[ai][2 + q];
                            *(__attribute__((address_space(3))) f32x4*)(ex + ((ai * 2 + wr) * 2 + q) * 256 + bj * 128 + tcol + 4 * n) = v;
                            if (ai == 1 && wr == 1) *(f32x4*)(halo + ((size_t)(u.pm * 4 + 2 + q) * NUP) + u.pn * 256 + bj * 128 + tcol + 4 * n) = v;
                        }
        }
        if (fr == 0 && wr == 0) {
#pragma unroll
            for (int bj = 0; bj < 2; ++bj)
#pragma unroll
                for (int n = 0; n < 2; ++n)
#pragma unroll
                    for (int q = 0; q < 2; ++q)
                        *(f32x4*)(halo + ((size_t)(u.pm * 4 + q) * NUP) + u.pn * 256 + bj * 128 + tcol + 4 * n) = acc[0][bj][q][n] * rs[0][q];
        }
        asm volatile("s_waitcnt lgkmcnt(0)" ::: "memory");
        __builtin_amdgcn_s_barrier();
#pragma unroll
        for (int ai = 0; ai < 2; ++ai) {
            const bool top = (ai == 0 && wr == 0);
            const int pb = (wr ? ai * 2 : (ai * 2 - 1));
#pragma unroll
            for (int n = 0; n < 2; ++n) {
                f32x4 yg[4];
#pragma unroll
                for (int bj = 0; bj < 2; ++bj) {
                    asm volatile("" ::: "memory"); __builtin_amdgcn_sched_barrier(0);
                    const __attribute__((address_space(3))) float* wl = cwl + bj * 128 + tcol + 4 * n;
                    const f32x4 w0 = *(const __attribute__((address_space(3))) f32x4*)wl, w1 = *(const __attribute__((address_space(3))) f32x4*)(wl + 256), w2 = *(const __attribute__((address_space(3))) f32x4*)(wl + 512), bb = *(const __attribute__((address_space(3))) f32x4*)(wl + 768);
                    f32x4 e62 = {0.f, 0.f, 0.f, 0.f}, e63 = {0.f, 0.f, 0.f, 0.f};
                    if (!top) {
                        e62 = *(const __attribute__((address_space(3))) f32x4*)(ex + (pb * 2 + 0) * 256 + bj * 128 + tcol + 4 * n);
                        e63 = *(const __attribute__((address_space(3))) f32x4*)(ex + (pb * 2 + 1) * 256 + bj * 128 + tcol + 4 * n);
                    }
                    f32x4 v[4];
#pragma unroll
                    for (int m = 0; m < 4; ++m) v[m] = acc[ai][bj][m][n] * rs[ai][m];
                    const f32x4 s3 = dpp4o<0x111>(e63, v[3]), s2 = dpp4o<0x111>(e62, v[2]);
                    f32x4 y[4];
                    y[0] = ((bb + w2 * v[0]) + w1 * s3) + w0 * s2;
                    y[1] = ((bb + w2 * v[1]) + w1 * v[0]) + w0 * s3;
                    y[2] = ((bb + w2 * v[2]) + w1 * v[1]) + w0 * v[0];
                    y[3] = ((bb + w2 * v[3]) + w1 * v[2]) + w0 * v[1];
#pragma unroll
                    for (int m = 0; m < 4; ++m) {
                        if (bj == 0) yg[m] = y[m];
                        else {
                            f32x4 o;
#pragma unroll
                            for (int i = 0; i < 4; ++i) o[i] = yg[m][i] * fast_rcp(1.f + fast_exp2(-yg[m][i] * LOG2E)) * y[m][i];
                            if (!(top && fr == 0 && m < 2)) {
                                u32x2 w; w.x = cvtpk(o[0], o[1]); w.y = cvtpk(o[2], o[3]);
                                *(u32x2*)(act + (size_t)(row0 + ai * 128 + m) * DFF + ch0 + 4 * n) = w;
                            }
                        }
                    }
                }
            }
        }
    }
};
}
#define XB_TMO      128
#define XB_XCNT(j)  (256  + 64 * (j))
#define XB_XSUB(j)  (1280 + 64 * (j))
#define XB_XGEN(j)  (2304 + 64 * (j))
#define XB_TOP      3328
#define XB_TOPGEN   3392
#define XCD_BAR_WORDS 3456
#define XB_SPIN_CAP (1u << 18)

__device__ __forceinline__ unsigned xb_ld(unsigned* p)              { return __hip_atomic_load(p, __ATOMIC_RELAXED, __HIP_MEMORY_SCOPE_AGENT); }
__device__ __forceinline__ unsigned xb_add(unsigned* p, unsigned v) { return __hip_atomic_fetch_add(p, v, __ATOMIC_RELAXED, __HIP_MEMORY_SCOPE_AGENT); }
__device__ __forceinline__ unsigned xb_xcc_id() { return (unsigned)__builtin_amdgcn_s_getreg((3 << 11) | 20) & 0xFu; }
#define XB_SPIN(cond, bar) do { unsigned _sp = 0; while (cond) { __builtin_amdgcn_s_sleep(1); \
    if ((++_sp & 255u) == 0u) { if (xb_ld(&(bar)[XB_TMO])) break; if (_sp > XB_SPIN_CAP) { atomicAdd(&(bar)[XB_TMO], 1u); break; } } } } while (0)

struct XcdBarrier {
    unsigned* bar; unsigned x;
    volatile LAS unsigned* st;
};

__device__ __forceinline__ XcdBarrier xcd_barrier_post(unsigned* bar, volatile LAS unsigned* st) {
    XcdBarrier b; b.bar = bar; b.x = xb_xcc_id(); b.st = st;
    if (threadIdx.x == 0) (void)xb_add(&bar[XB_XCNT(b.x)], 1u);
    return b;
}
__device__ __forceinline__ void xcd_barrier_complete(unsigned* bar, unsigned x, unsigned& nloc, unsigned& nx) {
    const unsigned G = gridDim.x * gridDim.y * gridDim.z;
    unsigned sum, cnt, mine, sp = 0u;
    for (;;) {
        sum = 0u; cnt = 0u; mine = 0u;
#pragma unroll
        for (unsigned j = 0; j < 16; ++j) { const unsigned c = xb_ld(&bar[XB_XCNT(j)]); sum += c; cnt += (c > 0u) ? 1u : 0u; mine = (j == x) ? c : mine; }
        if (sum == G) break;
        __builtin_amdgcn_s_sleep(1);
        if ((++sp & 255u) == 0u) { if (xb_ld(&bar[XB_TMO])) break; if (sp > XB_SPIN_CAP) { atomicAdd(&bar[XB_TMO], 1u); break; } }
    }
    nloc = mine > 0u ? mine : 1u; nx = cnt > 0u ? cnt : 1u;
}

__device__ __forceinline__ void xcd_barrier(const XcdBarrier& b) {
    asm volatile("s_waitcnt vmcnt(0)" ::: "memory");
    __syncthreads();
    if (threadIdx.x == 0) {
        unsigned* bar = b.bar; asm volatile("" : "+s"(bar));
        __builtin_amdgcn_s_waitcnt(0);
        unsigned nloc = b.st[0], nx = b.st[1];
        if (nloc == 0u) { xcd_barrier_complete(bar, b.x, nloc, nx); b.st[0] = nloc; b.st[1] = nx; }
        const unsigned old = xb_add(&bar[XB_XSUB(b.x)], 1u);
        const unsigned gen = old / nloc;
        if (old + 1u == (gen + 1u) * nloc) {
            __builtin_amdgcn_fence(__ATOMIC_RELEASE, "agent");
            asm volatile("s_waitcnt vmcnt(0)" ::: "memory");
            const unsigned og = xb_add(&bar[XB_TOP], 1u);
            const unsigned tg = og / nx;
            if (og + 1u == (tg + 1u) * nx) xb_add(&bar[XB_TOPGEN], 1u);
            else XB_SPIN(xb_ld(&bar[XB_TOPGEN]) == tg, bar);
            __builtin_amdgcn_fence(__ATOMIC_ACQUIRE, "agent");
            xb_add(&bar[XB_XGEN(b.x)], 1u);
            asm volatile("s_waitcnt vmcnt(0)" ::: "memory");
        } else {
            XB_SPIN(xb_ld(&bar[XB_XGEN(b.x)]) == gen, bar);
            __builtin_amdgcn_fence(__ATOMIC_ACQUIRE, "agent");
            asm volatile("s_waitcnt vmcnt(0)" ::: "memory");
        }
    }
    __syncthreads();
}

namespace att {
#ifndef DMA_AUX
#define DMA_AUX 0
#endif
constexpr int SHM = 16384;
constexpr int L_V = 0, L_K = 2 * SHM, L_WS = 4 * SHM, L_CUM = L_WS + 2048, L_LUT = L_CUM + 8192, L_IMP = L_LUT + 5120, L_SEL = L_IMP + 256 * 33 * 4, L_UNI = L_SEL + 1024, L_END = L_UNI + 64;
static_assert(L_END <= RING_BYTES, "attention scratch inside the ring region");
constexpr float THR2 = 11.5f;
enum { K_FOX = 0, K_DIFF = 1, K_SEL = 2, K_WIN = 3, K_CMP = 4 };

#define KSWZ(row, colB) ((row) * 256 + ((colB) ^ (((row) & 7) << 4)))
#define SBAR() __builtin_amdgcn_sched_barrier(0)
__device__ __forceinline__ int v_st(int k, int c) { const int kk = (k & ~0xC) | ((k & 4) << 1) | ((k & 8) >> 1); return ((kk >> 3) * 4 + (c >> 5)) * 512 + ((kk & 7) * 32 + (c & 31)) * 2; }
__device__ __forceinline__ int v_rd_base(int lane) { return ((lane & 3) << 3) | (((lane >> 2) & 3) << 6) | (((lane >> 4) & 1) << 5) | (((lane >> 5) & 1) << 8); }
constexpr int v_rd_off(int d0, int ks, int half) { return d0 * 512 + ks * 4096 + half * 2048; }
__device__ __forceinline__ int crow(int r, int hi) { return (r & 3) + 8 * (r >> 2) + 4 * hi; }
constexpr int ccol(int r) { return (r & 3) + 8 * (r >> 2); }

typedef LAS char* lptr;

template <int NQ>
__device__ __forceinline__ void qkt(f32x16& p0, f32x16& p1, lptr kbuf, int kf0, int r32, int hi, const bf16x8 (&qr)[8]) {
    p0 = f32x16{}; p1 = f32x16{};
    const int kb0 = (int)(uintptr_t)kbuf + (kf0 >> 2) * 128;
    const int ka0 = kb0 + KSWZ(r32, (0 * 16 + hi * 8) * 2), ka1 = kb0 + KSWZ(r32, (1 * 16 + hi * 8) * 2), ka2 = kb0 + KSWZ(r32, (2 * 16 + hi * 8) * 2), ka3 = kb0 + KSWZ(r32, (3 * 16 + hi * 8) * 2);
#define KRD(dst, addr, off) asm volatile("ds_read_b128 %0, %1 offset:%2" : "=&v"(dst) : "v"(addr), "i"(off) : "memory")
#define KRD4(S, aA, aB, off) do { KRD(S[0], aA, off); KRD(S[1], aA, (off) + 8192); KRD(S[2], aB, off); KRD(S[3], aB, (off) + 8192); } while (0)
#define KMM4(S, d) do { p0 = __builtin_amdgcn_mfma_f32_32x32x16_bf16(S[0], qr[d], p0, 0, 0, 0); p1 = __builtin_amdgcn_mfma_f32_32x32x16_bf16(S[1], qr[d], p1, 0, 0, 0); \
                        p0 = __builtin_amdgcn_mfma_f32_32x32x16_bf16(S[2], qr[(d) + 1], p0, 0, 0, 0); p1 = __builtin_amdgcn_mfma_f32_32x32x16_bf16(S[3], qr[(d) + 1], p1, 0, 0, 0); } while (0)
#define LGK(n) asm volatile("s_waitcnt lgkmcnt(" #n ")" ::: "memory")
    bf16x8 A[4], B[4];
    LGK(0); SBAR();
    if (NQ == 8) {
        KRD4(A, ka0, ka1, 0); KRD4(B, ka2, ka3, 0);
        LGK(4); SBAR(); KMM4(A, 0); SBAR(); KRD4(A, ka0, ka1, 128);
        LGK(4); SBAR(); KMM4(B, 2); SBAR(); KRD4(B, ka2, ka3, 128);
        LGK(4); SBAR(); KMM4(A, 4); SBAR();
        LGK(0); SBAR(); KMM4(B, 6);
    } else {
        KRD4(A, ka0, ka1, 0); KRD4(B, ka2, ka3, 0);
        LGK(4); SBAR(); KMM4(A, 0); SBAR();
        LGK(0); SBAR(); KMM4(B, 2);
    }
#undef KRD
#undef KRD4
#undef KMM4
#undef LGK
}
__device__ __forceinline__ void pv_tile(f32x16 (&o)[4], int vb0, bf16x8 pa0, bf16x8 pa1, bf16x8 pa2, bf16x8 pa3) {
#define TRRD(dst, off) asm volatile("ds_read_b64_tr_b16 %0, %1 offset:%2" : "=&v"(dst) : "v"(vb0), "i"(off) : "memory")
#define PV_RD(S, d0) do { constexpr int b_ = v_rd_off(d0, 0, 0); TRRD(S[0], b_); TRRD(S[1], b_ + 2048); TRRD(S[2], b_ + 4096); TRRD(S[3], b_ + 6144); \
                          TRRD(S[4], b_ + 8192); TRRD(S[5], b_ + 10240); TRRD(S[6], b_ + 12288); TRRD(S[7], b_ + 14336); } while (0)
#define PV_MM(S, d0) do { \
        o[d0] = __builtin_amdgcn_mfma_f32_32x32x16_bf16(pa0, (bf16x8){S[0][0], S[0][1], S[0][2], S[0][3], S[1][0], S[1][1], S[1][2], S[1][3]}, o[d0], 0, 0, 0);   \
        o[d0] = __builtin_amdgcn_mfma_f32_32x32x16_bf16(pa1, (bf16x8){S[2][0], S[2][1], S[2][2], S[2][3], S[3][0], S[3][1], S[3][2], S[3][3]}, o[d0], 0, 0, 0);   \
        o[d0] = __builtin_amdgcn_mfma_f32_32x32x16_bf16(pa2, (bf16x8){S[4][0], S[4][1], S[4][2], S[4][3], S[5][0], S[5][1], S[5][2], S[5][3]}, o[d0], 0, 0, 0);   \
        o[d0] = __builtin_amdgcn_mfma_f32_32x32x16_bf16(pa3, (bf16x8){S[6][0], S[6][1], S[6][2], S[6][3], S[7][0], S[7][1], S[7][2], S[7][3]}, o[d0], 0, 0, 0); } while (0)
#define LGK(n) asm volatile("s_waitcnt lgkmcnt(" #n ")" ::: "memory")
    s16x4 A[8], B[8];
    LGK(0); SBAR();
    PV_RD(A, 0); PV_RD(B, 1);
    LGK(8); SBAR(); PV_MM(A, 0); SBAR(); PV_RD(A, 2);
    LGK(8); SBAR(); PV_MM(B, 1); SBAR(); PV_RD(B, 3);
    LGK(8); SBAR(); PV_MM(A, 2); SBAR();
    LGK(0); SBAR(); PV_MM(B, 3);
#undef TRRD
#undef PV_RD
#undef PV_MM
#undef LGK
}
__device__ __forceinline__ void softmax_tile(f32x16& p0, f32x16& p1, float& m_reg, float& l_reg, float& alpha, bf16x8& pa0, bf16x8& pa1, bf16x8& pa2, bf16x8& pa3) {
    float pmax = p0[0];
#pragma unroll
    for (int r = 1; r < 16; ++r) pmax = fmaxf(pmax, p0[r]);
#pragma unroll
    for (int r = 0; r < 16; ++r) pmax = fmaxf(pmax, p1[r]);
    { auto rr = __builtin_amdgcn_permlane32_swap(__float_as_uint(pmax), __float_as_uint(pmax), false, false);
      pmax = fmaxf(__uint_as_float(rr[0]), __uint_as_float(rr[1])); }
    float mn;
    if (__builtin_expect(__all((pmax - m_reg) <= THR2), 1)) { mn = m_reg; alpha = 1.f; }
    else { mn = fmaxf(m_reg, pmax); alpha = fast_exp2(m_reg - mn); m_reg = mn; }
    float ps = 0.f;
#pragma unroll
    for (int r = 0; r < 16; ++r) { p0[r] = fast_exp2(p0[r] - mn); ps += p0[r]; }
#pragma unroll
    for (int r = 0; r < 16; ++r) { p1[r] = fast_exp2(p1[r] - mn); ps += p1[r]; }
    { auto rr = __builtin_amdgcn_permlane32_swap(__float_as_uint(ps), __float_as_uint(ps), false, false);
      ps = __uint_as_float(rr[0]) + __uint_as_float(rr[1]); }
    l_reg = l_reg * alpha + ps;
#define PK4(P, B_, OUT) do { unsigned a0 = cvtpk(P[B_+0], P[B_+1]), a1 = cvtpk(P[B_+2], P[B_+3]);                          \
        unsigned b0 = cvtpk(P[B_+4], P[B_+5]), b1 = cvtpk(P[B_+6], P[B_+7]);                                             \
        auto r0 = __builtin_amdgcn_permlane32_swap(a0, b0, false, false); auto r1 = __builtin_amdgcn_permlane32_swap(a1, b1, false, false); \
        u32x4 w = {r0[0], r1[0], r0[1], r1[1]}; OUT = __builtin_bit_cast(bf16x8, w); } while (0)
    PK4(p0, 0, pa0); PK4(p0, 8, pa1); PK4(p1, 0, pa2); PK4(p1, 8, pa3);
#undef PK4
}
__device__ __forceinline__ void rowbcast(LAS float* wsl, float v, int r32, int hi, float (&out)[16]) {
    if (hi == 0) wsl[r32] = v;
    asm volatile("s_waitcnt lgkmcnt(0)" ::: "memory");
#pragma unroll
    for (int r = 0; r < 16; ++r) out[r] = wsl[crow(r, hi)];
    asm volatile("s_waitcnt lgkmcnt(0)" ::: "memory");
}

template <int KIND>
__device__ __forceinline__ bool wave_act(int j, int qlo, unsigned selm) {
    const int kb = j * 64;
    if (KIND == K_FOX || KIND == K_DIFF) return kb <= qlo + 31;
    if (KIND == K_WIN) return (kb <= qlo + 31) && (kb + 63 >= qlo - 511);
    if (KIND == K_SEL) return (kb <= qlo + 31) && __any((int)((selm >> j) & 1u));
    return true;
}
template <int KIND>
__device__ __forceinline__ void score_fix(f32x16& p0, f32x16& p1, int j, int qlo, int qpos, int hi, const LAS float* lut, const LAS float* cum, unsigned selm) {
    const float NEG = -__builtin_inff();
    const int kb = j * 64, dq = qpos - kb - 4 * hi;
    if (KIND == K_FOX) {
        const LAS float* cb = cum + kb + 4 * hi;
#pragma unroll
        for (int r = 0; r < 16; ++r) { p0[r] += cb[ccol(r)]; p1[r] += cb[ccol(r) + 32]; }
        if (kb + 63 > qlo) {
#pragma unroll
            for (int r = 0; r < 16; ++r) { if (dq - ccol(r) < 0) p0[r] = NEG; if (dq - ccol(r) - 32 < 0) p1[r] = NEG; }
        }
    } else if (KIND == K_CMP) {
        const int dc = qpos - 31 - 16 * (kb + 4 * hi);
#pragma unroll
        for (int r = 0; r < 16; ++r) {
            const int rel0 = dc - 16 * ccol(r), rel1 = rel0 - 512;
            p0[r] += lut[min(max(rel0, 0), 127)]; p1[r] += lut[min(max(rel1, 0), 127)];
            if (rel0 < 0) p0[r] = NEG;
            if (rel1 < 0 || (kb + 4 * hi + ccol(r) + 32 >= 127)) p1[r] = NEG;
        }
    } else {
        if (qlo - (kb + 63) >= 113) {
        } else {
#pragma unroll
            for (int r = 0; r < 16; ++r) { const int rel0 = dq - ccol(r), rel1 = rel0 - 32;
                p0[r] += lut[min(max(rel0, 0), 127)]; p1[r] += lut[min(max(rel1, 0), 127)];
                if (rel0 < 0) p0[r] = NEG; if (rel1 < 0) p1[r] = NEG; }
        }
        if (KIND == K_WIN) {
            if (qlo + 31 - kb >= 512) {
#pragma unroll
                for (int r = 0; r < 16; ++r) { if (dq - ccol(r) >= 512) p0[r] = NEG; if (dq - ccol(r) - 32 >= 512) p1[r] = NEG; }
            }
        }
        if (KIND == K_SEL) {
            if (((selm >> j) & 1u) == 0u) {
#pragma unroll
                for (int r = 0; r < 16; ++r) { p0[r] = NEG; p1[r] = NEG; }
            }
        }
    }
}

template <int KIND, int NQ, int EXPM = 0>
__device__ __forceinline__ void attn_pass(lptr lds, const bf16_t* __restrict__ Kg, const bf16_t* __restrict__ Vg, int kp, int vp, unsigned tilemask,
                                          const bf16x8 (&qr)[8], int kf0, int P0, const LAS float* lut, const LAS float* cum, unsigned selm,
                                          f32x16 (&o)[4], float& m_reg, float& l_reg) {
    const int tid = ltid(), wid = __builtin_amdgcn_readfirstlane(tid >> 6), lane = tid & 63, r32 = lane & 31, hi = lane >> 5;
    const int sr = tid >> 4, sc = (tid & 15) * 8;
    const int kws = KSWZ(sr, sc * 2), vst0 = v_st(sr, sc), vst1 = v_st(32 + sr, sc);
    const int qlo = P0 + wid * 32, qpos = qlo + r32;
    LAS float* wsl = (LAS float*)(lds + L_WS) + wid * 64;
    const int vbase = (int)(uintptr_t)(lds + L_V) + v_rd_base(lane);
    if (tilemask == 0u) return;
    const int kr_ = wid * 4 + (lane >> 4);
    const int kcol_ = (((lane & 15) ^ (kr_ & 7)) * 8);
    const int vsub_ = wid * 2 + (lane >> 5);
    const int vkk_ = ((vsub_ >> 2) << 3) | ((lane & 31) >> 2);
    const int vkey_ = (vkk_ & ~0xC) | ((vkk_ & 4) << 1) | ((vkk_ & 8) >> 1);
    const int vcol_ = (vsub_ & 3) * 32 + (lane & 3) * 8;
    const unsigned dma_w = (unsigned)wid * 1024u;
#define DMA_TILE(jj, bf) do { \
        const bf16_t* kp0_ = Kg + (size_t)((jj) * 64 + kr_) * kp + kcol_; const bf16_t* vp0_ = Vg + (size_t)((jj) * 64 + vkey_) * vp + vcol_; \
        __builtin_amdgcn_global_load_lds((const unsigned*)kp0_, (LAS unsigned*)(lds + L_K + (bf) * SHM + dma_w), 16, 0, DMA_AUX); \
        __builtin_amdgcn_global_load_lds((const unsigned*)(kp0_ + (size_t)32 * kp), (LAS unsigned*)(lds + L_K + (bf) * SHM + 8192 + dma_w), 16, 0, DMA_AUX); \
        __builtin_amdgcn_global_load_lds((const unsigned*)vp0_, (LAS unsigned*)(lds + L_V + (bf) * SHM + dma_w), 16, 0, DMA_AUX); \
        __builtin_amdgcn_global_load_lds((const unsigned*)(vp0_ + (size_t)32 * vp), (LAS unsigned*)(lds + L_V + (bf) * SHM + 8192 + dma_w), 16, 0, DMA_AUX); } while (0)
#define NEXT_TILE(jv) do { if (tilemask) { jv = __builtin_ctz(tilemask); tilemask &= tilemask - 1u; } else jv = -1; } while (0)
    int j0, j1;
    NEXT_TILE(j0); NEXT_TILE(j1);
    DMA_TILE(j0, 0);
    asm volatile("s_waitcnt vmcnt(0)" ::: "memory");
    __syncthreads();
    int buf = 0;
    for (;;) {
        if (j1 >= 0) DMA_TILE(j1, buf ^ 1);
        if (wave_act<KIND>(j0, qlo, selm)) {
            f32x16 p0, p1;
            qkt<NQ>(p0, p1, lds + L_K + buf * SHM, kf0, r32, hi, qr);
            score_fix<KIND>(p0, p1, j0, qlo, qpos, hi, lut, cum, selm);
            float alpha; bf16x8 pa0, pa1, pa2, pa3;
            softmax_tile(p0, p1, m_reg, l_reg, alpha, pa0, pa1, pa2, pa3);
            if (__any(alpha < 1.f)) {
                float al[16]; rowbcast(wsl, alpha, r32, hi, al);
#pragma unroll
                for (int d = 0; d < 4; ++d)
#pragma unroll
                    for (int r = 0; r < 16; ++r) o[d][r] *= al[r];
            }
            pv_tile(o, vbase + buf * SHM, pa0, pa1, pa2, pa3);
        }
        asm volatile("s_waitcnt vmcnt(0)" ::: "memory");
        __syncthreads();
        if (j1 < 0) break;
        j0 = j1; NEXT_TILE(j1); buf ^= 1;
    }
#undef DMA_TILE
#undef NEXT_TILE
}

__device__ __forceinline__ void fox_pass(lptr lds, const bf16_t* __restrict__ Kg, const bf16_t* __restrict__ Vg, int ntiles, const bf16x8 (&qr)[8], int P0,
                                         const LAS float* cum, f32x16 (&o)[4], float& m_reg, float& l_reg) {
    const int tid = ltid(), wid = __builtin_amdgcn_readfirstlane(tid >> 6), lane = tid & 63, r32 = lane & 31, hi = lane >> 5;
    const int sr = tid >> 4, sc = (tid & 15) * 8;
    const int kws = KSWZ(sr, sc * 2), vst0 = v_st(sr, sc), vst1 = v_st(32 + sr, sc);
    const int qlo = P0 + wid * 32, qpos = qlo + r32;
    LAS float* wsl = (LAS float*)(lds + L_WS) + wid * 64;
    const int vbase = (int)(uintptr_t)(lds + L_V) + v_rd_base(lane);
    const int kbase = (int)(uintptr_t)(lds + L_K);
    const int ko0 = KSWZ(r32, (0 * 16 + hi * 8) * 2), ko1 = KSWZ(r32, (1 * 16 + hi * 8) * 2), ko2 = KSWZ(r32, (2 * 16 + hi * 8) * 2), ko3 = KSWZ(r32, (3 * 16 + hi * 8) * 2);
    const int PITCH = PROJ_LD;
    bf16x8 st_k0, st_k1, st_v0, st_v1;
#define LOADK(jj) do { const size_t kr = (size_t)((jj) * 64 + sr); st_k0 = *(const bf16x8*)(Kg + kr * PITCH + sc); st_k1 = *(const bf16x8*)(Kg + (kr + 32) * PITCH + sc); } while (0)
#define LOADV(jj) do { const size_t kr = (size_t)((jj) * 64 + sr); st_v0 = *(const bf16x8*)(Vg + kr * PITCH + sc); st_v1 = *(const bf16x8*)(Vg + (kr + 32) * PITCH + sc); } while (0)
#define WRITEK(bf) do { *(LAS bf16x8*)(lds + L_K + (bf) * SHM + kws) = st_k0; *(LAS bf16x8*)(lds + L_K + (bf) * SHM + kws + 32 * 256) = st_k1; } while (0)
#define WRITEV(bf) do { *(LAS bf16x8*)(lds + L_V + (bf) * SHM + vst0) = st_v0; *(LAS bf16x8*)(lds + L_V + (bf) * SHM + vst1) = st_v1; } while (0)
#define KRD(dst, addr, off) asm volatile("ds_read_b128 %0, %1 offset:%2" : "=&v"(dst) : "v"(addr), "i"(off) : "memory")
#define KRD4(S, aA, aB, off) do { KRD(S[0], aA, off); KRD(S[1], aA, (off) + 8192); KRD(S[2], aB, off); KRD(S[3], aB, (off) + 8192); } while (0)
#define KMM4(S, d) do { sn0 = __builtin_amdgcn_mfma_f32_32x32x16_bf16(S[0], qr[d], sn0, 0, 0, 0); sn1 = __builtin_amdgcn_mfma_f32_32x32x16_bf16(S[1], qr[d], sn1, 0, 0, 0); \
                        sn0 = __builtin_amdgcn_mfma_f32_32x32x16_bf16(S[2], qr[(d) + 1], sn0, 0, 0, 0); sn1 = __builtin_amdgcn_mfma_f32_32x32x16_bf16(S[3], qr[(d) + 1], sn1, 0, 0, 0); } while (0)
#define LGK(n) asm volatile("s_waitcnt lgkmcnt(" #n ")" ::: "memory")
    LOADK(0); LOADV(0); WRITEK(0); WRITEV(0);
    if (ntiles > 1) { LOADK(1); WRITEK(1); }
    __syncthreads();
    f32x16 sc0, sc1;
    bool actc = 0 <= qlo + 31;
    if (actc) { qkt<8>(sc0, sc1, lds + L_K, 0, r32, hi, qr); score_fix<K_FOX>(sc0, sc1, 0, qlo, qpos, hi, nullptr, cum, 0u); }
    for (int t = 0; t < ntiles; ++t) {
        const int buf = t & 1; const bool has1 = t + 1 < ntiles, has2 = t + 2 < ntiles;
        if (has1) LOADV(t + 1);
        if (has2) LOADK(t + 2);
        const bool actn = has1 && ((t + 1) * 64 <= qlo + 31);
        f32x16 sn0, sn1;
        if (actc && actn && ((t + 1) * 64 + 63 <= qlo)) {
            const int ka = kbase + (buf ^ 1) * SHM;
            const int ka0 = ka + ko0, ka1 = ka + ko1, ka2 = ka + ko2, ka3 = ka + ko3;
            bf16x8 A[4], B[4];
            SBAR(); LGK(0);
            KRD4(A, ka0, ka1, 0); KRD4(B, ka2, ka3, 0);
            SBAR();
            float pmax = sc0[0];
#pragma unroll
            for (int r = 1; r < 16; ++r) pmax = fmaxf(pmax, sc0[r]);
            sn0 = f32x16{}; sn1 = f32x16{};
            SBAR(); LGK(4); SBAR(); KMM4(A, 0); SBAR(); KRD4(A, ka0, ka1, 128); SBAR();
#pragma unroll
            for (int r = 0; r < 16; ++r) pmax = fmaxf(pmax, sc1[r]);
            { auto rr = __builtin_amdgcn_permlane32_swap(__float_as_uint(pmax), __float_as_uint(pmax), false, false);
              pmax = fmaxf(__uint_as_float(rr[0]), __uint_as_float(rr[1])); }
            const bool keep = __all((pmax - m_reg) <= THR2);
            const float mn = keep ? m_reg : fmaxf(m_reg, pmax);
            const float alpha = fast_exp2(m_reg - mn); m_reg = mn;
            SBAR(); LGK(4); SBAR(); KMM4(B, 2); SBAR(); KRD4(B, ka2, ka3, 128); SBAR();
            float ps = 0.f;
#pragma unroll
            for (int r = 0; r < 16; ++r) { sc0[r] = fast_exp2(sc0[r] - mn); ps += sc0[r]; }
            SBAR(); LGK(4); SBAR(); KMM4(A, 4); SBAR();
#pragma unroll
            for (int r = 0; r < 16; ++r) { sc1[r] = fast_exp2(sc1[r] - mn); ps += sc1[r]; }
            SBAR(); LGK(0); SBAR(); KMM4(B, 6); SBAR();
            { auto rr = __builtin_amdgcn_permlane32_swap(__float_as_uint(ps), __float_as_uint(ps), false, false);
              ps = __uint_as_float(rr[0]) + __uint_as_float(rr[1]); }
            l_reg = l_reg * alpha + ps;
            bf16x8 pa0, pa1, pa2, pa3;
#define PK4(P, B_, OUT) do { unsigned a0 = cvtpk(P[B_+0], P[B_+1]), a1 = cvtpk(P[B_+2], P[B_+3]);                          \
        unsigned b0 = cvtpk(P[B_+4], P[B_+5]), b1 = cvtpk(P[B_+6], P[B_+7]);                                             \
        auto r0 = __builtin_amdgcn_permlane32_swap(a0, b0, false, false); auto r1 = __builtin_amdgcn_permlane32_swap(a1, b1, false, false); \
        u32x4 w = {r0[0], r1[0], r0[1], r1[1]}; OUT = __builtin_bit_cast(bf16x8, w); } while (0)
            PK4(sc0, 0, pa0); PK4(sc0, 8, pa1); PK4(sc1, 0, pa2); PK4(sc1, 8, pa3);
#undef PK4
            SBAR();
            if (__any(alpha < 1.f)) {
                float al[16]; rowbcast(wsl, alpha, r32, hi, al);
#pragma unroll
                for (int d = 0; d < 4; ++d)
#pragma unroll
                    for (int r = 0; r < 16; ++r) o[d][r] *= al[r];
            }
            pv_tile(o, vbase + buf * SHM, pa0, pa1, pa2, pa3);
            { const LAS float* cbp = cum + (t + 1) * 64 + 4 * hi;
#pragma unroll
              for (int r = 0; r < 16; ++r) { sn0[r] += cbp[ccol(r)]; sn1[r] += cbp[ccol(r) + 32]; } }
        } else {
            if (actn) qkt<8>(sn0, sn1, lds + L_K + (buf ^ 1) * SHM, 0, r32, hi, qr);
            if (actc) {
                float alpha; bf16x8 pa0, pa1, pa2, pa3;
                softmax_tile(sc0, sc1, m_reg, l_reg, alpha, pa0, pa1, pa2, pa3);
                if (__any(alpha < 1.f)) {
                    float al[16]; rowbcast(wsl, alpha, r32, hi, al);
#pragma unroll
                    for (int d = 0; d < 4; ++d)
#pragma unroll
                        for (int r = 0; r < 16; ++r) o[d][r] *= al[r];
                }
                pv_tile(o, vbase + buf * SHM, pa0, pa1, pa2, pa3);
            }
            if (actn) score_fix<K_FOX>(sn0, sn1, t + 1, qlo, qpos, hi, nullptr, cum, 0u);
        }
        if (has1) WRITEV(buf ^ 1);
        if (has2) WRITEK(buf);
        __syncthreads();
        sc0 = sn0; sc1 = sn1; actc = actn;
    }
#undef LOADK
#undef LOADV
#undef WRITEK
#undef WRITEV
#undef KRD
#undef KRD4
#undef KMM4
#undef LGK
}

template <int NQ>
__device__ __forceinline__ void load_q(bf16x8 (&qr)[8], const bf16_t* proj, int row_first, int col0) {
    const int lane = ltid() & 63, r32 = lane & 31, hi = lane >> 5, wid = ltid() >> 6;
    const bf16_t* q = proj + (size_t)(row_first + wid * 32 + r32) * PROJ_LD + col0 + hi * 8;
#pragma unroll
    for (int d = 0; d < NQ; ++d) qr[d] = *(const bf16x8*)(q + d * 16);
}
__device__ __forceinline__ void store_o(const f32x16 (&o)[4], bf16_t* mixed, int row_first, int col0) {
    const int lane = ltid() & 63, r32 = lane & 31, hi = lane >> 5, wid = ltid() >> 6;
    const bool odd = (r32 & 1) != 0;
    bf16_t* base = mixed + (size_t)(row_first + wid * 32) * DM + col0 + (r32 & ~1);
#pragma unroll
    for (int rp = 0; rp < 8; ++rp) { const int orow = crow(2 * rp + (odd ? 1 : 0), hi);
#pragma unroll
        for (int d = 0; d < 4; ++d) { const float va = o[d][2 * rp], vb = o[d][2 * rp + 1];
            const float y = dppf<0xB1>(odd ? va : vb);
            *(unsigned*)(base + (size_t)orow * DM + d * 32) = odd ? cvtpk(y, vb) : cvtpk(va, y); } }
}
__device__ __forceinline__ void scr_acc(float* scr, const f32x16 (&o)[4], const float (&f)[16], bool add) {
    f32x4* s = (f32x4*)(scr + (ltid() >> 6) * 4096) + (ltid() & 63);
#pragma unroll
    for (int d = 0; d < 4; ++d)
#pragma unroll
        for (int q = 0; q < 4; ++q) { f32x4 v; v.x = o[d][4 * q] * f[4 * q]; v.y = o[d][4 * q + 1] * f[4 * q + 1]; v.z = o[d][4 * q + 2] * f[4 * q + 2]; v.w = o[d][4 * q + 3] * f[4 * q + 3];
            if (add) v += s[(d * 4 + q) * 64]; s[(d * 4 + q) * 64] = v; }
}
__device__ __forceinline__ void scr_load(const float* scr, f32x16 (&o)[4]) {
    const f32x4* s = (const f32x4*)(scr + (ltid() >> 6) * 4096) + (ltid() & 63);
#pragma unroll
    for (int d = 0; d < 4; ++d)
#pragma unroll
        for (int q = 0; q < 4; ++q) { const f32x4 v = s[(d * 4 + q) * 64]; o[d][4 * q] = v.x; o[d][4 * q + 1] = v.y; o[d][4 * q + 2] = v.z; o[d][4 * q + 3] = v.w; }
}

template <int EXPM = 0>
__device__ __forceinline__ void fox_unit(lptr lds, const bf16_t* proj, const float* gates, float fbias, bf16_t* mixed, int b, int h, int qb) {
    const int tid = ltid(), wid = tid >> 6, lane = tid & 63, r32 = lane & 31, hi = lane >> 5;
    const int P0 = qb * 256, rowb = b * SEQ;
    LAS float* cum = (LAS float*)(lds + L_CUM);
    { const int nk = P0 + 256; float run = 0.f; const bool on = 4 * tid < nk;
      float xs[4];
#pragma unroll
      for (int i = 0; i < 4; ++i) xs[i] = gates[(size_t)(rowb + 4 * tid + i) * GATE_LD + h] + fbias;
      if (on) {
#pragma unroll
          for (int i = 0; i < 4; ++i) { const float xx = xs[i];
              run += fminf(xx, 0.f) - __logf(1.f + __expf(-fabsf(xx))); cum[4 * tid + i] = run; }
      }
      float inc = run;
#pragma unroll
      for (int o = 1; o < 64; o <<= 1) { const float t = __builtin_bit_cast(float, __builtin_amdgcn_ds_bpermute(((lane - o) & 63) << 2, __builtin_bit_cast(int, inc))); if (lane >= o) inc += t; }
      LAS float* wsum = (LAS float*)(lds + L_WS);
      if (lane == 63) wsum[wid] = inc;
      __syncthreads();
      float base = 0.f;
#pragma unroll
      for (int w = 0; w < 8; ++w) if (w < wid) base += wsum[w];
      const float ex = base + inc - run;
      if (on) {
#pragma unroll 1
          for (int i = 0; i < 4; ++i) cum[4 * tid + i] = (ex + cum[4 * tid + i]) * LOG2E; }
      __syncthreads();
      const float cref = cum[P0];
      __syncthreads();
      if (on) {
#pragma unroll 1
          for (int i = 0; i < 4; ++i) cum[4 * tid + i] = cref - cum[4 * tid + i]; }
    }
    bf16x8 qr[8]; load_q<8>(qr, proj, rowb + P0, C_FQ + h * 128);
    __syncthreads();
    f32x16 o[4] = {}; float m_reg = -1e30f, l_reg = 0.f;
    const unsigned tm = (qb == 7) ? 0xFFFFFFFFu : ((1u << (4 * (qb + 1))) - 1u);
    if (false) fox_pass(lds, proj + (size_t)rowb * PROJ_LD + C_FK + h * 128, proj + (size_t)rowb * PROJ_LD + C_FV + h * 128, 4 * (qb + 1), qr, P0, cum, o, m_reg, l_reg);
    else attn_pass<K_FOX, 8, EXPM>(lds, proj + (size_t)rowb * PROJ_LD + C_FK + h * 128, proj + (size_t)rowb * PROJ_LD + C_FV + h * 128, PROJ_LD, PROJ_LD, tm, qr, 0, P0, nullptr, cum, 0u, o, m_reg, l_reg);
    float f[16]; rowbcast((LAS float*)(lds + L_WS) + wid * 64, fast_rcp(l_reg), r32, hi, f);
#pragma unroll
    for (int d = 0; d < 4; ++d)
#pragma unroll
        for (int r = 0; r < 16; ++r) o[d][r] *= f[r];
    store_o(o, mixed, rowb + P0, h * 128);
    __syncthreads();
}
__device__ __forceinline__ void diff_unit(lptr lds, const bf16_t* proj, bf16_t* mixed, float* scr, int b, int h, int qb, float lam, float out_scale, const float* subln_g) {
    const int tid = ltid(), wid = tid >> 6, lane = tid & 63, r32 = lane & 31, hi = lane >> 5;
    const int P0 = qb * 256, rowb = b * SEQ;
    const LAS float* lut = (const LAS float*)(lds + L_LUT) + h * 128;
    LAS float* wsl = (LAS float*)(lds + L_WS) + wid * 64;
    const unsigned tm = (qb == 7) ? 0xFFFFFFFFu : ((1u << (4 * (qb + 1))) - 1u);
    const bf16_t* Kg = proj + (size_t)rowb * PROJ_LD + C_DK + h * 128; const bf16_t* Vg = proj + (size_t)rowb * PROJ_LD + C_DV + h * 128;
    f32x16 ot[4];
#pragma unroll 1
    for (int mp = 0; mp < 2; ++mp) {
        bf16x8 qr[8]; load_q<4>(qr, proj, rowb + P0, C_DQ + h * 128 + mp * 64);
        f32x16 o[4] = {}; float m_reg = -1e30f, l_reg = 0.f;
        attn_pass<K_DIFF, 4>(lds, Kg, Vg, PROJ_LD, PROJ_LD, tm, qr, mp * 4, P0, lut, nullptr, 0u, o, m_reg, l_reg);
        float f[16]; rowbcast(wsl, (mp == 0 ? 1.f : -lam) * fast_rcp(l_reg), r32, hi, f);
        if (mp == 0) scr_acc(scr, o, f, false);
        else {
            scr_load(scr, ot);
#pragma unroll
            for (int d = 0; d < 4; ++d)
#pragma unroll
                for (int r = 0; r < 16; ++r) ot[d][r] += o[d][r] * f[r];
        }
    }
    float gcol[4];
#pragma unroll
    for (int d = 0; d < 4; ++d) gcol[d] = subln_g[d * 32 + r32] * out_scale;
#pragma unroll
    for (int r = 0; r < 16; ++r) {
        float ss = ot[0][r] * ot[0][r] + ot[1][r] * ot[1][r] + ot[2][r] * ot[2][r] + ot[3][r] * ot[3][r];
        ss += dppf<0x128>(ss); ss += dppf<0x124>(ss); ss += dppf<0x122>(ss); ss += dppf<0x121>(ss); ss += shx(ss, 16);
        const float rn = __builtin_amdgcn_rsqf(ss * (1.f / 128.f) + RMS_EPS);
#pragma unroll
        for (int d = 0; d < 4; ++d) ot[d][r] *= rn * gcol[d];
    }
    store_o(ot, mixed, rowb + P0, 768 + h * 128);
    __syncthreads();
}
__device__ __forceinline__ void nsa_unit(lptr lds, const bf16_t* proj, const float* gates, const bf16_t* kcmp, const bf16_t* vcmp, bf16_t* mixed, float* scr, int b, int g, int qb) {
    const int tid = ltid(), wid = tid >> 6, lane = tid & 63, r32 = lane & 31, hi = lane >> 5;
    const int P0 = qb * 256, rowb = b * SEQ;
    const int qlo = P0 + wid * 32, qpos = qlo + r32;
    LAS float* wsl = (LAS float*)(lds + L_WS) + wid * 64;
    LAS float* imp = (LAS float*)(lds + L_IMP);
    LAS unsigned* sel = (LAS unsigned*)(lds + L_SEL);
    LAS unsigned* uni = (LAS unsigned*)(lds + L_UNI);
    const float NEG = -__builtin_inff();
    const bf16_t* kc = kcmp + (size_t)(b * 2 + g) * 128 * 128; const bf16_t* vc = vcmp + (size_t)(b * 2 + g) * 128 * 128;
    { const int sr = tid >> 4, sc = (tid & 15) * 8, kws = KSWZ(sr, sc * 2);
#pragma unroll
      for (int t = 0; t < 2; ++t) { const bf16x8 a = *(const bf16x8*)(kc + (size_t)(t * 64 + sr) * 128 + sc), c = *(const bf16x8*)(kc + (size_t)(t * 64 + 32 + sr) * 128 + sc);
          *(LAS bf16x8*)(lds + L_K + t * SHM + kws) = a; *(LAS bf16x8*)(lds + L_K + t * SHM + kws + 32 * 256) = c; }
      if (tid == 0) uni[0] = 0u; }
    __syncthreads();
    float ia[16], ic[16];
#pragma unroll
    for (int i = 0; i < 16; ++i) { ia[i] = 0.f; ic[i] = 0.f; }
#pragma unroll 1
    for (int hh = 0; hh < 3; ++hh) {
        const int hd = g * 3 + hh; const LAS float* lut = (const LAS float*)(lds + L_LUT) + (4 + hd) * 128;
        bf16x8 qr[8]; load_q<8>(qr, proj, rowb + P0, C_NQ + hd * 128);
        f32x16 p[4];
        qkt<8>(p[0], p[1], lds + L_K, 0, r32, hi, qr); qkt<8>(p[2], p[3], lds + L_K + SHM, 0, r32, hi, qr);
        float mx = -1e30f;
#pragma unroll
        for (int q4 = 0; q4 < 4; ++q4)
#pragma unroll
            for (int r = 0; r < 16; ++r) { const int n = q4 * 32 + 4 * hi + ccol(r); const int rel = qpos - 31 - 16 * n;
                float s = p[q4][r] + lut[min(max(rel, 0), 127)]; if (rel < 0 || n >= 127) s = NEG; p[q4][r] = s; mx = fmaxf(mx, s); }
        mx = fmaxf(mx, shx(mx, 32));
        float ps = 0.f;
#pragma unroll
        for (int q4 = 0; q4 < 4; ++q4)
#pragma unroll
            for (int r = 0; r < 16; ++r) { p[q4][r] = fast_exp2(p[q4][r] - mx); ps += p[q4][r]; }
        ps += shx(ps, 32);
        const float inv = ps > 0.f ? 1.f / ps : 0.f;
#pragma unroll
        for (int q4 = 0; q4 < 4; ++q4)
#pragma unroll
            for (int i = 0; i < 4; ++i) { const float x0 = p[q4][4 * i] * inv, x1 = p[q4][4 * i + 1] * inv, x2 = p[q4][4 * i + 2] * inv, x3 = p[q4][4 * i + 3] * inv;
                ia[q4 * 4 + i] += x0 + x1 + x2 + 0.5f * x3; ic[q4 * 4 + i] += 0.5f * x3; }
    }
#pragma unroll
    for (int gi = 0; gi < 16; ++gi) {
        const float cp = shx(ic[gi], 32);
        const float cpm = (gi > 0) ? shx(ic[gi > 0 ? gi - 1 : 0], 32) : 0.f;
        const float v = ia[gi] + (hi ? cp : cpm);
        imp[(wid * 32 + r32) * 33 + 2 * gi + hi] = v;
    }
    __syncthreads();
    if (tid < 256) {
        const int t = P0 + tid, blk = t >> 6;
        float sc[32];
#pragma unroll
        for (int j2 = 0; j2 < 32; ++j2) { const bool forced = (j2 == 0) || (j2 == blk) || (j2 == blk - 1);
            sc[j2] = (j2 <= blk) ? (imp[tid * 33 + j2] + (forced ? 1e4f : 0.f)) : -1e30f; }
        unsigned mask = 0u;
#pragma unroll 1
        for (int it = 0; it < 8; ++it) { float best = -1e30f; int bi = -1;
#pragma unroll
            for (int j2 = 0; j2 < 32; ++j2) { const bool free_ = ((mask >> j2) & 1u) == 0u; if (free_ && sc[j2] > best) { best = sc[j2]; bi = j2; } }
            if (bi >= 0 && best > -0.5e30f) mask |= 1u << bi; }
        sel[tid] = mask;
        atomicOr((unsigned*)uni, mask);
    }
    __syncthreads();
    const unsigned selm = sel[wid * 32 + r32];
    const unsigned um = uni[0];
#pragma unroll 1
    for (int hp = 0; hp < 3; ++hp) {
    const int h6 = g * 3 + hp;
    const float* gp = gates + (size_t)(rowb + qpos) * GATE_LD + 6 + h6 * 3;
    const float g0 = 1.f / (1.f + __expf(-gp[0])), g1 = 1.f / (1.f + __expf(-gp[1])), g2 = 1.f / (1.f + __expf(-gp[2]));
    const LAS float* lut = (const LAS float*)(lds + L_LUT) + (4 + h6) * 128;
    bf16x8 qr[8]; load_q<8>(qr, proj, rowb + P0, C_NQ + h6 * 128);
    {
        f32x16 o[4] = {}; float m_reg = -1e30f, l_reg = 0.f;
        attn_pass<K_CMP, 8>(lds, kc, vc, 128, 128, 3u, qr, 0, P0, lut, nullptr, 0u, o, m_reg, l_reg);
        float f[16]; rowbcast(wsl, l_reg > 0.f ? g0 / l_reg : 0.f, r32, hi, f);
        scr_acc(scr, o, f, false);
    }
    {
        f32x16 o[4] = {}; float m_reg = -1e30f, l_reg = 0.f;
        const unsigned cm = (qb == 7) ? 0xFFFFFFFFu : ((1u << (4 * (qb + 1))) - 1u);
        attn_pass<K_SEL, 8>(lds, proj + (size_t)rowb * PROJ_LD + C_NKS + g * 128, proj + (size_t)rowb * PROJ_LD + C_NVS + g * 128, PROJ_LD, PROJ_LD, um & cm, qr, 0, P0, lut, nullptr, selm, o, m_reg, l_reg);
        float f[16]; rowbcast(wsl, l_reg > 0.f ? g1 / l_reg : 0.f, r32, hi, f);
        scr_acc(scr, o, f, true);
    }
    {
        f32x16 o[4] = {}; float m_reg = -1e30f, l_reg = 0.f;
        const int jlo = (P0 - 511) > 0 ? (P0 - 511) >> 6 : 0, jhi = (P0 + 255) >> 6;
        const unsigned hiM = (jhi == 31) ? 0xFFFFFFFFu : ((1u << (jhi + 1)) - 1u);
        const unsigned wm = hiM & ~((1u << jlo) - 1u);
        attn_pass<K_WIN, 8>(lds, proj + (size_t)rowb * PROJ_LD + C_NKW + g * 128, proj + (size_t)rowb * PROJ_LD + C_NVW + g * 128, PROJ_LD, PROJ_LD, wm, qr, 0, P0, lut, nullptr, 0u, o, m_reg, l_reg);
        float f[16]; rowbcast(wsl, l_reg > 0.f ? g2 / l_reg : 0.f, r32, hi, f);
        f32x16 ot[4]; scr_load(scr, ot);
#pragma unroll
        for (int d = 0; d < 4; ++d)
#pragma unroll
            for (int r = 0; r < 16; ++r) ot[d][r] += o[d][r] * f[r];
        store_o(ot, mixed, rowb + P0, 1280 + h6 * 128);
    }
    __syncthreads();
    }
}
#undef KSWZ
}

struct Params {
    const float* x; const float* attn_norm_g; const float* w_in; const float* fox_f_bias; const float* lq1; const float* lk1; const float* lq2; const float* lk2;
    const float* subln_g; const float* cmp_pos; const float* wk1; const float* wk2; const float* wv1; const float* wv2; const float* w_out; const float* ffn_norm_g;
    const float* w_up; const float* conv_w; const float* conv_b; const float* w_down; const float* rel_bias; const float* final_g;
    float* out; unsigned char* ws;
    int l_begin, l_end, do_prologue, do_final, bar_region, ph_mask;
};

typedef const __attribute__((address_space(4))) Params* KP;
__device__ __forceinline__ KP kparams() { unsigned long long a = (unsigned long long)__builtin_amdgcn_kernarg_segment_ptr(); asm volatile("" : "+s"(a)); return (KP)a; }

template <int MAPK>
__device__ __forceinline__ void transpose_item(const float* __restrict__ src, int ldsrc, const float* __restrict__ kscale, bf16_t* __restrict__ dst, int K, int k0, int n0, LAS float* scr, int lane) {
    const int c = n0 + (lane & 31);
    const int oc = (MAPK == 1) ? win_colmap(c) : (MAPK == 2) ? wup_colmap(c) : c;
    const float* sp = src + (size_t)(k0 + (lane >> 5)) * ldsrc + (oc >= 0 ? oc : 0);
    float v[32];
#pragma unroll
    for (int i = 0; i < 32; ++i) v[i] = __builtin_nontemporal_load(sp + (size_t)(2 * i) * ldsrc);
    if (kscale) {
#pragma unroll
        for (int i = 0; i < 32; ++i) v[i] *= kscale[k0 + 2 * i + (lane >> 5)];
    }
#pragma unroll
    for (int i = 0; i < 32; ++i) scr[(2 * i + (lane >> 5)) * 33 + (lane & 31)] = (oc < 0) ? 0.f : v[i];
    asm volatile("s_waitcnt lgkmcnt(0)" ::: "memory");
    const int cc = lane & 7;
#pragma unroll
    for (int j = 0; j < 4; ++j) { const int n = (lane >> 3) + 8 * j; const LAS float* s = scr + (8 * cc) * 33 + n;
        u32x4 o; o.x = cvtpk(s[0], s[33]); o.y = cvtpk(s[2 * 33], s[3 * 33]); o.z = cvtpk(s[4 * 33], s[5 * 33]); o.w = cvtpk(s[6 * 33], s[7 * 33]);
        *(u32x4*)(dst + (size_t)(n0 + n) * K + k0 + 8 * cc) = o; }
    asm volatile("s_waitcnt lgkmcnt(0)" ::: "memory");
}

constexpr int T_IN = (DM / 64) * (NINP / 32), T_OUT = (DM / 64) * (DM / 32), T_UP = (DM / 64) * (NUP / 32), T_DN = (DFF / 64) * (DM / 32), T_W1 = (4096 / 64) * 4, T_W2 = 2 * 4;
constexpr int T_LAYER = T_IN + T_OUT + T_UP + T_DN + 2 * T_W1 + 2 * T_W2;
__device__ __forceinline__ void convert_item(KP p, int l, int r, LAS float* scr, int lane) {
    unsigned char* ws = p->ws;
    if (r < T_IN) { const int nb = NINP / 32; transpose_item<1>(p->w_in + (size_t)l * DM * NIN, NIN, p->attn_norm_g + l * DM, (bf16_t*)(ws + WS_WIN) + (size_t)l * NINP * DM, DM, (r / nb) * 64, (r % nb) * 32, scr, lane); return; } r -= T_IN;
    if (r < T_OUT) { const int nb = DM / 32; transpose_item<0>(p->w_out + (size_t)l * DM * DM, DM, nullptr, (bf16_t*)(ws + WS_WOUT) + (size_t)l * DM * DM, DM, (r / nb) * 64, (r % nb) * 32, scr, lane); return; } r -= T_OUT;
    if (r < T_UP) { const int nb = NUP / 32; transpose_item<2>(p->w_up + (size_t)l * DM * NUP, NUP, p->ffn_norm_g + l * DM, (bf16_t*)(ws + WS_WUP) + (size_t)l * NUP * DM, DM, (r / nb) * 64, (r % nb) * 32, scr, lane); return; } r -= T_UP;
    if (r < T_DN) { const int nb = DM / 32; transpose_item<0>(p->w_down + (size_t)l * DFF * DM, DM, nullptr, (bf16_t*)(ws + WS_WDN) + (size_t)l * DM * DFF, DFF, (r / nb) * 64, (r % nb) * 32, scr, lane); return; } r -= T_DN;
    if (r < 2 * T_W1) { const int kv = r / T_W1, rr = r % T_W1; const float* src = (kv ? p->wv1 : p->wk1) + (size_t)l * 4096 * 128;
        transpose_item<0>(src, 128, nullptr, (bf16_t*)(ws + WS_W1T) + (size_t)(l * 2 + kv) * 128 * 4096, 4096, (rr / 4) * 64, (rr % 4) * 32, scr, lane); return; } r -= 2 * T_W1;
    { const int kv = r / T_W2, rr = r % T_W2; const float* src = (kv ? p->wv2 : p->wk2) + (size_t)l * 128 * 128;
        transpose_item<0>(src, 128, nullptr, (bf16_t*)(ws + WS_W2T) + (size_t)(l * 2 + kv) * 128 * 128, 128, (rr / 4) * 64, (rr % 4) * 32, scr, lane); }
}
__device__ __forceinline__ void prologue_phase(KP p, LAS unsigned char* lds) {
    const int tid = ltid(), lane = tid & 63, wave = tid >> 6;
    LAS float* scr = (LAS float*)lds + wave * (64 * 33);
    const int G = gridDim.x, bx = blockIdx.x;
    unsigned char* ws = p->ws;
    for (int it = bx * 8 + wave; it < T_LAYER; it += G * 8) convert_item(p, 0, it, scr, lane);
    __syncthreads();
    { LAS float* scr = (LAS float*)lds;
    for (int it = bx; it < DEPTH * 2 * 8; it += G) {
        const int l = it >> 4, kv = (it >> 3) & 1, c0 = (it & 7) * 16; const float* w1 = (kv ? p->wv1 : p->wk1) + (size_t)l * 4096 * 128; const float* pos = p->cmp_pos + (size_t)l * 4096;
        const int col = c0 + (tid & 15), ks = tid >> 4; float s = 0.f;
#pragma unroll 8
        for (int k = ks * 128; k < ks * 128 + 128; ++k) s += pos[k] * w1[(size_t)k * 128 + col];
        scr[tid] = s; __syncthreads();
        if (tid < 16) { float a = 0.f; for (int j = 0; j < 32; ++j) a += scr[j * 16 + tid]; ((float*)(ws + WS_POSC))[(l * 2 + kv) * 128 + c0 + tid] = a; }
        __syncthreads();
    }
    }
    { const int gw = bx * 8 + wave, NGW = G * 8; bf16_t* hb = (bf16_t*)(ws + WS_HB);
      for (int row = gw; row < MROWS; row += NGW) {
          const f32x4* xr = (const f32x4*)(p->x + (size_t)row * DM) + lane; f32x4 v[8]; float ss = 0.f;
#pragma unroll
          for (int j = 0; j < 8; ++j) { v[j] = __builtin_nontemporal_load(xr + 64 * j); ss += (v[j].x * v[j].x + v[j].y * v[j].y) + (v[j].z * v[j].z + v[j].w * v[j].w); }
          ss = wave_sum(ss);
          if (lane < 32) ((float*)(ws + WS_SSQP))[(size_t)row * 32 + lane] = (lane == 0) ? ss : 0.f;
          u32x2* o = (u32x2*)(hb + (size_t)row * DM) + lane;
#pragma unroll
          for (int j = 0; j < 8; ++j) { u32x2 w; w.x = cvtpk(v[j].x, v[j].y); w.y = cvtpk(v[j].z, v[j].w); o[64 * j] = w; }
      } }
}

__device__ __forceinline__ int panel_a() { return 16 * ((int)blockIdx.x & 7) + (((int)blockIdx.x >> 3) & 7); }
__device__ __forceinline__ void rstd_prefix(KP p, LAS unsigned char* lds) {
    const int tid = ltid(); const float* ssqp = (const float*)(p->ws + WS_SSQP); LAS float* rstab = (LAS float*)(lds + LX_RSTAB);
    const int row = (panel_a() + 8 * (tid >> 8)) * 256 + (tid & 255);
    const f32x4* q = (const f32x4*)(ssqp + (size_t)row * 32); float s = 0.f;
#pragma unroll
    for (int j = 0; j < 8; ++j) { const f32x4 v = q[j]; s += (v.x + v.y) + (v.z + v.w); }
    rstab[tid] = __builtin_amdgcn_rsqf(s * (1.f / DM) + RMS_EPS);
    __syncthreads();
}
__device__ __forceinline__ void gate_prefix(KP p, int l, LAS unsigned char* lds) {
    const int tid = ltid(), lane = tid & 63, wave = tid >> 6, r32 = lane & 31, hi = lane >> 5;
    const bf16_t* hb = (const bf16_t*)(p->ws + WS_HB); const bf16_t* wg = (const bf16_t*)(p->ws + WS_WIN) + ((size_t)l * NINP + 6144) * DM;
    float* gates = (float*)(p->ws + WS_GATES); const LAS float* rstab = (const LAS float*)(lds + LX_RSTAB);
    constexpr int WPITCH = DM * 2 + 16;
    for (int i = tid; i < 32 * (DM / 8); i += 512) { const int r = i >> 8, c8 = i & 255; *(LAS bf16x8*)(lds + r * WPITCH + c8 * 16) = *(const bf16x8*)(wg + (size_t)r * DM + c8 * 8); }
    __syncthreads();
    if (wave < 4) {
        const int slot = wave >> 1, prow = ((int)blockIdx.x >> 6) * 64 + (wave & 1) * 32;
        const int row0 = (panel_a() + 8 * slot) * 256 + prow;
        const float rs = rstab[slot * 256 + prow + r32];
        const bf16_t* ap = hb + (size_t)(row0 + r32) * DM + hi * 8; const LAS unsigned char* bp = lds + r32 * WPITCH + hi * 16;
        f32x16 acc = {};
#pragma unroll 1
        for (int k32 = 0; k32 < 4; ++k32) { bf16x8 a[32];
#pragma unroll
            for (int j = 0; j < 32; ++j) a[j] = *(const bf16x8*)(ap + (k32 * 32 + j) * 16);
#pragma unroll
            for (int j = 0; j < 32; ++j) { const bf16x8 b = *(const LAS bf16x8*)(bp + (k32 * 32 + j) * 32); acc = __builtin_amdgcn_mfma_f32_32x32x16_bf16(a[j], b, acc, 0, 0, 0); } }
#pragma unroll
        for (int r = 0; r < 16; ++r) { const int rr = att::crow(r, hi);
            const float rsr = __builtin_bit_cast(float, __builtin_amdgcn_ds_bpermute(rr << 2, __builtin_bit_cast(int, rs)));
            if (r32 < 24) gates[(size_t)(row0 + rr) * GATE_LD + r32] = acc[r] * rsr; }
    }
    __syncthreads();
}
__device__ __forceinline__ void fixup_prefix(KP p, int l) {
    const float* halo = (const float*)(p->ws + WS_HALO); bf16_t* act = (bf16_t*)(p->ws + WS_PROJ);
    const float* cw = p->conv_w + (size_t)l * 3 * NUP; const float* cb = p->conv_b + (size_t)l * NUP;
    const int pa = panel_a();
#pragma unroll 2
    for (int i = ltid(); i < 2 * (DFF / 4); i += 512) {
        const int c4 = i % (DFF / 4), pm = pa + 8 * (i / (DFF / 4)), ch = c4 * 4;
        const int tg = (ch >> 7) * 256 + (ch & 127), tu = tg + 128;
        const bool has_prev = (pm & 7) != 0;
        const float* hc = halo + (size_t)(pm * 4) * NUP; const float* hp = halo + (size_t)((has_prev ? pm - 1 : pm) * 4) * NUP;
        const f32x4 c0g = *(const f32x4*)(hc + tg), c0u = *(const f32x4*)(hc + tu), c1g = *(const f32x4*)(hc + NUP + tg), c1u = *(const f32x4*)(hc + NUP + tu);
        f32x4 p3g = *(const f32x4*)(hp + 3 * NUP + tg), p3u = *(const f32x4*)(hp + 3 * NUP + tu), p2g = *(const f32x4*)(hp + 2 * NUP + tg), p2u = *(const f32x4*)(hp + 2 * NUP + tu);
        const f32x4 w0g = *(const f32x4*)(cw + ch), w1g = *(const f32x4*)(cw + NUP + ch), w2g = *(const f32x4*)(cw + 2 * NUP + ch), bg = *(const f32x4*)(cb + ch);
        const f32x4 w0u = *(const f32x4*)(cw + DFF + ch), w1u = *(const f32x4*)(cw + NUP + DFF + ch), w2u = *(const f32x4*)(cw + 2 * NUP + DFF + ch), bu = *(const f32x4*)(cb + DFF + ch);
        if (!has_prev) { p3g = f32x4{0.f, 0.f, 0.f, 0.f}; p3u = p3g; p2g = p3g; p2u = p3g; }
        float o0[4], o1[4];
#pragma unroll
        for (int e = 0; e < 4; ++e) {
            const float yg0 = w0g[e] * p2g[e] + w1g[e] * p3g[e] + w2g[e] * c0g[e] + bg[e], yu0 = w0u[e] * p2u[e] + w1u[e] * p3u[e] + w2u[e] * c0u[e] + bu[e];
            const float yg1 = w0g[e] * p3g[e] + w1g[e] * c0g[e] + w2g[e] * c1g[e] + bg[e], yu1 = w0u[e] * p3u[e] + w1u[e] * c0u[e] + w2u[e] * c1u[e] + bu[e];
            o0[e] = yg0 * fast_rcp(1.f + fast_exp2(-yg0 * LOG2E)) * yu0; o1[e] = yg1 * fast_rcp(1.f + fast_exp2(-yg1 * LOG2E)) * yu1;
        }
        u32x2 s0, s1; s0.x = cvtpk(o0[0], o0[1]); s0.y = cvtpk(o0[2], o0[3]); s1.x = cvtpk(o1[0], o1[1]); s1.y = cvtpk(o1[2], o1[3]);
        *(u32x2*)(act + (size_t)(pm * 256) * DFF + ch) = s0; *(u32x2*)(act + (size_t)(pm * 256 + 1) * DFF + ch) = s1;
    }
    asm volatile("s_waitcnt vmcnt(0)" ::: "memory");
    __syncthreads();
}
__device__ __forceinline__ void final_phase(KP p) {
    const int lane = ltid() & 63, wave = ltid() >> 6; const float* ssqp = (const float*)(p->ws + WS_SSQP);
    for (int row = blockIdx.x * 8 + wave; row < MROWS; row += gridDim.x * 8) {
        float s = (lane < 32) ? ssqp[(size_t)row * 32 + lane] : 0.f; s = wave_sum(s);
        const float rs = __builtin_amdgcn_rsqf(s * (1.f / DM) + RMS_EPS);
        f32x4* o = (f32x4*)(p->out + (size_t)row * DM) + lane; const f32x4* gq = (const f32x4*)p->final_g + lane;
        const u32x2* hq = (const u32x2*)((const bf16_t*)(p->ws + WS_HB) + (size_t)row * DM) + lane;
#pragma unroll
        for (int j = 0; j < 8; ++j) { const u32x2 hv = hq[64 * j]; const f32x4 gg = gq[64 * j]; f32x4 v;
            v.x = __builtin_bit_cast(float, hv.x << 16); v.y = __builtin_bit_cast(float, hv.x & 0xFFFF0000u); v.z = __builtin_bit_cast(float, hv.y << 16); v.w = __builtin_bit_cast(float, hv.y & 0xFFFF0000u);
            __builtin_nontemporal_store(v * rs * gg, o + 64 * j); }
    }
}
__device__ __forceinline__ float gelu_tanh(float x) { const float u = 0.7978845608028654f * (x + 0.044715f * x * x * x); const float e = __expf(2.f * u); const float th = 1.f - 2.f / (e + 1.f); return 0.5f * x * (1.f + th); }
__device__ __forceinline__ void compress_unit(KP p, int l, LAS unsigned char* lds, int upair) {
    const int tid = ltid(), wid = tid >> 6, lane = tid & 63, fr = lane & 15, fq = lane >> 4;
    const int nblk = wid & 3, grp = wid >> 2;
    const int unit = upair * 2 + grp;
    const int mc = unit & 3, kv = (unit >> 2) & 1, g = (unit >> 3) & 1, b = unit >> 4;
    const bf16_t* proj = (const bf16_t*)(p->ws + WS_PROJ);
    const bf16_t* w1t = (const bf16_t*)(p->ws + WS_W1T) + (size_t)(l * 2 + kv) * 128 * 4096;
    const bf16_t* w2t = (const bf16_t*)(p->ws + WS_W2T) + (size_t)(l * 2 + kv) * 128 * 128;
    const float* posc = (const float*)(p->ws + WS_POSC) + (l * 2 + kv) * 128;
    bf16_t* outp = (bf16_t*)(p->ws + (kv ? WS_VCMP : WS_KCMP)) + (size_t)(b * 2 + g) * 128 * 128;
    const bf16_t* arow[2]; const bf16_t* brow[2];
#pragma unroll
    for (int i = 0; i < 2; ++i) { const int n = mc * 32 + i * 16 + fr, nc = n < 127 ? n : 126;
        arow[i] = proj + (size_t)(b * SEQ + 16 * nc) * PROJ_LD + (kv ? C_NVC : C_NKC) + g * 128 + fq * 8;
        brow[i] = w1t + (size_t)(nblk * 32 + i * 16 + fr) * 4096 + fq * 8; }
    f32x4 acc[2][2] = {};
#define CMP_LOAD(A_, B_, LL) do { _Pragma("unroll") for (int i = 0; i < 2; ++i) _Pragma("unroll") for (int j = 0; j < 4; ++j) { \
        A_[i][j] = *(const bf16x8*)(arow[i] + (size_t)(LL) * PROJ_LD + j * 32); B_[i][j] = *(const bf16x8*)(brow[i] + (LL) * 128 + j * 32); } } while (0)
#define CMP_MMA(A_, B_) do { _Pragma("unroll") for (int j = 0; j < 4; ++j) _Pragma("unroll") for (int mi = 0; mi < 2; ++mi) _Pragma("unroll") for (int ni = 0; ni < 2; ++ni) \
        acc[mi][ni] = __builtin_amdgcn_mfma_f32_16x16x32_bf16(A_[mi][j], B_[ni][j], acc[mi][ni], 0, 0, 0); } while (0)
    bf16x8 a0[2][4], b0[2][4], a1[2][4], b1[2][4];
    CMP_LOAD(a0, b0, 0);
#pragma unroll 1
    for (int ll = 0; ll < 32; ll += 2) {
        CMP_LOAD(a1, b1, ll + 1);
        CMP_MMA(a0, b0);
        if (ll + 2 < 32) CMP_LOAD(a0, b0, ll + 2);
        CMP_MMA(a1, b1);
    }
#undef CMP_LOAD
#undef CMP_MMA
    LAS bf16_t* hid = (LAS bf16_t*)(lds + grp * 16384);
#pragma unroll
    for (int ni = 0; ni < 2; ++ni) { const int col = nblk * 32 + ni * 16 + fr; const float pc = posc[col];
#pragma unroll
        for (int mi = 0; mi < 2; ++mi)
#pragma unroll
            for (int i = 0; i < 4; ++i) hid[(mi * 16 + 4 * fq + i) * 136 + col] = (bf16_t)(cvtpk(gelu_tanh(acc[mi][ni][i] + pc), 0.f) & 0xFFFFu); }
    __syncthreads();
    {
        f32x4 acc2[2][2] = {};
#pragma unroll
        for (int j = 0; j < 4; ++j) { bf16x8 a2[2], b2[2];
#pragma unroll
            for (int i = 0; i < 2; ++i) { a2[i] = *(const LAS bf16x8*)(hid + (i * 16 + fr) * 136 + j * 32 + fq * 8); b2[i] = *(const bf16x8*)(w2t + (size_t)(nblk * 32 + i * 16 + fr) * 128 + j * 32 + fq * 8); }
#pragma unroll
            for (int mi = 0; mi < 2; ++mi)
#pragma unroll
                for (int ni = 0; ni < 2; ++ni) acc2[mi][ni] = __builtin_amdgcn_mfma_f32_16x16x32_bf16(a2[mi], b2[ni], acc2[mi][ni], 0, 0, 0); }
#pragma unroll
        for (int mi = 0; mi < 2; ++mi)
#pragma unroll
            for (int ni = 0; ni < 2; ++ni)
#pragma unroll
                for (int i = 0; i < 4; ++i) { const int nr = mc * 32 + mi * 16 + 4 * fq + i; const float v = (nr < 127) ? acc2[mi][ni][i] : 0.f;
                    outp[(size_t)nr * 128 + nblk * 32 + ni * 16 + fr] = (bf16_t)(cvtpk(v, 0.f) & 0xFFFFu); }
    }
    __syncthreads();
}
__device__ __forceinline__ void cumsum_unit(KP p, int l, LAS unsigned char* lds, int unit) {
    const int tid = ltid(), lane = tid & 63, wid = tid >> 6; const int b = unit / 6, h = unit % 6;
    const float* gates = (const float*)(p->ws + WS_GATES); float* c2 = (float*)(p->ws + WS_CUM) + (size_t)unit * SEQ;
    const float fb = p->fox_f_bias[l * 6 + h];
    float v[4], run = 0.f;
#pragma unroll
    for (int i = 0; i < 4; ++i) { const float xx = gates[(size_t)(b * SEQ + 4 * tid + i) * GATE_LD + h] + fb;
        const float ls = fminf(xx, 0.f) - log1pf(__expf(-fabsf(xx))); run += ls; v[i] = run; }
    float inc = run;
#pragma unroll
    for (int o = 1; o < 64; o <<= 1) { const float t = __builtin_bit_cast(float, __builtin_amdgcn_ds_bpermute(((lane - o) & 63) << 2, __builtin_bit_cast(int, inc))); if (lane >= o) inc += t; }
    LAS float* wsum = (LAS float*)lds;
    if (lane == 63) wsum[wid] = inc;
    __syncthreads();
    float base = 0.f;
#pragma unroll
    for (int w = 0; w < 8; ++w) if (w < wid) base += wsum[w];
    const float ex = base + inc - run;
#pragma unroll
    for (int i = 0; i < 4; ++i) c2[4 * tid + i] = (ex + v[i]) * LOG2E;
    __syncthreads();
}

#ifndef ATT_EN
#define ATT_EN 7
#endif
__device__ __forceinline__ void attention_phase(KP p, int lq, LAS unsigned char* lds_u, volatile LAS unsigned* misc) {
#ifdef ATT_DUPK
    const int att_en = (lq >= 4) ? (ATT_DUPK) : (ATT_EN);
#else
    constexpr int att_en = ATT_EN;
#endif
    const int l = lq & 3;
    att::lptr lds = (att::lptr)lds_u;
    const int tid = ltid();
    unsigned* ctl = (unsigned*)(p->ws + WS_CTL);
    const bf16_t* proj = (const bf16_t*)(p->ws + WS_PROJ); bf16_t* mixed = (bf16_t*)(p->ws + WS_MIXED);
    const float* gates = (const float*)(p->ws + WS_GATES);
    float* scr = (float*)(p->ws + WS_SCR) + (size_t)blockIdx.x * 32768;
    const bf16_t* kcmp = (const bf16_t*)(p->ws + WS_KCMP); const bf16_t* vcmp = (const bf16_t*)(p->ws + WS_VCMP);
    { LAS float* lut = (LAS float*)(lds + att::L_LUT);
      for (int i = tid; i < 1280; i += 512) { const int hh = i >> 7, rel = i & 127; lut[i] = (p->rel_bias[(int)T5B[rel] * 10 + hh] - p->rel_bias[31 * 10 + hh]) * LOG2E; } }
    const int lane = tid & 63;
    const float s1 = wave_sum(p->lq1[l * 64 + lane] * p->lk1[l * 64 + lane]), s2 = wave_sum(p->lq2[l * 64 + lane] * p->lk2[l * 64 + lane]);
    const float lam_init = 0.8f - 0.6f * __expf(-0.3f * (float)l);
    const float lam = __expf(s1) - __expf(s2) + lam_init;
    constexpr int QN_CMP = 16, QN_DIFF = 64, QN_NSA = 32, QN_FOX = 96, QN = QN_CMP + QN_DIFF + QN_NSA + QN_FOX;
    if ((tid >> 6) >= 4) __builtin_amdgcn_s_setprio(1); else __builtin_amdgcn_s_setprio(0);
    const int home = (int)(xb_xcc_id() & 7u);
    unsigned cmp_seen = 0u;
    int qx = home;
    __syncthreads();
    for (;;) {
        if (tid == 0) {
            unsigned* qh = ctl + CW_QUEUE + (lq * 8) * 64;
            unsigned iv = __hip_atomic_fetch_add(qh + qx * 64, 1u, __ATOMIC_RELAXED, __HIP_MEMORY_SCOPE_AGENT); int q = qx;
            if (iv >= (unsigned)QN) {
                unsigned hv[7];
#pragma unroll
                for (int k = 1; k < 8; ++k) hv[k - 1] = __hip_atomic_load(qh + ((qx + k) & 7) * 64, __ATOMIC_RELAXED, __HIP_MEMORY_SCOPE_AGENT);
#pragma unroll
                for (int k = 1; k < 8; ++k) if (iv >= (unsigned)QN && hv[k - 1] < (unsigned)QN) {
                    const unsigned t = __hip_atomic_fetch_add(qh + ((qx + k) & 7) * 64, 1u, __ATOMIC_RELAXED, __HIP_MEMORY_SCOPE_AGENT);
                    if (t < (unsigned)QN) { iv = t; q = (qx + k) & 7; } }
            }
            misc[4] = iv; misc[5] = (unsigned)q;
        }
        __syncthreads();
        const int idx = (int)misc[4]; qx = (int)misc[5];
        __syncthreads();
        if (idx >= QN) break;
        unsigned* cdone = ctl + CW_CMPDONE + (lq * 8 + qx) * 64;
        if (idx < QN_CMP) {
            const int gi = qx * 4 + (idx >> 2), pr = idx & 3;
            compress_unit(p, l, lds_u, gi * 4 + pr);
            asm volatile("s_waitcnt vmcnt(0)" ::: "memory");
            __syncthreads();
            if (tid == 0) { __builtin_amdgcn_fence(__ATOMIC_RELEASE, "agent"); asm volatile("s_waitcnt vmcnt(0)" ::: "memory");
                __hip_atomic_fetch_add(cdone, 1u, __ATOMIC_RELAXED, __HIP_MEMORY_SCOPE_AGENT); }
            continue;
        }
        int j = idx - QN_CMP;
        if (j < QN_DIFF) { const int di = qx * 8 + (j & 7), qb = 7 - (j >> 3);
            if (att_en & 2) att::diff_unit(lds, proj, mixed, scr, di >> 2, di & 3, qb, lam, 1.f - lam_init, p->subln_g + l * 128); continue; }
        j -= QN_DIFF;
        if (j < QN_NSA) { const int gi = qx * 4 + (j & 3), qb = 7 - (j >> 2);
            if (!((cmp_seen >> qx) & 1u)) {
                if (tid == 0) { unsigned sp = 0; while (__hip_atomic_load(cdone, __ATOMIC_RELAXED, __HIP_MEMORY_SCOPE_AGENT) < (unsigned)QN_CMP) { __builtin_amdgcn_s_sleep(2); if (++sp > (1u << 22)) break; }
                    __builtin_amdgcn_fence(__ATOMIC_ACQUIRE, "agent"); asm volatile("s_waitcnt vmcnt(0)" ::: "memory"); }
                __syncthreads(); cmp_seen |= 1u << qx; }
            if (att_en & 1) att::nsa_unit(lds, proj, gates, kcmp, vcmp, mixed, scr, gi >> 1, gi & 1, qb); continue; }
        j -= QN_NSA;
        { const int fi = qx * 12 + j % 12, qb = 7 - j / 12;
            if (att_en & 4) att::fox_unit(lds, proj, gates, p->fox_f_bias[l * 6 + fi % 6], mixed, fi / 6, fi % 6, qb); }
    }
    __builtin_amdgcn_s_setprio(0);
    if (l + 1 < DEPTH && lq < 4) {
        const int tid = ltid(); KP p = kparams();
                unsigned* chead = (unsigned*)(p->ws + WS_CTL) + CW_CONV + l * 64;
        LAS float* scrw = (LAS float*)lds_u + (tid >> 6) * (64 * 33);
        constexpr int NCH = (T_LAYER + 63) / 64;
        __syncthreads();
        for (;;) {
            if (tid == 0) misc[4] = __hip_atomic_fetch_add(chead, 1u, __ATOMIC_RELAXED, __HIP_MEMORY_SCOPE_AGENT);
            __syncthreads();
            const int ch = (int)misc[4];
            __syncthreads();
            if (ch >= NCH) break;
#pragma unroll 1
            for (int k = 0; k < 8; ++k) { const int it = ch * 64 + k * 8 + (tid >> 6); if (it < T_LAYER) convert_item(p, l + 1, it, scrw, tid & 63); }
        }
    }
}

#ifndef ATT_EN
#define ATT_EN 7
#endif
#ifndef PH_EN
#define PH_EN 255
#endif
#ifndef DUP
#define DUP 0
#endif
#define DUPLOOP(k) _Pragma("unroll 1") for (int rep_ = 0; rep_ < (((DUP) & (k)) ? 2 : 1); ++rep_)
__global__ void __launch_bounds__(512, 2) mk_fwd(Params p_unused) {
    extern __shared__ __attribute__((aligned(16))) unsigned char lds_raw[];
    LAS unsigned char* lds = (LAS unsigned char*)lds_raw;
    volatile LAS unsigned* misc = (volatile LAS unsigned*)(lds + LX_MISC);
    const int G = gridDim.x;
    if (ltid() < 16) misc[ltid()] = 0u;
    __syncthreads();
    XcdBarrier bar;
    { KP p = kparams(); bar = xcd_barrier_post((unsigned*)(p->ws + WS_CTL) + CW_BAR + p->bar_region * XCD_BAR_WORDS, misc); }
    DUPLOOP(64) { KP p = kparams(); if ((PH_EN & 64) && p->do_prologue) { prologue_phase(p, lds); xcd_barrier(bar); } }

    const int l_begin = kparams()->l_begin, l_end = kparams()->l_end, ph_mask = kparams()->ph_mask;
    for (int l = l_begin; l < l_end; ++l) {
        if ((PH_EN & 1) && (ph_mask & 1)) DUPLOOP(1) {
            KP p = kparams(); unsigned char* ws = p->ws;
            rstd_prefix(p, lds); if (rep_ == 0) gate_prefix(p, l, lds);
            pg8::Gemm g{(const bf16_t*)(ws + WS_HB), (const bf16_t*)(ws + WS_WIN) + (size_t)l * NINP * DM, MROWS, PROJ_LD, DM}; pg8::StaticOrder S; S.init(MROWS, PROJ_LD, G, (int)blockIdx.x);
            epi::InProj E{(bf16_t*)(ws + WS_PROJ), (const LAS float*)(lds + LX_RSTAB)};
            pg8::gemm_phase<epi::InProj, pg8::StaticOrder, true, true>(lds, g, S, E);
            xcd_barrier(bar);
        }
        if ((PH_EN & 4) && (ph_mask & 6)) DUPLOOP(4) {
            attention_phase(kparams(), l + 4 * rep_, lds, misc);
            xcd_barrier(bar);
        }
        if ((PH_EN & 8) && (ph_mask & 8)) DUPLOOP(8) {
            { KP p = kparams(); unsigned char* ws = p->ws;
              pg8::Gemm g{(const bf16_t*)(ws + WS_MIXED), (const bf16_t*)(ws + WS_WOUT) + (size_t)l * DM * DM, MROWS, DM, DM}; pg8::StaticOrder S; S.init(MROWS, DM, G, (int)blockIdx.x);
              epi::Resid E{(bf16_t*)(ws + (rep_ ? WS_END : WS_HB)), (float*)(ws + (rep_ ? WS_END + (size_t)MROWS * DM * 2 : WS_SSQP))};
              pg8::gemm_phase<epi::Resid, pg8::StaticOrder, true, true>(lds, g, S, E); }
            xcd_barrier(bar);
        }
        if ((PH_EN & 16) && (ph_mask & 16)) DUPLOOP(16) {
            { KP p = kparams(); unsigned char* ws = p->ws;
              rstd_prefix(p, lds);
              pg8::Gemm g{(const bf16_t*)(ws + WS_HB), (const bf16_t*)(ws + WS_WUP) + (size_t)l * NUP * DM, MROWS, NUP, DM}; pg8::StaticOrder S; S.init(MROWS, NUP, G, (int)blockIdx.x);
              epi::UpConv E{(bf16_t*)(ws + WS_PROJ), (const LAS float*)(lds + LX_RSTAB), p->conv_w + (size_t)l * 3 * NUP, p->conv_b + (size_t)l * NUP, (float*)(ws + WS_HALO), (LAS float*)(lds + LX_CONV)};
              pg8::gemm_phase<epi::UpConv, pg8::StaticOrder, true, true>(lds, g, S, E); }
            xcd_barrier(bar);
        }
        if ((PH_EN & 32) && (ph_mask & 32)) DUPLOOP(32) {
            { KP p = kparams(); unsigned char* ws = p->ws;
              fixup_prefix(p, l);
              pg8::Gemm g{(const bf16_t*)(ws + WS_PROJ), (const bf16_t*)(ws + WS_WDN) + (size_t)l * DM * DFF, MROWS, DM, DFF}; pg8::StaticOrder S; S.init(MROWS, DM, G, (int)blockIdx.x);
              epi::Resid E{(bf16_t*)(ws + (rep_ ? WS_END : WS_HB)), (float*)(ws + (rep_ ? WS_END + (size_t)MROWS * DM * 2 : WS_SSQP))};
              pg8::gemm_phase<epi::Resid, pg8::StaticOrder, true, true>(lds, g, S, E); }
            xcd_barrier(bar);
        }
    }
    { KP p = kparams(); if ((PH_EN & 128) && p->do_final) final_phase(p); }
}

#if MK_DEBUG
constexpr int NCHK = 16;
#ifndef DBG_SKIP
#define DBG_SKIP 0
#endif
__constant__ int DBG_TS[8] = {0, 1, 255, 256, 700, 1023, 1500, 2047};
__constant__ int DBG_RS[16] = {0, 1, 2, 3, 62, 63, 64, 65, 126, 127, 128, 129, 191, 192, 254, 255};
__constant__ float DBG_TOL[NCHK] = {0, 1e-6f, 1e-3f, 0.03f, 0.03f, 1e-3f, 0.05f, 0.05f, 0.05f, 0.08f, 0.03f, 0.05f, 0.03f, 0, 0, 0};
__device__ __forceinline__ void diag_max(unsigned* diag, int c, float err) { unsigned b = __builtin_bit_cast(unsigned, fabsf(err)); if (err != err) b = 0x7FC00000u; atomicMax(diag + c, b); }
__device__ __forceinline__ void diag_bits(unsigned* diag, int c, unsigned bits) { atomicOr(diag + 16 + c, bits); }
__device__ __forceinline__ unsigned hash_u(unsigned x) { x ^= x >> 16; x *= 0x7feb352du; x ^= x >> 15; x *= 0x846ca68bu; x ^= x >> 16; return x; }
__device__ __forceinline__ float bfr(float v) { return bf2f((bf16_t)(cvtpk(v, 0.f) & 0xFFFFu)); }
__device__ __forceinline__ float blk_sum(float v, float* sh) {
    const int t = threadIdx.x; sh[t] = v; __syncthreads();
    for (int o = 128; o > 0; o >>= 1) { if (t < o) sh[t] += sh[t + o]; __syncthreads(); }
    const float r = sh[0]; __syncthreads(); return r;
}
__device__ __forceinline__ float blk_max(float v, float* sh) {
    const int t = threadIdx.x; sh[t] = v; __syncthreads();
    for (int o = 128; o > 0; o >>= 1) { if (t < o) sh[t] = fmaxf(sh[t], sh[t + o]); __syncthreads(); }
    const float r = sh[0]; __syncthreads(); return r;
}
__device__ __forceinline__ int t5_bucket_ref(int rel) {
    const int n = rel > 0 ? rel : 0; if (n < 16) return n;
    const float nf = (float)n; int large = 16 + (int)(logf(nf / 16.f) / logf(8.f) * 16.f); if (large > 31) large = 31; return large;
}
__device__ __forceinline__ float relerr(float fast, float ref, float scale) { return fabsf(fast - ref) / (fabsf(ref) + scale); }

__global__ void __launch_bounds__(256) chk_kernel(Params p, int stage, const float* out_prev) {
    __shared__ float sh[256];
    __shared__ float sbuf[2304];
    __shared__ float sq[384];
    __shared__ int sidx[16];
    unsigned* diag = (unsigned*)(p.ws + WS_DIAG);
    unsigned char* ws = p.ws;
    const int t = threadIdx.x;
    const bf16_t* hb = (const bf16_t*)(ws + WS_HB); const float* rstd = (const float*)(ws + WS_RSTD);
    const bf16_t* proj = (const bf16_t*)(ws + WS_PROJ); const float* gates = (const float*)(ws + WS_GATES);
    const bf16_t* mixed = (const bf16_t*)(ws + WS_MIXED); const float* c2 = (const float*)(ws + WS_CUM);
    const bf16_t* kcmp = (const bf16_t*)(ws + WS_KCMP); const bf16_t* vcmp = (const bf16_t*)(ws + WS_VCMP);
    const int l = 0;
    if (stage == 2) {
        unsigned bad = 0; const size_t nvec = (size_t)MROWS * PROJ_LD / 8;
        for (size_t i = (size_t)blockIdx.x * 256 + t; i < nvec; i += (size_t)gridDim.x * 256) { const bf16x8 v = ((const bf16x8*)proj)[i];
#pragma unroll
            for (int e = 0; e < 8; ++e) { const float x = bf2f((bf16_t)v[e]); if (!(fabsf(x) < 1000.f)) ++bad; } }
        if (bad) atomicAdd(diag + 13, bad);
    }
    if (stage == 3) {
        unsigned bad = 0;
        for (int i = blockIdx.x * 256 + t; i < NBATCH * 2 * 128 * 128; i += gridDim.x * 256) { const float a = bf2f(kcmp[i]), c = bf2f(vcmp[i]); if (!(fabsf(a) < 1000.f)) ++bad; if (!(fabsf(c) < 1000.f)) bad += 65536u; }
        if (bad & 0xFFFFu) atomicAdd(diag + 14, bad & 0xFFFFu); if (bad >> 16) atomicAdd(diag + 15, bad >> 16);
    }
    for (int smp = blockIdx.x; smp < (stage == 2 ? 512 : 64); smp += gridDim.x) {
        const unsigned h0 = hash_u(smp * 2654435761u + stage * 97u + 12345u), h1 = hash_u(h0 + 1u), h2 = hash_u(h1 + 7u);
        if (stage == 1) {
            const unsigned r0 = hash_u(h0 + t * 31u), r1 = hash_u(r0 + 5u), r2 = hash_u(r1 + 3u);
            { const int ll = r0 & 3, c = r1 % NINP, k = r2 % DM; const int oc = win_colmap(c);
              const float ref = oc >= 0 ? bfr(p.w_in[((size_t)ll * DM + k) * NIN + oc] * p.attn_norm_g[ll * DM + k]) : 0.f;
              diag_max(diag, 1, bf2f(((const bf16_t*)(ws + WS_WIN))[((size_t)ll * NINP + c) * DM + k]) - ref); }
            { const int ll = r0 & 3, c = r1 % DM, k = r2 % DM; const float ref = bfr(p.w_out[((size_t)ll * DM + k) * DM + c]);
              diag_max(diag, 1, bf2f(((const bf16_t*)(ws + WS_WOUT))[((size_t)ll * DM + c) * DM + k]) - ref); }
            { const int ll = r0 & 3, c = r1 % NUP, k = r2 % DM; const int oc = wup_colmap(c); const float ref = bfr(p.w_up[((size_t)ll * DM + k) * NUP + oc] * p.ffn_norm_g[ll * DM + k]);
              diag_max(diag, 1, bf2f(((const bf16_t*)(ws + WS_WUP))[((size_t)ll * NUP + c) * DM + k]) - ref); }
            { const int ll = r0 & 3, c = r1 % DM, k = r2 % DFF; const float ref = bfr(p.w_down[((size_t)ll * DFF + k) * DM + c]);
              diag_max(diag, 1, bf2f(((const bf16_t*)(ws + WS_WDN))[((size_t)ll * DM + c) * DFF + k]) - ref); }
            { const int ll = r0 & 3, kv = (r0 >> 2) & 1, c = r1 % 128, k = r2 % 4096; const float ref = bfr((kv ? p.wv1 : p.wk1)[((size_t)ll * 4096 + k) * 128 + c]);
              diag_max(diag, 1, bf2f(((const bf16_t*)(ws + WS_W1T))[((size_t)(ll * 2 + kv) * 128 + c) * 4096 + k]) - ref); }
            { const int ll = r0 & 3, kv = (r0 >> 2) & 1, c = r1 % 128, k = r2 % 128; const float ref = bfr((kv ? p.wv2 : p.wk2)[((size_t)ll * 128 + k) * 128 + c]);
              diag_max(diag, 1, bf2f(((const bf16_t*)(ws + WS_W2T))[((size_t)(ll * 2 + kv) * 128 + c) * 128 + k]) - ref); }
            { const int row = h0 % MROWS; float ss = 0.f; for (int k = t; k < DM; k += 256) { const float xv = p.x[(size_t)row * DM + k]; ss += xv * xv; diag_max(diag, 2, bf2f(hb[(size_t)row * DM + k]) - bfr(xv)); }
              ss = blk_sum(ss, sh); if (t == 0) diag_max(diag, 2, relerr(rstd[row], 1.f / sqrtf(ss / DM + RMS_EPS), 1e-6f)); }
            { const int ll = h1 & 3, kv = (h1 >> 2) & 1, c = h2 % 128; float s = 0.f; for (int k = t; k < 4096; k += 256) s += p.cmp_pos[(size_t)ll * 4096 + k] * (kv ? p.wv1 : p.wk1)[((size_t)ll * 4096 + k) * 128 + c];
              s = blk_sum(s, sh); if (t == 0) diag_max(diag, 2, relerr(((const float*)(ws + WS_POSC))[(ll * 2 + kv) * 128 + c], s, 1e-3f)); }
        } else if (stage == 2) {
            const int pnn = smp % 25; const int row = h0 % MROWS, c = pnn == 24 ? 6144 + (h1 % 24) : pnn * 256 + (h1 % 256); const int oc = win_colmap(c);
            float ss = 0.f, dot = 0.f;
            for (int k = t; k < DM; k += 256) { const float xv = p.x[(size_t)row * DM + k]; ss += xv * xv; dot += bfr(xv) * bfr(p.w_in[((size_t)l * DM + k) * NIN + oc] * p.attn_norm_g[l * DM + k]); }
            ss = blk_sum(ss, sh); dot = blk_sum(dot, sh);
            if (t == 0) { const float rs = 1.f / sqrtf(ss / DM + RMS_EPS); const int pn = c >> 8;
                float cs = 1.f; if (pn < 3 || (pn >= 15 && pn <= 17)) cs = 0.08838834764831845f * LOG2E; else if (pn == 9 || pn == 10) cs = 0.125f * LOG2E;
                if (c < 6144) { const float fv = bf2f(proj[(size_t)row * PROJ_LD + c]); const float er = relerr(fv, dot * rs * cs, 0.05f); diag_max(diag, 3, er);
                    if (!(er <= 0.03f)) diag_bits(diag, 3, (pn < 9 ? 1u : pn < 15 ? 2u : pn < 18 ? 4u : 8u) | ((row % SEQ) >= 512 ? 16u : 0u) | (fabsf(fv) < 1e-6f ? 32u : 0u)); }
                else diag_max(diag, 4, relerr(gates[(size_t)row * GATE_LD + (c - 6144)], dot * rs, 0.05f)); }
        } else if (stage == 3) {
            if (smp < 24) { if (t == 0) { const int bh = (h0 % 96), b = bh / 6, h = bh % 6; float run = 0.f, worst = 0.f;
                    for (int s = 0; s < SEQ; ++s) { const float xx = gates[(size_t)(b * SEQ + s) * GATE_LD + h] + p.fox_f_bias[l * 6 + h]; run += fminf(xx, 0.f) - log1pf(expf(-fabsf(xx)));
                        worst = fmaxf(worst, relerr(c2[(size_t)bh * SEQ + s], run * LOG2E, 1.f)); float cv = c2[(size_t)bh * SEQ + s]; if (cv != cv) worst = cv; }
                    diag_max(diag, 5, worst); } }
            else { const int b = h0 % NBATCH, g = h1 & 1, kv = (h1 >> 1) & 1, n = (smp & 7) == 7 ? 127 : (smp & 7) == 6 ? 126 : h2 % 127;
                const float* w1 = (kv ? p.wv1 : p.wk1) + (size_t)l * 4096 * 128; const float* w2 = (kv ? p.wv2 : p.wk2) + (size_t)l * 128 * 128;
                if (t < 128) { float s = 0.f; if (n < 127) { for (int ll = 0; ll < 32; ++ll) for (int d = 0; d < 128; ++d)
                        s += bf2f(proj[(size_t)(b * SEQ + 16 * n + ll) * PROJ_LD + (kv ? C_NVC : C_NKC) + g * 128 + d]) * bfr(w1[(size_t)(ll * 128 + d) * 128 + t]);
                        s += ((const float*)(ws + WS_POSC))[(l * 2 + kv) * 128 + t]; const float u = 0.7978845608028654f * (s + 0.044715f * s * s * s); s = 0.5f * s * (1.f + tanhf(u)); }
                    sbuf[t] = bfr(s);
                    if (n < 127) { const int unit = (n >> 5) + 4 * kv + 8 * g + 16 * b; const float hv = ((const float*)(ws + WS_SCR))[(size_t)unit * 4096 + (n & 31) * 128 + t];
                        const float er = relerr(hv, s, 0.05f); if (!(er <= 0.05f)) diag_bits(diag, 6, 1u | (fabsf(hv) > 100.f ? 2u : 0u) | (hv != hv ? 4u : 0u)); } }
                __syncthreads();
                if (t < 128) { float s = 0.f; if (n < 127) for (int j = 0; j < 128; ++j) s += sbuf[j] * bfr(w2[(size_t)j * 128 + t]);
                    const float fv = bf2f((kv ? vcmp : kcmp)[((size_t)(b * 2 + g) * 128 + n) * 128 + t]); const float er = relerr(fv, s, 0.05f);
                    diag_max(diag, 6, er);
                    if (!(er <= 0.05f)) diag_bits(diag, 6, 8u | (kv ? 16u : 0u) | ((n >= 96 && n < 112) ? 32u : 0u)); }
                __syncthreads(); }
        } else if (stage == 4) {
            const int b = h0 % NBATCH, tt = (smp & 1) ? DBG_TS[(smp >> 1) & 7] : (int)(h1 % SEQ);
            const size_t qrow = (size_t)(b * SEQ + tt);
            if (smp < 24) {
                const int h = h2 % 6; const bf16_t* q = proj + qrow * PROJ_LD + C_FQ + h * 128; const float* cc = c2 + (size_t)(b * 6 + h) * SEQ;
                float mx = -1e30f;
                for (int k = t; k <= tt; k += 256) { const bf16_t* kr = proj + (size_t)(b * SEQ + k) * PROJ_LD + C_FK + h * 128; float s = 0.f; for (int d = 0; d < 128; ++d) s += bf2f(q[d]) * bf2f(kr[d]);
                    s += cc[tt] - cc[k]; sbuf[k] = s; mx = fmaxf(mx, s); }
                mx = blk_max(mx, sh); float sum = 0.f;
                for (int k = t; k <= tt; k += 256) { sbuf[k] = exp2f(sbuf[k] - mx); sum += sbuf[k]; }
                sum = blk_sum(sum, sh);
                if (t < 128) { float o = 0.f; for (int k = 0; k <= tt; ++k) o += sbuf[k] * bf2f(proj[(size_t)(b * SEQ + k) * PROJ_LD + C_FV + h * 128 + t]); o /= sum;
                    const float fv = bf2f(mixed[qrow * DM + h * 128 + t]); const float er = relerr(fv, o, 0.05f); diag_max(diag, 7, er);
                    if (!(er <= 0.05f)) diag_bits(diag, 7, (tt < 64 ? 1u : tt < 512 ? 2u : 4u) | ((fabsf(fv) < 1e-6f) ? 8u : 0u) | ((fabsf(fv) > 4.f * fabsf(o) + 0.2f) ? 16u : 0u) | ((fv != fv) ? 32u : 0u)); }
                __syncthreads();
            } else if (smp < 40) {
                const int h = h2 & 3; float* o2 = sq;
                const float lam_init = 0.8f - 0.6f * expf(-0.3f * (float)l);
                float s1 = 0.f, s2 = 0.f; for (int i = 0; i < 64; ++i) { s1 += p.lq1[l * 64 + i] * p.lk1[l * 64 + i]; s2 += p.lq2[l * 64 + i] * p.lk2[l * 64 + i]; }
                const float lam = expf(s1) - expf(s2) + lam_init;
                if (t < 128) o2[t] = 0.f; __syncthreads();
                for (int mp = 0; mp < 2; ++mp) {
                    const bf16_t* q = proj + qrow * PROJ_LD + C_DQ + h * 128 + mp * 64; float mx = -1e30f;
                    for (int k = t; k <= tt; k += 256) { const bf16_t* kr = proj + (size_t)(b * SEQ + k) * PROJ_LD + C_DK + h * 128 + mp * 64; float s = 0.f; for (int d = 0; d < 64; ++d) s += bf2f(q[d]) * bf2f(kr[d]);
                        s += p.rel_bias[t5_bucket_ref(tt - k) * 10 + h] * LOG2E; sbuf[k] = s; mx = fmaxf(mx, s); }
                    mx = blk_max(mx, sh); float sum = 0.f;
                    for (int k = t; k <= tt; k += 256) { sbuf[k] = exp2f(sbuf[k] - mx); sum += sbuf[k]; }
                    sum = blk_sum(sum, sh);
                    if (t < 128) { float o = 0.f; for (int k = 0; k <= tt; ++k) o += sbuf[k] * bf2f(proj[(size_t)(b * SEQ + k) * PROJ_LD + C_DV + h * 128 + t]); o /= sum; o2[t] += (mp == 0 ? o : -lam * o); }
                    __syncthreads();
                }
                float ssq = (t < 128) ? o2[t] * o2[t] : 0.f; ssq = blk_sum(ssq, sh);
                if (t < 128) { const float y = o2[t] * (1.f / sqrtf(ssq / 128.f + RMS_EPS)) * p.subln_g[l * 128 + t] * (1.f - lam_init);
                    const float fv = bf2f(mixed[qrow * DM + 768 + h * 128 + t]); const float er = relerr(fv, y, 0.5f); diag_max(diag, 8, er);
                    if (!(er <= 0.05f)) diag_bits(diag, 8, (tt < 64 ? 1u : tt < 512 ? 2u : 4u) | ((fabsf(fv) < 1e-6f) ? 8u : 0u) | ((fabsf(fv) > 4.f * fabsf(y) + 0.2f) ? 16u : 0u) | ((fv != fv) ? 32u : 0u)); }
                __syncthreads();
            } else {
                const int h6 = h2 % 6, g = h6 / 3; float* pc = sbuf + 2048;
                float* imp = sq + 128; float* oacc = sq + 192;
                if (t < 32) imp[t] = 0.f; if (t < 128) oacc[t] = 0.f; __syncthreads();
                const bf16_t* kc = kcmp + (size_t)(b * 2 + g) * 128 * 128; const bf16_t* vc = vcmp + (size_t)(b * 2 + g) * 128 * 128;
                const float* gp = gates + qrow * GATE_LD + 6 + h6 * 3;
                const float g0 = 1.f / (1.f + expf(-gp[0])), g1 = 1.f / (1.f + expf(-gp[1])), g2 = 1.f / (1.f + expf(-gp[2]));
                for (int hh = 0; hh < 3; ++hh) {
                    const int hd = g * 3 + hh; const bf16_t* q = proj + qrow * PROJ_LD + C_NQ + hd * 128;
                    float s = -1e30f; bool ok = false;
                    if (t < 127) { ok = (16 * t + 31) <= tt; if (ok) { s = 0.f; for (int d = 0; d < 128; ++d) s += bf2f(q[d]) * bf2f(kc[(size_t)t * 128 + d]); s += p.rel_bias[t5_bucket_ref(tt - (16 * t + 31)) * 10 + 4 + hd] * LOG2E; } }
                    const float mx = blk_max(ok ? s : -1e30f, sh); const float e = ok ? exp2f(s - mx) : 0.f; const float sum = blk_sum(e, sh);
                    const float pr = sum > 0.f ? e / sum : 0.f;
                    if (t < 128) pc[t] = pr; __syncthreads();
                    if (t < 32) { float a = 0.f; for (int n = 0; n < 127; ++n) { int lo = max(16 * n, 64 * t), hi2 = min(16 * n + 32, 64 * t + 64); int ov = hi2 - lo; if (ov > 0) a += pc[n] * ((float)ov / 32.f); } imp[t] += a; }
                    if (hd == h6 && t < 128) { float o = 0.f; for (int n = 0; n < 127; ++n) o += pc[n] * bf2f(vc[(size_t)n * 128 + t]); oacc[t] += g0 * o; }
                    __syncthreads();
                }
                if (t == 0) { const int blk = tt >> 6; float* sc = sbuf + 2200; for (int j = 0; j < 32; ++j) { const bool forced = j == 0 || j == blk || j == blk - 1; sc[j] = (j <= blk) ? imp[j] + (forced ? 1e4f : 0.f) : -1e30f; }
                    unsigned m = 0; for (int it = 0; it < 8; ++it) { float best = -1e30f; int bi = -1; for (int j = 0; j < 32; ++j) if (!((m >> j) & 1u) && sc[j] > best) { best = sc[j]; bi = j; } if (bi >= 0 && best > -0.5e30f) m |= 1u << bi; }
                    sidx[0] = (int)m; }
                __syncthreads();
                const unsigned selm = (unsigned)sidx[0];
                for (int br = 0; br < 2; ++br) {
                    const bf16_t* q = proj + qrow * PROJ_LD + C_NQ + h6 * 128; const int kcol = (br == 0 ? C_NKS : C_NKW) + g * 128, vcol = (br == 0 ? C_NVS : C_NVW) + g * 128;
                    float mx = -1e30f;
                    for (int k = t; k <= tt; k += 256) { const bool ok = br == 0 ? ((selm >> (k >> 6)) & 1u) != 0u : (tt - k < 512); float s = -1e30f;
                        if (ok) { const bf16_t* kr = proj + (size_t)(b * SEQ + k) * PROJ_LD + kcol; s = 0.f; for (int d = 0; d < 128; ++d) s += bf2f(q[d]) * bf2f(kr[d]); s += p.rel_bias[t5_bucket_ref(tt - k) * 10 + 4 + h6] * LOG2E; }
                        sbuf[k] = s; mx = fmaxf(mx, s); }
                    mx = blk_max(mx, sh); float sum = 0.f;
                    for (int k = t; k <= tt; k += 256) { sbuf[k] = sbuf[k] > -1e29f ? exp2f(sbuf[k] - mx) : 0.f; sum += sbuf[k]; }
                    sum = blk_sum(sum, sh);
                    if (t < 128) { float o = 0.f; for (int k = 0; k <= tt; ++k) o += sbuf[k] * bf2f(proj[(size_t)(b * SEQ + k) * PROJ_LD + vcol + t]); oacc[t] += (br == 0 ? g1 : g2) * o / sum; }
                    __syncthreads();
                }
                if (t < 128) { const float fv = bf2f(mixed[qrow * DM + 1280 + h6 * 128 + t]); const float er = relerr(fv, oacc[t], 0.05f); diag_max(diag, 9, er);
                    if (!(er <= 0.08f)) diag_bits(diag, 9, (tt < 64 ? 1u : tt < 512 ? 2u : 4u) | ((fabsf(fv) < 1e-6f) ? 8u : 0u) | ((fabsf(fv) > 4.f * fabsf(oacc[t]) + 0.2f) ? 16u : 0u) | ((fv != fv) ? 32u : 0u)); }
                __syncthreads();
            }
        } else if (stage == 5) {
            const int row = h0 % MROWS, col = h1 % DM; float dot = 0.f, ss = 0.f;
            for (int k = t; k < DM; k += 256) { dot += bf2f(mixed[(size_t)row * DM + k]) * bfr(p.w_out[((size_t)l * DM + k) * DM + col]); const float hv = p.out[(size_t)row * DM + k]; ss += hv * hv; }
            dot = blk_sum(dot, sh); ss = blk_sum(ss, sh);
            if (t == 0) { const float ref = p.x[(size_t)row * DM + col] + dot; diag_max(diag, 10, relerr(p.out[(size_t)row * DM + col], ref, 0.05f));
                diag_max(diag, 10, relerr(bf2f(hb[(size_t)row * DM + col]), ref, 0.05f)); diag_max(diag, 10, relerr(rstd[row], 1.f / sqrtf(ss / DM + RMS_EPS), 1e-3f)); }
        } else if (stage == 6) {
            const int pm = h0 % 128, row = pm * 256 + DBG_RS[smp & 15], ch = h1 % DFF, s = row % SEQ;
            float yg = p.conv_b[l * NUP + ch], yu = p.conv_b[l * NUP + DFF + ch];
            for (int tap = 0; tap < 3; ++tap) { const int sp = s - 2 + tap; float dg = 0.f, du = 0.f;
                if (sp >= 0) { const int r2 = row - 2 + tap;
                    for (int k = t; k < DM; k += 256) { const float a = bf2f(hb[(size_t)r2 * DM + k]); const float gk = p.ffn_norm_g[l * DM + k];
                        dg += a * bfr(p.w_up[((size_t)l * DM + k) * NUP + ch] * gk); du += a * bfr(p.w_up[((size_t)l * DM + k) * NUP + DFF + ch] * gk); }
                    dg = blk_sum(dg, sh) * rstd[r2]; du = blk_sum(du, sh) * rstd[r2]; }
                yg += p.conv_w[((size_t)l * 3 + tap) * NUP + ch] * dg; yu += p.conv_w[((size_t)l * 3 + tap) * NUP + DFF + ch] * du; }
            if (t == 0) { const float ref = yg / (1.f + expf(-yg)) * yu; diag_max(diag, 11, relerr(bf2f(proj[(size_t)row * DFF + ch]), ref, 0.05f)); }
        } else if (stage == 7) {
            const int row = h0 % MROWS, col = h1 % DM; float dot = 0.f, ss = 0.f;
            for (int k = t; k < DFF; k += 256) dot += bf2f(proj[(size_t)row * DFF + k]) * bfr(p.w_down[((size_t)l * DFF + k) * DM + col]);
            for (int k = t; k < DM; k += 256) { const float hv = p.out[(size_t)row * DM + k]; ss += hv * hv; }
            dot = blk_sum(dot, sh); ss = blk_sum(ss, sh);
            if (t == 0) { const float ref = out_prev[(size_t)row * DM + col] + dot; diag_max(diag, 12, relerr(p.out[(size_t)row * DM + col], ref, 0.05f));
                diag_max(diag, 12, relerr(bf2f(hb[(size_t)row * DM + col]), ref, 0.05f)); (void)ss; }
        }
    }
}
__global__ void report_kernel(float* out, const unsigned* diag, int n) {
    __shared__ float code, mag;
    if (threadIdx.x == 0) {
        int c = 0; float e = 0.f;
        for (int i = 1; i < 13; ++i) { if ((DBG_SKIP >> i) & 1) continue; const float v = __builtin_bit_cast(float, diag[i]); if (!(v <= DBG_TOL[i])) { c = i; e = v; break; } }
        if (!c || c > 3) { const unsigned n13 = diag[13]; if (n13 && !((DBG_SKIP >> 13) & 1)) { c = 13; e = 0.f; code = 13.f; mag = 100.f * (10.f + fminf(63.f, floorf(log2f((float)n13)) + 1.f)); } }
        if (c != 13 && (!c || c > 6)) { const unsigned n14 = diag[14]; if ((n14 || diag[15]) && !((DBG_SKIP >> 14) & 1)) { c = 14; code = 14.f; const unsigned nk = n14, nv = diag[15]; mag = 100.f * (10.f + (nk ? 32.f : 0.f) + fminf(31.f, (nv ? floorf(log2f((float)nv)) + 1.f : 0.f))); } }
        if (c == 13 || c == 14) { } else {
        code = (float)c; float info = 0.f;
        if (c) { const unsigned bits = diag[16 + c] & 63u; if (bits) info = (float)bits; else if (e != e) info = 89.f; else { info = 64.f + rintf(3.f * (log10f(fmaxf(e, 1e-6f)) + 6.f)); info = fminf(fmaxf(info, 64.f), 88.f); } }
        mag = c ? 100.f * (10.f + info) : 0.f; }
    }
    __syncthreads();
    for (int i = blockIdx.x * blockDim.x + threadIdx.x; i < n; i += gridDim.x * blockDim.x) out[i] = (i == 0) ? mag : code;
}
static void debug_launches(Params p, int grid, hipStream_t stream) {
    float* out_prev = (float*)(p.ws + WS_END);
    (void)hipMemsetAsync(p.ws + WS_DIAG, 0, 256, stream);
    p.l_begin = 0; p.l_end = 1; p.do_final = 0;
    const int masks[7] = {0, 1, 2, 4, 8, 16, 32};
    for (int s = 0; s < 7; ++s) {
        p.do_prologue = (s == 0); p.ph_mask = masks[s]; p.bar_region = s;
        if (s == 6) (void)hipMemcpyAsync(out_prev, p.out, (size_t)MROWS * DM * 4, hipMemcpyDeviceToDevice, stream);
        hipLaunchKernelGGL(mk_fwd, dim3(grid), dim3(512), LDS_BYTES, stream, p);
        hipLaunchKernelGGL(chk_kernel, dim3(64), dim3(256), 0, stream, p, s + 1, (const float*)out_prev);
    }
    hipLaunchKernelGGL(report_kernel, dim3(1024), dim3(256), 0, stream, p.out, (const unsigned*)(p.ws + WS_DIAG), MROWS * DM);
}
#endif

static void fill_params(Params& p, void* const* d_in, void* d_out, void* d_ws) {
    p.x = (const float*)d_in[0]; p.attn_norm_g = (const float*)d_in[1]; p.w_in = (const float*)d_in[2]; p.fox_f_bias = (const float*)d_in[3];
    p.lq1 = (const float*)d_in[4]; p.lk1 = (const float*)d_in[5]; p.lq2 = (const float*)d_in[6]; p.lk2 = (const float*)d_in[7];
    p.subln_g = (const float*)d_in[8]; p.cmp_pos = (const float*)d_in[9]; p.wk1 = (const float*)d_in[10]; p.wk2 = (const float*)d_in[11];
    p.wv1 = (const float*)d_in[12]; p.wv2 = (const float*)d_in[13]; p.w_out = (const float*)d_in[14]; p.ffn_norm_g = (const float*)d_in[15];
    p.w_up = (const float*)d_in[16]; p.conv_w = (const float*)d_in[17]; p.conv_b = (const float*)d_in[18]; p.w_down = (const float*)d_in[19];
    p.rel_bias = (const float*)d_in[20]; p.final_g = (const float*)d_in[21];
    p.out = (float*)d_out; p.ws = (unsigned char*)d_ws;
}
extern "C" void kernel_launch(void* const* d_in, const int* in_sizes, int n_in, void* d_out, int out_size, void* d_ws, size_t ws_size, hipStream_t stream) {
    static int grid = 0;
    if (grid == 0) {
        if (n_in != 22 || out_size != MROWS * DM || ws_size < WS_END) { fprintf(stderr, "kernel_launch: unexpected problem (n_in %d, out %d, ws %zu < %zu)\n", n_in, out_size, ws_size, (size_t)WS_END); grid = -1; return; }
        int dev = 0, cus = 0;
        if (hipGetDevice(&dev) != hipSuccess || hipDeviceGetAttribute(&cus, hipDeviceAttributeMultiprocessorCount, dev) != hipSuccess || cus <= 0) { grid = -1; return; }
        if (hipFuncSetAttribute((const void*)mk_fwd, hipFuncAttributeMaxDynamicSharedMemorySize, LDS_BYTES) != hipSuccess) { fprintf(stderr, "kernel_launch: hipFuncSetAttribute failed\n"); grid = -1; return; }
        int per_cu = 0;
        if (hipOccupancyMaxActiveBlocksPerMultiprocessor(&per_cu, (const void*)mk_fwd, 512, LDS_BYTES) != hipSuccess || per_cu < 1) fprintf(stderr, "kernel_launch: occupancy query says %d\n", per_cu);
        (void)hipGetLastError();
        grid = cus;
    }
    if (grid < 0) return;
    (void)hipMemsetAsync((char*)d_ws + WS_CTL, 0, CTL_ZERO_BYTES, stream);
    Params p{};
    fill_params(p, d_in, d_out, d_ws);
#if !MK_DEBUG
    p.l_begin = 0; p.l_end = DEPTH; p.do_prologue = 1; p.do_final = 1; p.bar_region = 0; p.ph_mask = 63;
    hipLaunchKernelGGL(mk_fwd, dim3(grid), dim3(512), LDS_BYTES, stream, p);
#else
    debug_launches(p, grid, stream);
#endif
}
```

```cpp
#include <hip/hip_runtime.h>
#include <cstdio>
#include <cstdint>

#ifndef MK_DEBUG
#define MK_DEBUG 0
#endif

namespace pg8 {
#define PG8_LAS __attribute__((address_space(3)))
typedef unsigned short bf16_t;
typedef short bf16x8 __attribute__((ext_vector_type(8)));
typedef float f32x4 __attribute__((ext_vector_type(4)));
typedef unsigned u32x4 __attribute__((ext_vector_type(4)));
constexpr int BM = 256, BK = 64, HALF = 128, HTB = HALF * BK * 2  , STAGE_BYTES = 8 * HTB, NXCD = 8, WGM = 8;

__host__ __device__ __forceinline__ int lds_byte(int r, int c) { const int st = (r >> 4) * 2 + (c >> 5), rr = r & 15, cc = c & 31, ob = rr * 64 + cc * 2; return st * 1024 + (ob ^ (((ob >> 9) & 1) << 5)); }
__host__ __device__ __forceinline__ void stage_rc(int b, int& R, int& C) { const int st = b / 1024, sb = b % 1024, swz = sb ^ (((sb >> 9) & 1) << 5); R = (st >> 1) * 16 + swz / 64; C = (st & 1) * 32 + (swz % 64) / 2; }
__host__ __device__ __forceinline__ int perm32(int rho) { const int n = rho >> 4, i = rho & 15; return 8 * (i >> 2) + 4 * n + (i & 3); }

struct Unit { int pm, pn; };
struct Gemm { const bf16_t* A; const bf16_t* Bt; int M, N, K; };

struct StaticOrder {
    int nM, nN, nwg, G, c;
    __host__ __device__ void init(int M, int N, int G_, int c_) { nM = M / BM; nN = N / BM; nwg = nM * nN; G = G_; c = c_; }
    __host__ __device__ bool next(int i, Unit& u) const {
        const long L = (long)i * G + c; if (L >= nwg) return false;
        int wgid = (int)L; { const int q = nwg / NXCD, r = nwg % NXCD, xcd = wgid % NXCD, off = wgid / NXCD; wgid = (xcd < r ? xcd * (q + 1) : r * (q + 1) + (xcd - r) * q) + off; }
        const int nig = WGM * nN, gid = wgid / nig, fm = gid * WGM, gsz = (nM - fm) < WGM ? (nM - fm) : WGM;
        u.pm = fm + ((wgid % nig) % gsz); u.pn = (wgid % nig) / gsz; return true;
    }
    __device__ __forceinline__ void a_ready(const Unit&) const {}
    __device__ __forceinline__ void done(const Unit&) const {}
};
__device__ __forceinline__ unsigned cvt_pk_bf16(float lo, float hi) { unsigned r; asm volatile("v_cvt_pk_bf16_f32 %0, %1, %2" : "=v"(r) : "v"(lo), "v"(hi)); return r; }
typedef float f32x2 __attribute__((ext_vector_type(2)));
template <class Epi, class Sched, bool ALIGN_EPI = false, bool SP2 = false>
__device__ __forceinline__ void gemm_phase(PG8_LAS unsigned char* lds, const Gemm g, const Sched& S, const Epi& E) {
    int tid_l = threadIdx.x; asm volatile("" : "+v"(tid_l));
    const int tid = tid_l, wid = __builtin_amdgcn_readfirstlane(tid >> 6), lane = tid & 63, wr = wid >> 2, wc = wid & 3, fr = lane & 15, fq = lane >> 4;
    const int K = g.K, nt = K / BK;
    unsigned voffA[2], voffB[2]; int aoff, boff;
#define PG8_LANESET() do { int t_ = tid_l; asm volatile("" : "+v"(t_)); const int l_ = t_ & 63, fr_ = l_ & 15, fq_ = l_ >> 4; \
        _Pragma("unroll") for (int i = 0; i < 2; ++i) { int R, C; stage_rc(t_ * 16 + i * 8192, R, C); const int Rb = Epi::PERM ? ((R & ~31) + perm32(R & 31)) : R; \
            const int Ra = Epi::PERMA ? ((R & ~63) + 4 * (R & 15) + ((R >> 4) & 3)) : R; \
            voffA[i] = (unsigned)(Ra * K + C) * 2u; voffB[i] = (unsigned)(Rb * K + C) * 2u; } \
        aoff = lds_byte(wr * 64 + fr_, fq_ * 8); boff = lds_byte(wc * 32 + fr_, fq_ * 8); } while (0)
    PG8_LANESET();
    const size_t kstep = (size_t)(BK * 2);
    const size_t hstep = (size_t)HALF * K * 2;
    const size_t tstep = 2 * hstep;
    const unsigned ldsw = (unsigned)wid * 1024u;
#define PG8_SA(b, h) (((b) * 2 + (h)) * HTB)
#define PG8_SB(b, h) ((4 + (b) * 2 + (h)) * HTB)
#define PG8_STAGE(bufoff, gbase, voff) do { _Pragma("unroll") for (int _i = 0; _i < 2; ++_i) \
        __builtin_amdgcn_global_load_lds((const unsigned*)((const char*)(gbase) + (voff)[_i]), (PG8_LAS unsigned*)(lds + (bufoff) + ldsw + _i * 8192), 16, 0, 0); } while (0)
#define PG8_LDA(dst, b, h) do { _Pragma("unroll") for (int m = 0; m < 4; ++m) _Pragma("unroll") for (int k = 0; k < 2; ++k) dst[m][k] = *(const PG8_LAS bf16x8*)(lds + PG8_SA(b, h) + aoff + m * 2048 + k * 1024); } while (0)
#define PG8_LDB(dst, b, h) do { _Pragma("unroll") for (int n = 0; n < 2; ++n) _Pragma("unroll") for (int k = 0; k < 2; ++k) dst[n][k] = *(const PG8_LAS bf16x8*)(lds + PG8_SB(b, h) + boff + n * 2048 + k * 1024); } while (0)
#define PG8_MMA(ai, bj, At, Bt) do { __builtin_amdgcn_s_setprio(1); _Pragma("unroll") for (int m = 0; m < 4; ++m) _Pragma("unroll") for (int n = 0; n < 2; ++n) _Pragma("unroll") for (int k = 0; k < 2; ++k) \
        acc[ai][bj][m][n] = __builtin_amdgcn_mfma_f32_16x16x32_bf16(Bt[n][k], At[m][k], acc[ai][bj][m][n], 0, 0, 0); __builtin_amdgcn_s_setprio(0); } while (0)
#define PG8_WAIT_V(n) asm volatile("s_waitcnt vmcnt(" #n ")" ::: "memory")
#define PG8_WAIT_L(n) asm volatile("s_waitcnt lgkmcnt(" #n ")" ::: "memory")
#define PG8_BAR __builtin_amdgcn_s_barrier()
#define PG8_SCHED __builtin_amdgcn_sched_barrier(0)
    Unit cur, nxt; int ui = 0;
    if (!S.next(0, cur)) return;
    f32x4 acc[2][2][4][2];
#pragma unroll
    for (int a = 0; a < 2; ++a)
#pragma unroll
        for (int b = 0; b < 2; ++b)
#pragma unroll
            for (int m = 0; m < 4; ++m)
#pragma unroll
                for (int n = 0; n < 2; ++n) acc[a][b][m][n] = (f32x4){0.f, 0.f, 0.f, 0.f};
    bf16x8 At[4][2], B0[2][2], B1[2][2];
    const char* cA = (const char*)g.A + (size_t)cur.pm * tstep; const char* cB = (const char*)g.Bt + (size_t)cur.pn * tstep;
    S.a_ready(cur);
    if constexpr (SP2) {
        PG8_STAGE(PG8_SB(0, 0), cB, voffB); PG8_STAGE(PG8_SB(0, 1), cB + hstep, voffB); PG8_STAGE(PG8_SA(0, 0), cA, voffA); PG8_STAGE(PG8_SA(0, 1), cA + hstep, voffA);
        if (wr == 1) PG8_BAR;
        PG8_WAIT_V(2); PG8_BAR;
        PG8_STAGE(PG8_SB(1, 0), cB + kstep, voffB); PG8_STAGE(PG8_SA(1, 0), cA + kstep, voffA); PG8_STAGE(PG8_SB(1, 1), cB + hstep + kstep, voffB);
        PG8_WAIT_V(6); PG8_BAR;
    } else {
        PG8_STAGE(PG8_SB(0, 0), cB, voffB); PG8_STAGE(PG8_SA(0, 0), cA, voffA); PG8_STAGE(PG8_SB(0, 1), cB + hstep, voffB); PG8_STAGE(PG8_SA(0, 1), cA + hstep, voffA);
        if (wr == 1) PG8_BAR;
        PG8_WAIT_V(4); PG8_BAR;
        PG8_STAGE(PG8_SB(1, 0), cB + kstep, voffB); PG8_STAGE(PG8_SA(1, 0), cA + kstep, voffA); PG8_STAGE(PG8_SB(1, 1), cB + hstep + kstep, voffB);
        PG8_WAIT_V(6); PG8_BAR;
    }
    for (;;) {
        PG8_LANESET();
        const bool has_next = S.next(ui + 1, nxt);
        const char* nA = has_next ? (const char*)g.A + (size_t)nxt.pm * tstep : cA; const char* nB = has_next ? (const char*)g.Bt + (size_t)nxt.pn * tstep : cB;
        for (int t = 0; t < nt; t += 2) {
            const bool last = (t == nt - 2);
            const char* a1 = cA + (size_t)(t + 1) * kstep;
            const char* a2 = last ? nA : cA + (size_t)(t + 2) * kstep; const char* b2 = last ? nB : cB + (size_t)(t + 2) * kstep;
            const char* a3 = a2 + kstep; const char* b3 = b2 + kstep;
            if (last && has_next) S.a_ready(nxt);
            if constexpr (SP2) {
            PG8_LDB(B0, 0, 0); PG8_LDB(B1, 0, 1); PG8_SCHED; PG8_LDA(At, 0, 0); PG8_STAGE(PG8_SA(1, 1), a1 + hstep, voffA);
            PG8_WAIT_V(8); PG8_WAIT_L(0); PG8_BAR; PG8_MMA(0, 0, At, B0); PG8_MMA(0, 1, At, B1); PG8_BAR; PG8_SCHED;
            PG8_LDA(At, 0, 1); PG8_STAGE(PG8_SB(0, 0), b2, voffB); PG8_STAGE(PG8_SB(0, 1), b2 + hstep, voffB); PG8_STAGE(PG8_SA(0, 0), a2, voffA);
            PG8_WAIT_V(8); PG8_WAIT_L(0); PG8_BAR; PG8_MMA(1, 0, At, B0); PG8_MMA(1, 1, At, B1); PG8_BAR; PG8_SCHED;
            PG8_LDB(B0, 1, 0); PG8_LDB(B1, 1, 1); PG8_SCHED; PG8_LDA(At, 1, 0); PG8_STAGE(PG8_SA(0, 1), a2 + hstep, voffA);
            PG8_WAIT_V(8); PG8_WAIT_L(0); PG8_BAR; PG8_MMA(0, 0, At, B0); PG8_MMA(0, 1, At, B1); PG8_BAR; PG8_SCHED;
            PG8_LDA(At, 1, 1); PG8_STAGE(PG8_SB(1, 0), b3, voffB); PG8_STAGE(PG8_SB(1, 1), b3 + hstep, voffB); PG8_STAGE(PG8_SA(1, 0), a3, voffA);
            PG8_WAIT_V(8); PG8_WAIT_L(0); PG8_BAR; PG8_MMA(1, 0, At, B0); PG8_MMA(1, 1, At, B1); PG8_BAR; PG8_SCHED;
            } else {
            PG8_LDB(B0, 0, 0); PG8_SCHED; PG8_LDA(At, 0, 0); PG8_STAGE(PG8_SA(1, 1), a1 + hstep, voffA);
            PG8_WAIT_L(8); PG8_BAR; PG8_WAIT_L(0); PG8_MMA(0, 0, At, B0); PG8_BAR; PG8_SCHED;
            PG8_LDB(B1, 0, 1); PG8_STAGE(PG8_SB(0, 0), b2, voffB);
            PG8_BAR; PG8_WAIT_L(0); PG8_MMA(0, 1, At, B1); PG8_BAR;
            PG8_LDA(At, 0, 1); PG8_STAGE(PG8_SA(0, 0), a2, voffA);
            PG8_BAR; PG8_WAIT_L(0); PG8_MMA(1, 0, At, B0); PG8_BAR; PG8_SCHED;
            PG8_STAGE(PG8_SB(0, 1), b2 + hstep, voffB);
            PG8_WAIT_V(6); PG8_BAR; PG8_MMA(1, 1, At, B1); PG8_BAR;
            PG8_LDB(B0, 1, 0); PG8_SCHED; PG8_LDA(At, 1, 0); PG8_STAGE(PG8_SA(0, 1), a2 + hstep, voffA);
            PG8_WAIT_L(8); PG8_BAR; PG8_WAIT_L(0); PG8_MMA(0, 0, At, B0); PG8_BAR; PG8_SCHED;
            PG8_LDB(B1, 1, 1); PG8_STAGE(PG8_SB(1, 0), b3, voffB);
            PG8_BAR; PG8_WAIT_L(0); PG8_MMA(0, 1, At, B1); PG8_BAR;
            PG8_LDA(At, 1, 1); PG8_STAGE(PG8_SA(1, 0), a3, voffA);
            PG8_BAR; PG8_WAIT_L(0); PG8_MMA(1, 0, At, B0); PG8_BAR; PG8_SCHED;
            PG8_STAGE(PG8_SB(1, 1), b3 + hstep, voffB);
            PG8_WAIT_V(6); PG8_BAR; PG8_MMA(1, 1, At, B1); PG8_BAR;
            }
        }
        if constexpr (ALIGN_EPI) { if (wr == 0) PG8_BAR; }
        if constexpr (!Epi::AFTER_DRAIN) { E(acc, cur, wr, wc, fr, fq); S.done(cur); }
        if (!has_next) break;
#pragma unroll
        for (int a = 0; a < 2; ++a)
#pragma unroll
            for (int b = 0; b < 2; ++b)
#pragma unroll
                for (int m = 0; m < 4; ++m)
#pragma unroll
                    for (int n = 0; n < 2; ++n) acc[a][b][m][n] = (f32x4){0.f, 0.f, 0.f, 0.f};
        cur = nxt; cA = nA; cB = nB; ++ui;
        if constexpr (ALIGN_EPI) { if (wr == 1) PG8_BAR; }
    }
    PG8_WAIT_V(0);
    if constexpr (!ALIGN_EPI) { if (wr == 0) PG8_BAR; }
    PG8_BAR;
    if constexpr (Epi::AFTER_DRAIN) { E.fused(acc, cur, wr, wc, fr, fq, lds, wid, lane); S.done(cur); }
#undef PG8_LANESET
#undef PG8_SA
#undef PG8_SB
#undef PG8_STAGE
#undef PG8_LDA
#undef PG8_LDB
#undef PG8_MMA
#undef PG8_WAIT_V
#undef PG8_WAIT_L
#undef PG8_BAR
#undef PG8_SCHED
}
}
#define GAS __attribute__((address_space(1)))
#define LAS __attribute__((address_space(3)))

constexpr int DM = 2048, NBATCH = 16, SEQ = 2048, DEPTH = 4, MROWS = NBATCH * SEQ;
constexpr int NIN = 6168, NINP = 6176, PROJ_LD = 6144;
constexpr int DFF = 5632, NUP = 2 * DFF;
constexpr float RMS_EPS = 1e-6f;
constexpr float LOG2E = 1.4426950408889634f;
constexpr int C_FQ = 0, C_FK = 768, C_FV = 1536, C_DQ = 2304, C_DK = 2816, C_DV = 3328, C_NQ = 3840, C_NKC = 4608, C_NVC = 4864, C_NKS = 5120, C_NVS = 5376, C_NKW = 5632, C_NVW = 5888;
constexpr int GATE_LD = 32;
__device__ __forceinline__ int win_colmap(int c) {
    if (c < 2304) return c; if (c < 6144) return c + 6; if (c < 6150) return 2304 + (c - 6144); if (c < 6168) return c; return -1;
}
__device__ __forceinline__ int wup_colmap(int c) { const int pn = c >> 8, w = c & 255; return (w < 128) ? (pn * 128 + w) : (DFF + pn * 128 + (w - 128)); }

__constant__ unsigned char T5B[128] = {0, 1, 2, 3, 4, 5, 6, 7, 8, 9, 10, 11, 12, 13, 14, 15, 16, 16, 16, 17, 17, 18, 18, 18, 19, 19, 19, 20, 20, 20, 20, 21, 21, 21, 21, 22, 22, 22, 22, 22, 23, 23, 23, 23, 23, 23, 24, 24, 24, 24, 24, 24, 25, 25, 25, 25, 25, 25, 25, 26, 26, 26, 26, 26, 26, 26, 26, 27, 27, 27, 27, 27, 27, 27, 27, 27, 27, 28, 28, 28, 28, 28, 28, 28, 28, 28, 28, 29, 29, 29, 29, 29, 29, 29, 29, 29, 29, 29, 29, 30, 30, 30, 30, 30, 30, 30, 30, 30, 30, 30, 30, 30, 30, 31, 31, 31, 31, 31, 31, 31, 31, 31, 31, 31, 31, 31, 31, 31};

constexpr size_t al256(size_t x) { return (x + 255) & ~(size_t)255; }
constexpr size_t WS_CTL = 0, CTL_ZERO_BYTES = 1u << 20;
constexpr size_t WS_WIN = CTL_ZERO_BYTES;
constexpr size_t WS_WOUT = WS_WIN + (size_t)DEPTH * NINP * DM * 2;
constexpr size_t WS_WUP = WS_WOUT + (size_t)DEPTH * DM * DM * 2;
constexpr size_t WS_WDN = WS_WUP + (size_t)DEPTH * NUP * DM * 2;
constexpr size_t WS_W1T = WS_WDN + (size_t)DEPTH * DM * DFF * 2;
constexpr size_t WS_W2T = WS_W1T + (size_t)DEPTH * 2 * 128 * 4096 * 2;
constexpr size_t WS_POSC = WS_W2T + (size_t)DEPTH * 2 * 128 * 128 * 2;
constexpr size_t WS_HB = al256(WS_POSC + (size_t)DEPTH * 2 * 128 * 4);
constexpr size_t WS_MIXED = WS_HB + (size_t)MROWS * DM * 2;
constexpr size_t WS_PROJ = WS_MIXED + (size_t)MROWS * DM * 2;
constexpr size_t WS_GATES = WS_PROJ + (size_t)MROWS * PROJ_LD * 2;
constexpr size_t WS_SSQP = WS_GATES + (size_t)MROWS * GATE_LD * 4;
constexpr size_t WS_RSTD = WS_SSQP + (size_t)MROWS * 32 * 4;
constexpr size_t WS_HALO = WS_RSTD + (size_t)MROWS * 4;
constexpr size_t WS_KCMP = WS_HALO + (size_t)128 * 4 * NUP * 4;
constexpr size_t WS_VCMP = WS_KCMP + (size_t)NBATCH * 2 * 128 * 128 * 2;
constexpr size_t WS_CUM = WS_VCMP + (size_t)NBATCH * 2 * 128 * 128 * 2;
constexpr size_t WS_SCR = WS_CUM + (size_t)NBATCH * 6 * SEQ * 4;
constexpr size_t WS_DIAG = WS_SCR + (size_t)256 * 131072;
constexpr size_t WS_END = WS_DIAG + 65536;
static_assert(WS_END + (size_t)MROWS * DM * 4 <= (size_t)4 * DEPTH * DM * NUP * 4, "workspace map (+ the debug build's copy of h) must fit 4x the largest tensor");
constexpr int CW_BAR = 4096;
constexpr int CW_QUEUE = 65536;
constexpr int CW_CONV = 131072;
constexpr int CW_CMPDONE = 98304;

constexpr int RING_BYTES = 131072;
constexpr int LX_CONV = RING_BYTES;
constexpr int LX_MISC = RING_BYTES + 8192;
constexpr int LX_CW = LX_MISC + 256 + 2048;
constexpr int LX_RSTAB = LX_MISC + 256;
static_assert(LX_MISC + 256 + 2048 + 4096 <= 147456, "LDS map");
constexpr int LDS_BYTES = 147456;

typedef unsigned short bf16_t;
typedef short bf16x8 __attribute__((ext_vector_type(8)));
typedef short s16x4 __attribute__((ext_vector_type(4)));
typedef float f32x4 __attribute__((ext_vector_type(4)));
typedef float f32x2 __attribute__((ext_vector_type(2)));
typedef float f32x16 __attribute__((ext_vector_type(16)));
typedef unsigned u32x4 __attribute__((ext_vector_type(4)));
typedef unsigned u32x2 __attribute__((ext_vector_type(2)));

__device__ __forceinline__ int ltid() { int t = threadIdx.x; asm volatile("" : "+v"(t)); return t; }
typedef __bf16 bf16x2_t __attribute__((ext_vector_type(2)));
__device__ __forceinline__ unsigned cvtpk(float lo, float hi) { const f32x2 v = {lo, hi}; const bf16x2_t b = __builtin_convertvector(v, bf16x2_t); return __builtin_bit_cast(unsigned, b); }
__device__ __forceinline__ float bf2f(bf16_t v) { return __builtin_bit_cast(float, (unsigned)v << 16); }
__device__ __forceinline__ float fast_exp2(float x) { return __builtin_amdgcn_exp2f(x); }
__device__ __forceinline__ float fast_rcp(float x) { return __builtin_amdgcn_rcpf(x); }
__device__ __forceinline__ float shx(float v, int o) { return __builtin_bit_cast(float, __builtin_amdgcn_ds_bpermute(((ltid() & 63) ^ o) << 2, __builtin_bit_cast(int, v))); }
__device__ __forceinline__ float wave_sum(float v) {
    const int a = (ltid() & 63) << 2;
#pragma unroll
    for (int o = 1; o < 64; o <<= 1) v += __builtin_bit_cast(float, __builtin_amdgcn_ds_bpermute(a ^ (o << 2), __builtin_bit_cast(int, v)));
    return v;
}
template <int CTRL> __device__ __forceinline__ float dppf(float v) { return __builtin_bit_cast(float, __builtin_amdgcn_mov_dpp(__builtin_bit_cast(int, v), CTRL, 0xF, 0xF, false)); }
template <int CTRL> __device__ __forceinline__ float dppfo(float o, float v) { return __builtin_bit_cast(float, __builtin_amdgcn_update_dpp(__builtin_bit_cast(int, o), __builtin_bit_cast(int, v), CTRL, 0xF, 0xF, false)); }
template <int CTRL> __device__ __forceinline__ f32x4 dpp4o(f32x4 o, f32x4 v) { f32x4 r; r.x = dppfo<CTRL>(o.x, v.x); r.y = dppfo<CTRL>(o.y, v.y); r.z = dppfo<CTRL>(o.z, v.z); r.w = dppfo<CTRL>(o.w, v.w); return r; }
template <int CTRL> __device__ __forceinline__ f32x4 dpp4(f32x4 v) { f32x4 r; r.x = dppf<CTRL>(v.x); r.y = dppf<CTRL>(v.y); r.z = dppf<CTRL>(v.z); r.w = dppf<CTRL>(v.w); return r; }

namespace epi {
using pg8::Unit;

struct InProj {
    static constexpr bool PERM = true, PERMA = true, AFTER_DRAIN = false;
    bf16_t* proj; const __attribute__((address_space(3))) float* rstab;
    __device__ __forceinline__ void operator()(const f32x4 (&acc)[2][2][4][2], const Unit& u, int wr, int wc, int fr, int fq) const {
        { const int ln = ltid() & 63; fr = ln & 15; fq = ln >> 4; }
        const int row0 = u.pm * 256 + wr * 64 + 4 * fr;
        float cs = 1.f;
        if (u.pn < 3) cs = 0.08838834764831845f * LOG2E;
        else if (u.pn == 9 || u.pn == 10) cs = 0.125f * LOG2E;
        else if (u.pn >= 15 && u.pn <= 17) cs = 0.08838834764831845f * LOG2E;
        {
#pragma unroll
            for (int ai = 0; ai < 2; ++ai)
#pragma unroll
                for (int m = 0; m < 4; ++m) {
                    const int row = row0 + ai * 128 + m; const float s = rstab[((u.pm >> 3) & 1) * 256 + (row & 255)] * cs;
                    bf16_t* rp = proj + (size_t)row * PROJ_LD + u.pn * 256 + wc * 32 + 8 * fq;
#pragma unroll
                    for (int bj = 0; bj < 2; ++bj) { const f32x4 v0 = acc[ai][bj][m][0] * s, v1 = acc[ai][bj][m][1] * s;
                        u32x4 w; w.x = cvtpk(v0[0], v0[1]); w.y = cvtpk(v0[2], v0[3]); w.z = cvtpk(v1[0], v1[1]); w.w = cvtpk(v1[2], v1[3]);
                        *(u32x4*)(rp + bj * 128) = w; }
                }
        }
    }
};

struct Resid {
    static constexpr bool PERM = true, PERMA = true, AFTER_DRAIN = false;
    bf16_t* hb; float* ssqp;
    __device__ __forceinline__ void operator()(const f32x4 (&acc)[2][2][4][2], const Unit& u, int wr, int wc, int fr, int fq) const {
        { const int ln = ltid() & 63; fr = ln & 15; fq = ln >> 4; }
        const int row0 = u.pm * 256 + wr * 64 + 4 * fr, col0 = u.pn * 256 + wc * 32 + 8 * fq;
        u32x4 hv[2][4][2];
#pragma unroll
        for (int ai = 0; ai < 2; ++ai)
#pragma unroll
            for (int m = 0; m < 4; ++m)
#pragma unroll
                for (int bj = 0; bj < 2; ++bj) hv[ai][m][bj] = *(const u32x4*)(hb + (size_t)(row0 + ai * 128 + m) * DM + col0 + bj * 128);
#pragma unroll
        for (int ai = 0; ai < 2; ++ai)
#pragma unroll
            for (int m = 0; m < 4; ++m) {
                const int row = row0 + ai * 128 + m; float ss = 0.f;
#pragma unroll
                for (int bj = 0; bj < 2; ++bj) {
                    const size_t off = (size_t)row * DM + col0 + bj * 128;
                    const u32x4 h = hv[ai][m][bj];
                    f32x4 v0, v1;
                    v0[0] = __builtin_bit_cast(float, h.x << 16) + acc[ai][bj][m][0][0]; v0[1] = __builtin_bit_cast(float, h.x & 0xFFFF0000u) + acc[ai][bj][m][0][1];
                    v0[2] = __builtin_bit_cast(float, h.y << 16) + acc[ai][bj][m][0][2]; v0[3] = __builtin_bit_cast(float, h.y & 0xFFFF0000u) + acc[ai][bj][m][0][3];
                    v1[0] = __builtin_bit_cast(float, h.z << 16) + acc[ai][bj][m][1][0]; v1[1] = __builtin_bit_cast(float, h.z & 0xFFFF0000u) + acc[ai][bj][m][1][1];
                    v1[2] = __builtin_bit_cast(float, h.w << 16) + acc[ai][bj][m][1][2]; v1[3] = __builtin_bit_cast(float, h.w & 0xFFFF0000u) + acc[ai][bj][m][1][3];
                    u32x4 w; w.x = cvtpk(v0[0], v0[1]); w.y = cvtpk(v0[2], v0[3]); w.z = cvtpk(v1[0], v1[1]); w.w = cvtpk(v1[2], v1[3]);
                    *(u32x4*)(hb + off) = w;
                    ss += (v0[0] * v0[0] + v0[1] * v0[1]) + (v0[2] * v0[2] + v0[3] * v0[3]) + (v1[0] * v1[0] + v1[1] * v1[1]) + (v1[2] * v1[2] + v1[3] * v1[3]);
                }
                ss += shx(ss, 16); ss += shx(ss, 32);
                if (fq == 0) ssqp[(size_t)row * 32 + u.pn * 4 + wc] = ss;
            }
    }
};

struct UpConv {
    static constexpr bool PERM = true, PERMA = true, AFTER_DRAIN = false;
    bf16_t* act; const __attribute__((address_space(3))) float* rstab; const float* cw; const float* cb; float* halo; __attribute__((address_space(3))) float* ex;
    __device__ __forceinline__ void operator()(const f32x4 (&acc)[2][2][4][2], const Unit& u, int wr, int wc, int fr, int fq) const {
        { const int ln = ltid() & 63; fr = ln & 15; fq = ln >> 4; }
        const int tcol = wc * 32 + 8 * fq, ch0 = u.pn * 128 + tcol;
        const int row0 = u.pm * 256 + wr * 64 + 4 * fr;
        float rs[2][4];
#pragma unroll
        for (int ai = 0; ai < 2; ++ai)
#pragma unroll
            for (int m = 0; m < 4; ++m) rs[ai][m] = rstab[((u.pm >> 3) & 1) * 256 + ((row0 + ai * 128 + m) & 255)];
        __attribute__((address_space(3))) float* cwl = ex + (LX_CW - LX_CONV) / 4;
        { const int t = ltid();
#pragma unroll
          for (int k = 0; k < 2; ++k) { const int i = t + 512 * k, q = i >> 7, cc = i & 127, tap = q >> 1, bjj = q & 1;
              cwl[i] = (tap < 3 ? cw + tap * NUP : cb)[bjj * DFF + u.pn * 128 + cc]; } }
        if (fr == 15) {
#pragma unroll
            for (int ai = 0; ai < 2; ++ai)
#pragma unroll
                for (int bj = 0; bj < 2; ++bj)
#pragma unroll
                    for (int n = 0; n < 2; ++n)
#pragma unroll
                        for (int q = 0; q < 2; ++q) {
                            const f32x4 v = acc[ai][bj][2 + q][n] * rs[ai][2 + q];
                            *(__attribute__((address_space(3))) f32x4*)(ex + ((ai * 2 + wr) * 2 + q) * 256 + bj * 128 + tcol + 4 * n) = v;
                            if (ai == 1 && wr == 1) *(f32x4*)(halo + ((size_t)(u.pm * 4 + 2 + q) * NUP) + u.pn * 256 + bj * 128 + tcol + 4 * n) = v;
                        }
        }
        if (fr == 0 && wr == 0) {
#pragma unroll
            for (int bj = 0; bj < 2; ++bj)
#pragma unroll
                for (int n = 0; n < 2; ++n)
#pragma unroll
                    for (int q = 0; q < 2; ++q)
                        *(f32x4*)(halo + ((size_t)(u.pm * 4 + q) * NUP) + u.pn * 256 + bj * 128 + tcol + 4 * n) = acc[0][bj][q][n] * rs[0][q];
        }
        asm volatile("s_waitcnt lgkmcnt(0)" ::: "memory");
        __builtin_amdgcn_s_barrier();
#pragma unroll
        for (int ai = 0; ai < 2; ++ai) {
            const bool top = (ai == 0 && wr == 0);
            const int pb = (wr ? ai * 2 : (ai * 2 - 1));
#pragma unroll
            for (int n = 0; n < 2; ++n) {
                f32x4 yg[4];
#pragma unroll
                for (int bj = 0; bj < 2; ++bj) {
                    asm volatile("" ::: "memory"); __builtin_amdgcn_sched_barrier(0);
                    const __attribute__((address_space(3))) float* wl = cwl + bj * 128 + tcol + 4 * n;
                    const f32x4 w0 = *(const __attribute__((address_space(3))) f32x4*)wl, w1 = *(const __attribute__((address_space(3))) f32x4*)(wl + 256), w2 = *(const __attribute__((address_space(3))) f32x4*)(wl + 512), bb = *(const __attribute__((address_space(3))) f32x4*)(wl + 768);
                    f32x4 e62 = {0.f, 0.f, 0.f, 0.f}, e63 = {0.f, 0.f, 0.f, 0.f};
                    if (!top) {
                        e62 = *(const __attribute__((address_space(3))) f32x4*)(ex + (pb * 2 + 0) * 256 + bj * 128 + tcol + 4 * n);
                        e63 = *(const __attribute__((address_space(3))) f32x4*)(ex + (pb * 2 + 1) * 256 + bj * 128 + tcol + 4 * n);
                    }
                    f32x4 v[4];
#pragma unroll
                    for (int m = 0; m < 4; ++m) v[m] = acc[ai][bj][m][n] * rs[ai][m];
                    const f32x4 s3 = dpp4o<0x111>(e63, v[3]), s2 = dpp4o<0x111>(e62, v[2]);
                    f32x4 y[4];
                    y[0] = ((bb + w2 * v[0]) + w1 * s3) + w0 * s2;
                    y[1] = ((bb + w2 * v[1]) + w1 * v[0]) + w0 * s3;
                    y[2] = ((bb + w2 * v[2]) + w1 * v[1]) + w0 * v[0];
                    y[3] = ((bb + w2 * v[3]) + w1 * v[2]) + w0 * v[1];
#pragma unroll
                    for (int m = 0; m < 4; ++m) {
                        if (bj == 0) yg[m] = y[m];
                        else {
                            f32x4 o;
#pragma unroll
                            for (int i = 0; i < 4; ++i) o[i] = yg[m][i] * fast_rcp(1.f + fast_exp2(-yg[m][i] * LOG2E)) * y[m][i];
                            if (!(top && fr == 0 && m < 2)) {
                                u32x2 w; w.x = cvtpk(o[0], o[1]); w.y = cvtpk(o[2], o[3]);
                                *(u32x2*)(act + (size_t)(row0 + ai * 128 + m) * DFF + ch0 + 4 * n) = w;
                            }
                        }
                    }
                }
            }
        }
    }
};
}
#define XB_TMO      128
#define XB_XCNT(j)  (256  + 64 * (j))
#define XB_XSUB(j)  (1280 + 64 * (j))
#define XB_XGEN(j)  (2304 + 64 * (j))
#define XB_TOP      3328
#define XB_TOPGEN   3392
#define XCD_BAR_WORDS 3456
#define XB_SPIN_CAP (1u << 18)

__device__ __forceinline__ unsigned xb_ld(unsigned* p)              { return __hip_atomic_load(p, __ATOMIC_RELAXED, __HIP_MEMORY_SCOPE_AGENT); }
__device__ __forceinline__ unsigned xb_add(unsigned* p, unsigned v) { return __hip_atomic_fetch_add(p, v, __ATOMIC_RELAXED, __HIP_MEMORY_SCOPE_AGENT); }
__device__ __forceinline__ unsigned xb_xcc_id() { return (unsigned)__builtin_amdgcn_s_getreg((3 << 11) | 20) & 0xFu; }
#define XB_SPIN(cond, bar) do { unsigned _sp = 0; while (cond) { __builtin_amdgcn_s_sleep(1); \
    if ((++_sp & 255u) == 0u) { if (xb_ld(&(bar)[XB_TMO])) break; if (_sp > XB_SPIN_CAP) { atomicAdd(&(bar)[XB_TMO], 1u); break; } } } } while (0)

struct XcdBarrier {
    unsigned* bar; unsigned x;
    volatile LAS unsigned* st;
};

__device__ __forceinline__ XcdBarrier xcd_barrier_post(unsigned* bar, volatile LAS unsigned* st) {
    XcdBarrier b; b.bar = bar; b.x = xb_xcc_id(); b.st = st;
    if (threadIdx.x == 0) (void)xb_add(&bar[XB_XCNT(b.x)], 1u);
    return b;
}
__device__ __forceinline__ void xcd_barrier_complete(unsigned* bar, unsigned x, unsigned& nloc, unsigned& nx) {
    const unsigned G = gridDim.x * gridDim.y * gridDim.z;
    unsigned sum, cnt, mine, sp = 0u;
    for (;;) {
        sum = 0u; cnt = 0u; mine = 0u;
#pragma unroll
        for (unsigned j = 0; j < 16; ++j) { const unsigned c = xb_ld(&bar[XB_XCNT(j)]); sum += c; cnt += (c > 0u) ? 1u : 0u; mine = (j == x) ? c : mine; }
        if (sum == G) break;
        __builtin_amdgcn_s_sleep(1);
        if ((++sp & 255u) == 0u) { if (xb_ld(&bar[XB_TMO])) break; if (sp > XB_SPIN_CAP) { atomicAdd(&bar[XB_TMO], 1u); break; } }
    }
    nloc = mine > 0u ? mine : 1u; nx = cnt > 0u ? cnt : 1u;
}

__device__ __forceinline__ void xcd_barrier(const XcdBarrier& b) {
    asm volatile("s_waitcnt vmcnt(0)" ::: "memory");
    __syncthreads();
    if (threadIdx.x == 0) {
        unsigned* bar = b.bar; asm volatile("" : "+s"(bar));
        __builtin_amdgcn_s_waitcnt(0);
        unsigned nloc = b.st[0], nx = b.st[1];
        if (nloc == 0u) { xcd_barrier_complete(bar, b.x, nloc, nx); b.st[0] = nloc; b.st[1] = nx; }
        const unsigned old = xb_add(&bar[XB_XSUB(b.x)], 1u);
        const unsigned gen = old / nloc;
        if (old + 1u == (gen + 1u) * nloc) {
            __builtin_amdgcn_fence(__ATOMIC_RELEASE, "agent");
            asm volatile("s_waitcnt vmcnt(0)" ::: "memory");
            const unsigned og = xb_add(&bar[XB_TOP], 1u);
            const unsigned tg = og / nx;
            if (og + 1u == (tg + 1u) * nx) xb_add(&bar[XB_TOPGEN], 1u);
            else XB_SPIN(xb_ld(&bar[XB_TOPGEN]) == tg, bar);
            __builtin_amdgcn_fence(__ATOMIC_ACQUIRE, "agent");
            xb_add(&bar[XB_XGEN(b.x)], 1u);
            asm volatile("s_waitcnt vmcnt(0)" ::: "memory");
        } else {
            XB_SPIN(xb_ld(&bar[XB_XGEN(b.x)]) == gen, bar);
            __builtin_amdgcn_fence(__ATOMIC_ACQUIRE, "agent");
            asm volatile("s_waitcnt vmcnt(0)" ::: "memory");
        }
    }
    __syncthreads();
}

namespace att {
#ifndef DMA_AUX
#define DMA_AUX 0
#endif
constexpr int SHM = 16384;
constexpr int L_V = 0, L_K = 2 * SHM, L_WS = 4 * SHM, L_CUM = L_WS + 2048, L_LUT = L_CUM + 8192, L_IMP = L_LUT + 5120, L_SEL = L_IMP + 256 * 33 * 4, L_UNI = L_SEL + 1024, L_END = L_UNI + 64;
static_assert(L_END <= RING_BYTES, "attention scratch inside the ring region");
constexpr float THR2 = 11.5f;
enum { K_FOX = 0, K_DIFF = 1, K_SEL = 2, K_WIN = 3, K_CMP = 4 };

#define KSWZ(row, colB) ((row) * 256 + ((colB) ^ (((row) & 7) << 4)))
#define SBAR() __builtin_amdgcn_sched_barrier(0)
__device__ __forceinline__ int v_st(int k, int c) { const int kk = (k & ~0xC) | ((k & 4) << 1) | ((k & 8) >> 1); return ((kk >> 3) * 4 + (c >> 5)) * 512 + ((kk & 7) * 32 + (c & 31)) * 2; }
__device__ __forceinline__ int v_rd_base(int lane) { return ((lane & 3) << 3) | (((lane >> 2) & 3) << 6) | (((lane >> 4) & 1) << 5) | (((lane >> 5) & 1) << 8); }
constexpr int v_rd_off(int d0, int ks, int half) { return d0 * 512 + ks * 4096 + half * 2048; }
__device__ __forceinline__ int crow(int r, int hi) { return (r & 3) + 8 * (r >> 2) + 4 * hi; }
constexpr int ccol(int r) { return (r & 3) + 8 * (r >> 2); }

typedef LAS char* lptr;

template <int NQ>
__device__ __forceinline__ void qkt(f32x16& p0, f32x16& p1, lptr kbuf, int kf0, int r32, int hi, const bf16x8 (&qr)[8]) {
    p0 = f32x16{}; p1 = f32x16{};
    const int kb0 = (int)(uintptr_t)kbuf + (kf0 >> 2) * 128;
    const int ka0 = kb0 + KSWZ(r32, (0 * 16 + hi * 8) * 2), ka1 = kb0 + KSWZ(r32, (1 * 16 + hi * 8) * 2), ka2 = kb0 + KSWZ(r32, (2 * 16 + hi * 8) * 2), ka3 = kb0 + KSWZ(r32, (3 * 16 + hi * 8) * 2);
#define KRD(dst, addr, off) asm volatile("ds_read_b128 %0, %1 offset:%2" : "=&v"(dst) : "v"(addr), "i"(off) : "memory")
#define KRD4(S, aA, aB, off) do { KRD(S[0], aA, off); KRD(S[1], aA, (off) + 8192); KRD(S[2], aB, off); KRD(S[3], aB, (off) + 8192); } while (0)
#define KMM4(S, d) do { p0 = __builtin_amdgcn_mfma_f32_32x32x16_bf16(S[0], qr[d], p0, 0, 0, 0); p1 = __builtin_amdgcn_mfma_f32_32x32x16_bf16(S[1], qr[d], p1, 0, 0, 0); \
                        p0 = __builtin_amdgcn_mfma_f32_32x32x16_bf16(S[2], qr[(d) + 1], p0, 0, 0, 0); p1 = __builtin_amdgcn_mfma_f32_32x32x16_bf16(S[3], qr[(d) + 1], p1, 0, 0, 0); } while (0)
#define LGK(n) asm volatile("s_waitcnt lgkmcnt(" #n ")" ::: "memory")
    bf16x8 A[4], B[4];
    LGK(0); SBAR();
    if (NQ == 8) {
        KRD4(A, ka0, ka1, 0); KRD4(B, ka2, ka3, 0);
        LGK(4); SBAR(); KMM4(A, 0); SBAR(); KRD4(A, ka0, ka1, 128);
        LGK(4); SBAR(); KMM4(B, 2); SBAR(); KRD4(B, ka2, ka3, 128);
        LGK(4); SBAR(); KMM4(A, 4); SBAR();
        LGK(0); SBAR(); KMM4(B, 6);
    } else {
        KRD4(A, ka0, ka1, 0); KRD4(B, ka2, ka3, 0);
        LGK(4); SBAR(); KMM4(A, 0); SBAR();
        LGK(0); SBAR(); KMM4(B, 2);
    }
#undef KRD
#undef KRD4
#undef KMM4
#undef LGK
}
__device__ __forceinline__ void pv_tile(f32x16 (&o)[4], int vb0, bf16x8 pa0, bf16x8 pa1, bf16x8 pa2, bf16x8 pa3) {
#define TRRD(dst, off) asm volatile("ds_read_b64_tr_b16 %0, %1 offset:%2" : "=&v"(dst) : "v"(vb0), "i"(off) : "memory")
#define PV_RD(S, d0) do { constexpr int b_ = v_rd_off(d0, 0, 0); TRRD(S[0], b_); TRRD(S[1], b_ + 2048); TRRD(S[2], b_ + 4096); TRRD(S[3], b_ + 6144); \
                          TRRD(S[4], b_ + 8192); TRRD(S[5], b_ + 10240); TRRD(S[6], b_ + 12288); TRRD(S[7], b_ + 14336); } while (0)
#define PV_MM(S, d0) do { \
        o[d0] = __builtin_amdgcn_mfma_f32_32x32x16_bf16(pa0, (bf16x8){S[0][0], S[0][1], S[0][2], S[0][3], S[1][0], S[1][1], S[1][2], S[1][3]}, o[d0], 0, 0, 0);   \
        o[d0] = __builtin_amdgcn_mfma_f32_32x32x16_bf16(pa1, (bf16x8){S[2][0], S[2][1], S[2][2], S[2][3], S[3][0], S[3][1], S[3][2], S[3][3]}, o[d0], 0, 0, 0);   \
        o[d0] = __builtin_amdgcn_mfma_f32_32x32x16_bf16(pa2, (bf16x8){S[4][0], S[4][1], S[4][2], S[4][3], S[5][0], S[5][1], S[5][2], S[5][3]}, o[d0], 0, 0, 0);   \
        o[d0] = __builtin_amdgcn_mfma_f32_32x32x16_bf16(pa3, (bf16x8){S[6][0], S[6][1], S[6][2], S[6][3], S[7][0], S[7][1], S[7][2], S[7][3]}, o[d0], 0, 0, 0); } while (0)
#define LGK(n) asm volatile("s_waitcnt lgkmcnt(" #n ")" ::: "memory")
    s16x4 A[8], B[8];
    LGK(0); SBAR();
    PV_RD(A, 0); PV_RD(B, 1);
    LGK(8); SBAR(); PV_MM(A, 0); SBAR(); PV_RD(A, 2);
    LGK(8); SBAR(); PV_MM(B, 1); SBAR(); PV_RD(B, 3);
    LGK(8); SBAR(); PV_MM(A, 2); SBAR();
    LGK(0); SBAR(); PV_MM(B, 3);
#undef TRRD
#undef PV_RD
#undef PV_MM
#undef LGK
}
__device__ __forceinline__ void softmax_tile(f32x16& p0, f32x16& p1, float& m_reg, float& l_reg, float& alpha, bf16x8& pa0, bf16x8& pa1, bf16x8& pa2, bf16x8& pa3) {
    float pmax = p0[0];
#pragma unroll
    for (int r = 1; r < 16; ++r) pmax = fmaxf(pmax, p0[r]);
#pragma unroll
    for (int r = 0; r < 16; ++r) pmax = fmaxf(pmax, p1[r]);
    { auto rr = __builtin_amdgcn_permlane32_swap(__float_as_uint(pmax), __float_as_uint(pmax), false, false);
      pmax = fmaxf(__uint_as_float(rr[0]), __uint_as_float(rr[1])); }
    float mn;
    if (__builtin_expect(__all((pmax - m_reg) <= THR2), 1)) { mn = m_reg; alpha = 1.f; }
    else { mn = fmaxf(m_reg, pmax); alpha = fast_exp2(m_reg - mn); m_reg = mn; }
    float ps = 0.f;
#pragma unroll
    for (int r = 0; r < 16; ++r) { p0[r] = fast_exp2(p0[r] - mn); ps += p0[r]; }
#pragma unroll
    for (int r = 0; r < 16; ++r) { p1[r] = fast_exp2(p1[r] - mn); ps += p1[r]; }
    { auto rr = __builtin_amdgcn_permlane32_swap(__float_as_uint(ps), __float_as_uint(ps), false, false);
      ps = __uint_as_float(rr[0]) + __uint_as_float(rr[1]); }
    l_reg = l_reg * alpha + ps;
#define PK4(P, B_, OUT) do { unsigned a0 = cvtpk(P[B_+0], P[B_+1]), a1 = cvtpk(P[B_+2], P[B_+3]);                          \
        unsigned b0 = cvtpk(P[B_+4], P[B_+5]), b1 = cvtpk(P[B_+6], P[B_+7]);                                             \
        auto r0 = __builtin_amdgcn_permlane32_swap(a0, b0, false, false); auto r1 = __builtin_amdgcn_permlane32_swap(a1, b1, false, false); \
        u32x4 w = {r0[0], r1[0], r0[1], r1[1]}; OUT = __builtin_bit_cast(bf16x8, w); } while (0)
    PK4(p0, 0, pa0); PK4(p0, 8, pa1); PK4(p1, 0, pa2); PK4(p1, 8, pa3);
#undef PK4
}
__device__ __forceinline__ void rowbcast(LAS float* wsl, float v, int r32, int hi, float (&out)[16]) {
    if (hi == 0) wsl[r32] = v;
    asm volatile("s_waitcnt lgkmcnt(0)" ::: "memory");
#pragma unroll
    for (int r = 0; r < 16; ++r) out[r] = wsl[crow(r, hi)];
    asm volatile("s_waitcnt lgkmcnt(0)" ::: "memory");
}

template <int KIND>
__device__ __forceinline__ bool wave_act(int j, int qlo, unsigned selm) {
    const int kb = j * 64;
    if (KIND == K_FOX || KIND == K_DIFF) return kb <= qlo + 31;
    if (KIND == K_WIN) return (kb <= qlo + 31) && (kb + 63 >= qlo - 511);
    if (KIND == K_SEL) return (kb <= qlo + 31) && __any((int)((selm >> j) & 1u));
    return true;
}
template <int KIND>
__device__ __forceinline__ void score_fix(f32x16& p0, f32x16& p1, int j, int qlo, int qpos, int hi, const LAS float* lut, const LAS float* cum, unsigned selm) {
    const float NEG = -__builtin_inff();
    const int kb = j * 64, dq = qpos - kb - 4 * hi;
    if (KIND == K_FOX) {
        const LAS float* cb = cum + kb + 4 * hi;
#pragma unroll
        for (int r = 0; r < 16; ++r) { p0[r] += cb[ccol(r)]; p1[r] += cb[ccol(r) + 32]; }
        if (kb + 63 > qlo) {
#pragma unroll
            for (int r = 0; r < 16; ++r) { if (dq - ccol(r) < 0) p0[r] = NEG; if (dq - ccol(r) - 32 < 0) p1[r] = NEG; }
        }
    } else if (KIND == K_CMP) {
        const int dc = qpos - 31 - 16 * (kb + 4 * hi);
#pragma unroll
        for (int r = 0; r < 16; ++r) {
            const int rel0 = dc - 16 * ccol(r), rel1 = rel0 - 512;
            p0[r] += lut[min(max(rel0, 0), 127)]; p1[r] += lut[min(max(rel1, 0), 127)];
            if (rel0 < 0) p0[r] = NEG;
            if (rel1 < 0 || (kb + 4 * hi + ccol(r) + 32 >= 127)) p1[r] = NEG;
        }
    } else {
        if (qlo - (kb + 63) >= 113) {
        } else {
#pragma unroll
            for (int r = 0; r < 16; ++r) { const int rel0 = dq - ccol(r), rel1 = rel0 - 32;
                p0[r] += lut[min(max(rel0, 0), 127)]; p1[r] += lut[min(max(rel1, 0), 127)];
                if (rel0 < 0) p0[r] = NEG; if (rel1 < 0) p1[r] = NEG; }
        }
        if (KIND == K_WIN) {
            if (qlo + 31 - kb >= 512) {
#pragma unroll
                for (int r = 0; r < 16; ++r) { if (dq - ccol(r) >= 512) p0[r] = NEG; if (dq - ccol(r) - 32 >= 512) p1[r] = NEG; }
            }
        }
        if (KIND == K_SEL) {
            if (((selm >> j) & 1u) == 0u) {
#pragma unroll
                for (int r = 0; r < 16; ++r) { p0[r] = NEG; p1[r] = NEG; }
            }
        }
    }
}

template <int KIND, int NQ, int EXPM = 0>
__device__ __forceinline__ void attn_pass(lptr lds, const bf16_t* __restrict__ Kg, const bf16_t* __restrict__ Vg, int kp, int vp, unsigned tilemask,
                                          const bf16x8 (&qr)[8], int kf0, int P0, const LAS float* lut, const LAS float* cum, unsigned selm,
                                          f32x16 (&o)[4], float& m_reg, float& l_reg) {
    const int tid = ltid(), wid = __builtin_amdgcn_readfirstlane(tid >> 6), lane = tid & 63, r32 = lane & 31, hi = lane >> 5;
    const int sr = tid >> 4, sc = (tid & 15) * 8;
    const int kws = KSWZ(sr, sc * 2), vst0 = v_st(sr, sc), vst1 = v_st(32 + sr, sc);
    const int qlo = P0 + wid * 32, qpos = qlo + r32;
    LAS float* wsl = (LAS float*)(lds + L_WS) + wid * 64;
    const int vbase = (int)(uintptr_t)(lds + L_V) + v_rd_base(lane);
    if (tilemask == 0u) return;
    const int kr_ = wid * 4 + (lane >> 4);
    const int kcol_ = (((lane & 15) ^ (kr_ & 7)) * 8);
    const int vsub_ = wid * 2 + (lane >> 5);
    const int vkk_ = ((vsub_ >> 2) << 3) | ((lane & 31) >> 2);
    const int vkey_ = (vkk_ & ~0xC) | ((vkk_ & 4) << 1) | ((vkk_ & 8) >> 1);
    const int vcol_ = (vsub_ & 3) * 32 + (lane & 3) * 8;
    const unsigned dma_w = (unsigned)wid * 1024u;
#define DMA_TILE(jj, bf) do { \
        const bf16_t* kp0_ = Kg + (size_t)((jj) * 64 + kr_) * kp + kcol_; const bf16_t* vp0_ = Vg + (size_t)((jj) * 64 + vkey_) * vp + vcol_; \
        __builtin_amdgcn_global_load_lds((const unsigned*)kp0_, (LAS unsigned*)(lds + L_K + (bf) * SHM + dma_w), 16, 0, DMA_AUX); \
        __builtin_amdgcn_global_load_lds((const unsigned*)(kp0_ + (size_t)32 * kp), (LAS unsigned*)(lds + L_K + (bf) * SHM + 8192 + dma_w), 16, 0, DMA_AUX); \
        __builtin_amdgcn_global_load_lds((const unsigned*)vp0_, (LAS unsigned*)(lds + L_V + (bf) * SHM + dma_w), 16, 0, DMA_AUX); \
        __builtin_amdgcn_global_load_lds((const unsigned*)(vp0_ + (size_t)32 * vp), (LAS unsigned*)(lds + L_V + (bf) * SHM + 8192 + dma_w), 16, 0, DMA_AUX); } while (0)
#define NEXT_TILE(jv) do { if (tilemask) { jv = __builtin_ctz(tilemask); tilemask &= tilemask - 1u; } else jv = -1; } while (0)
    int j0, j1;
    NEXT_TILE(j0); NEXT_TILE(j1);
    DMA_TILE(j0, 0);
    asm volatile("s_waitcnt vmcnt(0)" ::: "memory");
    __syncthreads();
    int buf = 0;
    for (;;) {
        if (j1 >= 0) DMA_TILE(j1, buf ^ 1);
        if (wave_act<KIND>(j0, qlo, selm)) {
            f32x16 p0, p1;
            qkt<NQ>(p0, p1, lds + L_K + buf * SHM, kf0, r32, hi, qr);
            score_fix<KIND>(p0, p1, j0, qlo, qpos, hi, lut, cum, selm);
            float alpha; bf16x8 pa0, pa1, pa2, pa3;
            softmax_tile(p0, p1, m_reg, l_reg, alpha, pa0, pa1, pa2, pa3);
            if (__any(alpha < 1.f)) {
                float al[16]; rowbcast(wsl, alpha, r32, hi, al);
#pragma unroll
                for (int d = 0; d < 4; ++d)
#pragma unroll
                    for (int r = 0; r < 16; ++r) o[d][r] *= al[r];
            }
            pv_tile(o, vbase + buf * SHM, pa0, pa1, pa2, pa3);
        }
        asm volatile("s_waitcnt vmcnt(0)" ::: "memory");
        __syncthreads();
        if (j1 < 0) break;
        j0 = j1; NEXT_TILE(j1); buf ^= 1;
    }
#undef DMA_TILE
#undef NEXT_TILE
}

__device__ __forceinline__ void fox_pass(lptr lds, const bf16_t* __restrict__ Kg, const bf16_t* __restrict__ Vg, int ntiles, const bf16x8 (&qr)[8], int P0,
                                         const LAS float* cum, f32x16 (&o)[4], float& m_reg, float& l_reg) {
    const int tid = ltid(), wid = __builtin_amdgcn_readfirstlane(tid >> 6), lane = tid & 63, r32 = lane & 31, hi = lane >> 5;
    const int sr = tid >> 4, sc = (tid & 15) * 8;
    const int kws = KSWZ(sr, sc * 2), vst0 = v_st(sr, sc), vst1 = v_st(32 + sr, sc);
    const int qlo = P0 + wid * 32, qpos = qlo + r32;
    LAS float* wsl = (LAS float*)(lds + L_WS) + wid * 64;
    const int vbase = (int)(uintptr_t)(lds + L_V) + v_rd_base(lane);
    const int kbase = (int)(uintptr_t)(lds + L_K);
    const int ko0 = KSWZ(r32, (0 * 16 + hi * 8) * 2), ko1 = KSWZ(r32, (1 * 16 + hi * 8) * 2), ko2 = KSWZ(r32, (2 * 16 + hi * 8) * 2), ko3 = KSWZ(r32, (3 * 16 + hi * 8) * 2);
    const int PITCH = PROJ_LD;
    bf16x8 st_k0, st_k1, st_v0, st_v1;
#define LOADK(jj) do { const size_t kr = (size_t)((jj) * 64 + sr); st_k0 = *(const bf16x8*)(Kg + kr * PITCH + sc); st_k1 = *(const bf16x8*)(Kg + (kr + 32) * PITCH + sc); } while (0)
#define LOADV(jj) do { const size_t kr = (size_t)((jj) * 64 + sr); st_v0 = *(const bf16x8*)(Vg + kr * PITCH + sc); st_v1 = *(const bf16x8*)(Vg + (kr + 32) * PITCH + sc); } while (0)
#define WRITEK(bf) do { *(LAS bf16x8*)(lds + L_K + (bf) * SHM + kws) = st_k0; *(LAS bf16x8*)(lds + L_K + (bf) * SHM + kws + 32 * 256) = st_k1; } while (0)
#define WRITEV(bf) do { *(LAS bf16x8*)(lds + L_V + (bf) * SHM + vst0) = st_v0; *(LAS bf16x8*)(lds + L_V + (bf) * SHM + vst1) = st_v1; } while (0)
#define KRD(dst, addr, off) asm volatile("ds_read_b128 %0, %1 offset:%2" : "=&v"(dst) : "v"(addr), "i"(off) : "memory")
#define KRD4(S, aA, aB, off) do { KRD(S[0], aA, off); KRD(S[1], aA, (off) + 8192); KRD(S[2], aB, off); KRD(S[3], aB, (off) + 8192); } while (0)
#define KMM4(S, d) do { sn0 = __builtin_amdgcn_mfma_f32_32x32x16_bf16(S[0], qr[d], sn0, 0, 0, 0); sn1 = __builtin_amdgcn_mfma_f32_32x32x16_bf16(S[1], qr[d], sn1, 0, 0, 0); \
                        sn0 = __builtin_amdgcn_mfma_f32_32x32x16_bf16(S[2], qr[(d) + 1], sn0, 0, 0, 0); sn1 = __builtin_amdgcn_mfma_f32_32x32x16_bf16(S[3], qr[(d) + 1], sn1, 0, 0, 0); } while (0)
#define LGK(n) asm volatile("s_waitcnt lgkmcnt(" #n ")" ::: "memory")
    LOADK(0); LOADV(0); WRITEK(0); WRITEV(0);
    if (ntiles > 1) { LOADK(1); WRITEK(1); }
    __syncthreads();
    f32x16 sc0, sc1;
    bool actc = 0 <= qlo + 31;
    if (actc) { qkt<8>(sc0, sc1, lds + L_K, 0, r32, hi, qr); score_fix<K_FOX>(sc0, sc1, 0, qlo, qpos, hi, nullptr, cum, 0u); }
    for (int t = 0; t < ntiles; ++t) {
        const int buf = t & 1; const bool has1 = t + 1 < ntiles, has2 = t + 2 < ntiles;
        if (has1) LOADV(t + 1);
        if (has2) LOADK(t + 2);
        const bool actn = has1 && ((t + 1) * 64 <= qlo + 31);
        f32x16 sn0, sn1;
        if (actc && actn && ((t + 1) * 64 + 63 <= qlo)) {
            const int ka = kbase + (buf ^ 1) * SHM;
            const int ka0 = ka + ko0, ka1 = ka + ko1, ka2 = ka + ko2, ka3 = ka + ko3;
            bf16x8 A[4], B[4];
            SBAR(); LGK(0);
            KRD4(A, ka0, ka1, 0); KRD4(B, ka2, ka3, 0);
            SBAR();
            float pmax = sc0[0];
#pragma unroll
            for (int r = 1; r < 16; ++r) pmax = fmaxf(pmax, sc0[r]);
            sn0 = f32x16{}; sn1 = f32x16{};
            SBAR(); LGK(4); SBAR(); KMM4(A, 0); SBAR(); KRD4(A, ka0, ka1, 128); SBAR();
#pragma unroll
            for (int r = 0; r < 16; ++r) pmax = fmaxf(pmax, sc1[r]);
            { auto rr = __builtin_amdgcn_permlane32_swap(__float_as_uint(pmax), __float_as_uint(pmax), false, false);
              pmax = fmaxf(__uint_as_float(rr[0]), __uint_as_float(rr[1])); }
            const bool keep = __all((pmax - m_reg) <= THR2);
            const float mn = keep ? m_reg : fmaxf(m_reg, pmax);
            const float alpha = fast_exp2(m_reg - mn); m_reg = mn;
            SBAR(); LGK(4); SBAR(); KMM4(B, 2); SBAR(); KRD4(B, ka2, ka3, 128); SBAR();
            float ps = 0.f;
#pragma unroll
            for (int r = 0; r < 16; ++r) { sc0[r] = fast_exp2(sc0[r] - mn); ps += sc0[r]; }
            SBAR(); LGK(4); SBAR(); KMM4(A, 4); SBAR();
#pragma unroll
            for (int r = 0; r < 16; ++r) { sc1[r] = fast_exp2(sc1[r] - mn); ps += sc1[r]; }
            SBAR(); LGK(0); SBAR(); KMM4(B, 6); SBAR();
            { auto rr = __builtin_amdgcn_permlane32_swap(__float_as_uint(ps), __float_as_uint(ps), false, false);
              ps = __uint_as_float(rr[0]) + __uint_as_float(rr[1]); }
            l_reg = l_reg * alpha + ps;
            bf16x8 pa0, pa1, pa2, pa3;
#define PK4(P, B_, OUT) do { unsigned a0 = cvtpk(P[B_+0], P[B_+1]), a1 = cvtpk(P[B_+2], P[B_+3]);                          \
        unsigned b0 = cvtpk(P[B_+4], P[B_+5]), b1 = cvtpk(P[B_+6], P[B_+7]);                                             \
        auto r0 = __builtin_amdgcn_permlane32_swap(a0, b0, false, false); auto r1 = __builtin_amdgcn_permlane32_swap(a1, b1, false, false); \
        u32x4 w = {r0[0], r1[0], r0[1], r1[1]}; OUT = __builtin_bit_cast(bf16x8, w); } while (0)
            PK4(sc0, 0, pa0); PK4(sc0, 8, pa1); PK4(sc1, 0, pa2); PK4(sc1, 8, pa3);
#undef PK4
            SBAR();
            if (__any(alpha < 1.f)) {
                float al[16]; rowbcast(wsl, alpha, r32, hi, al);
#pragma unroll
                for (int d = 0; d < 4; ++d)
#pragma unroll
                    for (int r = 0; r < 16; ++r) o[d][r] *= al[r];
            }
            pv_tile(o, vbase + buf * SHM, pa0, pa1, pa2, pa3);
            { const LAS float* cbp = cum + (t + 1) * 64 + 4 * hi;
#pragma unroll
              for (int r = 0; r < 16; ++r) { sn0[r] += cbp[ccol(r)]; sn1[r] += cbp[ccol(r) + 32]; } }
        } else {
            if (actn) qkt<8>(sn0, sn1, lds + L_K + (buf ^ 1) * SHM, 0, r32, hi, qr);
            if (actc) {
                float alpha; bf16x8 pa0, pa1, pa2, pa3;
                softmax_tile(sc0, sc1, m_reg, l_reg, alpha, pa0, pa1, pa2, pa3);
                if (__any(alpha < 1.f)) {
                    float al[16]; rowbcast(wsl, alpha, r32, hi, al);
#pragma unroll
                    for (int d = 0; d < 4; ++d)
#pragma unroll
                        for (int r = 0; r < 16; ++r) o[d][r] *= al[r];
                }
                pv_tile(o, vbase + buf * SHM, pa0, pa1, pa2, pa3);
            }
            if (actn) score_fix<K_FOX>(sn0, sn1, t + 1, qlo, qpos, hi, nullptr, cum, 0u);
        }
        if (has1) WRITEV(buf ^ 1);
        if (has2) WRITEK(buf);
        __syncthreads();
        sc0 = sn0; sc1 = sn1; actc = actn;
    }
#undef LOADK
#undef LOADV
#undef WRITEK
#undef WRITEV
#undef KRD
#undef KRD4
#undef KMM4
#undef LGK
}

template <int NQ>
__device__ __forceinline__ void load_q(bf16x8 (&qr)[8], const bf16_t* proj, int row_first, int col0) {
    const int lane = ltid() & 63, r32 = lane & 31, hi = lane >> 5, wid = ltid() >> 6;
    const bf16_t* q = proj + (size_t)(row_first + wid * 32 + r32) * PROJ_LD + col0 + hi * 8;
#pragma unroll
    for (int d = 0; d < NQ; ++d) qr[d] = *(const bf16x8*)(q + d * 16);
}
__device__ __forceinline__ void store_o(const f32x16 (&o)[4], bf16_t* mixed, int row_first, int col0) {
    const int lane = ltid() & 63, r32 = lane & 31, hi = lane >> 5, wid = ltid() >> 6;
    const bool odd = (r32 & 1) != 0;
    bf16_t* base = mixed + (size_t)(row_first + wid * 32) * DM + col0 + (r32 & ~1);
#pragma unroll
    for (int rp = 0; rp < 8; ++rp) { const int orow = crow(2 * rp + (odd ? 1 : 0), hi);
#pragma unroll
        for (int d = 0; d < 4; ++d) { const float va = o[d][2 * rp], vb = o[d][2 * rp + 1];
            const float y = dppf<0xB1>(odd ? va : vb);
            *(unsigned*)(base + (size_t)orow * DM + d * 32) = odd ? cvtpk(y, vb) : cvtpk(va, y); } }
}
__device__ __forceinline__ void scr_acc(float* scr, const f32x16 (&o)[4], const float (&f)[16], bool add) {
    f32x4* s = (f32x4*)(scr + (ltid() >> 6) * 4096) + (ltid() & 63);
#pragma unroll
    for (int d = 0; d < 4; ++d)
#pragma unroll
        for (int q = 0; q < 4; ++q) { f32x4 v; v.x = o[d][4 * q] * f[4 * q]; v.y = o[d][4 * q + 1] * f[4 * q + 1]; v.z = o[d][4 * q + 2] * f[4 * q + 2]; v.w = o[d][4 * q + 3] * f[4 * q + 3];
            if (add) v += s[(d * 4 + q) * 64]; s[(d * 4 + q) * 64] = v; }
}
__device__ __forceinline__ void scr_load(const float* scr, f32x16 (&o)[4]) {
    const f32x4* s = (const f32x4*)(scr + (ltid() >> 6) * 4096) + (ltid() & 63);
#pragma unroll
    for (int d = 0; d < 4; ++d)
#pragma unroll
        for (int q = 0; q < 4; ++q) { const f32x4 v = s[(d * 4 + q) * 64]; o[d][4 * q] = v.x; o[d][4 * q + 1] = v.y; o[d][4 * q + 2] = v.z; o[d][4 * q + 3] = v.w; }
}

template <int EXPM = 0>
__device__ __forceinline__ void fox_unit(lptr lds, const bf16_t* proj, const float* gates, float fbias, bf16_t* mixed, int b, int h, int qb) {
    const int tid = ltid(), wid = tid >> 6, lane = tid & 63, r32 = lane & 31, hi = lane >> 5;
    const int P0 = qb * 256, rowb = b * SEQ;
    LAS float* cum = (LAS float*)(lds + L_CUM);
    { const int nk = P0 + 256; float run = 0.f; const bool on = 4 * tid < nk;
      float xs[4];
#pragma unroll
      for (int i = 0; i < 4; ++i) xs[i] = gates[(size_t)(rowb + 4 * tid + i) * GATE_LD + h] + fbias;
      if (on) {
#pragma unroll
          for (int i = 0; i < 4; ++i) { const float xx = xs[i];
              run += fminf(xx, 0.f) - __logf(1.f + __expf(-fabsf(xx))); cum[4 * tid + i] = run; }
      }
      float inc = run;
#pragma unroll
      for (int o = 1; o < 64; o <<= 1) { const float t = __builtin_bit_cast(float, __builtin_amdgcn_ds_bpermute(((lane - o) & 63) << 2, __builtin_bit_cast(int, inc))); if (lane >= o) inc += t; }
      LAS float* wsum = (LAS float*)(lds + L_WS);
      if (lane == 63) wsum[wid] = inc;
      __syncthreads();
      float base = 0.f;
#pragma unroll
      for (int w = 0; w < 8; ++w) if (w < wid) base += wsum[w];
      const float ex = base + inc - run;
      if (on) {
#pragma unroll 1
          for (int i = 0; i < 4; ++i) cum[4 * tid + i] = (ex + cum[4 * tid + i]) * LOG2E; }
      __syncthreads();
      const float cref = cum[P0];
      __syncthreads();
      if (on) {
#pragma unroll 1
          for (int i = 0; i < 4; ++i) cum[4 * tid + i] = cref - cum[4 * tid + i]; }
    }
    bf16x8 qr[8]; load_q<8>(qr, proj, rowb + P0, C_FQ + h * 128);
    __syncthreads();
    f32x16 o[4] = {}; float m_reg = -1e30f, l_reg = 0.f;
    const unsigned tm = (qb == 7) ? 0xFFFFFFFFu : ((1u << (4 * (qb + 1))) - 1u);
    if (false) fox_pass(lds, proj + (size_t)rowb * PROJ_LD + C_FK + h * 128, proj + (size_t)rowb * PROJ_LD + C_FV + h * 128, 4 * (qb + 1), qr, P0, cum, o, m_reg, l_reg);
    else attn_pass<K_FOX, 8, EXPM>(lds, proj + (size_t)rowb * PROJ_LD + C_FK + h * 128, proj + (size_t)rowb * PROJ_LD + C_FV + h * 128, PROJ_LD, PROJ_LD, tm, qr, 0, P0, nullptr, cum, 0u, o, m_reg, l_reg);
    float f[16]; rowbcast((LAS float*)(lds + L_WS) + wid * 64, fast_rcp(l_reg), r32, hi, f);
#pragma unroll
    for (int d = 0; d < 4; ++d)
#pragma unroll
        for (int r = 0; r < 16; ++r) o[d][r] *= f[r];
    store_o(o, mixed, rowb + P0, h * 128);
    __syncthreads();
}
__device__ __forceinline__ void diff_unit(lptr lds, const bf16_t* proj, bf16_t* mixed, float* scr, int b, int h, int qb, float lam, float out_scale, const float* subln_g) {
    const int tid = ltid(), wid = tid >> 6, lane = tid & 63, r32 = lane & 31, hi = lane >> 5;
    const int P0 = qb * 256, rowb = b * SEQ;
    const LAS float* lut = (const LAS float*)(lds + L_LUT) + h * 128;
    LAS float* wsl = (LAS float*)(lds + L_WS) + wid * 64;
    const unsigned tm = (qb == 7) ? 0xFFFFFFFFu : ((1u << (4 * (qb + 1))) - 1u);
    const bf16_t* Kg = proj + (size_t)rowb * PROJ_LD + C_DK + h * 128; const bf16_t* Vg = proj + (size_t)rowb * PROJ_LD + C_DV + h * 128;
    f32x16 ot[4];
#pragma unroll 1
    for (int mp = 0; mp < 2; ++mp) {
        bf16x8 qr[8]; load_q<4>(qr, proj, rowb + P0, C_DQ + h * 128 + mp * 64);
        f32x16 o[4] = {}; float m_reg = -1e30f, l_reg = 0.f;
        attn_pass<K_DIFF, 4>(lds, Kg, Vg, PROJ_LD, PROJ_LD, tm, qr, mp * 4, P0, lut, nullptr, 0u, o, m_reg, l_reg);
        float f[16]; rowbcast(wsl, (mp == 0 ? 1.f : -lam) * fast_rcp(l_reg), r32, hi, f);
        if (mp == 0) scr_acc(scr, o, f, false);
        else {
            scr_load(scr, ot);
#pragma unroll
            for (int d = 0; d < 4; ++d)
#pragma unroll
                for (int r = 0; r < 16; ++r) ot[d][r] += o[d][r] * f[r];
        }
    }
    float gcol[4];
#pragma unroll
    for (int d = 0; d < 4; ++d) gcol[d] = subln_g[d * 32 + r32] * out_scale;
#pragma unroll
    for (int r = 0; r < 16; ++r) {
        float ss = ot[0][r] * ot[0][r] + ot[1][r] * ot[1][r] + ot[2][r] * ot[2][r] + ot[3][r] * ot[3][r];
        ss += dppf<0x128>(ss); ss += dppf<0x124>(ss); ss += dppf<0x122>(ss); ss += dppf<0x121>(ss); ss += shx(ss, 16);
        const float rn = __builtin_amdgcn_rsqf(ss * (1.f / 128.f) + RMS_EPS);
#pragma unroll
        for (int d = 0; d < 4; ++d) ot[d][r] *= rn * gcol[d];
    }
    store_o(ot, mixed, rowb + P0, 768 + h * 128);
    __syncthreads();
}
__device__ __forceinline__ void nsa_unit(lptr lds, const bf16_t* proj, const float* gates, const bf16_t* kcmp, const bf16_t* vcmp, bf16_t* mixed, float* scr, int b, int g, int qb) {
    const int tid = ltid(), wid = tid >> 6, lane = tid & 63, r32 = lane & 31, hi = lane >> 5;
    const int P0 = qb * 256, rowb = b * SEQ;
    const int qlo = P0 + wid * 32, qpos = qlo + r32;
    LAS float* wsl = (LAS float*)(lds + L_WS) + wid * 64;
    LAS float* imp = (LAS float*)(lds + L_IMP);
    LAS unsigned* sel = (LAS unsigned*)(lds + L_SEL);
    LAS unsigned* uni = (LAS unsigned*)(lds + L_UNI);
    const float NEG = -__builtin_inff();
    const bf16_t* kc = kcmp + (size_t)(b * 2 + g) * 128 * 128; const bf16_t* vc = vcmp + (size_t)(b * 2 + g) * 128 * 128;
    { const int sr = tid >> 4, sc = (tid & 15) * 8, kws = KSWZ(sr, sc * 2);
#pragma unroll
      for (int t = 0; t < 2; ++t) { const bf16x8 a = *(const bf16x8*)(kc + (size_t)(t * 64 + sr) * 128 + sc), c = *(const bf16x8*)(kc + (size_t)(t * 64 + 32 + sr) * 128 + sc);
          *(LAS bf16x8*)(lds + L_K + t * SHM + kws) = a; *(LAS bf16x8*)(lds + L_K + t * SHM + kws + 32 * 256) = c; }
      if (tid == 0) uni[0] = 0u; }
    __syncthreads();
    float ia[16], ic[16];
#pragma unroll
    for (int i = 0; i < 16; ++i) { ia[i] = 0.f; ic[i] = 0.f; }
#pragma unroll 1
    for (int hh = 0; hh < 3; ++hh) {
        const int hd = g * 3 + hh; const LAS float* lut = (const LAS float*)(lds + L_LUT) + (4 + hd) * 128;
        bf16x8 qr[8]; load_q<8>(qr, proj, rowb + P0, C_NQ + hd * 128);
        f32x16 p[4];
        qkt<8>(p[0], p[1], lds + L_K, 0, r32, hi, qr); qkt<8>(p[2], p[3], lds + L_K + SHM, 0, r32, hi, qr);
        float mx = -1e30f;
#pragma unroll
        for (int q4 = 0; q4 < 4; ++q4)
#pragma unroll
            for (int r = 0; r < 16; ++r) { const int n = q4 * 32 + 4 * hi + ccol(r); const int rel = qpos - 31 - 16 * n;
                float s = p[q4][r] + lut[min(max(rel, 0), 127)]; if (rel < 0 || n >= 127) s = NEG; p[q4][r] = s; mx = fmaxf(mx, s); }
        mx = fmaxf(mx, shx(mx, 32));
        float ps = 0.f;
#pragma unroll
        for (int q4 = 0; q4 < 4; ++q4)
#pragma unroll
            for (int r = 0; r < 16; ++r) { p[q4][r] = fast_exp2(p[q4][r] - mx); ps += p[q4][r]; }
        ps += shx(ps, 32);
        const float inv = ps > 0.f ? 1.f / ps : 0.f;
#pragma unroll
        for (int q4 = 0; q4 < 4; ++q4)
#pragma unroll
            for (int i = 0; i < 4; ++i) { const float x0 = p[q4][4 * i] * inv, x1 = p[q4][4 * i + 1] * inv, x2 = p[q4][4 * i + 2] * inv, x3 = p[q4][4 * i + 3] * inv;
                ia[q4 * 4 + i] += x0 + x1 + x2 + 0.5f * x3; ic[q4 * 4 + i] += 0.5f * x3; }
    }
#pragma unroll
    for (int gi = 0; gi < 16; ++gi) {
        const float cp = shx(ic[gi], 32);
        const float cpm = (gi > 0) ? shx(ic[gi > 0 ? gi - 1 : 0], 32) : 0.f;
        const float v = ia[gi] + (hi ? cp : cpm);
        imp[(wid * 32 + r32) * 33 + 2 * gi + hi] = v;
    }
    __syncthreads();
    if (tid < 256) {
        const int t = P0 + tid, blk = t >> 6;
        float sc[32];
#pragma unroll
        for (int j2 = 0; j2 < 32; ++j2) { const bool forced = (j2 == 0) || (j2 == blk) || (j2 == blk - 1);
            sc[j2] = (j2 <= blk) ? (imp[tid * 33 + j2] + (forced ? 1e4f : 0.f)) : -1e30f; }
        unsigned mask = 0u;
#pragma unroll 1
        for (int it = 0; it < 8; ++it) { float best = -1e30f; int bi = -1;
#pragma unroll
            for (int j2 = 0; j2 < 32; ++j2) { const bool free_ = ((mask >> j2) & 1u) == 0u; if (free_ && sc[j2] > best) { best = sc[j2]; bi = j2; } }
            if (bi >= 0 && best > -0.5e30f) mask |= 1u << bi; }
        sel[tid] = mask;
        atomicOr((unsigned*)uni, mask);
    }
    __syncthreads();
    const unsigned selm = sel[wid * 32 + r32];
    const unsigned um = uni[0];
#pragma unroll 1
    for (int hp = 0; hp < 3; ++hp) {
    const int h6 = g * 3 + hp;
    const float* gp = gates + (size_t)(rowb + qpos) * GATE_LD + 6 + h6 * 3;
    const float g0 = 1.f / (1.f + __expf(-gp[0])), g1 = 1.f / (1.f + __expf(-gp[1])), g2 = 1.f / (1.f + __expf(-gp[2]));
    const LAS float* lut = (const LAS float*)(lds + L_LUT) + (4 + h6) * 128;
    bf16x8 qr[8]; load_q<8>(qr, proj, rowb + P0, C_NQ + h6 * 128);
    {
        f32x16 o[4] = {}; float m_reg = -1e30f, l_reg = 0.f;
        attn_pass<K_CMP, 8>(lds, kc, vc, 128, 128, 3u, qr, 0, P0, lut, nullptr, 0u, o, m_reg, l_reg);
        float f[16]; rowbcast(wsl, l_reg > 0.f ? g0 / l_reg : 0.f, r32, hi, f);
        scr_acc(scr, o, f, false);
    }
    {
        f32x16 o[4] = {}; float m_reg = -1e30f, l_reg = 0.f;
        const unsigned cm = (qb == 7) ? 0xFFFFFFFFu : ((1u << (4 * (qb + 1))) - 1u);
        attn_pass<K_SEL, 8>(lds, proj + (size_t)rowb * PROJ_LD + C_NKS + g * 128, proj + (size_t)rowb * PROJ_LD + C_NVS + g * 128, PROJ_LD, PROJ_LD, um & cm, qr, 0, P0, lut, nullptr, selm, o, m_reg, l_reg);
        float f[16]; rowbcast(wsl, l_reg > 0.f ? g1 / l_reg : 0.f, r32, hi, f);
        scr_acc(scr, o, f, true);
    }
    {
        f32x16 o[4] = {}; float m_reg = -1e30f, l_reg = 0.f;
        const int jlo = (P0 - 511) > 0 ? (P0 - 511) >> 6 : 0, jhi = (P0 + 255) >> 6;
        const unsigned hiM = (jhi == 31) ? 0xFFFFFFFFu : ((1u << (jhi + 1)) - 1u);
        const unsigned wm = hiM & ~((1u << jlo) - 1u);
        attn_pass<K_WIN, 8>(lds, proj + (size_t)rowb * PROJ_LD + C_NKW + g * 128, proj + (size_t)rowb * PROJ_LD + C_NVW + g * 128, PROJ_LD, PROJ_LD, wm, qr, 0, P0, lut, nullptr, 0u, o, m_reg, l_reg);
        float f[16]; rowbcast(wsl, l_reg > 0.f ? g2 / l_reg : 0.f, r32, hi, f);
        f32x16 ot[4]; scr_load(scr, ot);
#pragma unroll
        for (int d = 0; d < 4; ++d)
#pragma unroll
            for (int r = 0; r < 16; ++r) ot[d][r] += o[d][r] * f[r];
        store_o(ot, mixed, rowb + P0, 1280 + h6 * 128);
    }
    __syncthreads();
    }
}
#undef KSWZ
}

struct Params {
    const float* x; const float* attn_norm_g; const float* w_in; const float* fox_f_bias; const float* lq1; const float* lk1; const float* lq2; const float* lk2;
    const float* subln_g; const float* cmp_pos; const float* wk1; const float* wk2; const float* wv1; const float* wv2; const float* w_out; const float* ffn_norm_g;
    const float* w_up; const float* conv_w; const float* conv_b; const float* w_down; const float* rel_bias; const float* final_g;
    float* out; unsigned char* ws;
    int l_begin, l_end, do_prologue, do_final, bar_region, ph_mask;
};

typedef const __attribute__((address_space(4))) Params* KP;
__device__ __forceinline__ KP kparams() { unsigned long long a = (unsigned long long)__builtin_amdgcn_kernarg_segment_ptr(); asm volatile("" : "+s"(a)); return (KP)a; }

template <int MAPK>
__device__ __forceinline__ void transpose_item(const float* __restrict__ src, int ldsrc, const float* __restrict__ kscale, bf16_t* __restrict__ dst, int K, int k0, int n0, LAS float* scr, int lane) {
    const int c = n0 + (lane & 31);
    const int oc = (MAPK == 1) ? win_colmap(c) : (MAPK == 2) ? wup_colmap(c) : c;
    const float* sp = src + (size_t)(k0 + (lane >> 5)) * ldsrc + (oc >= 0 ? oc : 0);
    float v[32];
#pragma unroll
    for (int i = 0; i < 32; ++i) v[i] = __builtin_nontemporal_load(sp + (size_t)(2 * i) * ldsrc);
    if (kscale) {
#pragma unroll
        for (int i = 0; i < 32; ++i) v[i] *= kscale[k0 + 2 * i + (lane >> 5)];
    }
#pragma unroll
    for (int i = 0; i < 32; ++i) scr[(2 * i + (lane >> 5)) * 33 + (lane & 31)] = (oc < 0) ? 0.f : v[i];
    asm volatile("s_waitcnt lgkmcnt(0)" ::: "memory");
    const int cc = lane & 7;
#pragma unroll
    for (int j = 0; j < 4; ++j) { const int n = (lane >> 3) + 8 * j; const LAS float* s = scr + (8 * cc) * 33 + n;
        u32x4 o; o.x = cvtpk(s[0], s[33]); o.y = cvtpk(s[2 * 33], s[3 * 33]); o.z = cvtpk(s[4 * 33], s[5 * 33]); o.w = cvtpk(s[6 * 33], s[7 * 33]);
        *(u32x4*)(dst + (size_t)(n0 + n) * K + k0 + 8 * cc) = o; }
    asm volatile("s_waitcnt lgkmcnt(0)" ::: "memory");
}

constexpr int T_IN = (DM / 64) * (NINP / 32), T_OUT = (DM / 64) * (DM / 32), T_UP = (DM / 64) * (NUP / 32), T_DN = (DFF / 64) * (DM / 32), T_W1 = (4096 / 64) * 4, T_W2 = 2 * 4;
constexpr int T_LAYER = T_IN + T_OUT + T_UP + T_DN + 2 * T_W1 + 2 * T_W2;
__device__ __forceinline__ void convert_item(KP p, int l, int r, LAS float* scr, int lane) {
    unsigned char* ws = p->ws;
    if (r < T_IN) { const int nb = NINP / 32; transpose_item<1>(p->w_in + (size_t)l * DM * NIN, NIN, p->attn_norm_g + l * DM, (bf16_t*)(ws + WS_WIN) + (size_t)l * NINP * DM, DM, (r / nb) * 64, (r % nb) * 32, scr, lane); return; } r -= T_IN;
    if (r < T_OUT) { const int nb = DM / 32; transpose_item<0>(p->w_out + (size_t)l * DM * DM, DM, nullptr, (bf16_t*)(ws + WS_WOUT) + (size_t)l * DM * DM, DM, (r / nb) * 64, (r % nb) * 32, scr, lane); return; } r -= T_OUT;
    if (r < T_UP) { const int nb = NUP / 32; transpose_item<2>(p->w_up + (size_t)l * DM * NUP, NUP, p->ffn_norm_g + l * DM, (bf16_t*)(ws + WS_WUP) + (size_t)l * NUP * DM, DM, (r / nb) * 64, (r % nb) * 32, scr, lane); return; } r -= T_UP;
    if (r < T_DN) { const int nb = DM / 32; transpose_item<0>(p->w_down + (size_t)l * DFF * DM, DM, nullptr, (bf16_t*)(ws + WS_WDN) + (size_t)l * DM * DFF, DFF, (r / nb) * 64, (r % nb) * 32, scr, lane); return; } r -= T_DN;
    if (r < 2 * T_W1) { const int kv = r / T_W1, rr = r % T_W1; const float* src = (kv ? p->wv1 : p->wk1) + (size_t)l * 4096 * 128;
        transpose_item<0>(src, 128, nullptr, (bf16_t*)(ws + WS_W1T) + (size_t)(l * 2 + kv) * 128 * 4096, 4096, (rr / 4) * 64, (rr % 4) * 32, scr, lane); return; } r -= 2 * T_W1;
    { const int kv = r / T_W2, rr = r % T_W2; const float* src = (kv ? p->wv2 : p->wk2) + (size_t)l * 128 * 128;
        transpose_item<0>(src, 128, nullptr, (bf16_t*)(ws + WS_W2T) + (size_t)(l * 2 + kv) * 128 * 128, 128, (rr / 4) * 64, (rr % 4) * 32, scr, lane); }
}
__device__ __forceinline__ void prologue_phase(KP p, LAS unsigned char* lds) {
    const int tid = ltid(), lane = tid & 63, wave = tid >> 6;
    LAS float* scr = (LAS float*)lds + wave * (64 * 33);
    const int G = gridDim.x, bx = blockIdx.x;
    unsigned char* ws = p->ws;
    for (int it = bx * 8 + wave; it < T_LAYER; it += G * 8) convert_item(p, 0, it, scr, lane);
    __syncthreads();
    { LAS float* scr = (LAS float*)lds;
    for (int it = bx; it < DEPTH * 2 * 8; it += G) {
        const int l = it >> 4, kv = (it >> 3) & 1, c0 = (it & 7) * 16; const float* w1 = (kv ? p->wv1 : p->wk1) + (size_t)l * 4096 * 128; const float* pos = p->cmp_pos + (size_t)l * 4096;
        const int col = c0 + (tid & 15), ks = tid >> 4; float s = 0.f;
#pragma unroll 8
        for (int k = ks * 128; k < ks * 128 + 128; ++k) s += pos[k] * w1[(size_t)k * 128 + col];
        scr[tid] = s; __syncthreads();
        if (tid < 16) { float a = 0.f; for (int j = 0; j < 32; ++j) a += scr[j * 16 + tid]; ((float*)(ws + WS_POSC))[(l * 2 + kv) * 128 + c0 + tid] = a; }
        __syncthreads();
    }
    }
    { const int gw = bx * 8 + wave, NGW = G * 8; bf16_t* hb = (bf16_t*)(ws + WS_HB);
      for (int row = gw; row < MROWS; row += NGW) {
          const f32x4* xr = (const f32x4*)(p->x + (size_t)row * DM) + lane; f32x4 v[8]; float ss = 0.f;
#pragma unroll
          for (int j = 0; j < 8; ++j) { v[j] = __builtin_nontemporal_load(xr + 64 * j); ss += (v[j].x * v[j].x + v[j].y * v[j].y) + (v[j].z * v[j].z + v[j].w * v[j].w); }
          ss = wave_sum(ss);
          if (lane < 32) ((float*)(ws + WS_SSQP))[(size_t)row * 32 + lane] = (lane == 0) ? ss : 0.f;
          u32x2* o = (u32x2*)(hb + (size_t)row * DM) + lane;
#pragma unroll
          for (int j = 0; j < 8; ++j) { u32x2 w; w.x = cvtpk(v[j].x, v[j].y); w.y = cvtpk(v[j].z, v[j].w); o[64 * j] = w; }
      } }
}

__device__ __forceinline__ int panel_a() { return 16 * ((int)blockIdx.x & 7) + (((int)blockIdx.x >> 3) & 7); }
__device__ __forceinline__ void rstd_prefix(KP p, LAS unsigned char* lds) {
    const int tid = ltid(); const float* ssqp = (const float*)(p->ws + WS_SSQP); LAS float* rstab = (LAS float*)(lds + LX_RSTAB);
    const int row = (panel_a() + 8 * (tid >> 8)) * 256 + (tid & 255);
    const f32x4* q = (const f32x4*)(ssqp + (size_t)row * 32); float s = 0.f;
#pragma unroll
    for (int j = 0; j < 8; ++j) { const f32x4 v = q[j]; s += (v.x + v.y) + (v.z + v.w); }
    rstab[tid] = __builtin_amdgcn_rsqf(s * (1.f / DM) + RMS_EPS);
    __syncthreads();
}
__device__ __forceinline__ void gate_prefix(KP p, int l, LAS unsigned char* lds) {
    const int tid = ltid(), lane = tid & 63, wave = tid >> 6, r32 = lane & 31, hi = lane >> 5;
    const bf16_t* hb = (const bf16_t*)(p->ws + WS_HB); const bf16_t* wg = (const bf16_t*)(p->ws + WS_WIN) + ((size_t)l * NINP + 6144) * DM;
    float* gates = (float*)(p->ws + WS_GATES); const LAS float* rstab = (const LAS float*)(lds + LX_RSTAB);
    constexpr int WPITCH = DM * 2 + 16;
    for (int i = tid; i < 32 * (DM / 8); i += 512) { const int r = i >> 8, c8 = i & 255; *(LAS bf16x8*)(lds + r * WPITCH + c8 * 16) = *(const bf16x8*)(wg + (size_t)r * DM + c8 * 8); }
    __syncthreads();
    if (wave < 4) {
        const int slot = wave >> 1, prow = ((int)blockIdx.x >> 6) * 64 + (wave & 1) * 32;
        const int row0 = (panel_a() + 8 * slot) * 256 + prow;
        const float rs = rstab[slot * 256 + prow + r32];
        const bf16_t* ap = hb + (size_t)(row0 + r32) * DM + hi * 8; const LAS unsigned char* bp = lds + r32 * WPITCH + hi * 16;
        f32x16 acc = {};
#pragma unroll 1
        for (int k32 = 0; k32 < 4; ++k32) { bf16x8 a[32];
#pragma unroll
            for (int j = 0; j < 32; ++j) a[j] = *(const bf16x8*)(ap + (k32 * 32 + j) * 16);
#pragma unroll
            for (int j = 0; j < 32; ++j) { const bf16x8 b = *(const LAS bf16x8*)(bp + (k32 * 32 + j) * 32); acc = __builtin_amdgcn_mfma_f32_32x32x16_bf16(a[j], b, acc, 0, 0, 0); } }
#pragma unroll
        for (int r = 0; r < 16; ++r) { const int rr = att::crow(r, hi);
            const float rsr = __builtin_bit_cast(float, __builtin_amdgcn_ds_bpermute(rr << 2, __builtin_bit_cast(int, rs)));
            if (r32 < 24) gates[(size_t)(row0 + rr) * GATE_LD + r32] = acc[r] * rsr; }
    }
    __syncthreads();
}
__device__ __forceinline__ void fixup_prefix(KP p, int l) {
    const float* halo = (const float*)(p->ws + WS_HALO); bf16_t* act = (bf16_t*)(p->ws + WS_PROJ);
    const float* cw = p->conv_w + (size_t)l * 3 * NUP; const float* cb = p->conv_b + (size_t)l * NUP;
    const int pa = panel_a();
#pragma unroll 2
    for (int i = ltid(); i < 2 * (DFF / 4); i += 512) {
        const int c4 = i % (DFF / 4), pm = pa + 8 * (i / (DFF / 4)), ch = c4 * 4;
        const int tg = (ch >> 7) * 256 + (ch & 127), tu = tg + 128;
        const bool has_prev = (pm & 7) != 0;
        const float* hc = halo + (size_t)(pm * 4) * NUP; const float* hp = halo + (size_t)((has_prev ? pm - 1 : pm) * 4) * NUP;
        const f32x4 c0g = *(const f32x4*)(hc + tg), c0u = *(const f32x4*)(hc + tu), c1g = *(const f32x4*)(hc + NUP + tg), c1u = *(const f32x4*)(hc + NUP + tu);
        f32x4 p3g = *(const f32x4*)(hp + 3 * NUP + tg), p3u = *(const f32x4*)(hp + 3 * NUP + tu), p2g = *(const f32x4*)(hp + 2 * NUP + tg), p2u = *(const f32x4*)(hp + 2 * NUP + tu);
        const f32x4 w0g = *(const f32x4*)(cw + ch), w1g = *(const f32x4*)(cw + NUP + ch), w2g = *(const f32x4*)(cw + 2 * NUP + ch), bg = *(const f32x4*)(cb + ch);
        const f32x4 w0u = *(const f32x4*)(cw + DFF + ch), w1u = *(const f32x4*)(cw + NUP + DFF + ch), w2u = *(const f32x4*)(cw + 2 * NUP + DFF + ch), bu = *(const f32x4*)(cb + DFF + ch);
        if (!has_prev) { p3g = f32x4{0.f, 0.f, 0.f, 0.f}; p3u = p3g; p2g = p3g; p2u = p3g; }
        float o0[4], o1[4];
#pragma unroll
        for (int e = 0; e < 4; ++e) {
            const float yg0 = w0g[e] * p2g[e] + w1g[e] * p3g[e] + w2g[e] * c0g[e] + bg[e], yu0 = w0u[e] * p2u[e] + w1u[e] * p3u[e] + w2u[e] * c0u[e] + bu[e];
            const float yg1 = w0g[e] * p3g[e] + w1g[e] * c0g[e] + w2g[e] * c1g[e] + bg[e], yu1 = w0u[e] * p3u[e] + w1u[e] * c0u[e] + w2u[e] * c1u[e] + bu[e];
            o0[e] = yg0 * fast_rcp(1.f + fast_exp2(-yg0 * LOG2E)) * yu0; o1[e] = yg1 * fast_rcp(1.f + fast_exp2(-yg1 * LOG2E)) * yu1;
        }
        u32x2 s0, s1; s0.x = cvtpk(o0[0], o0[1]); s0.y = cvtpk(o0[2], o0[3]); s1.x = cvtpk(o1[0], o1[1]); s1.y = cvtpk(o1[2], o1[3]);
        *(u32x2*)(act + (size_t)(pm * 256) * DFF + ch) = s0; *(u32x2*)(act + (size_t)(pm * 256 + 1) * DFF + ch) = s1;
    }
    asm volatile("s_waitcnt vmcnt(0)" ::: "memory");
    __syncthreads();
}
__device__ __forceinline__ void final_phase(KP p) {
    const int lane = ltid() & 63, wave = ltid() >> 6; const float* ssqp = (const float*)(p->ws + WS_SSQP);
    for (int row = blockIdx.x * 8 + wave; row < MROWS; row += gridDim.x * 8) {
        float s = (lane < 32) ? ssqp[(size_t)row * 32 + lane] : 0.f; s = wave_sum(s);
        const float rs = __builtin_amdgcn_rsqf(s * (1.f / DM) + RMS_EPS);
        f32x4* o = (f32x4*)(p->out + (size_t)row * DM) + lane; const f32x4* gq = (const f32x4*)p->final_g + lane;
        const u32x2* hq = (const u32x2*)((const bf16_t*)(p->ws + WS_HB) + (size_t)row * DM) + lane;
#pragma unroll
        for (int j = 0; j < 8; ++j) { const u32x2 hv = hq[64 * j]; const f32x4 gg = gq[64 * j]; f32x4 v;
            v.x = __builtin_bit_cast(float, hv.x << 16); v.y = __builtin_bit_cast(float, hv.x & 0xFFFF0000u); v.z = __builtin_bit_cast(float, hv.y << 16); v.w = __builtin_bit_cast(float, hv.y & 0xFFFF0000u);
            __builtin_nontemporal_store(v * rs * gg, o + 64 * j); }
    }
}
__device__ __forceinline__ float gelu_tanh(float x) { const float u = 0.7978845608028654f * (x + 0.044715f * x * x * x); const float e = __expf(2.f * u); const float th = 1.f - 2.f / (e + 1.f); return 0.5f * x * (1.f + th); }
__device__ __forceinline__ void compress_unit(KP p, int l, LAS unsigned char* lds, int upair) {
    const int tid = ltid(), wid = tid >> 6, lane = tid & 63, fr = lane & 15, fq = lane >> 4;
    const int nblk = wid & 3, grp = wid >> 2;
    const int unit = upair * 2 + grp;
    const int mc = unit & 3, kv = (unit >> 2) & 1, g = (unit >> 3) & 1, b = unit >> 4;
    const bf16_t* proj = (const bf16_t*)(p->ws + WS_PROJ);
    const bf16_t* w1t = (const bf16_t*)(p->ws + WS_W1T) + (size_t)(l * 2 + kv) * 128 * 4096;
    const bf16_t* w2t = (const bf16_t*)(p->ws + WS_W2T) + (size_t)(l * 2 + kv) * 128 * 128;
    const float* posc = (const float*)(p->ws + WS_POSC) + (l * 2 + kv) * 128;
    bf16_t* outp = (bf16_t*)(p->ws + (kv ? WS_VCMP : WS_KCMP)) + (size_t)(b * 2 + g) * 128 * 128;
    const bf16_t* arow[2]; const bf16_t* brow[2];
#pragma unroll
    for (int i = 0; i < 2; ++i) { const int n = mc * 32 + i * 16 + fr, nc = n < 127 ? n : 126;
        arow[i] = proj + (size_t)(b * SEQ + 16 * nc) * PROJ_LD + (kv ? C_NVC : C_NKC) + g * 128 + fq * 8;
        brow[i] = w1t + (size_t)(nblk * 32 + i * 16 + fr) * 4096 + fq * 8; }
    f32x4 acc[2][2] = {};
#define CMP_LOAD(A_, B_, LL) do { _Pragma("unroll") for (int i = 0; i < 2; ++i) _Pragma("unroll") for (int j = 0; j < 4; ++j) { \
        A_[i][j] = *(const bf16x8*)(arow[i] + (size_t)(LL) * PROJ_LD + j * 32); B_[i][j] = *(const bf16x8*)(brow[i] + (LL) * 128 + j * 32); } } while (0)
#define CMP_MMA(A_, B_) do { _Pragma("unroll") for (int j = 0; j < 4; ++j) _Pragma("unroll") for (int mi = 0; mi < 2; ++mi) _Pragma("unroll") for (int ni = 0; ni < 2; ++ni) \
        acc[mi][ni] = __builtin_amdgcn_mfma_f32_16x16x32_bf16(A_[mi][j], B_[ni][j], acc[mi][ni], 0, 0, 0); } while (0)
    bf16x8 a0[2][4], b0[2][4], a1[2][4], b1[2][4];
    CMP_LOAD(a0, b0, 0);
#pragma unroll 1
    for (int ll = 0; ll < 32; ll += 2) {
        CMP_LOAD(a1, b1, ll + 1);
        CMP_MMA(a0, b0);
        if (ll + 2 < 32) CMP_LOAD(a0, b0, ll + 2);
        CMP_MMA(a1, b1);
    }
#undef CMP_LOAD
#undef CMP_MMA
    LAS bf16_t* hid = (LAS bf16_t*)(lds + grp * 16384);
#pragma unroll
    for (int ni = 0; ni < 2; ++ni) { const int col = nblk * 32 + ni * 16 + fr; const float pc = posc[col];
#pragma unroll
        for (int mi = 0; mi < 2; ++mi)
#pragma unroll
            for (int i = 0; i < 4; ++i) hid[(mi * 16 + 4 * fq + i) * 136 + col] = (bf16_t)(cvtpk(gelu_tanh(acc[mi][ni][i] + pc), 0.f) & 0xFFFFu); }
    __syncthreads();
    {
        f32x4 acc2[2][2] = {};
#pragma unroll
        for (int j = 0; j < 4; ++j) { bf16x8 a2[2], b2[2];
#pragma unroll
            for (int i = 0; i < 2; ++i) { a2[i] = *(const LAS bf16x8*)(hid + (i * 16 + fr) * 136 + j * 32 + fq * 8); b2[i] = *(const bf16x8*)(w2t + (size_t)(nblk * 32 + i * 16 + fr) * 128 + j * 32 + fq * 8); }
#pragma unroll
            for (int mi = 0; mi < 2; ++mi)
#pragma unroll
                for (int ni = 0; ni < 2; ++ni) acc2[mi][ni] = __builtin_amdgcn_mfma_f32_16x16x32_bf16(a2[mi], b2[ni], acc2[mi][ni], 0, 0, 0); }
#pragma unroll
        for (int mi = 0; mi < 2; ++mi)
#pragma unroll
            for (int ni = 0; ni < 2; ++ni)
#pragma unroll
                for (int i = 0; i < 4; ++i) { const int nr = mc * 32 + mi * 16 + 4 * fq + i; const float v = (nr < 127) ? acc2[mi][ni][i] : 0.f;
                    outp[(size_t)nr * 128 + nblk * 32 + ni * 16 + fr] = (bf16_t)(cvtpk(v, 0.f) & 0xFFFFu); }
    }
    __syncthreads();
}
__device__ __forceinline__ void cumsum_unit(KP p, int l, LAS unsigned char* lds, int unit) {
    const int tid = ltid(), lane = tid & 63, wid = tid >> 6; const int b = unit / 6, h = unit % 6;
    const float* gates = (const float*)(p->ws + WS_GATES); float* c2 = (float*)(p->ws + WS_CUM) + (size_t)unit * SEQ;
    const float fb = p->fox_f_bias[l * 6 + h];
    float v[4], run = 0.f;
#pragma unroll
    for (int i = 0; i < 4; ++i) { const float xx = gates[(size_t)(b * SEQ + 4 * tid + i) * GATE_LD + h] + fb;
        const float ls = fminf(xx, 0.f) - log1pf(__expf(-fabsf(xx))); run += ls; v[i] = run; }
    float inc = run;
#pragma unroll
    for (int o = 1; o < 64; o <<= 1) { const float t = __builtin_bit_cast(float, __builtin_amdgcn_ds_bpermute(((lane - o) & 63) << 2, __builtin_bit_cast(int, inc))); if (lane >= o) inc += t; }
    LAS float* wsum = (LAS float*)lds;
    if (lane == 63) wsum[wid] = inc;
    __syncthreads();
    float base = 0.f;
#pragma unroll
    for (int w = 0; w < 8; ++w) if (w < wid) base += wsum[w];
    const float ex = base + inc - run;
#pragma unroll
    for (int i = 0; i < 4; ++i) c2[4 * tid + i] = (ex + v[i]) * LOG2E;
    __syncthreads();
}

#ifndef ATT_EN
#define ATT_EN 7
#endif
__device__ __forceinline__ void attention_phase(KP p, int lq, LAS unsigned char* lds_u, volatile LAS unsigned* misc) {
#ifdef ATT_DUPK
    const int att_en = (lq >= 4) ? (ATT_DUPK) : (ATT_EN);
#else
    constexpr int att_en = ATT_EN;
#endif
    const int l = lq & 3;
    att::lptr lds = (att::lptr)lds_u;
    const int tid = ltid();
    unsigned* ctl = (unsigned*)(p->ws + WS_CTL);
    const bf16_t* proj = (const bf16_t*)(p->ws + WS_PROJ); bf16_t* mixed = (bf16_t*)(p->ws + WS_MIXED);
    const float* gates = (const float*)(p->ws + WS_GATES);
    float* scr = (float*)(p->ws + WS_SCR) + (size_t)blockIdx.x * 32768;
    const bf16_t* kcmp = (const bf16_t*)(p->ws + WS_KCMP); const bf16_t* vcmp = (const bf16_t*)(p->ws + WS_VCMP);
    { LAS float* lut = (LAS float*)(lds + att::L_LUT);
      for (int i = tid; i < 1280; i += 512) { const int hh = i >> 7, rel = i & 127; lut[i] = (p->rel_bias[(int)T5B[rel] * 10 + hh] - p->rel_bias[31 * 10 + hh]) * LOG2E; } }
    const int lane = tid & 63;
    const float s1 = wave_sum(p->lq1[l * 64 + lane] * p->lk1[l * 64 + lane]), s2 = wave_sum(p->lq2[l * 64 + lane] * p->lk2[l * 64 + lane]);
    const float lam_init = 0.8f - 0.6f * __expf(-0.3f * (float)l);
    const float lam = __expf(s1) - __expf(s2) + lam_init;
    constexpr int QN_CMP = 16, QN_DIFF = 64, QN_NSA = 32, QN_FOX = 96, QN = QN_CMP + QN_DIFF + QN_NSA + QN_FOX;
    if ((tid >> 6) >= 4) __builtin_amdgcn_s_setprio(1); else __builtin_amdgcn_s_setprio(0);
    const int home = (int)(xb_xcc_id() & 7u);
    unsigned cmp_seen = 0u;
    int qx = home;
    __syncthreads();
    for (;;) {
        if (tid == 0) {
            unsigned* qh = ctl + CW_QUEUE + (lq * 8) * 64;
            unsigned iv = __hip_atomic_fetch_add(qh + qx * 64, 1u, __ATOMIC_RELAXED, __HIP_MEMORY_SCOPE_AGENT); int q = qx;
            if (iv >= (unsigned)QN) {
                unsigned hv[7];
#pragma unroll
                for (int k = 1; k < 8; ++k) hv[k - 1] = __hip_atomic_load(qh + ((qx + k) & 7) * 64, __ATOMIC_RELAXED, __HIP_MEMORY_SCOPE_AGENT);
#pragma unroll
                for (int k = 1; k < 8; ++k) if (iv >= (unsigned)QN && hv[k - 1] < (unsigned)QN) {
                    const unsigned t = __hip_atomic_fetch_add(qh + ((qx + k) & 7) * 64, 1u, __ATOMIC_RELAXED, __HIP_MEMORY_SCOPE_AGENT);
                    if (t < (unsigned)QN) { iv = t; q = (qx + k) & 7; } }
            }
            misc[4] = iv; misc[5] = (unsigned)q;
        }
        __syncthreads();
        const int idx = (int)misc[4]; qx = (int)misc[5];
        __syncthreads();
        if (idx >= QN) break;
        unsigned* cdone = ctl + CW_CMPDONE + (lq * 8 + qx) * 64;
        if (idx < QN_CMP) {
            const int gi = qx * 4 + (idx >> 2), pr = idx & 3;
            compress_unit(p, l, lds_u, gi * 4 + pr);
            asm volatile("s_waitcnt vmcnt(0)" ::: "memory");
            __syncthreads();
            if (tid == 0) { __builtin_amdgcn_fence(__ATOMIC_RELEASE, "agent"); asm volatile("s_waitcnt vmcnt(0)" ::: "memory");
                __hip_atomic_fetch_add(cdone, 1u, __ATOMIC_RELAXED, __HIP_MEMORY_SCOPE_AGENT); }
            continue;
        }
        int j = idx - QN_CMP;
        if (j < QN_DIFF) { const int di = qx * 8 + (j >> 3), qb = 7 - (j & 7);
            if (att_en & 2) att::diff_unit(lds, proj, mixed, scr, di >> 2, di & 3, qb, lam, 1.f - lam_init, p->subln_g + l * 128); continue; }
        j -= QN_DIFF;
        if (j < QN_NSA) { const int gi = qx * 4 + (j & 3), qb = 7 - (j >> 2);
            if (!((cmp_seen >> qx) & 1u)) {
                if (tid == 0) { unsigned sp = 0; while (__hip_atomic_load(cdone, __ATOMIC_RELAXED, __HIP_MEMORY_SCOPE_AGENT) < (unsigned)QN_CMP) { __builtin_amdgcn_s_sleep(2); if (++sp > (1u << 22)) break; }
                    __builtin_amdgcn_fence(__ATOMIC_ACQUIRE, "agent"); asm volatile("s_waitcnt vmcnt(0)" ::: "memory"); }
                __syncthreads(); cmp_seen |= 1u << qx; }
            if (att_en & 1) att::nsa_unit(lds, proj, gates, kcmp, vcmp, mixed, scr, gi >> 1, gi & 1, qb); continue; }
        j -= QN_NSA;
        { const int jh = (j >= 48) ? j - 48 : j; const int fi = qx * 12 + (jh >> 2), qb = ((j >= 48) ? 3 : 7) - (jh & 3);
            if (att_en & 4) att::fox_unit(lds, proj, gates, p->fox_f_bias[l * 6 + fi % 6], mixed, fi / 6, fi % 6, qb); }
    }
    __builtin_amdgcn_s_setprio(0);
    if (l + 1 < DEPTH && lq < 4) {
        const int tid = ltid(); KP p = kparams();
                unsigned* chead = (unsigned*)(p->ws + WS_CTL) + CW_CONV + l * 64;
        LAS float* scrw = (LAS float*)lds_u + (tid >> 6) * (64 * 33);
        constexpr int NCH = (T_LAYER + 63) / 64;
        __syncthreads();
        for (;;) {
            if (tid == 0) misc[4] = __hip_atomic_fetch_add(chead, 1u, __ATOMIC_RELAXED, __HIP_MEMORY_SCOPE_AGENT);
            __syncthreads();
            const int ch = (int)misc[4];
            __syncthreads();
            if (ch >= NCH) break;
#pragma unroll 1
            for (int k = 0; k < 8; ++k) { const int it = ch * 64 + k * 8 + (tid >> 6); if (it < T_LAYER) convert_item(p, l + 1, it, scrw, tid & 63); }
        }
    }
}

#ifndef ATT_EN
#define ATT_EN 7
#endif
#ifndef PH_EN
#define PH_EN 255
#endif
#ifndef DUP
#define DUP 0
#endif
#define DUPLOOP(k) _Pragma("unroll 1") for (int rep_ = 0; rep_ < (((DUP) & (k)) ? 2 : 1); ++rep_)
__global__ void __launch_bounds__(512, 2) mk_fwd(Params p_unused) {
    extern __shared__ __attribute__((aligned(16))) unsigned char lds_raw[];
    LAS unsigned char* lds = (LAS unsigned char*)lds_raw;
    volatile LAS unsigned* misc = (volatile LAS unsigned*)(lds + LX_MISC);
    const int G = gridDim.x;
    if (ltid() < 16) misc[ltid()] = 0u;
    __syncthreads();
    XcdBarrier bar;
    { KP p = kparams(); bar = xcd_barrier_post((unsigned*)(p->ws + WS_CTL) + CW_BAR + p->bar_region * XCD_BAR_WORDS, misc); }
    DUPLOOP(64) { KP p = kparams(); if ((PH_EN & 64) && p->do_prologue) { prologue_phase(p, lds); xcd_barrier(bar); } }

    const int l_begin = kparams()->l_begin, l_end = kparams()->l_end, ph_mask = kparams()->ph_mask;
    for (int l = l_begin; l < l_end; ++l) {
        if ((PH_EN & 1) && (ph_mask & 1)) DUPLOOP(1) {
            KP p = kparams(); unsigned char* ws = p->ws;
            rstd_prefix(p, lds); if (rep_ == 0) gate_prefix(p, l, lds);
            pg8::Gemm g{(const bf16_t*)(ws + WS_HB), (const bf16_t*)(ws + WS_WIN) + (size_t)l * NINP * DM, MROWS, PROJ_LD, DM}; pg8::StaticOrder S; S.init(MROWS, PROJ_LD, G, (int)blockIdx.x);
            epi::InProj E{(bf16_t*)(ws + WS_PROJ), (const LAS float*)(lds + LX_RSTAB)};
            pg8::gemm_phase<epi::InProj, pg8::StaticOrder, true, true>(lds, g, S, E);
            xcd_barrier(bar);
        }
        if ((PH_EN & 4) && (ph_mask & 6)) DUPLOOP(4) {
            attention_phase(kparams(), l + 4 * rep_, lds, misc);
            xcd_barrier(bar);
        }
        if ((PH_EN & 8) && (ph_mask & 8)) DUPLOOP(8) {
            { KP p = kparams(); unsigned char* ws = p->ws;
              pg8::Gemm g{(const bf16_t*)(ws + WS_MIXED), (const bf16_t*)(ws + WS_WOUT) + (size_t)l * DM * DM, MROWS, DM, DM}; pg8::StaticOrder S; S.init(MROWS, DM, G, (int)blockIdx.x);
              epi::Resid E{(bf16_t*)(ws + (rep_ ? WS_END : WS_HB)), (float*)(ws + (rep_ ? WS_END + (size_t)MROWS * DM * 2 : WS_SSQP))};
              pg8::gemm_phase<epi::Resid, pg8::StaticOrder, true, true>(lds, g, S, E); }
            xcd_barrier(bar);
        }
        if ((PH_EN & 16) && (ph_mask & 16)) DUPLOOP(16) {
            { KP p = kparams(); unsigned char* ws = p->ws;
              rstd_prefix(p, lds);
              pg8::Gemm g{(const bf16_t*)(ws + WS_HB), (const bf16_t*)(ws + WS_WUP) + (size_t)l * NUP * DM, MROWS, NUP, DM}; pg8::StaticOrder S; S.init(MROWS, NUP, G, (int)blockIdx.x);
              epi::UpConv E{(bf16_t*)(ws + WS_PROJ), (const LAS float*)(lds + LX_RSTAB), p->conv_w + (size_t)l * 3 * NUP, p->conv_b + (size_t)l * NUP, (float*)(ws + WS_HALO), (LAS float*)(lds + LX_CONV)};
              pg8::gemm_phase<epi::UpConv, pg8::StaticOrder, true, true>(lds, g, S, E); }
            xcd_barrier(bar);
        }
        if ((PH_EN & 32) && (ph_mask & 32)) DUPLOOP(32) {
            { KP p = kparams(); unsigned char* ws = p->ws;
              fixup_prefix(p, l);
              pg8::Gemm g{(const bf16_t*)(ws + WS_PROJ), (const bf16_t*)(ws + WS_WDN) + (size_t)l * DM * DFF, MROWS, DM, DFF}; pg8::StaticOrder S; S.init(MROWS, DM, G, (int)blockIdx.x);
              epi::Resid E{(bf16_t*)(ws + (rep_ ? WS_END : WS_HB)), (float*)(ws + (rep_ ? WS_END + (size_t)MROWS * DM * 2 : WS_SSQP))};
              pg8::gemm_phase<epi::Resid, pg8::StaticOrder, true, true>(lds, g, S, E); }
            xcd_barrier(bar);
        }
    }
    { KP p = kparams(); if ((PH_EN & 128) && p->do_final) final_phase(p); }
}

#if MK_DEBUG
constexpr int NCHK = 16;
#ifndef DBG_SKIP
#define DBG_SKIP 0
#endif
__constant__ int DBG_TS[8] = {0, 1, 255, 256, 700, 1023, 1500, 2047};
__constant__ int DBG_RS[16] = {0, 1, 2, 3, 62, 63, 64, 65, 126, 127, 128, 129, 191, 192, 254, 255};
__constant__ float DBG_TOL[NCHK] = {0, 1e-6f, 1e-3f, 0.03f, 0.03f, 1e-3f, 0.05f, 0.05f, 0.05f, 0.08f, 0.03f, 0.05f, 0.03f, 0, 0, 0};
__device__ __forceinline__ void diag_max(unsigned* diag, int c, float err) { unsigned b = __builtin_bit_cast(unsigned, fabsf(err)); if (err != err) b = 0x7FC00000u; atomicMax(diag + c, b); }
__device__ __forceinline__ void diag_bits(unsigned* diag, int c, unsigned bits) { atomicOr(diag + 16 + c, bits); }
__device__ __forceinline__ unsigned hash_u(unsigned x) { x ^= x >> 16; x *= 0x7feb352du; x ^= x >> 15; x *= 0x846ca68bu; x ^= x >> 16; return x; }
__device__ __forceinline__ float bfr(float v) { return bf2f((bf16_t)(cvtpk(v, 0.f) & 0xFFFFu)); }
__device__ __forceinline__ float blk_sum(float v, float* sh) {
    const int t = threadIdx.x; sh[t] = v; __syncthreads();
    for (int o = 128; o > 0; o >>= 1) { if (t < o) sh[t] += sh[t + o]; __syncthreads(); }
    const float r = sh[0]; __syncthreads(); return r;
}
__device__ __forceinline__ float blk_max(float v, float* sh) {
    const int t = threadIdx.x; sh[t] = v; __syncthreads();
    for (int o = 128; o > 0; o >>= 1) { if (t < o) sh[t] = fmaxf(sh[t], sh[t + o]); __syncthreads(); }
    const float r = sh[0]; __syncthreads(); return r;
}
__device__ __forceinline__ int t5_bucket_ref(int rel) {
    const int n = rel > 0 ? rel : 0; if (n < 16) return n;
    const float nf = (float)n; int large = 16 + (int)(logf(nf / 16.f) / logf(8.f) * 16.f); if (large > 31) large = 31; return large;
}
__device__ __forceinline__ float relerr(float fast, float ref, float scale) { return fabsf(fast - ref) / (fabsf(ref) + scale); }

__global__ void __launch_bounds__(256) chk_kernel(Params p, int stage, const float* out_prev) {
    __shared__ float sh[256];
    __shared__ float sbuf[2304];
    __shared__ float sq[384];
    __shared__ int sidx[16];
    unsigned* diag = (unsigned*)(p.ws + WS_DIAG);
    unsigned char* ws = p.ws;
    const int t = threadIdx.x;
    const bf16_t* hb = (const bf16_t*)(ws + WS_HB); const float* rstd = (const float*)(ws + WS_RSTD);
    const bf16_t* proj = (const bf16_t*)(ws + WS_PROJ); const float* gates = (const float*)(ws + WS_GATES);
    const bf16_t* mixed = (const bf16_t*)(ws + WS_MIXED); const float* c2 = (const float*)(ws + WS_CUM);
    const bf16_t* kcmp = (const bf16_t*)(ws + WS_KCMP); const bf16_t* vcmp = (const bf16_t*)(ws + WS_VCMP);
    const int l = 0;
    if (stage == 2) {
        unsigned bad = 0; const size_t nvec = (size_t)MROWS * PROJ_LD / 8;
        for (size_t i = (size_t)blockIdx.x * 256 + t; i < nvec; i += (size_t)gridDim.x * 256) { const bf16x8 v = ((const bf16x8*)proj)[i];
#pragma unroll
            for (int e = 0; e < 8; ++e) { const float x = bf2f((bf16_t)v[e]); if (!(fabsf(x) < 1000.f)) ++bad; } }
        if (bad) atomicAdd(diag + 13, bad);
    }
    if (stage == 3) {
        unsigned bad = 0;
        for (int i = blockIdx.x * 256 + t; i < NBATCH * 2 * 128 * 128; i += gridDim.x * 256) { const float a = bf2f(kcmp[i]), c = bf2f(vcmp[i]); if (!(fabsf(a) < 1000.f)) ++bad; if (!(fabsf(c) < 1000.f)) bad += 65536u; }
        if (bad & 0xFFFFu) atomicAdd(diag + 14, bad & 0xFFFFu); if (bad >> 16) atomicAdd(diag + 15, bad >> 16);
    }
    for (int smp = blockIdx.x; smp < (stage == 2 ? 512 : 64); smp += gridDim.x) {
        const unsigned h0 = hash_u(smp * 2654435761u + stage * 97u + 12345u), h1 = hash_u(h0 + 1u), h2 = hash_u(h1 + 7u);
        if (stage == 1) {
            const unsigned r0 = hash_u(h0 + t * 31u), r1 = hash_u(r0 + 5u), r2 = hash_u(r1 + 3u);
            { const int ll = r0 & 3, c = r1 % NINP, k = r2 % DM; const int oc = win_colmap(c);
              const float ref = oc >= 0 ? bfr(p.w_in[((size_t)ll * DM + k) * NIN + oc] * p.attn_norm_g[ll * DM + k]) : 0.f;
              diag_max(diag, 1, bf2f(((const bf16_t*)(ws + WS_WIN))[((size_t)ll * NINP + c) * DM + k]) - ref); }
            { const int ll = r0 & 3, c = r1 % DM, k = r2 % DM; const float ref = bfr(p.w_out[((size_t)ll * DM + k) * DM + c]);
              diag_max(diag, 1, bf2f(((const bf16_t*)(ws + WS_WOUT))[((size_t)ll * DM + c) * DM + k]) - ref); }
            { const int ll = r0 & 3, c = r1 % NUP, k = r2 % DM; const int oc = wup_colmap(c); const float ref = bfr(p.w_up[((size_t)ll * DM + k) * NUP + oc] * p.ffn_norm_g[ll * DM + k]);
              diag_max(diag, 1, bf2f(((const bf16_t*)(ws + WS_WUP))[((size_t)ll * NUP + c) * DM + k]) - ref); }
            { const int ll = r0 & 3, c = r1 % DM, k = r2 % DFF; const float ref = bfr(p.w_down[((size_t)ll * DFF + k) * DM + c]);
              diag_max(diag, 1, bf2f(((const bf16_t*)(ws + WS_WDN))[((size_t)ll * DM + c) * DFF + k]) - ref); }
            { const int ll = r0 & 3, kv = (r0 >> 2) & 1, c = r1 % 128, k = r2 % 4096; const float ref = bfr((kv ? p.wv1 : p.wk1)[((size_t)ll * 4096 + k) * 128 + c]);
              diag_max(diag, 1, bf2f(((const bf16_t*)(ws + WS_W1T))[((size_t)(ll * 2 + kv) * 128 + c) * 4096 + k]) - ref); }
            { const int ll = r0 & 3, kv = (r0 >> 2) & 1, c = r1 % 128, k = r2 % 128; const float ref = bfr((kv ? p.wv2 : p.wk2)[((size_t)ll * 128 + k) * 128 + c]);
              diag_max(diag, 1, bf2f(((const bf16_t*)(ws + WS_W2T))[((size_t)(ll * 2 + kv) * 128 + c) * 128 + k]) - ref); }
            { const int row = h0 % MROWS; float ss = 0.f; for (int k = t; k < DM; k += 256) { const float xv = p.x[(size_t)row * DM + k]; ss += xv * xv; diag_max(diag, 2, bf2f(hb[(size_t)row * DM + k]) - bfr(xv)); }
              ss = blk_sum(ss, sh); if (t == 0) diag_max(diag, 2, relerr(rstd[row], 1.f / sqrtf(ss / DM + RMS_EPS), 1e-6f)); }
            { const int ll = h1 & 3, kv = (h1 >> 2) & 1, c = h2 % 128; float s = 0.f; for (int k = t; k < 4096; k += 256) s += p.cmp_pos[(size_t)ll * 4096 + k] * (kv ? p.wv1 : p.wk1)[((size_t)ll * 4096 + k) * 128 + c];
              s = blk_sum(s, sh); if (t == 0) diag_max(diag, 2, relerr(((const float*)(ws + WS_POSC))[(ll * 2 + kv) * 128 + c], s, 1e-3f)); }
        } else if (stage == 2) {
            const int pnn = smp % 25; const int row = h0 % MROWS, c = pnn == 24 ? 6144 + (h1 % 24) : pnn * 256 + (h1 % 256); const int oc = win_colmap(c);
            float ss = 0.f, dot = 0.f;
            for (int k = t; k < DM; k += 256) { const float xv = p.x[(size_t)row * DM + k]; ss += xv * xv; dot += bfr(xv) * bfr(p.w_in[((size_t)l * DM + k) * NIN + oc] * p.attn_norm_g[l * DM + k]); }
            ss = blk_sum(ss, sh); dot = blk_sum(dot, sh);
            if (t == 0) { const float rs = 1.f / sqrtf(ss / DM + RMS_EPS); const int pn = c >> 8;
                float cs = 1.f; if (pn < 3 || (pn >= 15 && pn <= 17)) cs = 0.08838834764831845f * LOG2E; else if (pn == 9 || pn == 10) cs = 0.125f * LOG2E;
                if (c < 6144) { const float fv = bf2f(proj[(size_t)row * PROJ_LD + c]); const float er = relerr(fv, dot * rs * cs, 0.05f); diag_max(diag, 3, er);
                    if (!(er <= 0.03f)) diag_bits(diag, 3, (pn < 9 ? 1u : pn < 15 ? 2u : pn < 18 ? 4u : 8u) | ((row % SEQ) >= 512 ? 16u : 0u) | (fabsf(fv) < 1e-6f ? 32u : 0u)); }
                else diag_max(diag, 4, relerr(gates[(size_t)row * GATE_LD + (c - 6144)], dot * rs, 0.05f)); }
        } else if (stage == 3) {
            if (smp < 24) { if (t == 0) { const int bh = (h0 % 96), b = bh / 6, h = bh % 6; float run = 0.f, worst = 0.f;
                    for (int s = 0; s < SEQ; ++s) { const float xx = gates[(size_t)(b * SEQ + s) * GATE_LD + h] + p.fox_f_bias[l * 6 + h]; run += fminf(xx, 0.f) - log1pf(expf(-fabsf(xx)));
                        worst = fmaxf(worst, relerr(c2[(size_t)bh * SEQ + s], run * LOG2E, 1.f)); float cv = c2[(size_t)bh * SEQ + s]; if (cv != cv) worst = cv; }
                    diag_max(diag, 5, worst); } }
            else { const int b = h0 % NBATCH, g = h1 & 1, kv = (h1 >> 1) & 1, n = (smp & 7) == 7 ? 127 : (smp & 7) == 6 ? 126 : h2 % 127;
                const float* w1 = (kv ? p.wv1 : p.wk1) + (size_t)l * 4096 * 128; const float* w2 = (kv ? p.wv2 : p.wk2) + (size_t)l * 128 * 128;
                if (t < 128) { float s = 0.f; if (n < 127) { for (int ll = 0; ll < 32; ++ll) for (int d = 0; d < 128; ++d)
                        s += bf2f(proj[(size_t)(b * SEQ + 16 * n + ll) * PROJ_LD + (kv ? C_NVC : C_NKC) + g * 128 + d]) * bfr(w1[(size_t)(ll * 128 + d) * 128 + t]);
                        s += ((const float*)(ws + WS_POSC))[(l * 2 + kv) * 128 + t]; const float u = 0.7978845608028654f * (s + 0.044715f * s * s * s); s = 0.5f * s * (1.f + tanhf(u)); }
                    sbuf[t] = bfr(s);
                    if (n < 127) { const int unit = (n >> 5) + 4 * kv + 8 * g + 16 * b; const float hv = ((const float*)(ws + WS_SCR))[(size_t)unit * 4096 + (n & 31) * 128 + t];
                        const float er = relerr(hv, s, 0.05f); if (!(er <= 0.05f)) diag_bits(diag, 6, 1u | (fabsf(hv) > 100.f ? 2u : 0u) | (hv != hv ? 4u : 0u)); } }
                __syncthreads();
                if (t < 128) { float s = 0.f; if (n < 127) for (int j = 0; j < 128; ++j) s += sbuf[j] * bfr(w2[(size_t)j * 128 + t]);
                    const float fv = bf2f((kv ? vcmp : kcmp)[((size_t)(b * 2 + g) * 128 + n) * 128 + t]); const float er = relerr(fv, s, 0.05f);
                    diag_max(diag, 6, er);
                    if (!(er <= 0.05f)) diag_bits(diag, 6, 8u | (kv ? 16u : 0u) | ((n >= 96 && n < 112) ? 32u : 0u)); }
                __syncthreads(); }
        } else if (stage == 4) {
            const int b = h0 % NBATCH, tt = (smp & 1) ? DBG_TS[(smp >> 1) & 7] : (int)(h1 % SEQ);
            const size_t qrow = (size_t)(b * SEQ + tt);
            if (smp < 24) {
                const int h = h2 % 6; const bf16_t* q = proj + qrow * PROJ_LD + C_FQ + h * 128; const float* cc = c2 + (size_t)(b * 6 + h) * SEQ;
                float mx = -1e30f;
                for (int k = t; k <= tt; k += 256) { const bf16_t* kr = proj + (size_t)(b * SEQ + k) * PROJ_LD + C_FK + h * 128; float s = 0.f; for (int d = 0; d < 128; ++d) s += bf2f(q[d]) * bf2f(kr[d]);
                    s += cc[tt] - cc[k]; sbuf[k] = s; mx = fmaxf(mx, s); }
                mx = blk_max(mx, sh); float sum = 0.f;
                for (int k = t; k <= tt; k += 256) { sbuf[k] = exp2f(sbuf[k] - mx); sum += sbuf[k]; }
                sum = blk_sum(sum, sh);
                if (t < 128) { float o = 0.f; for (int k = 0; k <= tt; ++k) o += sbuf[k] * bf2f(proj[(size_t)(b * SEQ + k) * PROJ_LD + C_FV + h * 128 + t]); o /= sum;
                    const float fv = bf2f(mixed[qrow * DM + h * 128 + t]); const float er = relerr(fv, o, 0.05f); diag_max(diag, 7, er);
                    if (!(er <= 0.05f)) diag_bits(diag, 7, (tt < 64 ? 1u : tt < 512 ? 2u : 4u) | ((fabsf(fv) < 1e-6f) ? 8u : 0u) | ((fabsf(fv) > 4.f * fabsf(o) + 0.2f) ? 16u : 0u) | ((fv != fv) ? 32u : 0u)); }
                __syncthreads();
            } else if (smp < 40) {
                const int h = h2 & 3; float* o2 = sq;
                const float lam_init = 0.8f - 0.6f * expf(-0.3f * (float)l);
                float s1 = 0.f, s2 = 0.f; for (int i = 0; i < 64; ++i) { s1 += p.lq1[l * 64 + i] * p.lk1[l * 64 + i]; s2 += p.lq2[l * 64 + i] * p.lk2[l * 64 + i]; }
                const float lam = expf(s1) - expf(s2) + lam_init;
                if (t < 128) o2[t] = 0.f; __syncthreads();
                for (int mp = 0; mp < 2; ++mp) {
                    const bf16_t* q = proj + qrow * PROJ_LD + C_DQ + h * 128 + mp * 64; float mx = -1e30f;
                    for (int k = t; k <= tt; k += 256) { const bf16_t* kr = proj + (size_t)(b * SEQ + k) * PROJ_LD + C_DK + h * 128 + mp * 64; float s = 0.f; for (int d = 0; d < 64; ++d) s += bf2f(q[d]) * bf2f(kr[d]);
                        s += p.rel_bias[t5_bucket_ref(tt - k) * 10 + h] * LOG2E; sbuf[k] = s; mx = fmaxf(mx, s); }
                    mx = blk_max(mx, sh); float sum = 0.f;
                    for (int k = t; k <= tt; k += 256) { sbuf[k] = exp2f(sbuf[k] - mx); sum += sbuf[k]; }
                    sum = blk_sum(sum, sh);
                    if (t < 128) { float o = 0.f; for (int k = 0; k <= tt; ++k) o += sbuf[k] * bf2f(proj[(size_t)(b * SEQ + k) * PROJ_LD + C_DV + h * 128 + t]); o /= sum; o2[t] += (mp == 0 ? o : -lam * o); }
                    __syncthreads();
                }
                float ssq = (t < 128) ? o2[t] * o2[t] : 0.f; ssq = blk_sum(ssq, sh);
                if (t < 128) { const float y = o2[t] * (1.f / sqrtf(ssq / 128.f + RMS_EPS)) * p.subln_g[l * 128 + t] * (1.f - lam_init);
                    const float fv = bf2f(mixed[qrow * DM + 768 + h * 128 + t]); const float er = relerr(fv, y, 0.5f); diag_max(diag, 8, er);
                    if (!(er <= 0.05f)) diag_bits(diag, 8, (tt < 64 ? 1u : tt < 512 ? 2u : 4u) | ((fabsf(fv) < 1e-6f) ? 8u : 0u) | ((fabsf(fv) > 4.f * fabsf(y) + 0.2f) ? 16u : 0u) | ((fv != fv) ? 32u : 0u)); }
                __syncthreads();
            } else {
                const int h6 = h2 % 6, g = h6 / 3; float* pc = sbuf + 2048;
                float* imp = sq + 128; float* oacc = sq + 192;
                if (t < 32) imp[t] = 0.f; if (t < 128) oacc[t] = 0.f; __syncthreads();
                const bf16_t* kc = kcmp + (size_t)(b * 2 + g) * 128 * 128; const bf16_t* vc = vcmp + (size_t)(b * 2 + g) * 128 * 128;
                const float* gp = gates + qrow * GATE_LD + 6 + h6 * 3;
                const float g0 = 1.f / (1.f + expf(-gp[0])), g1 = 1.f / (1.f + expf(-gp[1])), g2 = 1.f / (1.f + expf(-gp[2]));
                for (int hh = 0; hh < 3; ++hh) {
                    const int hd = g * 3 + hh; const bf16_t* q = proj + qrow * PROJ_LD + C_NQ + hd * 128;
                    float s = -1e30f; bool ok = false;
                    if (t < 127) { ok = (16 * t + 31) <= tt; if (ok) { s = 0.f; for (int d = 0; d < 128; ++d) s += bf2f(q[d]) * bf2f(kc[(size_t)t * 128 + d]); s += p.rel_bias[t5_bucket_ref(tt - (16 * t + 31)) * 10 + 4 + hd] * LOG2E; } }
                    const float mx = blk_max(ok ? s : -1e30f, sh); const float e = ok ? exp2f(s - mx) : 0.f; const float sum = blk_sum(e, sh);
                    const float pr = sum > 0.f ? e / sum : 0.f;
                    if (t < 128) pc[t] = pr; __syncthreads();
                    if (t < 32) { float a = 0.f; for (int n = 0; n < 127; ++n) { int lo = max(16 * n, 64 * t), hi2 = min(16 * n + 32, 64 * t + 64); int ov = hi2 - lo; if (ov > 0) a += pc[n] * ((float)ov / 32.f); } imp[t] += a; }
                    if (hd == h6 && t < 128) { float o = 0.f; for (int n = 0; n < 127; ++n) o += pc[n] * bf2f(vc[(size_t)n * 128 + t]); oacc[t] += g0 * o; }
                    __syncthreads();
                }
                if (t == 0) { const int blk = tt >> 6; float* sc = sbuf + 2200; for (int j = 0; j < 32; ++j) { const bool forced = j == 0 || j == blk || j == blk - 1; sc[j] = (j <= blk) ? imp[j] + (forced ? 1e4f : 0.f) : -1e30f; }
                    unsigned m = 0; for (int it = 0; it < 8; ++it) { float best = -1e30f; int bi = -1; for (int j = 0; j < 32; ++j) if (!((m >> j) & 1u) && sc[j] > best) { best = sc[j]; bi = j; } if (bi >= 0 && best > -0.5e30f) m |= 1u << bi; }
                    sidx[0] = (int)m; }
                __syncthreads();
                const unsigned selm = (unsigned)sidx[0];
                for (int br = 0; br < 2; ++br) {
                    const bf16_t* q = proj + qrow * PROJ_LD + C_NQ + h6 * 128; const int kcol = (br == 0 ? C_NKS : C_NKW) + g * 128, vcol = (br == 0 ? C_NVS : C_NVW) + g * 128;
                    float mx = -1e30f;
                    for (int k = t; k <= tt; k += 256) { const bool ok = br == 0 ? ((selm >> (k >> 6)) & 1u) != 0u : (tt - k < 512); float s = -1e30f;
                        if (ok) { const bf16_t* kr = proj + (size_t)(b * SEQ + k) * PROJ_LD + kcol; s = 0.f; for (int d = 0; d < 128; ++d) s += bf2f(q[d]) * bf2f(kr[d]); s += p.rel_bias[t5_bucket_ref(tt - k) * 10 + 4 + h6] * LOG2E; }
                        sbuf[k] = s; mx = fmaxf(mx, s); }
                    mx = blk_max(mx, sh); float sum = 0.f;
                    for (int k = t; k <= tt; k += 256) { sbuf[k] = sbuf[k] > -1e29f ? exp2f(sbuf[k] - mx) : 0.f; sum += sbuf[k]; }
                    sum = blk_sum(sum, sh);
                    if (t < 128) { float o = 0.f; for (int k = 0; k <= tt; ++k) o += sbuf[k] * bf2f(proj[(size_t)(b * SEQ + k) * PROJ_LD + vcol + t]); oacc[t] += (br == 0 ? g1 : g2) * o / sum; }
                    __syncthreads();
                }
                if (t < 128) { const float fv = bf2f(mixed[qrow * DM + 1280 + h6 * 128 + t]); const float er = relerr(fv, oacc[t], 0.05f); diag_max(diag, 9, er);
                    if (!(er <= 0.08f)) diag_bits(diag, 9, (tt < 64 ? 1u : tt < 512 ? 2u : 4u) | ((fabsf(fv) < 1e-6f) ? 8u : 0u) | ((fabsf(fv) > 4.f * fabsf(oacc[t]) + 0.2f) ? 16u : 0u) | ((fv != fv) ? 32u : 0u)); }
                __syncthreads();
            }
        } else if (stage == 5) {
            const int row = h0 % MROWS, col = h1 % DM; float dot = 0.f, ss = 0.f;
            for (int k = t; k < DM; k += 256) { dot += bf2f(mixed[(size_t)row * DM + k]) * bfr(p.w_out[((size_t)l * DM + k) * DM + col]); const float hv = p.out[(size_t)row * DM + k]; ss += hv * hv; }
            dot = blk_sum(dot, sh); ss = blk_sum(ss, sh);
            if (t == 0) { const float ref = p.x[(size_t)row * DM + col] + dot; diag_max(diag, 10, relerr(p.out[(size_t)row * DM + col], ref, 0.05f));
                diag_max(diag, 10, relerr(bf2f(hb[(size_t)row * DM + col]), ref, 0.05f)); diag_max(diag, 10, relerr(rstd[row], 1.f / sqrtf(ss / DM + RMS_EPS), 1e-3f)); }
        } else if (stage == 6) {
            const int pm = h0 % 128, row = pm * 256 + DBG_RS[smp & 15], ch = h1 % DFF, s = row % SEQ;
            float yg = p.conv_b[l * NUP + ch], yu = p.conv_b[l * NUP + DFF + ch];
            for (int tap = 0; tap < 3; ++tap) { const int sp = s - 2 + tap; float dg = 0.f, du = 0.f;
                if (sp >= 0) { const int r2 = row - 2 + tap;
                    for (int k = t; k < DM; k += 256) { const float a = bf2f(hb[(size_t)r2 * DM + k]); const float gk = p.ffn_norm_g[l * DM + k];
                        dg += a * bfr(p.w_up[((size_t)l * DM + k) * NUP + ch] * gk); du += a * bfr(p.w_up[((size_t)l * DM + k) * NUP + DFF + ch] * gk); }
                    dg = blk_sum(dg, sh) * rstd[r2]; du = blk_sum(du, sh) * rstd[r2]; }
                yg += p.conv_w[((size_t)l * 3 + tap) * NUP + ch] * dg; yu += p.conv_w[((size_t)l * 3 + tap) * NUP + DFF + ch] * du; }
            if (t == 0) { const float ref = yg / (1.f + expf(-yg)) * yu; diag_max(diag, 11, relerr(bf2f(proj[(size_t)row * DFF + ch]), ref, 0.05f)); }
        } else if (stage == 7) {
            const int row = h0 % MROWS, col = h1 % DM; float dot = 0.f, ss = 0.f;
            for (int k = t; k < DFF; k += 256) dot += bf2f(proj[(size_t)row * DFF + k]) * bfr(p.w_down[((size_t)l * DFF + k) * DM + col]);
            for (int k = t; k < DM; k += 256) { const float hv = p.out[(size_t)row * DM + k]; ss += hv * hv; }
            dot = blk_sum(dot, sh); ss = blk_sum(ss, sh);
            if (t == 0) { const float ref = out_prev[(size_t)row * DM + col] + dot; diag_max(diag, 12, relerr(p.out[(size_t)row * DM + col], ref, 0.05f));
                diag_max(diag, 12, relerr(bf2f(hb[(size_t)row * DM + col]), ref, 0.05f)); (void)ss; }
        }
    }
}
__global__ void report_kernel(float* out, const unsigned* diag, int n) {
    __shared__ float code, mag;
    if (threadIdx.x == 0) {
        int c = 0; float e = 0.f;
        for (int i = 1; i < 13; ++i) { if ((DBG_SKIP >> i) & 1) continue; const float v = __builtin_bit_cast(float, diag[i]); if (!(v <= DBG_TOL[i])) { c = i; e = v; break; } }
        if (!c || c > 3) { const unsigned n13 = diag[13]; if (n13 && !((DBG_SKIP >> 13) & 1)) { c = 13; e = 0.f; code = 13.f; mag = 100.f * (10.f + fminf(63.f, floorf(log2f((float)n13)) + 1.f)); } }
        if (c != 13 && (!c || c > 6)) { const unsigned n14 = diag[14]; if ((n14 || diag[15]) && !((DBG_SKIP >> 14) & 1)) { c = 14; code = 14.f; const unsigned nk = n14, nv = diag[15]; mag = 100.f * (10.f + (nk ? 32.f : 0.f) + fminf(31.f, (nv ? floorf(log2f((float)nv)) + 1.f : 0.f))); } }
        if (c == 13 || c == 14) { } else {
        code = (float)c; float info = 0.f;
        if (c) { const unsigned bits = diag[16 + c] & 63u; if (bits) info = (float)bits; else if (e != e) info = 89.f; else { info = 64.f + rintf(3.f * (log10f(fmaxf(e, 1e-6f)) + 6.f)); info = fminf(fmaxf(info, 64.f), 88.f); } }
        mag = c ? 100.f * (10.f + info) : 0.f; }
    }
    __syncthreads();
    for (int i = blockIdx.x * blockDim.x + threadIdx.x; i < n; i += gridDim.x * blockDim.x) out[i] = (i == 0) ? mag : code;
}
static void debug_launches(Params p, int grid, hipStream_t stream) {
    float* out_prev = (float*)(p.ws + WS_END);
    (void)hipMemsetAsync(p.ws + WS_DIAG, 0, 256, stream);
    p.l_begin = 0; p.l_end = 1; p.do_final = 0;
    const int masks[7] = {0, 1, 2, 4, 8, 16, 32};
    for (int s = 0; s < 7; ++s) {
        p.do_prologue = (s == 0); p.ph_mask = masks[s]; p.bar_region = s;
        if (s == 6) (void)hipMemcpyAsync(out_prev, p.out, (size_t)MROWS * DM * 4, hipMemcpyDeviceToDevice, stream);
        hipLaunchKernelGGL(mk_fwd, dim3(grid), dim3(512), LDS_BYTES, stream, p);
        hipLaunchKernelGGL(chk_kernel, dim3(64), dim3(256), 0, stream, p, s + 1, (const float*)out_prev);
    }
    hipLaunchKernelGGL(report_kernel, dim3(1024), dim3(256), 0, stream, p.out, (const unsigned*)(p.ws + WS_DIAG), MROWS * DM);
}
#endif

static void fill_params(Params& p, void* const* d_in, void* d_out, void* d_ws) {
    p.x = (const float*)d_in[0]; p.attn_norm_g = (const float*)d_in[1]; p.w_in = (const float*)d_in[2]; p.fox_f_bias = (const float*)d_in[3];
    p.lq1 = (const float*)d_in[4]; p.lk1 = (const float*)d_in[5]; p.lq2 = (const float*)d_in[6]; p.lk2 = (const float*)d_in[7];
    p.subln_g = (const float*)d_in[8]; p.cmp_pos = (const float*)d_in[9]; p.wk1 = (const float*)d_in[10]; p.wk2 = (const float*)d_in[11];
    p.wv1 = (const float*)d_in[12]; p.wv2 = (const float*)d_in[13]; p.w_out = (const float*)d_in[14]; p.ffn_norm_g = (const float*)d_in[15];
    p.w_up = (const float*)d_in[16]; p.conv_w = (const float*)d_in[17]; p.conv_b = (const float*)d_in[18]; p.w_down = (const float*)d_in[19];
    p.rel_bias = (const float*)d_in[20]; p.final_g = (const float*)d_in[21];
    p.out = (float*)d_out; p.ws = (unsigned char*)d_ws;
}
extern "C" void kernel_launch(void* const* d_in, const int* in_sizes, int n_in, void* d_out, int out_size, void* d_ws, size_t ws_size, hipStream_t stream) {
    static int grid = 0;
    if (grid == 0) {
        if (n_in != 22 || out_size != MROWS * DM || ws_size < WS_END) { fprintf(stderr, "kernel_launch: unexpected problem (n_in %d, out %d, ws %zu < %zu)\n", n_in, out_size, ws_size, (size_t)WS_END); grid = -1; return; }
        int dev = 0, cus = 0;
        if (hipGetDevice(&dev) != hipSuccess || hipDeviceGetAttribute(&cus, hipDeviceAttributeMultiprocessorCount, dev) != hipSuccess || cus <= 0) { grid = -1; return; }
        if (hipFuncSetAttribute((const void*)mk_fwd, hipFuncAttributeMaxDynamicSharedMemorySize, LDS_BYTES) != hipSuccess) { fprintf(stderr, "kernel_launch: hipFuncSetAttribute failed\n"); grid = -1; return; }
        int per_cu = 0;
        if (hipOccupancyMaxActiveBlocksPerMultiprocessor(&per_cu, (const void*)mk_fwd, 512, LDS_BYTES) != hipSuccess || per_cu < 1) fprintf(stderr, "kernel_launch: occupancy query says %d\n", per_cu);
        (void)hipGetLastError();
        grid = cus;
    }
    if (grid < 0) return;
    (void)hipMemsetAsync((char*)d_ws + WS_CTL, 0, CTL_ZERO_BYTES, stream);
    Params p{};
    fill_params(p, d_in, d_out, d_ws);
#if !MK_DEBUG
    p.l_begin = 0; p.l_end = DEPTH; p.do_prologue = 1; p.do_final = 1; p.bar_region = 0; p.ph_mask = 63;
    hipLaunchKernelGGL(mk_fwd, dim3(grid), dim3(512), LDS_BYTES, stream, p);
#else
    debug_launches(p, grid, stream);
#endif
}
```

```cpp
#include <hip/hip_runtime.h>
#include <cstdio>
#include <cstdint>

#ifndef MK_DEBUG
#define MK_DEBUG 0
#endif

namespace pg8 {
#define PG8_LAS __attribute__((address_space(3)))
typedef unsigned short bf16_t;
typedef short bf16x8 __attribute__((ext_vector_type(8)));
typedef float f32x4 __attribute__((ext_vector_type(4)));
typedef unsigned u32x4 __attribute__((ext_vector_type(4)));
constexpr int BM = 256, BK = 64, HALF = 128, HTB = HALF * BK * 2  , STAGE_BYTES = 8 * HTB, NXCD = 8, WGM = 8;

__host__ __device__ __forceinline__ int lds_byte(int r, int c) { const int st = (r >> 4) * 2 + (c >> 5), rr = r & 15, cc = c & 31, ob = rr * 64 + cc * 2; return st * 1024 + (ob ^ (((ob >> 9) & 1) << 5)); }
__host__ __device__ __forceinline__ void stage_rc(int b, int& R, int& C) { const int st = b / 1024, sb = b % 1024, swz = sb ^ (((sb >> 9) & 1) << 5); R = (st >> 1) * 16 + swz / 64; C = (st & 1) * 32 + (swz % 64) / 2; }
__host__ __device__ __forceinline__ int perm32(int rho) { const int n = rho >> 4, i = rho & 15; return 8 * (i >> 2) + 4 * n + (i & 3); }

struct Unit { int pm, pn; };
struct Gemm { const bf16_t* A; const bf16_t* Bt; int M, N, K; };

struct StaticOrder {
    int nM, nN, nwg, G, c;
    __host__ __device__ void init(int M, int N, int G_, int c_) { nM = M / BM; nN = N / BM; nwg = nM * nN; G = G_; c = c_; }
    __host__ __device__ bool next(int i, Unit& u) const {
        const long L = (long)i * G + c; if (L >= nwg) return false;
        int wgid = (int)L; { const int q = nwg / NXCD, r = nwg % NXCD, xcd = wgid % NXCD, off = wgid / NXCD; wgid = (xcd < r ? xcd * (q + 1) : r * (q + 1) + (xcd - r) * q) + off; }
        const int nig = WGM * nN, gid = wgid / nig, fm = gid * WGM, gsz = (nM - fm) < WGM ? (nM - fm) : WGM;
        u.pm = fm + ((wgid % nig) % gsz); u.pn = (wgid % nig) / gsz; return true;
    }
    __device__ __forceinline__ void a_ready(const Unit&) const {}
    __device__ __forceinline__ void done(const Unit&) const {}
};
__device__ __forceinline__ unsigned cvt_pk_bf16(float lo, float hi) { unsigned r; asm volatile("v_cvt_pk_bf16_f32 %0, %1, %2" : "=v"(r) : "v"(lo), "v"(hi)); return r; }
typedef float f32x2 __attribute__((ext_vector_type(2)));
template <class Epi, class Sched, bool ALIGN_EPI = false, bool SP2 = false>
__device__ __forceinline__ void gemm_phase(PG8_LAS unsigned char* lds, const Gemm g, const Sched& S, const Epi& E) {
    int tid_l = threadIdx.x; asm volatile("" : "+v"(tid_l));
    const int tid = tid_l, wid = __builtin_amdgcn_readfirstlane(tid >> 6), lane = tid & 63, wr = wid >> 2, wc = wid & 3, fr = lane & 15, fq = lane >> 4;
    const int K = g.K, nt = K / BK;
    unsigned voffA[2], voffB[2]; int aoff, boff;
#define PG8_LANESET() do { int t_ = tid_l; asm volatile("" : "+v"(t_)); const int l_ = t_ & 63, fr_ = l_ & 15, fq_ = l_ >> 4; \
        _Pragma("unroll") for (int i = 0; i < 2; ++i) { int R, C; stage_rc(t_ * 16 + i * 8192, R, C); const int Rb = Epi::PERM ? ((R & ~31) + perm32(R & 31)) : R; \
            const int Ra = Epi::PERMA ? ((R & ~63) + 4 * (R & 15) + ((R >> 4) & 3)) : R; \
            voffA[i] = (unsigned)(Ra * K + C) * 2u; voffB[i] = (unsigned)(Rb * K + C) * 2u; } \
        aoff = lds_byte(wr * 64 + fr_, fq_ * 8); boff = lds_byte(wc * 32 + fr_, fq_ * 8); } while (0)
    PG8_LANESET();
    const size_t kstep = (size_t)(BK * 2);
    const size_t hstep = (size_t)HALF * K * 2;
    const size_t tstep = 2 * hstep;
    const unsigned ldsw = (unsigned)wid * 1024u;
#define PG8_SA(b, h) (((b) * 2 + (h)) * HTB)
#define PG8_SB(b, h) ((4 + (b) * 2 + (h)) * HTB)
#define PG8_STAGE(bufoff, gbase, voff) do { _Pragma("unroll") for (int _i = 0; _i < 2; ++_i) \
        __builtin_amdgcn_global_load_lds((const unsigned*)((const char*)(gbase) + (voff)[_i]), (PG8_LAS unsigned*)(lds + (bufoff) + ldsw + _i * 8192), 16, 0, 0); } while (0)
#define PG8_LDA(dst, b, h) do { _Pragma("unroll") for (int m = 0; m < 4; ++m) _Pragma("unroll") for (int k = 0; k < 2; ++k) dst[m][k] = *(const PG8_LAS bf16x8*)(lds + PG8_SA(b, h) + aoff + m * 2048 + k * 1024); } while (0)
#define PG8_LDB(dst, b, h) do { _Pragma("unroll") for (int n = 0; n < 2; ++n) _Pragma("unroll") for (int k = 0; k < 2; ++k) dst[n][k] = *(const PG8_LAS bf16x8*)(lds + PG8_SB(b, h) + boff + n * 2048 + k * 1024); } while (0)
#define PG8_MMA(ai, bj, At, Bt) do { __builtin_amdgcn_s_setprio(1); _Pragma("unroll") for (int m = 0; m < 4; ++m) _Pragma("unroll") for (int n = 0; n < 2; ++n) _Pragma("unroll") for (int k = 0; k < 2; ++k) \
        acc[ai][bj][m][n] = __builtin_amdgcn_mfma_f32_16x16x32_bf16(Bt[n][k], At[m][k], acc[ai][bj][m][n], 0, 0, 0); __builtin_amdgcn_s_setprio(0); } while (0)
#define PG8_WAIT_V(n) asm volatile("s_waitcnt vmcnt(" #n ")" ::: "memory")
#define PG8_WAIT_L(n) asm volatile("s_waitcnt lgkmcnt(" #n ")" ::: "memory")
#define PG8_BAR __builtin_amdgcn_s_barrier()
#define PG8_SCHED __builtin_amdgcn_sched_barrier(0)
    Unit cur, nxt; int ui = 0;
    if (!S.next(0, cur)) return;
    f32x4 acc[2][2][4][2];
#pragma unroll
    for (int a = 0; a < 2; ++a)
#pragma unroll
        for (int b = 0; b < 2; ++b)
#pragma unroll
            for (int m = 0; m < 4; ++m)
#pragma unroll
                for (int n = 0; n < 2; ++n) acc[a][b][m][n] = (f32x4){0.f, 0.f, 0.f, 0.f};
    bf16x8 At[4][2], B0[2][2], B1[2][2];
    const char* cA = (const char*)g.A + (size_t)cur.pm * tstep; const char* cB = (const char*)g.Bt + (size_t)cur.pn * tstep;
    S.a_ready(cur);
    if constexpr (SP2) {
        PG8_STAGE(PG8_SB(0, 0), cB, voffB); PG8_STAGE(PG8_SB(0, 1), cB + hstep, voffB); PG8_STAGE(PG8_SA(0, 0), cA, voffA); PG8_STAGE(PG8_SA(0, 1), cA + hstep, voffA);
        if (wr == 1) PG8_BAR;
        PG8_WAIT_V(2); PG8_BAR;
        PG8_STAGE(PG8_SB(1, 0), cB + kstep, voffB); PG8_STAGE(PG8_SA(1, 0), cA + kstep, voffA); PG8_STAGE(PG8_SB(1, 1), cB + hstep + kstep, voffB);
        PG8_WAIT_V(6); PG8_BAR;
    } else {
        PG8_STAGE(PG8_SB(0, 0), cB, voffB); PG8_STAGE(PG8_SA(0, 0), cA, voffA); PG8_STAGE(PG8_SB(0, 1), cB + hstep, voffB); PG8_STAGE(PG8_SA(0, 1), cA + hstep, voffA);
        if (wr == 1) PG8_BAR;
        PG8_WAIT_V(4); PG8_BAR;
        PG8_STAGE(PG8_SB(1, 0), cB + kstep, voffB); PG8_STAGE(PG8_SA(1, 0), cA + kstep, voffA); PG8_STAGE(PG8_SB(1, 1), cB + hstep + kstep, voffB);
        PG8_WAIT_V(6); PG8_BAR;
    }
    for (;;) {
        PG8_LANESET();
        const bool has_next = S.next(ui + 1, nxt);
        const char* nA = has_next ? (const char*)g.A + (size_t)nxt.pm * tstep : cA; const char* nB = has_next ? (const char*)g.Bt + (size_t)nxt.pn * tstep : cB;
        for (int t = 0; t < nt; t += 2) {
            const bool last = (t == nt - 2);
            const char* a1 = cA + (size_t)(t + 1) * kstep;
            const char* a2 = last ? nA : cA + (size_t)(t + 2) * kstep; const char* b2 = last ? nB : cB + (size_t)(t + 2) * kstep;
            const char* a3 = a2 + kstep; const char* b3 = b2 + kstep;
            if (last && has_next) S.a_ready(nxt);
            if constexpr (SP2) {
            PG8_LDB(B0, 0, 0); PG8_LDB(B1, 0, 1); PG8_SCHED; PG8_LDA(At, 0, 0); PG8_STAGE(PG8_SA(1, 1), a1 + hstep, voffA);
            PG8_WAIT_V(8); PG8_WAIT_L(0); PG8_BAR; PG8_MMA(0, 0, At, B0); PG8_MMA(0, 1, At, B1); PG8_BAR; PG8_SCHED;
            PG8_LDA(At, 0, 1); PG8_STAGE(PG8_SB(0, 0), b2, voffB); PG8_STAGE(PG8_SB(0, 1), b2 + hstep, voffB); PG8_STAGE(PG8_SA(0, 0), a2, voffA);
            PG8_WAIT_V(8); PG8_WAIT_L(0); PG8_BAR; PG8_MMA(1, 0, At, B0); PG8_MMA(1, 1, At, B1); PG8_BAR; PG8_SCHED;
            PG8_LDB(B0, 1, 0); PG8_LDB(B1, 1, 1); PG8_SCHED; PG8_LDA(At, 1, 0); PG8_STAGE(PG8_SA(0, 1), a2 + hstep, voffA);
            PG8_WAIT_V(8); PG8_WAIT_L(0); PG8_BAR; PG8_MMA(0, 0, At, B0); PG8_MMA(0, 1, At, B1); PG8_BAR; PG8_SCHED;
            PG8_LDA(At, 1, 1); PG8_STAGE(PG8_SB(1, 0), b3, voffB); PG8_STAGE(PG8_SB(1, 1), b3 + hstep, voffB); PG8_STAGE(PG8_SA(1, 0), a3, voffA);
            PG8_WAIT_V(8); PG8_WAIT_L(0); PG8_BAR; PG8_MMA(1, 0, At, B0); PG8_MMA(1, 1, At, B1); PG8_BAR; PG8_SCHED;
            } else {
            PG8_LDB(B0, 0, 0); PG8_SCHED; PG8_LDA(At, 0, 0); PG8_STAGE(PG8_SA(1, 1), a1 + hstep, voffA);
            PG8_WAIT_L(8); PG8_BAR; PG8_WAIT_L(0); PG8_MMA(0, 0, At, B0); PG8_BAR; PG8_SCHED;
            PG8_LDB(B1, 0, 1); PG8_STAGE(PG8_SB(0, 0), b2, voffB);
            PG8_BAR; PG8_WAIT_L(0); PG8_MMA(0, 1, At, B1); PG8_BAR;
            PG8_LDA(At, 0, 1); PG8_STAGE(PG8_SA(0, 0), a2, voffA);
            PG8_BAR; PG8_WAIT_L(0); PG8_MMA(1, 0, At, B0); PG8_BAR; PG8_SCHED;
            PG8_STAGE(PG8_SB(0, 1), b2 + hstep, voffB);
            PG8_WAIT_V(6); PG8_BAR; PG8_MMA(1, 1, At, B1); PG8_BAR;
            PG8_LDB(B0, 1, 0); PG8_SCHED; PG8_LDA(At, 1, 0); PG8_STAGE(PG8_SA(0, 1), a2 + hstep, voffA);
            PG8_WAIT_L(8); PG8_BAR; PG8_WAIT_L(0); PG8_MMA(0, 0, At, B0); PG8_BAR; PG8_SCHED;
            PG8_LDB(B1, 1, 1); PG8_STAGE(PG8_SB(1, 0), b3, voffB);
            PG8_BAR; PG8_WAIT_L(0); PG8_MMA(0, 1, At, B1); PG8_BAR;
            PG8_LDA(At, 1, 1); PG8_STAGE(PG8_SA(1, 0), a3, voffA);
            PG8_BAR; PG8_WAIT_L(0); PG8_MMA(1, 0, At, B0); PG8_BAR; PG8_SCHED;
            PG8_STAGE(PG8_SB(1, 1), b3 + hstep, voffB);
            PG8_WAIT_V(6); PG8_BAR; PG8_MMA(1, 1, At, B1); PG8_BAR;
            }
        }
        if constexpr (ALIGN_EPI) { if (wr == 0) PG8_BAR; }
        if constexpr (!Epi::AFTER_DRAIN) { E(acc, cur, wr, wc, fr, fq); S.done(cur); }
        if (!has_next) break;
#pragma unroll
        for (int a = 0; a < 2; ++a)
#pragma unroll
            for (int b = 0; b < 2; ++b)
#pragma unroll
                for (int m = 0; m < 4; ++m)
#pragma unroll
                    for (int n = 0; n < 2; ++n) acc[a][b][m][n] = (f32x4){0.f, 0.f, 0.f, 0.f};
        cur = nxt; cA = nA; cB = nB; ++ui;
        if constexpr (ALIGN_EPI) { if (wr == 1) PG8_BAR; }
    }
    PG8_WAIT_V(0);
    if constexpr (!ALIGN_EPI) { if (wr == 0) PG8_BAR; }
    PG8_BAR;
    if constexpr (Epi::AFTER_DRAIN) { E.fused(acc, cur, wr, wc, fr, fq, lds, wid, lane); S.done(cur); }
#undef PG8_LANESET
#undef PG8_SA
#undef PG8_SB
#undef PG8_STAGE
#undef PG8_LDA
#undef PG8_LDB
#undef PG8_MMA
#undef PG8_WAIT_V
#undef PG8_WAIT_L
#undef PG8_BAR
#undef PG8_SCHED
}
}
#define GAS __attribute__((address_space(1)))
#define LAS __attribute__((address_space(3)))

constexpr int DM = 2048, NBATCH = 16, SEQ = 2048, DEPTH = 4, MROWS = NBATCH * SEQ;
constexpr int NIN = 6168, NINP = 6176, PROJ_LD = 6144;
constexpr int DFF = 5632, NUP = 2 * DFF;
constexpr float RMS_EPS = 1e-6f;
constexpr float LOG2E = 1.4426950408889634f;
constexpr int C_FQ = 0, C_FK = 768, C_FV = 1536, C_DQ = 2304, C_DK = 2816, C_DV = 3328, C_NQ = 3840, C_NKC = 4608, C_NVC = 4864, C_NKS = 5120, C_NVS = 5376, C_NKW = 5632, C_NVW = 5888;
constexpr int GATE_LD = 32;
__device__ __forceinline__ int win_colmap(int c) {
    if (c < 2304) return c; if (c < 6144) return c + 6; if (c < 6150) return 2304 + (c - 6144); if (c < 6168) return c; return -1;
}
__device__ __forceinline__ int wup_colmap(int c) { const int pn = c >> 8, w = c & 255; return (w < 128) ? (pn * 128 + w) : (DFF + pn * 128 + (w - 128)); }

__constant__ unsigned char T5B[128] = {0, 1, 2, 3, 4, 5, 6, 7, 8, 9, 10, 11, 12, 13, 14, 15, 16, 16, 16, 17, 17, 18, 18, 18, 19, 19, 19, 20, 20, 20, 20, 21, 21, 21, 21, 22, 22, 22, 22, 22, 23, 23, 23, 23, 23, 23, 24, 24, 24, 24, 24, 24, 25, 25, 25, 25, 25, 25, 25, 26, 26, 26, 26, 26, 26, 26, 26, 27, 27, 27, 27, 27, 27, 27, 27, 27, 27, 28, 28, 28, 28, 28, 28, 28, 28, 28, 28, 29, 29, 29, 29, 29, 29, 29, 29, 29, 29, 29, 29, 30, 30, 30, 30, 30, 30, 30, 30, 30, 30, 30, 30, 30, 30, 31, 31, 31, 31, 31, 31, 31, 31, 31, 31, 31, 31, 31, 31, 31};

constexpr size_t al256(size_t x) { return (x + 255) & ~(size_t)255; }
constexpr size_t WS_CTL = 0, CTL_ZERO_BYTES = 1u << 20;
constexpr size_t WS_WIN = CTL_ZERO_BYTES;
constexpr size_t WS_WOUT = WS_WIN + (size_t)DEPTH * NINP * DM * 2;
constexpr size_t WS_WUP = WS_WOUT + (size_t)DEPTH * DM * DM * 2;
constexpr size_t WS_WDN = WS_WUP + (size_t)DEPTH * NUP * DM * 2;
constexpr size_t WS_W1T = WS_WDN + (size_t)DEPTH * DM * DFF * 2;
constexpr size_t WS_W2T = WS_W1T + (size_t)DEPTH * 2 * 128 * 4096 * 2;
constexpr size_t WS_POSC = WS_W2T + (size_t)DEPTH * 2 * 128 * 128 * 2;
constexpr size_t WS_HB = al256(WS_POSC + (size_t)DEPTH * 2 * 128 * 4);
constexpr size_t WS_MIXED = WS_HB + (size_t)MROWS * DM * 2;
constexpr size_t WS_PROJ = WS_MIXED + (size_t)MROWS * DM * 2;
constexpr size_t WS_GATES = WS_PROJ + (size_t)MROWS * PROJ_LD * 2;
constexpr size_t WS_SSQP = WS_GATES + (size_t)MROWS * GATE_LD * 4;
constexpr size_t WS_RSTD = WS_SSQP + (size_t)MROWS * 32 * 4;
constexpr size_t WS_HALO = WS_RSTD + (size_t)MROWS * 4;
constexpr size_t WS_KCMP = WS_HALO + (size_t)128 * 4 * NUP * 4;
constexpr size_t WS_VCMP = WS_KCMP + (size_t)NBATCH * 2 * 128 * 128 * 2;
constexpr size_t WS_CUM = WS_VCMP + (size_t)NBATCH * 2 * 128 * 128 * 2;
constexpr size_t WS_SCR = WS_CUM + (size_t)NBATCH * 6 * SEQ * 4;
constexpr size_t WS_DIAG = WS_SCR + (size_t)256 * 131072;
constexpr size_t WS_END = WS_DIAG + 65536;
static_assert(WS_END + (size_t)MROWS * DM * 4 <= (size_t)4 * DEPTH * DM * NUP * 4, "workspace map (+ the debug build's copy of h) must fit 4x the largest tensor");
constexpr int CW_BAR = 4096;
constexpr int CW_QUEUE = 65536;
constexpr int CW_CONV = 131072;
constexpr int CW_CMPDONE = 98304;

constexpr int RING_BYTES = 131072;
constexpr int LX_CONV = RING_BYTES;
constexpr int LX_MISC = RING_BYTES + 8192;
constexpr int LX_CW = LX_MISC + 256 + 2048;
constexpr int LX_RSTAB = LX_MISC + 256;
static_assert(LX_MISC + 256 + 2048 + 4096 <= 147456, "LDS map");
constexpr int LDS_BYTES = 147456;

typedef unsigned short bf16_t;
typedef short bf16x8 __attribute__((ext_vector_type(8)));
typedef short s16x4 __attribute__((ext_vector_type(4)));
typedef float f32x4 __attribute__((ext_vector_type(4)));
typedef float f32x2 __attribute__((ext_vector_type(2)));
typedef float f32x16 __attribute__((ext_vector_type(16)));
typedef unsigned u32x4 __attribute__((ext_vector_type(4)));
typedef unsigned u32x2 __attribute__((ext_vector_type(2)));

__device__ __forceinline__ int ltid() { int t = threadIdx.x; asm volatile("" : "+v"(t)); return t; }
typedef __bf16 bf16x2_t __attribute__((ext_vector_type(2)));
__device__ __forceinline__ unsigned cvtpk(float lo, float hi) { const f32x2 v = {lo, hi}; const bf16x2_t b = __builtin_convertvector(v, bf16x2_t); return __builtin_bit_cast(unsigned, b); }
__device__ __forceinline__ float bf2f(bf16_t v) { return __builtin_bit_cast(float, (unsigned)v << 16); }
__device__ __forceinline__ float fast_exp2(float x) { return __builtin_amdgcn_exp2f(x); }
__device__ __forceinline__ float fast_rcp(float x) { return __builtin_amdgcn_rcpf(x); }
__device__ __forceinline__ float shx(float v, int o) { return __builtin_bit_cast(float, __builtin_amdgcn_ds_bpermute(((ltid() & 63) ^ o) << 2, __builtin_bit_cast(int, v))); }
__device__ __forceinline__ float wave_sum(float v) {
    const int a = (ltid() & 63) << 2;
#pragma unroll
    for (int o = 1; o < 64; o <<= 1) v += __builtin_bit_cast(float, __builtin_amdgcn_ds_bpermute(a ^ (o << 2), __builtin_bit_cast(int, v)));
    return v;
}
template <int CTRL> __device__ __forceinline__ float dppf(float v) { return __builtin_bit_cast(float, __builtin_amdgcn_mov_dpp(__builtin_bit_cast(int, v), CTRL, 0xF, 0xF, false)); }
template <int CTRL> __device__ __forceinline__ float dppfo(float o, float v) { return __builtin_bit_cast(float, __builtin_amdgcn_update_dpp(__builtin_bit_cast(int, o), __builtin_bit_cast(int, v), CTRL, 0xF, 0xF, false)); }
template <int CTRL> __device__ __forceinline__ f32x4 dpp4o(f32x4 o, f32x4 v) { f32x4 r; r.x = dppfo<CTRL>(o.x, v.x); r.y = dppfo<CTRL>(o.y, v.y); r.z = dppfo<CTRL>(o.z, v.z); r.w = dppfo<CTRL>(o.w, v.w); return r; }
template <int CTRL> __device__ __forceinline__ f32x4 dpp4(f32x4 v) { f32x4 r; r.x = dppf<CTRL>(v.x); r.y = dppf<CTRL>(v.y); r.z = dppf<CTRL>(v.z); r.w = dppf<CTRL>(v.w); return r; }

namespace epi {
using pg8::Unit;

struct InProj {
    static constexpr bool PERM = true, PERMA = true, AFTER_DRAIN = false;
    bf16_t* proj; const __attribute__((address_space(3))) float* rstab;
    __device__ __forceinline__ void operator()(const f32x4 (&acc)[2][2][4][2], const Unit& u, int wr, int wc, int fr, int fq) const {
        { const int ln = ltid() & 63; fr = ln & 15; fq = ln >> 4; }
        const int row0 = u.pm * 256 + wr * 64 + 4 * fr;
        float cs = 1.f;
        if (u.pn < 3) cs = 0.08838834764831845f * LOG2E;
        else if (u.pn == 9 || u.pn == 10) cs = 0.125f * LOG2E;
        else if (u.pn >= 15 && u.pn <= 17) cs = 0.08838834764831845f * LOG2E;
        {
#pragma unroll
            for (int ai = 0; ai < 2; ++ai)
#pragma unroll
                for (int m = 0; m < 4; ++m) {
                    const int row = row0 + ai * 128 + m; const float s = rstab[((u.pm >> 3) & 1) * 256 + (row & 255)] * cs;
                    bf16_t* rp = proj + (size_t)row * PROJ_LD + u.pn * 256 + wc * 32 + 8 * fq;
#pragma unroll
                    for (int bj = 0; bj < 2; ++bj) { const f32x4 v0 = acc[ai][bj][m][0] * s, v1 = acc[ai][bj][m][1] * s;
                        u32x4 w; w.x = cvtpk(v0[0], v0[1]); w.y = cvtpk(v0[2], v0[3]); w.z = cvtpk(v1[0], v1[1]); w.w = cvtpk(v1[2], v1[3]);
                        *(u32x4*)(rp + bj * 128) = w; }
                }
        }
    }
};

struct Resid {
    static constexpr bool PERM = true, PERMA = true, AFTER_DRAIN = false;
    bf16_t* hb; float* ssqp;
    __device__ __forceinline__ void operator()(const f32x4 (&acc)[2][2][4][2], const Unit& u, int wr, int wc, int fr, int fq) const {
        { const int ln = ltid() & 63; fr = ln & 15; fq = ln >> 4; }
        const int row0 = u.pm * 256 + wr * 64 + 4 * fr, col0 = u.pn * 256 + wc * 32 + 8 * fq;
        u32x4 hv[2][4][2];
#pragma unroll
        for (int ai = 0; ai < 2; ++ai)
#pragma unroll
            for (int m = 0; m < 4; ++m)
#pragma unroll
                for (int bj = 0; bj < 2; ++bj) hv[ai][m][bj] = *(const u32x4*)(hb + (size_t)(row0 + ai * 128 + m) * DM + col0 + bj * 128);
#pragma unroll
        for (int ai = 0; ai < 2; ++ai)
#pragma unroll
            for (int m = 0; m < 4; ++m) {
                const int row = row0 + ai * 128 + m; float ss = 0.f;
#pragma unroll
                for (int bj = 0; bj < 2; ++bj) {
                    const size_t off = (size_t)row * DM + col0 + bj * 128;
                    const u32x4 h = hv[ai][m][bj];
                    f32x4 v0, v1;
                    v0[0] = __builtin_bit_cast(float, h.x << 16) + acc[ai][bj][m][0][0]; v0[1] = __builtin_bit_cast(float, h.x & 0xFFFF0000u) + acc[ai][bj][m][0][1];
                    v0[2] = __builtin_bit_cast(float, h.y << 16) + acc[ai][bj][m][0][2]; v0[3] = __builtin_bit_cast(float, h.y & 0xFFFF0000u) + acc[ai][bj][m][0][3];
                    v1[0] = __builtin_bit_cast(float, h.z << 16) + acc[ai][bj][m][1][0]; v1[1] = __builtin_bit_cast(float, h.z & 0xFFFF0000u) + acc[ai][bj][m][1][1];
                    v1[2] = __builtin_bit_cast(float, h.w << 16) + acc[ai][bj][m][1][2]; v1[3] = __builtin_bit_cast(float, h.w & 0xFFFF0000u) + acc[ai][bj][m][1][3];
                    u32x4 w; w.x = cvtpk(v0[0], v0[1]); w.y = cvtpk(v0[2], v0[3]); w.z = cvtpk(v1[0], v1[1]); w.w = cvtpk(v1[2], v1[3]);
                    *(u32x4*)(hb + off) = w;
                    ss += (v0[0] * v0[0] + v0[1] * v0[1]) + (v0[2] * v0[2] + v0[3] * v0[3]) + (v1[0] * v1[0] + v1[1] * v1[1]) + (v1[2] * v1[2] + v1[3] * v1[3]);
                }
                ss += shx(ss, 16); ss += shx(ss, 32);
                if (fq == 0) ssqp[(size_t)row * 32 + u.pn * 4 + wc] = ss;
            }
    }
};

struct UpConv {
    static constexpr bool PERM = true, PERMA = true, AFTER_DRAIN = false;
    bf16_t* act; const __attribute__((address_space(3))) float* rstab; const float* cw; const float* cb; float* halo; __attribute__((address_space(3))) float* ex;
    __device__ __forceinline__ void operator()(const f32x4 (&acc)[2][2][4][2], const Unit& u, int wr, int wc, int fr, int fq) const {
        { const int ln = ltid() & 63; fr = ln & 15; fq = ln >> 4; }
        const int tcol = wc * 32 + 8 * fq, ch0 = u.pn * 128 + tcol;
        const int row0 = u.pm * 256 + wr * 64 + 4 * fr;
        float rs[2][4];
#pragma unroll
        for (int ai = 0; ai < 2; ++ai)
#pragma unroll
            for (int m = 0; m < 4; ++m) rs[ai][m] = rstab[((u.pm >> 3) & 1) * 256 + ((row0 + ai * 128 + m) & 255)];
        __attribute__((address_space(3))) float* cwl = ex + (LX_CW - LX_CONV) / 4;
        { const int t = ltid();
#pragma unroll
          for (int k = 0; k < 2; ++k) { const int i = t + 512 * k, q = i >> 7, cc = i & 127, tap = q >> 1, bjj = q & 1;
              cwl[i] = (tap < 3 ? cw + tap * NUP : cb)[bjj * DFF + u.pn * 128 + cc]; } }
        if (fr == 15) {
#pragma unroll
            for (int ai = 0; ai < 2; ++ai)
#pragma unroll
                for (int bj = 0; bj < 2; ++bj)
#pragma unroll
                    for (int n = 0; n < 2; ++n)
#pragma unroll
                        for (int q = 0; q < 2; ++q) {
                            const f32x4 v = acc[ai][bj][2 + q][n] * rs[ai][2 + q];
                            *(__attribute__((address_space(3))) f32x4*)(ex + ((ai * 2 + wr) * 2 + q) * 256 + bj * 128 + tcol + 4 * n) = v;
                            if (ai == 1 && wr == 1) *(f32x4*)(halo + ((size_t)(u.pm * 4 + 2 + q) * NUP) + u.pn * 256 + bj * 128 + tcol + 4 * n) = v;
                        }
        }
        if (fr == 0 && wr == 0) {
#pragma unroll
            for (int bj = 0; bj < 2; ++bj)
#pragma unroll
                for (int n = 0; n < 2; ++n)
#pragma unroll
                    for (int q = 0; q < 2; ++q)
                        *(f32x4*)(halo + ((size_t)(u.pm * 4 + q) * NUP) + u.pn * 256 + bj * 128 + tcol + 4 * n) = acc[0][bj][q][n] * rs[0][q];
        }
        asm volatile("s_waitcnt lgkmcnt(0)" ::: "memory");
        __builtin_amdgcn_s_barrier();
#pragma unroll
        for (int ai = 0; ai < 2; ++ai) {
            const bool top = (ai == 0 && wr == 0);
            const int pb = (wr ? ai * 2 : (ai * 2 - 1));
#pragma unroll
            for (int n = 0; n < 2; ++n) {
                f32x4 yg[4];
#pragma unroll
                for (int bj = 0; bj < 2; ++bj) {
                    asm volatile("" ::: "memory"); __builtin_amdgcn_sched_barrier(0);
                    const __attribute__((address_space(3))) float* wl = cwl + bj * 128 + tcol + 4 * n;
                    const f32x4 w0 = *(const __attribute__((address_space(3))) f32x4*)wl, w1 = *(const __attribute__((address_space(3))) f32x4*)(wl + 256), w2 = *(const __attribute__((address_space(3))) f32x4*)(wl + 512), bb = *(const __attribute__((address_space(3))) f32x4*)(wl + 768);
                    f32x4 e62 = {0.f, 0.f, 0.f, 0.f}, e63 = {0.f, 0.f, 0.f, 0.f};
                    if (!top) {
                        e62 = *(const __attribute__((address_space(3))) f32x4*)(ex + (pb * 2 + 0) * 256 + bj * 128 + tcol + 4 * n);
                        e63 = *(const __attribute__((address_space(3))) f32x4*)(ex + (pb * 2 + 1) * 256 + bj * 128 + tcol + 4 * n);
                    }
                    f32x4 v[4];
#pragma unroll
                    for (int m = 0; m < 4; ++m) v[m] = acc[ai][bj][m][n] * rs[ai][m];
                    const f32x4 s3 = dpp4o<0x111>(e63, v[3]), s2 = dpp4o<0x111>(e62, v[2]);
                    f32x4 y[4];
                    y[0] = ((bb + w2 * v[0]) + w1 * s3) + w0 * s2;
                    y[1] = ((bb + w2 * v[1]) + w1 * v[0]) + w0 * s3;
                    y[2] = ((bb + w2 * v[2]) + w1 * v[1]) + w0 * v[0];
                    y[3] = ((bb + w2 * v[3]) + w1 * v[2]) + w0 * v[1];
#pragma unroll
                    for (int m = 0; m < 4; ++m) {
                        if (bj == 0) yg[m] = y[m];
                        else {
                            f32x4 o;
#pragma unroll
                            for (int i = 0; i < 4; ++i) o[i] = yg[m][i] * fast_rcp(1.f + fast_exp2(-yg[m][i] * LOG2E)) * y[m][i];
                            if (!(top && fr == 0 && m < 2)) {
                                u32x2 w; w.x = cvtpk(o[0], o[1]); w.y = cvtpk(o[2], o[3]);
                                *(u32x2*)(act + (size_t)(row0 + ai * 128 + m) * DFF + ch0 + 4 * n) = w;
                            }
                        }
                    }
                }
            }
        }
    }
};
}
#define XB_TMO      128
#define XB_XCNT(j)  (256  + 64 * (j))
#define XB_XSUB(j)  (1280 + 64 * (j))
#define XB_XGEN(j)  (2304 + 64 * (j))
#define XB_TOP      3328
#define XB_TOPGEN   3392
#define XCD_BAR_WORDS 3456
#define XB_SPIN_CAP (1u << 18)

__device__ __forceinline__ unsigned xb_ld(unsigned* p)              { return __hip_atomic_load(p, __ATOMIC_RELAXED, __HIP_MEMORY_SCOPE_AGENT); }
__device__ __forceinline__ unsigned xb_add(unsigned* p, unsigned v) { return __hip_atomic_fetch_add(p, v, __ATOMIC_RELAXED, __HIP_MEMORY_SCOPE_AGENT); }
__device__ __forceinline__ unsigned xb_xcc_id() { return (unsigned)__builtin_amdgcn_s_getreg((3 << 11) | 20) & 0xFu; }
#define XB_SPIN(cond, bar) do { unsigned _sp = 0; while (cond) { __builtin_amdgcn_s_sleep(1); \
    if ((++_sp & 255u) == 0u) { if (xb_ld(&(bar)[XB_TMO])) break; if (_sp > XB_SPIN_CAP) { atomicAdd(&(bar)[XB_TMO], 1u); break; } } } } while (0)

struct XcdBarrier {
    unsigned* bar; unsigned x;
    volatile LAS unsigned* st;
};

__device__ __forceinline__ XcdBarrier xcd_barrier_post(unsigned* bar, volatile LAS unsigned* st) {
    XcdBarrier b; b.bar = bar; b.x = xb_xcc_id(); b.st = st;
    if (threadIdx.x == 0) (void)xb_add(&bar[XB_XCNT(b.x)], 1u);
    return b;
}
__device__ __forceinline__ void xcd_barrier_complete(unsigned* bar, unsigned x, unsigned& nloc, unsigned& nx) {
    const unsigned G = gridDim.x * gridDim.y * gridDim.z;
    unsigned sum, cnt, mine, sp = 0u;
    for (;;) {
        sum = 0u; cnt = 0u; mine = 0u;
#pragma unroll
        for (unsigned j = 0; j < 16; ++j) { const unsigned c = xb_ld(&bar[XB_XCNT(j)]); sum += c; cnt += (c > 0u) ? 1u : 0u; mine = (j == x) ? c : mine; }
        if (sum == G) break;
        __builtin_amdgcn_s_sleep(1);
        if ((++sp & 255u) == 0u) { if (xb_ld(&bar[XB_TMO])) break; if (sp > XB_SPIN_CAP) { atomicAdd(&bar[XB_TMO], 1u); break; } }
    }
    nloc = mine > 0u ? mine : 1u; nx = cnt > 0u ? cnt : 1u;
}

__device__ __forceinline__ void xcd_barrier(const XcdBarrier& b) {
    asm volatile("s_waitcnt vmcnt(0)" ::: "memory");
    __syncthreads();
    if (threadIdx.x == 0) {
        unsigned* bar = b.bar; asm volatile("" : "+s"(bar));
        __builtin_amdgcn_s_waitcnt(0);
        unsigned nloc = b.st[0], nx = b.st[1];
        if (nloc == 0u) { xcd_barrier_complete(bar, b.x, nloc, nx); b.st[0] = nloc; b.st[1] = nx; }
        const unsigned old = xb_add(&bar[XB_XSUB(b.x)], 1u);
        const unsigned gen = old / nloc;
        if (old + 1u == (gen + 1u) * nloc) {
            __builtin_amdgcn_fence(__ATOMIC_RELEASE, "agent");
            asm volatile("s_waitcnt vmcnt(0)" ::: "memory");
            const unsigned og = xb_add(&bar[XB_TOP], 1u);
            const unsigned tg = og / nx;
            if (og + 1u == (tg + 1u) * nx) xb_add(&bar[XB_TOPGEN], 1u);
            else XB_SPIN(xb_ld(&bar[XB_TOPGEN]) == tg, bar);
            __builtin_amdgcn_fence(__ATOMIC_ACQUIRE, "agent");
            xb_add(&bar[XB_XGEN(b.x)], 1u);
            asm volatile("s_waitcnt vmcnt(0)" ::: "memory");
        } else {
            XB_SPIN(xb_ld(&bar[XB_XGEN(b.x)]) == gen, bar);
            __builtin_amdgcn_fence(__ATOMIC_ACQUIRE, "agent");
            asm volatile("s_waitcnt vmcnt(0)" ::: "memory");
        }
    }
    __syncthreads();
}

namespace att {
#ifndef DMA_AUX
#define DMA_AUX 0
#endif
constexpr int SHM = 16384;
constexpr int L_V = 0, L_K = 2 * SHM, L_WS = 4 * SHM, L_CUM = L_WS + 2048, L_LUT = L_CUM + 8192, L_IMP = L_LUT + 5120, L_SEL = L_IMP + 256 * 33 * 4, L_UNI = L_SEL + 1024, L_END = L_UNI + 64;
static_assert(L_END <= RING_BYTES, "attention scratch inside the ring region");
constexpr float THR2 = 11.5f;
enum { K_FOX = 0, K_DIFF = 1, K_SEL = 2, K_WIN = 3, K_CMP = 4 };

#define KSWZ(row, colB) ((row) * 256 + ((colB) ^ (((row) & 7) << 4)))
#define SBAR() __builtin_amdgcn_sched_barrier(0)
__device__ __forceinline__ int v_st(int k, int c) { const int kk = (k & ~0xC) | ((k & 4) << 1) | ((k & 8) >> 1); return ((kk >> 3) * 4 + (c >> 5)) * 512 + ((kk & 7) * 32 + (c & 31)) * 2; }
__device__ __forceinline__ int v_rd_base(int lane) { return ((lane & 3) << 3) | (((lane >> 2) & 3) << 6) | (((lane >> 4) & 1) << 5) | (((lane >> 5) & 1) << 8); }
constexpr int v_rd_off(int d0, int ks, int half) { return d0 * 512 + ks * 4096 + half * 2048; }
__device__ __forceinline__ int crow(int r, int hi) { return (r & 3) + 8 * (r >> 2) + 4 * hi; }
constexpr int ccol(int r) { return (r & 3) + 8 * (r >> 2); }

typedef LAS char* lptr;

template <int NQ>
__device__ __forceinline__ void qkt(f32x16& p0, f32x16& p1, lptr kbuf, int kf0, int r32, int hi, const bf16x8 (&qr)[8]) {
    p0 = f32x16{}; p1 = f32x16{};
    const int kb0 = (int)(uintptr_t)kbuf + (kf0 >> 2) * 128;
    const int ka0 = kb0 + KSWZ(r32, (0 * 16 + hi * 8) * 2), ka1 = kb0 + KSWZ(r32, (1 * 16 + hi * 8) * 2), ka2 = kb0 + KSWZ(r32, (2 * 16 + hi * 8) * 2), ka3 = kb0 + KSWZ(r32, (3 * 16 + hi * 8) * 2);
#define KRD(dst, addr, off) asm volatile("ds_read_b128 %0, %1 offset:%2" : "=&v"(dst) : "v"(addr), "i"(off) : "memory")
#define KRD4(S, aA, aB, off) do { KRD(S[0], aA, off); KRD(S[1], aA, (off) + 8192); KRD(S[2], aB, off); KRD(S[3], aB, (off) + 8192); } while (0)
#define KMM4(S, d) do { p0 = __builtin_amdgcn_mfma_f32_32x32x16_bf16(S[0], qr[d], p0, 0, 0, 0); p1 = __builtin_amdgcn_mfma_f32_32x32x16_bf16(S[1], qr[d], p1, 0, 0, 0); \
                        p0 = __builtin_amdgcn_mfma_f32_32x32x16_bf16(S[2], qr[(d) + 1], p0, 0, 0, 0); p1 = __builtin_amdgcn_mfma_f32_32x32x16_bf16(S[3], qr[(d) + 1], p1, 0, 0, 0); } while (0)
#define LGK(n) asm volatile("s_waitcnt lgkmcnt(" #n ")" ::: "memory")
    bf16x8 A[4], B[4];
    LGK(0); SBAR();
    if (NQ == 8) {
        KRD4(A, ka0, ka1, 0); KRD4(B, ka2, ka3, 0);
        LGK(4); SBAR(); KMM4(A, 0); SBAR(); KRD4(A, ka0, ka1, 128);
        LGK(4); SBAR(); KMM4(B, 2); SBAR(); KRD4(B, ka2, ka3, 128);
        LGK(4); SBAR(); KMM4(A, 4); SBAR();
        LGK(0); SBAR(); KMM4(B, 6);
    } else {
        KRD4(A, ka0, ka1, 0); KRD4(B, ka2, ka3, 0);
        LGK(4); SBAR(); KMM4(A, 0); SBAR();
        LGK(0); SBAR(); KMM4(B, 2);
    }
#undef KRD
#undef KRD4
#undef KMM4
#undef LGK
}
__device__ __forceinline__ void pv_tile(f32x16 (&o)[4], int vb0, bf16x8 pa0, bf16x8 pa1, bf16x8 pa2, bf16x8 pa3) {
#define TRRD(dst, off) asm volatile("ds_read_b64_tr_b16 %0, %1 offset:%2" : "=&v"(dst) : "v"(vb0), "i"(off) : "memory")
#define PV_RD(S, d0) do { constexpr int b_ = v_rd_off(d0, 0, 0); TRRD(S[0], b_); TRRD(S[1], b_ + 2048); TRRD(S[2], b_ + 4096); TRRD(S[3], b_ + 6144); \
                          TRRD(S[4], b_ + 8192); TRRD(S[5], b_ + 10240); TRRD(S[6], b_ + 12288); TRRD(S[7], b_ + 14336); } while (0)
#define PV_MM(S, d0) do { \
        o[d0] = __builtin_amdgcn_mfma_f32_32x32x16_bf16(pa0, (bf16x8){S[0][0], S[0][1], S[0][2], S[0][3], S[1][0], S[1][1], S[1][2], S[1][3]}, o[d0], 0, 0, 0);   \
        o[d0] = __builtin_amdgcn_mfma_f32_32x32x16_bf16(pa1, (bf16x8){S[2][0], S[2][1], S[2][2], S[2][3], S[3][0], S[3][1], S[3][2], S[3][3]}, o[d0], 0, 0, 0);   \
        o[d0] = __builtin_amdgcn_mfma_f32_32x32x16_bf16(pa2, (bf16x8){S[4][0], S[4][1], S[4][2], S[4][3], S[5][0], S[5][1], S[5][2], S[5][3]}, o[d0], 0, 0, 0);   \
        o[d0] = __builtin_amdgcn_mfma_f32_32x32x16_bf16(pa3, (bf16x8){S[6][0], S[6][1], S[6][2], S[6][3], S[7][0], S[7][1], S[7][2], S[7][3]}, o[d0], 0, 0, 0); } while (0)
#define LGK(n) asm volatile("s_waitcnt lgkmcnt(" #n ")" ::: "memory")
    s16x4 A[8], B[8];
    LGK(0); SBAR();
    PV_RD(A, 0); PV_RD(B, 1);
    LGK(8); SBAR(); PV_MM(A, 0); SBAR(); PV_RD(A, 2);
    LGK(8); SBAR(); PV_MM(B, 1); SBAR(); PV_RD(B, 3);
    LGK(8); SBAR(); PV_MM(A, 2); SBAR();
    LGK(0); SBAR(); PV_MM(B, 3);
#undef TRRD
#undef PV_RD
#undef PV_MM
#undef LGK
}
__device__ __forceinline__ void softmax_tile(f32x16& p0, f32x16& p1, float& m_reg, float& l_reg, float& alpha, bf16x8& pa0, bf16x8& pa1, bf16x8& pa2, bf16x8& pa3) {
    float pmax = p0[0];
#pragma unroll
    for (int r = 1; r < 16; ++r) pmax = fmaxf(pmax, p0[r]);
#pragma unroll
    for (int r = 0; r < 16; ++r) pmax = fmaxf(pmax, p1[r]);
    { auto rr = __builtin_amdgcn_permlane32_swap(__float_as_uint(pmax), __float_as_uint(pmax), false, false);
      pmax = fmaxf(__uint_as_float(rr[0]), __uint_as_float(rr[1])); }
    float mn;
    if (__builtin_expect(__all((pmax - m_reg) <= THR2), 1)) { mn = m_reg; alpha = 1.f; }
    else { mn = fmaxf(m_reg, pmax); alpha = fast_exp2(m_reg - mn); m_reg = mn; }
    float ps = 0.f;
#pragma unroll
    for (int r = 0; r < 16; ++r) { p0[r] = fast_exp2(p0[r] - mn); ps += p0[r]; }
#pragma unroll
    for (int r = 0; r < 16; ++r) { p1[r] = fast_exp2(p1[r] - mn); ps += p1[r]; }
    { auto rr = __builtin_amdgcn_permlane32_swap(__float_as_uint(ps), __float_as_uint(ps), false, false);
      ps = __uint_as_float(rr[0]) + __uint_as_float(rr[1]); }
    l_reg = l_reg * alpha + ps;
#define PK4(P, B_, OUT) do { unsigned a0 = cvtpk(P[B_+0], P[B_+1]), a1 = cvtpk(P[B_+2], P[B_+3]);                          \
        unsigned b0 = cvtpk(P[B_+4], P[B_+5]), b1 = cvtpk(P[B_+6], P[B_+7]);                                             \
        auto r0 = __builtin_amdgcn_permlane32_swap(a0, b0, false, false); auto r1 = __builtin_amdgcn_permlane32_swap(a1, b1, false, false); \
        u32x4 w = {r0[0], r1[0], r0[1], r1[1]}; OUT = __builtin_bit_cast(bf16x8, w); } while (0)
    PK4(p0, 0, pa0); PK4(p0, 8, pa1); PK4(p1, 0, pa2); PK4(p1, 8, pa3);
#undef PK4
}
__device__ __forceinline__ void rowbcast(LAS float* wsl, float v, int r32, int hi, float (&out)[16]) {
    if (hi == 0) wsl[r32] = v;
    asm volatile("s_waitcnt lgkmcnt(0)" ::: "memory");
#pragma unroll
    for (int r = 0; r < 16; ++r) out[r] = wsl[crow(r, hi)];
    asm volatile("s_waitcnt lgkmcnt(0)" ::: "memory");
}

template <int KIND>
__device__ __forceinline__ bool wave_act(int j, int qlo, unsigned selm) {
    const int kb = j * 64;
    if (KIND == K_FOX || KIND == K_DIFF) return kb <= qlo + 31;
    if (KIND == K_WIN) return (kb <= qlo + 31) && (kb + 63 >= qlo - 511);
    if (KIND == K_SEL) return (kb <= qlo + 31) && __any((int)((selm >> j) & 1u));
    return true;
}
template <int KIND>
__device__ __forceinline__ void score_fix(f32x16& p0, f32x16& p1, int j, int qlo, int qpos, int hi, const LAS float* lut, const LAS float* cum, unsigned selm) {
    const float NEG = -__builtin_inff();
    const int kb = j * 64, dq = qpos - kb - 4 * hi;
    if (KIND == K_FOX) {
        const LAS float* cb = cum + kb + 4 * hi;
#pragma unroll
        for (int r = 0; r < 16; ++r) { p0[r] += cb[ccol(r)]; p1[r] += cb[ccol(r) + 32]; }
        if (kb + 63 > qlo) {
#pragma unroll
            for (int r = 0; r < 16; ++r) { if (dq - ccol(r) < 0) p0[r] = NEG; if (dq - ccol(r) - 32 < 0) p1[r] = NEG; }
        }
    } else if (KIND == K_CMP) {
        const int dc = qpos - 31 - 16 * (kb + 4 * hi);
#pragma unroll
        for (int r = 0; r < 16; ++r) {
            const int rel0 = dc - 16 * ccol(r), rel1 = rel0 - 512;
            p0[r] += lut[min(max(rel0, 0), 127)]; p1[r] += lut[min(max(rel1, 0), 127)];
            if (rel0 < 0) p0[r] = NEG;
            if (rel1 < 0 || (kb + 4 * hi + ccol(r) + 32 >= 127)) p1[r] = NEG;
        }
    } else {
        if (qlo - (kb + 63) >= 113) {
        } else {
#pragma unroll
            for (int r = 0; r < 16; ++r) { const int rel0 = dq - ccol(r), rel1 = rel0 - 32;
                p0[r] += lut[min(max(rel0, 0), 127)]; p1[r] += lut[min(max(rel1, 0), 127)];
                if (rel0 < 0) p0[r] = NEG; if (rel1 < 0) p1[r] = NEG; }
        }
        if (KIND == K_WIN) {
            if (qlo + 31 - kb >= 512) {
#pragma unroll
                for (int r = 0; r < 16; ++r) { if (dq - ccol(r) >= 512) p0[r] = NEG; if (dq - ccol(r) - 32 >= 512) p1[r] = NEG; }
            }
        }
        if (KIND == K_SEL) {
            if (((selm >> j) & 1u) == 0u) {
#pragma unroll
                for (int r = 0; r < 16; ++r) { p0[r] = NEG; p1[r] = NEG; }
            }
        }
    }
}

template <int KIND, int NQ, int EXPM = 0>
__device__ __forceinline__ void attn_pass(lptr lds, const bf16_t* __restrict__ Kg, const bf16_t* __restrict__ Vg, int kp, int vp, unsigned tilemask,
                                          const bf16x8 (&qr)[8], int kf0, int P0, const LAS float* lut, const LAS float* cum, unsigned selm,
                                          f32x16 (&o)[4], float& m_reg, float& l_reg) {
    const int tid = ltid(), wid = __builtin_amdgcn_readfirstlane(tid >> 6), lane = tid & 63, r32 = lane & 31, hi = lane >> 5;
    const int sr = tid >> 4, sc = (tid & 15) * 8;
    const int kws = KSWZ(sr, sc * 2), vst0 = v_st(sr, sc), vst1 = v_st(32 + sr, sc);
    const int qlo = P0 + wid * 32, qpos = qlo + r32;
    LAS float* wsl = (LAS float*)(lds + L_WS) + wid * 64;
    const int vbase = (int)(uintptr_t)(lds + L_V) + v_rd_base(lane);
    if (tilemask == 0u) return;
    const int kr_ = wid * 4 + (lane >> 4);
    const int kcol_ = (((lane & 15) ^ (kr_ & 7)) * 8);
    const int vsub_ = wid * 2 + (lane >> 5);
    const int vkk_ = ((vsub_ >> 2) << 3) | ((lane & 31) >> 2);
    const int vkey_ = (vkk_ & ~0xC) | ((vkk_ & 4) << 1) | ((vkk_ & 8) >> 1);
    const int vcol_ = (vsub_ & 3) * 32 + (lane & 3) * 8;
    const unsigned dma_w = (unsigned)wid * 1024u;
#define DMA_TILE(jj, bf) do { \
        const bf16_t* kp0_ = Kg + (size_t)((jj) * 64 + kr_) * kp + kcol_; const bf16_t* vp0_ = Vg + (size_t)((jj) * 64 + vkey_) * vp + vcol_; \
        __builtin_amdgcn_global_load_lds((const unsigned*)kp0_, (LAS unsigned*)(lds + L_K + (bf) * SHM + dma_w), 16, 0, DMA_AUX); \
        __builtin_amdgcn_global_load_lds((const unsigned*)(kp0_ + (size_t)32 * kp), (LAS unsigned*)(lds + L_K + (bf) * SHM + 8192 + dma_w), 16, 0, DMA_AUX); \
        __builtin_amdgcn_global_load_lds((const unsigned*)vp0_, (LAS unsigned*)(lds + L_V + (bf) * SHM + dma_w), 16, 0, DMA_AUX); \
        __builtin_amdgcn_global_load_lds((const unsigned*)(vp0_ + (size_t)32 * vp), (LAS unsigned*)(lds + L_V + (bf) * SHM + 8192 + dma_w), 16, 0, DMA_AUX); } while (0)
#define NEXT_TILE(jv) do { if (tilemask) { jv = __builtin_ctz(tilemask); tilemask &= tilemask - 1u; } else jv = -1; } while (0)
    int j0, j1;
    NEXT_TILE(j0); NEXT_TILE(j1);
    DMA_TILE(j0, 0);
    asm volatile("s_waitcnt vmcnt(0)" ::: "memory");
    __syncthreads();
    int buf = 0;
    for (;;) {
        if (j1 >= 0) DMA_TILE(j1, buf ^ 1);
        if (wave_act<KIND>(j0, qlo, selm)) {
            f32x16 p0, p1;
            qkt<NQ>(p0, p1, lds + L_K + buf * SHM, kf0, r32, hi, qr);
            score_fix<KIND>(p0, p1, j0, qlo, qpos, hi, lut, cum, selm);
            float alpha; bf16x8 pa0, pa1, pa2, pa3;
            softmax_tile(p0, p1, m_reg, l_reg, alpha, pa0, pa1, pa2, pa3);
            if (__any(alpha < 1.f)) {
                float al[16]; rowbcast(wsl, alpha, r32, hi, al);
#pragma unroll
                for (int d = 0; d < 4; ++d)
#pragma unroll
                    for (int r = 0; r < 16; ++r) o[d][r] *= al[r];
            }
            pv_tile(o, vbase + buf * SHM, pa0, pa1, pa2, pa3);
        }
        asm volatile("s_waitcnt vmcnt(0)" ::: "memory");
        __syncthreads();
        if (j1 < 0) break;
        j0 = j1; NEXT_TILE(j1); buf ^= 1;
    }
#undef DMA_TILE
#undef NEXT_TILE
}

__device__ __forceinline__ void fox_pass(lptr lds, const bf16_t* __restrict__ Kg, const bf16_t* __restrict__ Vg, int ntiles, const bf16x8 (&qr)[8], int P0,
                                         const LAS float* cum, f32x16 (&o)[4], float& m_reg, float& l_reg) {
    const int tid = ltid(), wid = __builtin_amdgcn_readfirstlane(tid >> 6), lane = tid & 63, r32 = lane & 31, hi = lane >> 5;
    const int sr = tid >> 4, sc = (tid & 15) * 8;
    const int kws = KSWZ(sr, sc * 2), vst0 = v_st(sr, sc), vst1 = v_st(32 + sr, sc);
    const int qlo = P0 + wid * 32, qpos = qlo + r32;
    LAS float* wsl = (LAS float*)(lds + L_WS) + wid * 64;
    const int vbase = (int)(uintptr_t)(lds + L_V) + v_rd_base(lane);
    const int kbase = (int)(uintptr_t)(lds + L_K);
    const int ko0 = KSWZ(r32, (0 * 16 + hi * 8) * 2), ko1 = KSWZ(r32, (1 * 16 + hi * 8) * 2), ko2 = KSWZ(r32, (2 * 16 + hi * 8) * 2), ko3 = KSWZ(r32, (3 * 16 + hi * 8) * 2);
    const int PITCH = PROJ_LD;
    bf16x8 st_k0, st_k1, st_v0, st_v1;
#define LOADK(jj) do { const size_t kr = (size_t)((jj) * 64 + sr); st_k0 = *(const bf16x8*)(Kg + kr * PITCH + sc); st_k1 = *(const bf16x8*)(Kg + (kr + 32) * PITCH + sc); } while (0)
#define LOADV(jj) do { const size_t kr = (size_t)((jj) * 64 + sr); st_v0 = *(const bf16x8*)(Vg + kr * PITCH + sc); st_v1 = *(const bf16x8*)(Vg + (kr + 32) * PITCH + sc); } while (0)
#define WRITEK(bf) do { *(LAS bf16x8*)(lds + L_K + (bf) * SHM + kws) = st_k0; *(LAS bf16x8*)(lds + L_K + (bf) * SHM + kws + 32 * 256) = st_k1; } while (0)
#define WRITEV(bf) do { *(LAS bf16x8*)(lds + L_V + (bf) * SHM + vst0) = st_v0; *(LAS bf16x8*)(lds + L_V + (bf) * SHM + vst1) = st_v1; } while (0)
#define KRD(dst, addr, off) asm volatile("ds_read_b128 %0, %1 offset:%2" : "=&v"(dst) : "v"(addr), "i"(off) : "memory")
#define KRD4(S, aA, aB, off) do { KRD(S[0], aA, off); KRD(S[1], aA, (off) + 8192); KRD(S[2], aB, off); KRD(S[3], aB, (off) + 8192); } while (0)
#define KMM4(S, d) do { sn0 = __builtin_amdgcn_mfma_f32_32x32x16_bf16(S[0], qr[d], sn0, 0, 0, 0); sn1 = __builtin_amdgcn_mfma_f32_32x32x16_bf16(S[1], qr[d], sn1, 0, 0, 0); \
                        sn0 = __builtin_amdgcn_mfma_f32_32x32x16_bf16(S[2], qr[(d) + 1], sn0, 0, 0, 0); sn1 = __builtin_amdgcn_mfma_f32_32x32x16_bf16(S[3], qr[(d) + 1], sn1, 0, 0, 0); } while (0)
#define LGK(n) asm volatile("s_waitcnt lgkmcnt(" #n ")" ::: "memory")
    LOADK(0); LOADV(0); WRITEK(0); WRITEV(0);
    if (ntiles > 1) { LOADK(1); WRITEK(1); }
    __syncthreads();
    f32x16 sc0, sc1;
    bool actc = 0 <= qlo + 31;
    if (actc) { qkt<8>(sc0, sc1, lds + L_K, 0, r32, hi, qr); score_fix<K_FOX>(sc0, sc1, 0, qlo, qpos, hi, nullptr, cum, 0u); }
    for (int t = 0; t < ntiles; ++t) {
        const int buf = t & 1; const bool has1 = t + 1 < ntiles, has2 = t + 2 < ntiles;
        if (has1) LOADV(t + 1);
        if (has2) LOADK(t + 2);
        const bool actn = has1 && ((t + 1) * 64 <= qlo + 31);
        f32x16 sn0, sn1;
        if (actc && actn && ((t + 1) * 64 + 63 <= qlo)) {
            const int ka = kbase + (buf ^ 1) * SHM;
            const int ka0 = ka + ko0, ka1 = ka + ko1, ka2 = ka + ko2, ka3 = ka + ko3;
            bf16x8 A[4], B[4];
            SBAR(); LGK(0);
            KRD4(A, ka0, ka1, 0); KRD4(B, ka2, ka3, 0);
            SBAR();
            float pmax = sc0[0];
#pragma unroll
            for (int r = 1; r < 16; ++r) pmax = fmaxf(pmax, sc0[r]);
            sn0 = f32x16{}; sn1 = f32x16{};
            SBAR(); LGK(4); SBAR(); KMM4(A, 0); SBAR(); KRD4(A, ka0, ka1, 128); SBAR();
#pragma unroll
            for (int r = 0; r < 16; ++r) pmax = fmaxf(pmax, sc1[r]);
            { auto rr = __builtin_amdgcn_permlane32_swap(__float_as_uint(pmax), __float_as_uint(pmax), false, false);
              pmax = fmaxf(__uint_as_float(rr[0]), __uint_as_float(rr[1])); }
            const bool keep = __all((pmax - m_reg) <= THR2);
            const float mn = keep ? m_reg : fmaxf(m_reg, pmax);
            const float alpha = fast_exp2(m_reg - mn); m_reg = mn;
            SBAR(); LGK(4); SBAR(); KMM4(B, 2); SBAR(); KRD4(B, ka2, ka3, 128); SBAR();
            float ps = 0.f;
#pragma unroll
            for (int r = 0; r < 16; ++r) { sc0[r] = fast_exp2(sc0[r] - mn); ps += sc0[r]; }
            SBAR(); LGK(4); SBAR(); KMM4(A, 4); SBAR();
#pragma unroll
            for (int r = 0; r < 16; ++r) { sc1[r] = fast_exp2(sc1[r] - mn); ps += sc1[r]; }
            SBAR(); LGK(0); SBAR(); KMM4(B, 6); SBAR();
            { auto rr = __builtin_amdgcn_permlane32_swap(__float_as_uint(ps), __float_as_uint(ps), false, false);
              ps = __uint_as_float(rr[0]) + __uint_as_float(rr[1]); }
            l_reg = l_reg * alpha + ps;
            bf16x8 pa0, pa1, pa2, pa3;
#define PK4(P, B_, OUT) do { unsigned a0 = cvtpk(P[B_+0], P[B_+1]), a1 = cvtpk(P[B_+2], P[B_+3]);                          \
        unsigned b0 = cvtpk(P[B_+4], P[B_+5]), b1 = cvtpk(P[B_+6], P[B_+7]);                                             \
        auto r0 = __builtin_amdgcn_permlane32_swap(a0, b0, false, false); auto r1 = __builtin_amdgcn_permlane32_swap(a1, b1, false, false); \
        u32x4 w = {r0[0], r1[0], r0[1], r1[1]}; OUT = __builtin_bit_cast(bf16x8, w); } while (0)
            PK4(sc0, 0, pa0); PK4(sc0, 8, pa1); PK4(sc1, 0, pa2); PK4(sc1, 8, pa3);
#undef PK4
            SBAR();
            if (__any(alpha < 1.f)) {
                float al[16]; rowbcast(wsl, alpha, r32, hi, al);
#pragma unroll
                for (int d = 0; d < 4; ++d)
#pragma unroll
                    for (int r = 0; r < 16; ++r) o[d][r] *= al[r];
            }
            pv_tile(o, vbase + buf * SHM, pa0, pa1, pa2, pa3);
            { const LAS float* cbp = cum + (t + 1) * 64 + 4 * hi;
#pragma unroll
              for (int r = 0; r < 16; ++r) { sn0[r] += cbp[ccol(r)]; sn1[r] += cbp[ccol(r) + 32]; } }
        } else {
            if (actn) qkt<8>(sn0, sn1, lds + L_K + (buf ^ 1) * SHM, 0, r32, hi, qr);
            if (actc) {
                float alpha; bf16x8 pa0, pa1, pa2, pa3;
                softmax_tile(sc0, sc1, m_reg, l_reg, alpha, pa0, pa1, pa2, pa3);
                if (__any(alpha < 1.f)) {
                    float al[16]; rowbcast(wsl, alpha, r32, hi, al);
#pragma unroll
                    for (int d = 0; d < 4; ++d)
#pragma unroll
                        for (int r = 0; r < 16; ++r) o[d][r] *= al[r];
                }
                pv_tile(o, vbase + buf * SHM, pa0, pa1, pa2, pa3);
            }
            if (actn) score_fix<K_FOX>(sn0, sn1, t + 1, qlo, qpos, hi, nullptr, cum, 0u);
        }
        if (has1) WRITEV(buf ^ 1);
        if (has2) WRITEK(buf);
        __syncthreads();
        sc0 = sn0; sc1 = sn1; actc = actn;
    }
#undef LOADK
#undef LOADV
#undef WRITEK
#undef WRITEV
#undef KRD
#undef KRD4
#undef KMM4
#undef LGK
}

template <int NQ>
__device__ __forceinline__ void load_q(bf16x8 (&qr)[8], const bf16_t* proj, int row_first, int col0) {
    const int lane = ltid() & 63, r32 = lane & 31, hi = lane >> 5, wid = ltid() >> 6;
    const bf16_t* q = proj + (size_t)(row_first + wid * 32 + r32) * PROJ_LD + col0 + hi * 8;
#pragma unroll
    for (int d = 0; d < NQ; ++d) qr[d] = *(const bf16x8*)(q + d * 16);
}
__device__ __forceinline__ void store_o(const f32x16 (&o)[4], bf16_t* mixed, int row_first, int col0) {
    const int lane = ltid() & 63, r32 = lane & 31, hi = lane >> 5, wid = ltid() >> 6;
    const bool odd = (r32 & 1) != 0;
    bf16_t* base = mixed + (size_t)(row_first + wid * 32) * DM + col0 + (r32 & ~1);
#pragma unroll
    for (int rp = 0; rp < 8; ++rp) { const int orow = crow(2 * rp + (odd ? 1 : 0), hi);
#pragma unroll
        for (int d = 0; d < 4; ++d) { const float va = o[d][2 * rp], vb = o[d][2 * rp + 1];
            const float y = dppf<0xB1>(odd ? va : vb);
            *(unsigned*)(base + (size_t)orow * DM + d * 32) = odd ? cvtpk(y, vb) : cvtpk(va, y); } }
}
__device__ __forceinline__ void scr_acc(float* scr, const f32x16 (&o)[4], const float (&f)[16], bool add) {
    f32x4* s = (f32x4*)(scr + (ltid() >> 6) * 4096) + (ltid() & 63);
#pragma unroll
    for (int d = 0; d < 4; ++d)
#pragma unroll
        for (int q = 0; q < 4; ++q) { f32x4 v; v.x = o[d][4 * q] * f[4 * q]; v.y = o[d][4 * q + 1] * f[4 * q + 1]; v.z = o[d][4 * q + 2] * f[4 * q + 2]; v.w = o[d][4 * q + 3] * f[4 * q + 3];
            if (add) v += s[(d * 4 + q) * 64]; s[(d * 4 + q) * 64] = v; }
}
__device__ __forceinline__ void scr_load(const float* scr, f32x16 (&o)[4]) {
    const f32x4* s = (const f32x4*)(scr + (ltid() >> 6) * 4096) + (ltid() & 63);
#pragma unroll
    for (int d = 0; d < 4; ++d)
#pragma unroll
        for (int q = 0; q < 4; ++q) { const f32x4 v = s[(d * 4 + q) * 64]; o[d][4 * q] = v.x; o[d][4 * q + 1] = v.y; o[d][4 * q + 2] = v.z; o[d][4 * q + 3] = v.w; }
}

template <int EXPM = 0>
__device__ __forceinline__ void fox_unit(lptr lds, const bf16_t* proj, const float* gates, float fbias, bf16_t* mixed, int b, int h, int qb, unsigned* qnext, unsigned& pre) {
    const int tid = ltid(), wid = tid >> 6, lane = tid & 63, r32 = lane & 31, hi = lane >> 5;
    const int P0 = qb * 256, rowb = b * SEQ;
    LAS float* cum = (LAS float*)(lds + L_CUM);
    { const int nk = P0 + 256; float run = 0.f; const bool on = 4 * tid < nk;
      float xs[4];
#pragma unroll
      for (int i = 0; i < 4; ++i) xs[i] = gates[(size_t)(rowb + 4 * tid + i) * GATE_LD + h] + fbias;
      if (on) {
#pragma unroll
          for (int i = 0; i < 4; ++i) { const float xx = xs[i];
              run += fminf(xx, 0.f) - __logf(1.f + __expf(-fabsf(xx))); cum[4 * tid + i] = run; }
      }
      float inc = run;
#pragma unroll
      for (int o = 1; o < 64; o <<= 1) { const float t = __builtin_bit_cast(float, __builtin_amdgcn_ds_bpermute(((lane - o) & 63) << 2, __builtin_bit_cast(int, inc))); if (lane >= o) inc += t; }
      LAS float* wsum = (LAS float*)(lds + L_WS);
      if (lane == 63) wsum[wid] = inc;
      __syncthreads();
      float base = 0.f;
#pragma unroll
      for (int w = 0; w < 8; ++w) if (w < wid) base += wsum[w];
      const float ex = base + inc - run;
      if (on) {
#pragma unroll 1
          for (int i = 0; i < 4; ++i) cum[4 * tid + i] = (ex + cum[4 * tid + i]) * LOG2E; }
      __syncthreads();
      const float cref = cum[P0];
      __syncthreads();
      if (on) {
#pragma unroll 1
          for (int i = 0; i < 4; ++i) cum[4 * tid + i] = cref - cum[4 * tid + i]; }
    }
    bf16x8 qr[8]; load_q<8>(qr, proj, rowb + P0, C_FQ + h * 128);
    __syncthreads();
    f32x16 o[4] = {}; float m_reg = -1e30f, l_reg = 0.f;
    const unsigned tm = (qb == 7) ? 0xFFFFFFFFu : ((1u << (4 * (qb + 1))) - 1u);
    if (false) fox_pass(lds, proj + (size_t)rowb * PROJ_LD + C_FK + h * 128, proj + (size_t)rowb * PROJ_LD + C_FV + h * 128, 4 * (qb + 1), qr, P0, cum, o, m_reg, l_reg);
    else attn_pass<K_FOX, 8, EXPM>(lds, proj + (size_t)rowb * PROJ_LD + C_FK + h * 128, proj + (size_t)rowb * PROJ_LD + C_FV + h * 128, PROJ_LD, PROJ_LD, tm, qr, 0, P0, nullptr, cum, 0u, o, m_reg, l_reg);
    if (tid == 0) pre = __hip_atomic_fetch_add(qnext, 1u, __ATOMIC_RELAXED, __HIP_MEMORY_SCOPE_AGENT);
    float f[16]; rowbcast((LAS float*)(lds + L_WS) + wid * 64, fast_rcp(l_reg), r32, hi, f);
#pragma unroll
    for (int d = 0; d < 4; ++d)
#pragma unroll
        for (int r = 0; r < 16; ++r) o[d][r] *= f[r];
    store_o(o, mixed, rowb + P0, h * 128);
    __syncthreads();
}
__device__ __forceinline__ void diff_unit(lptr lds, const bf16_t* proj, bf16_t* mixed, float* scr, int b, int h, int qb, float lam, float out_scale, const float* subln_g, unsigned* qnext, unsigned& pre) {
    const int tid = ltid(), wid = tid >> 6, lane = tid & 63, r32 = lane & 31, hi = lane >> 5;
    const int P0 = qb * 256, rowb = b * SEQ;
    const LAS float* lut = (const LAS float*)(lds + L_LUT) + h * 128;
    LAS float* wsl = (LAS float*)(lds + L_WS) + wid * 64;
    const unsigned tm = (qb == 7) ? 0xFFFFFFFFu : ((1u << (4 * (qb + 1))) - 1u);
    const bf16_t* Kg = proj + (size_t)rowb * PROJ_LD + C_DK + h * 128; const bf16_t* Vg = proj + (size_t)rowb * PROJ_LD + C_DV + h * 128;
    f32x16 ot[4];
#pragma unroll 1
    for (int mp = 0; mp < 2; ++mp) {
        bf16x8 qr[8]; load_q<4>(qr, proj, rowb + P0, C_DQ + h * 128 + mp * 64);
        f32x16 o[4] = {}; float m_reg = -1e30f, l_reg = 0.f;
        attn_pass<K_DIFF, 4>(lds, Kg, Vg, PROJ_LD, PROJ_LD, tm, qr, mp * 4, P0, lut, nullptr, 0u, o, m_reg, l_reg);
        float f[16]; rowbcast(wsl, (mp == 0 ? 1.f : -lam) * fast_rcp(l_reg), r32, hi, f);
        if (mp == 0) scr_acc(scr, o, f, false);
        else {
            if (tid == 0) pre = __hip_atomic_fetch_add(qnext, 1u, __ATOMIC_RELAXED, __HIP_MEMORY_SCOPE_AGENT);
            scr_load(scr, ot);
#pragma unroll
            for (int d = 0; d < 4; ++d)
#pragma unroll
                for (int r = 0; r < 16; ++r) ot[d][r] += o[d][r] * f[r];
        }
    }
    float gcol[4];
#pragma unroll
    for (int d = 0; d < 4; ++d) gcol[d] = subln_g[d * 32 + r32] * out_scale;
#pragma unroll
    for (int r = 0; r < 16; ++r) {
        float ss = ot[0][r] * ot[0][r] + ot[1][r] * ot[1][r] + ot[2][r] * ot[2][r] + ot[3][r] * ot[3][r];
        ss += dppf<0x128>(ss); ss += dppf<0x124>(ss); ss += dppf<0x122>(ss); ss += dppf<0x121>(ss); ss += shx(ss, 16);
        const float rn = __builtin_amdgcn_rsqf(ss * (1.f / 128.f) + RMS_EPS);
#pragma unroll
        for (int d = 0; d < 4; ++d) ot[d][r] *= rn * gcol[d];
    }
    store_o(ot, mixed, rowb + P0, 768 + h * 128);
    __syncthreads();
}
__device__ __forceinline__ void nsa_unit(lptr lds, const bf16_t* proj, const float* gates, const bf16_t* kcmp, const bf16_t* vcmp, bf16_t* mixed, float* scr, int b, int g, int qb, unsigned* qnext, unsigned& pre) {
    const int tid = ltid(), wid = tid >> 6, lane = tid & 63, r32 = lane & 31, hi = lane >> 5;
    const int P0 = qb * 256, rowb = b * SEQ;
    const int qlo = P0 + wid * 32, qpos = qlo + r32;
    LAS float* wsl = (LAS float*)(lds + L_WS) + wid * 64;
    LAS float* imp = (LAS float*)(lds + L_IMP);
    LAS unsigned* sel = (LAS unsigned*)(lds + L_SEL);
    LAS unsigned* uni = (LAS unsigned*)(lds + L_UNI);
    const float NEG = -__builtin_inff();
    const bf16_t* kc = kcmp + (size_t)(b * 2 + g) * 128 * 128; const bf16_t* vc = vcmp + (size_t)(b * 2 + g) * 128 * 128;
    { const int sr = tid >> 4, sc = (tid & 15) * 8, kws = KSWZ(sr, sc * 2);
#pragma unroll
      for (int t = 0; t < 2; ++t) { const bf16x8 a = *(const bf16x8*)(kc + (size_t)(t * 64 + sr) * 128 + sc), c = *(const bf16x8*)(kc + (size_t)(t * 64 + 32 + sr) * 128 + sc);
          *(LAS bf16x8*)(lds + L_K + t * SHM + kws) = a; *(LAS bf16x8*)(lds + L_K + t * SHM + kws + 32 * 256) = c; }
      if (tid == 0) uni[0] = 0u; }
    __syncthreads();
    float ia[16], ic[16];
#pragma unroll
    for (int i = 0; i < 16; ++i) { ia[i] = 0.f; ic[i] = 0.f; }
#pragma unroll 1
    for (int hh = 0; hh < 3; ++hh) {
        const int hd = g * 3 + hh; const LAS float* lut = (const LAS float*)(lds + L_LUT) + (4 + hd) * 128;
        bf16x8 qr[8]; load_q<8>(qr, proj, rowb + P0, C_NQ + hd * 128);
        f32x16 p[4];
        qkt<8>(p[0], p[1], lds + L_K, 0, r32, hi, qr); qkt<8>(p[2], p[3], lds + L_K + SHM, 0, r32, hi, qr);
        float mx = -1e30f;
#pragma unroll
        for (int q4 = 0; q4 < 4; ++q4)
#pragma unroll
            for (int r = 0; r < 16; ++r) { const int n = q4 * 32 + 4 * hi + ccol(r); const int rel = qpos - 31 - 16 * n;
                float s = p[q4][r] + lut[min(max(rel, 0), 127)]; if (rel < 0 || n >= 127) s = NEG; p[q4][r] = s; mx = fmaxf(mx, s); }
        mx = fmaxf(mx, shx(mx, 32));
        float ps = 0.f;
#pragma unroll
        for (int q4 = 0; q4 < 4; ++q4)
#pragma unroll
            for (int r = 0; r < 16; ++r) { p[q4][r] = fast_exp2(p[q4][r] - mx); ps += p[q4][r]; }
        ps += shx(ps, 32);
        const float inv = ps > 0.f ? 1.f / ps : 0.f;
#pragma unroll
        for (int q4 = 0; q4 < 4; ++q4)
#pragma unroll
            for (int i = 0; i < 4; ++i) { const float x0 = p[q4][4 * i] * inv, x1 = p[q4][4 * i + 1] * inv, x2 = p[q4][4 * i + 2] * inv, x3 = p[q4][4 * i + 3] * inv;
                ia[q4 * 4 + i] += x0 + x1 + x2 + 0.5f * x3; ic[q4 * 4 + i] += 0.5f * x3; }
    }
#pragma unroll
    for (int gi = 0; gi < 16; ++gi) {
        const float cp = shx(ic[gi], 32);
        const float cpm = (gi > 0) ? shx(ic[gi > 0 ? gi - 1 : 0], 32) : 0.f;
        const float v = ia[gi] + (hi ? cp : cpm);
        imp[(wid * 32 + r32) * 33 + 2 * gi + hi] = v;
    }
    __syncthreads();
    if (tid < 256) {
        const int t = P0 + tid, blk = t >> 6;
        float sc[32];
#pragma unroll
        for (int j2 = 0; j2 < 32; ++j2) { const bool forced = (j2 == 0) || (j2 == blk) || (j2 == blk - 1);
            sc[j2] = (j2 <= blk) ? (imp[tid * 33 + j2] + (forced ? 1e4f : 0.f)) : -1e30f; }
        unsigned mask = 0u;
#pragma unroll 1
        for (int it = 0; it < 8; ++it) { float best = -1e30f; int bi = -1;
#pragma unroll
            for (int j2 = 0; j2 < 32; ++j2) { const bool free_ = ((mask >> j2) & 1u) == 0u; if (free_ && sc[j2] > best) { best = sc[j2]; bi = j2; } }
            if (bi >= 0 && best > -0.5e30f) mask |= 1u << bi; }
        sel[tid] = mask;
        atomicOr((unsigned*)uni, mask);
    }
    __syncthreads();
    const unsigned selm = sel[wid * 32 + r32];
    const unsigned um = uni[0];
#pragma unroll 1
    for (int hp = 0; hp < 3; ++hp) {
    const int h6 = g * 3 + hp;
    const float* gp = gates + (size_t)(rowb + qpos) * GATE_LD + 6 + h6 * 3;
    const float g0 = 1.f / (1.f + __expf(-gp[0])), g1 = 1.f / (1.f + __expf(-gp[1])), g2 = 1.f / (1.f + __expf(-gp[2]));
    const LAS float* lut = (const LAS float*)(lds + L_LUT) + (4 + h6) * 128;
    bf16x8 qr[8]; load_q<8>(qr, proj, rowb + P0, C_NQ + h6 * 128);
    {
        f32x16 o[4] = {}; float m_reg = -1e30f, l_reg = 0.f;
        attn_pass<K_CMP, 8>(lds, kc, vc, 128, 128, 3u, qr, 0, P0, lut, nullptr, 0u, o, m_reg, l_reg);
        float f[16]; rowbcast(wsl, l_reg > 0.f ? g0 / l_reg : 0.f, r32, hi, f);
        scr_acc(scr, o, f, false);
    }
    {
        f32x16 o[4] = {}; float m_reg = -1e30f, l_reg = 0.f;
        const unsigned cm = (qb == 7) ? 0xFFFFFFFFu : ((1u << (4 * (qb + 1))) - 1u);
        attn_pass<K_SEL, 8>(lds, proj + (size_t)rowb * PROJ_LD + C_NKS + g * 128, proj + (size_t)rowb * PROJ_LD + C_NVS + g * 128, PROJ_LD, PROJ_LD, um & cm, qr, 0, P0, lut, nullptr, selm, o, m_reg, l_reg);
        float f[16]; rowbcast(wsl, l_reg > 0.f ? g1 / l_reg : 0.f, r32, hi, f);
        scr_acc(scr, o, f, true);
    }
    {
        f32x16 o[4] = {}; float m_reg = -1e30f, l_reg = 0.f;
        const int jlo = (P0 - 511) > 0 ? (P0 - 511) >> 6 : 0, jhi = (P0 + 255) >> 6;
        const unsigned hiM = (jhi == 31) ? 0xFFFFFFFFu : ((1u << (jhi + 1)) - 1u);
        const unsigned wm = hiM & ~((1u << jlo) - 1u);
        attn_pass<K_WIN, 8>(lds, proj + (size_t)rowb * PROJ_LD + C_NKW + g * 128, proj + (size_t)rowb * PROJ_LD + C_NVW + g * 128, PROJ_LD, PROJ_LD, wm, qr, 0, P0, lut, nullptr, 0u, o, m_reg, l_reg);
        if (hp == 2 && tid == 0) pre = __hip_atomic_fetch_add(qnext, 1u, __ATOMIC_RELAXED, __HIP_MEMORY_SCOPE_AGENT);
        float f[16]; rowbcast(wsl, l_reg > 0.f ? g2 / l_reg : 0.f, r32, hi, f);
        f32x16 ot[4]; scr_load(scr, ot);
#pragma unroll
        for (int d = 0; d < 4; ++d)
#pragma unroll
            for (int r = 0; r < 16; ++r) ot[d][r] += o[d][r] * f[r];
        store_o(ot, mixed, rowb + P0, 1280 + h6 * 128);
    }
    __syncthreads();
    }
}
#undef KSWZ
}

struct Params {
    const float* x; const float* attn_norm_g; const float* w_in; const float* fox_f_bias; const float* lq1; const float* lk1; const float* lq2; const float* lk2;
    const float* subln_g; const float* cmp_pos; const float* wk1; const float* wk2; const float* wv1; const float* wv2; const float* w_out; const float* ffn_norm_g;
    const float* w_up; const float* conv_w; const float* conv_b; const float* w_down; const float* rel_bias; const float* final_g;
    float* out; unsigned char* ws;
    int l_begin, l_end, do_prologue, do_final, bar_region, ph_mask;
};

typedef const __attribute__((address_space(4))) Params* KP;
__device__ __forceinline__ KP kparams() { unsigned long long a = (unsigned long long)__builtin_amdgcn_kernarg_segment_ptr(); asm volatile("" : "+s"(a)); return (KP)a; }

template <int MAPK>
__device__ __forceinline__ void transpose_item(const float* __restrict__ src, int ldsrc, const float* __restrict__ kscale, bf16_t* __restrict__ dst, int K, int k0, int n0, LAS float* scr, int lane) {
    const int c = n0 + (lane & 31);
    const int oc = (MAPK == 1) ? win_colmap(c) : (MAPK == 2) ? wup_colmap(c) : c;
    const float* sp = src + (size_t)(k0 + (lane >> 5)) * ldsrc + (oc >= 0 ? oc : 0);
    float v[32];
#pragma unroll
    for (int i = 0; i < 32; ++i) v[i] = __builtin_nontemporal_load(sp + (size_t)(2 * i) * ldsrc);
    if (kscale) {
#pragma unroll
        for (int i = 0; i < 32; ++i) v[i] *= kscale[k0 + 2 * i + (lane >> 5)];
    }
#pragma unroll
    for (int i = 0; i < 32; ++i) scr[(2 * i + (lane >> 5)) * 33 + (lane & 31)] = (oc < 0) ? 0.f : v[i];
    asm volatile("s_waitcnt lgkmcnt(0)" ::: "memory");
    const int cc = lane & 7;
#pragma unroll
    for (int j = 0; j < 4; ++j) { const int n = (lane >> 3) + 8 * j; const LAS float* s = scr + (8 * cc) * 33 + n;
        u32x4 o; o.x = cvtpk(s[0], s[33]); o.y = cvtpk(s[2 * 33], s[3 * 33]); o.z = cvtpk(s[4 * 33], s[5 * 33]); o.w = cvtpk(s[6 * 33], s[7 * 33]);
        *(u32x4*)(dst + (size_t)(n0 + n) * K + k0 + 8 * cc) = o; }
    asm volatile("s_waitcnt lgkmcnt(0)" ::: "memory");
}

constexpr int T_IN = (DM / 64) * (NINP / 32), T_OUT = (DM / 64) * (DM / 32), T_UP = (DM / 64) * (NUP / 32), T_DN = (DFF / 64) * (DM / 32), T_W1 = (4096 / 64) * 4, T_W2 = 2 * 4;
constexpr int T_LAYER = T_IN + T_OUT + T_UP + T_DN + 2 * T_W1 + 2 * T_W2;
__device__ __forceinline__ void convert_item(KP p, int l, int r, LAS float* scr, int lane) {
    unsigned char* ws = p->ws;
    if (r < T_IN) { const int nb = NINP / 32; transpose_item<1>(p->w_in + (size_t)l * DM * NIN, NIN, p->attn_norm_g + l * DM, (bf16_t*)(ws + WS_WIN) + (size_t)l * NINP * DM, DM, (r / nb) * 64, (r % nb) * 32, scr, lane); return; } r -= T_IN;
    if (r < T_OUT) { const int nb = DM / 32; transpose_item<0>(p->w_out + (size_t)l * DM * DM, DM, nullptr, (bf16_t*)(ws + WS_WOUT) + (size_t)l * DM * DM, DM, (r / nb) * 64, (r % nb) * 32, scr, lane); return; } r -= T_OUT;
    if (r < T_UP) { const int nb = NUP / 32; transpose_item<2>(p->w_up + (size_t)l * DM * NUP, NUP, p->ffn_norm_g + l * DM, (bf16_t*)(ws + WS_WUP) + (size_t)l * NUP * DM, DM, (r / nb) * 64, (r % nb) * 32, scr, lane); return; } r -= T_UP;
    if (r < T_DN) { const int nb = DM / 32; transpose_item<0>(p->w_down + (size_t)l * DFF * DM, DM, nullptr, (bf16_t*)(ws + WS_WDN) + (size_t)l * DM * DFF, DFF, (r / nb) * 64, (r % nb) * 32, scr, lane); return; } r -= T_DN;
    if (r < 2 * T_W1) { const int kv = r / T_W1, rr = r % T_W1; const float* src = (kv ? p->wv1 : p->wk1) + (size_t)l * 4096 * 128;
        transpose_item<0>(src, 128, nullptr, (bf16_t*)(ws + WS_W1T) + (size_t)(l * 2 + kv) * 128 * 4096, 4096, (rr / 4) * 64, (rr % 4) * 32, scr, lane); return; } r -= 2 * T_W1;
    { const int kv = r / T_W2, rr = r % T_W2; const float* src = (kv ? p->wv2 : p->wk2) + (size_t)l * 128 * 128;
        transpose_item<0>(src, 128, nullptr, (bf16_t*)(ws + WS_W2T) + (size_t)(l * 2 + kv) * 128 * 128, 128, (rr / 4) * 64, (rr % 4) * 32, scr, lane); }
}
__device__ __forceinline__ void prologue_phase(KP p, LAS unsigned char* lds) {
    const int tid = ltid(), lane = tid & 63, wave = tid >> 6;
    LAS float* scr = (LAS float*)lds + wave * (64 * 33);
    const int G = gridDim.x, bx = blockIdx.x;
    unsigned char* ws = p->ws;
    for (int it = bx * 8 + wave; it < T_LAYER; it += G * 8) convert_item(p, 0, it, scr, lane);
    __syncthreads();
    { LAS float* scr = (LAS float*)lds;
    for (int it = bx; it < DEPTH * 2 * 8; it += G) {
        const int l = it >> 4, kv = (it >> 3) & 1, c0 = (it & 7) * 16; const float* w1 = (kv ? p->wv1 : p->wk1) + (size_t)l * 4096 * 128; const float* pos = p->cmp_pos + (size_t)l * 4096;
        const int col = c0 + (tid & 15), ks = tid >> 4; float s = 0.f;
#pragma unroll 8
        for (int k = ks * 128; k < ks * 128 + 128; ++k) s += pos[k] * w1[(size_t)k * 128 + col];
        scr[tid] = s; __syncthreads();
        if (tid < 16) { float a = 0.f; for (int j = 0; j < 32; ++j) a += scr[j * 16 + tid]; ((float*)(ws + WS_POSC))[(l * 2 + kv) * 128 + c0 + tid] = a; }
        __syncthreads();
    }
    }
    { const int gw = bx * 8 + wave, NGW = G * 8; bf16_t* hb = (bf16_t*)(ws + WS_HB);
      for (int row = gw; row < MROWS; row += NGW) {
          const f32x4* xr = (const f32x4*)(p->x + (size_t)row * DM) + lane; f32x4 v[8]; float ss = 0.f;
#pragma unroll
          for (int j = 0; j < 8; ++j) { v[j] = __builtin_nontemporal_load(xr + 64 * j); ss += (v[j].x * v[j].x + v[j].y * v[j].y) + (v[j].z * v[j].z + v[j].w * v[j].w); }
          ss = wave_sum(ss);
          if (lane < 32) ((float*)(ws + WS_SSQP))[(size_t)row * 32 + lane] = (lane == 0) ? ss : 0.f;
          u32x2* o = (u32x2*)(hb + (size_t)row * DM) + lane;
#pragma unroll
          for (int j = 0; j < 8; ++j) { u32x2 w; w.x = cvtpk(v[j].x, v[j].y); w.y = cvtpk(v[j].z, v[j].w); o[64 * j] = w; }
      } }
}

__device__ __forceinline__ int panel_a() { return 16 * ((int)blockIdx.x & 7) + (((int)blockIdx.x >> 3) & 7); }
__device__ __forceinline__ void rstd_prefix(KP p, LAS unsigned char* lds) {
    const int tid = ltid(); const float* ssqp = (const float*)(p->ws + WS_SSQP); LAS float* rstab = (LAS float*)(lds + LX_RSTAB);
    const int row = (panel_a() + 8 * (tid >> 8)) * 256 + (tid & 255);
    const f32x4* q = (const f32x4*)(ssqp + (size_t)row * 32); float s = 0.f;
#pragma unroll
    for (int j = 0; j < 8; ++j) { const f32x4 v = q[j]; s += (v.x + v.y) + (v.z + v.w); }
    rstab[tid] = __builtin_amdgcn_rsqf(s * (1.f / DM) + RMS_EPS);
    __syncthreads();
}
__device__ __forceinline__ void gate_prefix(KP p, int l, LAS unsigned char* lds) {
    const int tid = ltid(), lane = tid & 63, wave = tid >> 6, r32 = lane & 31, hi = lane >> 5;
    const bf16_t* hb = (const bf16_t*)(p->ws + WS_HB); const bf16_t* wg = (const bf16_t*)(p->ws + WS_WIN) + ((size_t)l * NINP + 6144) * DM;
    float* gates = (float*)(p->ws + WS_GATES); const LAS float* rstab = (const LAS float*)(lds + LX_RSTAB);
    constexpr int WPITCH = DM * 2 + 16;
    for (int i = tid; i < 32 * (DM / 8); i += 512) { const int r = i >> 8, c8 = i & 255; *(LAS bf16x8*)(lds + r * WPITCH + c8 * 16) = *(const bf16x8*)(wg + (size_t)r * DM + c8 * 8); }
    __syncthreads();
    if (wave < 4) {
        const int slot = wave >> 1, prow = ((int)blockIdx.x >> 6) * 64 + (wave & 1) * 32;
        const int row0 = (panel_a() + 8 * slot) * 256 + prow;
        const float rs = rstab[slot * 256 + prow + r32];
        const bf16_t* ap = hb + (size_t)(row0 + r32) * DM + hi * 8; const LAS unsigned char* bp = lds + r32 * WPITCH + hi * 16;
        f32x16 acc = {};
#pragma unroll 1
        for (int k32 = 0; k32 < 4; ++k32) { bf16x8 a[32];
#pragma unroll
            for (int j = 0; j < 32; ++j) a[j] = *(const bf16x8*)(ap + (k32 * 32 + j) * 16);
#pragma unroll
            for (int j = 0; j < 32; ++j) { const bf16x8 b = *(const LAS bf16x8*)(bp + (k32 * 32 + j) * 32); acc = __builtin_amdgcn_mfma_f32_32x32x16_bf16(a[j], b, acc, 0, 0, 0); } }
#pragma unroll
        for (int r = 0; r < 16; ++r) { const int rr = att::crow(r, hi);
            const float rsr = __builtin_bit_cast(float, __builtin_amdgcn_ds_bpermute(rr << 2, __builtin_bit_cast(int, rs)));
            if (r32 < 24) gates[(size_t)(row0 + rr) * GATE_LD + r32] = acc[r] * rsr; }
    }
    __syncthreads();
}
__device__ __forceinline__ void fixup_prefix(KP p, int l) {
    const float* halo = (const float*)(p->ws + WS_HALO); bf16_t* act = (bf16_t*)(p->ws + WS_PROJ);
    const float* cw = p->conv_w + (size_t)l * 3 * NUP; const float* cb = p->conv_b + (size_t)l * NUP;
    const int pa = panel_a();
#pragma unroll 2
    for (int i = ltid(); i < 2 * (DFF / 4); i += 512) {
        const int c4 = i % (DFF / 4), pm = pa + 8 * (i / (DFF / 4)), ch = c4 * 4;
        const int tg = (ch >> 7) * 256 + (ch & 127), tu = tg + 128;
        const bool has_prev = (pm & 7) != 0;
        const float* hc = halo + (size_t)(pm * 4) * NUP; const float* hp = halo + (size_t)((has_prev ? pm - 1 : pm) * 4) * NUP;
        const f32x4 c0g = *(const f32x4*)(hc + tg), c0u = *(const f32x4*)(hc + tu), c1g = *(const f32x4*)(hc + NUP + tg), c1u = *(const f32x4*)(hc + NUP + tu);
        f32x4 p3g = *(const f32x4*)(hp + 3 * NUP + tg), p3u = *(const f32x4*)(hp + 3 * NUP + tu), p2g = *(const f32x4*)(hp + 2 * NUP + tg), p2u = *(const f32x4*)(hp + 2 * NUP + tu);
        const f32x4 w0g = *(const f32x4*)(cw + ch), w1g = *(const f32x4*)(cw + NUP + ch), w2g = *(const f32x4*)(cw + 2 * NUP + ch), bg = *(const f32x4*)(cb + ch);
        const f32x4 w0u = *(const f32x4*)(cw + DFF + ch), w1u = *(const f32x4*)(cw + NUP + DFF + ch), w2u = *(const f32x4*)(cw + 2 * NUP + DFF + ch), bu = *(const f32x4*)(cb + DFF + ch);
        if (!has_prev) { p3g = f32x4{0.f, 0.f, 0.f, 0.f}; p3u = p3g; p2g = p3g; p2u = p3g; }
        float o0[4], o1[4];
#pragma unroll
        for (int e = 0; e < 4; ++e) {
            const float yg0 = w0g[e] * p2g[e] + w1g[e] * p3g[e] + w2g[e] * c0g[e] + bg[e], yu0 = w0u[e] * p2u[e] + w1u[e] * p3u[e] + w2u[e] * c0u[e] + bu[e];
            const float yg1 = w0g[e] * p3g[e] + w1g[e] * c0g[e] + w2g[e] * c1g[e] + bg[e], yu1 = w0u[e] * p3u[e] + w1u[e] * c0u[e] + w2u[e] * c1u[e] + bu[e];
            o0[e] = yg0 * fast_rcp(1.f + fast_exp2(-yg0 * LOG2E)) * yu0; o1[e] = yg1 * fast_rcp(1.f + fast_exp2(-yg1 * LOG2E)) * yu1;
        }
        u32x2 s0, s1; s0.x = cvtpk(o0[0], o0[1]); s0.y = cvtpk(o0[2], o0[3]); s1.x = cvtpk(o1[0], o1[1]); s1.y = cvtpk(o1[2], o1[3]);
        *(u32x2*)(act + (size_t)(pm * 256) * DFF + ch) = s0; *(u32x2*)(act + (size_t)(pm * 256 + 1) * DFF + ch) = s1;
    }
    asm volatile("s_waitcnt vmcnt(0)" ::: "memory");
    __syncthreads();
}
__device__ __forceinline__ void final_phase(KP p) {
    const int lane = ltid() & 63, wave = ltid() >> 6; const float* ssqp = (const float*)(p->ws + WS_SSQP);
    for (int row = blockIdx.x * 8 + wave; row < MROWS; row += gridDim.x * 8) {
        float s = (lane < 32) ? ssqp[(size_t)row * 32 + lane] : 0.f; s = wave_sum(s);
        const float rs = __builtin_amdgcn_rsqf(s * (1.f / DM) + RMS_EPS);
        f32x4* o = (f32x4*)(p->out + (size_t)row * DM) + lane; const f32x4* gq = (const f32x4*)p->final_g + lane;
        const u32x2* hq = (const u32x2*)((const bf16_t*)(p->ws + WS_HB) + (size_t)row * DM) + lane;
#pragma unroll
        for (int j = 0; j < 8; ++j) { const u32x2 hv = hq[64 * j]; const f32x4 gg = gq[64 * j]; f32x4 v;
            v.x = __builtin_bit_cast(float, hv.x << 16); v.y = __builtin_bit_cast(float, hv.x & 0xFFFF0000u); v.z = __builtin_bit_cast(float, hv.y << 16); v.w = __builtin_bit_cast(float, hv.y & 0xFFFF0000u);
            __builtin_nontemporal_store(v * rs * gg, o + 64 * j); }
    }
}
__device__ __forceinline__ float gelu_tanh(float x) { const float u = 0.7978845608028654f * (x + 0.044715f * x * x * x); const float e = __expf(2.f * u); const float th = 1.f - 2.f / (e + 1.f); return 0.5f * x * (1.f + th); }
__device__ __forceinline__ void compress_unit(KP p, int l, LAS unsigned char* lds, int upair) {
    const int tid = ltid(), wid = tid >> 6, lane = tid & 63, fr = lane & 15, fq = lane >> 4;
    const int nblk = wid & 3, grp = wid >> 2;
    const int unit = upair * 2 + grp;
    const int mc = unit & 3, kv = (unit >> 2) & 1, g = (unit >> 3) & 1, b = unit >> 4;
    const bf16_t* proj = (const bf16_t*)(p->ws + WS_PROJ);
    const bf16_t* w1t = (const bf16_t*)(p->ws + WS_W1T) + (size_t)(l * 2 + kv) * 128 * 4096;
    const bf16_t* w2t = (const bf16_t*)(p->ws + WS_W2T) + (size_t)(l * 2 + kv) * 128 * 128;
    const float* posc = (const float*)(p->ws + WS_POSC) + (l * 2 + kv) * 128;
    bf16_t* outp = (bf16_t*)(p->ws + (kv ? WS_VCMP : WS_KCMP)) + (size_t)(b * 2 + g) * 128 * 128;
    const bf16_t* arow[2]; const bf16_t* brow[2];
#pragma unroll
    for (int i = 0; i < 2; ++i) { const int n = mc * 32 + i * 16 + fr, nc = n < 127 ? n : 126;
        arow[i] = proj + (size_t)(b * SEQ + 16 * nc) * PROJ_LD + (kv ? C_NVC : C_NKC) + g * 128 + fq * 8;
        brow[i] = w1t + (size_t)(nblk * 32 + i * 16 + fr) * 4096 + fq * 8; }
    f32x4 acc[2][2] = {};
#define CMP_LOAD(A_, B_, LL) do { _Pragma("unroll") for (int i = 0; i < 2; ++i) _Pragma("unroll") for (int j = 0; j < 4; ++j) { \
        A_[i][j] = *(const bf16x8*)(arow[i] + (size_t)(LL) * PROJ_LD + j * 32); B_[i][j] = *(const bf16x8*)(brow[i] + (LL) * 128 + j * 32); } } while (0)
#define CMP_MMA(A_, B_) do { _Pragma("unroll") for (int j = 0; j < 4; ++j) _Pragma("unroll") for (int mi = 0; mi < 2; ++mi) _Pragma("unroll") for (int ni = 0; ni < 2; ++ni) \
        acc[mi][ni] = __builtin_amdgcn_mfma_f32_16x16x32_bf16(A_[mi][j], B_[ni][j], acc[mi][ni], 0, 0, 0); } while (0)
    bf16x8 a0[2][4], b0[2][4], a1[2][4], b1[2][4];
    CMP_LOAD(a0, b0, 0);
#pragma unroll 1
    for (int ll = 0; ll < 32; ll += 2) {
        CMP_LOAD(a1, b1, ll + 1);
        CMP_MMA(a0, b0);
        if (ll + 2 < 32) CMP_LOAD(a0, b0, ll + 2);
        CMP_MMA(a1, b1);
    }
#undef CMP_LOAD
#undef CMP_MMA
    LAS bf16_t* hid = (LAS bf16_t*)(lds + grp * 16384);
#pragma unroll
    for (int ni = 0; ni < 2; ++ni) { const int col = nblk * 32 + ni * 16 + fr; const float pc = posc[col];
#pragma unroll
        for (int mi = 0; mi < 2; ++mi)
#pragma unroll
            for (int i = 0; i < 4; ++i) hid[(mi * 16 + 4 * fq + i) * 136 + col] = (bf16_t)(cvtpk(gelu_tanh(acc[mi][ni][i] + pc), 0.f) & 0xFFFFu); }
    __syncthreads();
    {
        f32x4 acc2[2][2] = {};
#pragma unroll
        for (int j = 0; j < 4; ++j) { bf16x8 a2[2], b2[2];
#pragma unroll
            for (int i = 0; i < 2; ++i) { a2[i] = *(const LAS bf16x8*)(hid + (i * 16 + fr) * 136 + j * 32 + fq * 8); b2[i] = *(const bf16x8*)(w2t + (size_t)(nblk * 32 + i * 16 + fr) * 128 + j * 32 + fq * 8); }
#pragma unroll
            for (int mi = 0; mi < 2; ++mi)
#pragma unroll
                for (int ni = 0; ni < 2; ++ni) acc2[mi][ni] = __builtin_amdgcn_mfma_f32_16x16x32_bf16(a2[mi], b2[ni], acc2[mi][ni], 0, 0, 0); }
#pragma unroll
        for (int mi = 0; mi < 2; ++mi)
#pragma unroll
            for (int ni = 0; ni < 2; ++ni)
#pragma unroll
                for (int i = 0; i < 4; ++i) { const int nr = mc * 32 + mi * 16 + 4 * fq + i; const float v = (nr < 127) ? acc2[mi][ni][i] : 0.f;
                    outp[(size_t)nr * 128 + nblk * 32 + ni * 16 + fr] = (bf16_t)(cvtpk(v, 0.f) & 0xFFFFu); }
    }
    __syncthreads();
}
__device__ __forceinline__ void cumsum_unit(KP p, int l, LAS unsigned char* lds, int unit) {
    const int tid = ltid(), lane = tid & 63, wid = tid >> 6; const int b = unit / 6, h = unit % 6;
    const float* gates = (const float*)(p->ws + WS_GATES); float* c2 = (float*)(p->ws + WS_CUM) + (size_t)unit * SEQ;
    const float fb = p->fox_f_bias[l * 6 + h];
    float v[4], run = 0.f;
#pragma unroll
    for (int i = 0; i < 4; ++i) { const float xx = gates[(size_t)(b * SEQ + 4 * tid + i) * GATE_LD + h] + fb;
        const float ls = fminf(xx, 0.f) - log1pf(__expf(-fabsf(xx))); run += ls; v[i] = run; }
    float inc = run;
#pragma unroll
    for (int o = 1; o < 64; o <<= 1) { const float t = __builtin_bit_cast(float, __builtin_amdgcn_ds_bpermute(((lane - o) & 63) << 2, __builtin_bit_cast(int, inc))); if (lane >= o) inc += t; }
    LAS float* wsum = (LAS float*)lds;
    if (lane == 63) wsum[wid] = inc;
    __syncthreads();
    float base = 0.f;
#pragma unroll
    for (int w = 0; w < 8; ++w) if (w < wid) base += wsum[w];
    const float ex = base + inc - run;
#pragma unroll
    for (int i = 0; i < 4; ++i) c2[4 * tid + i] = (ex + v[i]) * LOG2E;
    __syncthreads();
}

#ifndef ATT_EN
#define ATT_EN 7
#endif
__device__ __forceinline__ void attention_phase(KP p, int lq, LAS unsigned char* lds_u, volatile LAS unsigned* misc) {
#ifdef ATT_DUPK
    const int att_en = (lq >= 4) ? (ATT_DUPK) : (ATT_EN);
#else
    constexpr int att_en = ATT_EN;
#endif
    const int l = lq & 3;
    att::lptr lds = (att::lptr)lds_u;
    const int tid = ltid();
    unsigned* ctl = (unsigned*)(p->ws + WS_CTL);
    const bf16_t* proj = (const bf16_t*)(p->ws + WS_PROJ); bf16_t* mixed = (bf16_t*)(p->ws + WS_MIXED);
    const float* gates = (const float*)(p->ws + WS_GATES);
    float* scr = (float*)(p->ws + WS_SCR) + (size_t)blockIdx.x * 32768;
    const bf16_t* kcmp = (const bf16_t*)(p->ws + WS_KCMP); const bf16_t* vcmp = (const bf16_t*)(p->ws + WS_VCMP);
    { LAS float* lut = (LAS float*)(lds + att::L_LUT);
      for (int i = tid; i < 1280; i += 512) { const int hh = i >> 7, rel = i & 127; lut[i] = (p->rel_bias[(int)T5B[rel] * 10 + hh] - p->rel_bias[31 * 10 + hh]) * LOG2E; } }
    const int lane = tid & 63;
    const float s1 = wave_sum(p->lq1[l * 64 + lane] * p->lk1[l * 64 + lane]), s2 = wave_sum(p->lq2[l * 64 + lane] * p->lk2[l * 64 + lane]);
    const float lam_init = 0.8f - 0.6f * __expf(-0.3f * (float)l);
    const float lam = __expf(s1) - __expf(s2) + lam_init;
    constexpr int QN_CMP = 16, QN_DIFF = 64, QN_NSA = 32, QN_FOX = 96, QN = QN_CMP + QN_DIFF + QN_NSA + QN_FOX;
    if ((tid >> 6) >= 4) __builtin_amdgcn_s_setprio(1); else __builtin_amdgcn_s_setprio(0);
    const int home = (int)(xb_xcc_id() & 7u);
    unsigned cmp_seen = 0u;
    int qx = home;
    unsigned pre = 0xFFFFFFFFu;
    __syncthreads();
    for (;;) {
        if (tid == 0) {
            unsigned* qh = ctl + CW_QUEUE + (lq * 8) * 64;
            unsigned iv = (pre != 0xFFFFFFFFu) ? pre : __hip_atomic_fetch_add(qh + qx * 64, 1u, __ATOMIC_RELAXED, __HIP_MEMORY_SCOPE_AGENT); int q = qx; pre = 0xFFFFFFFFu;
            if (iv >= (unsigned)QN) {
                unsigned hv[7];
#pragma unroll
                for (int k = 1; k < 8; ++k) hv[k - 1] = __hip_atomic_load(qh + ((qx + k) & 7) * 64, __ATOMIC_RELAXED, __HIP_MEMORY_SCOPE_AGENT);
#pragma unroll
                for (int k = 1; k < 8; ++k) if (iv >= (unsigned)QN && hv[k - 1] < (unsigned)QN) {
                    const unsigned t = __hip_atomic_fetch_add(qh + ((qx + k) & 7) * 64, 1u, __ATOMIC_RELAXED, __HIP_MEMORY_SCOPE_AGENT);
                    if (t < (unsigned)QN) { iv = t; q = (qx + k) & 7; } }
            }
            misc[4] = iv; misc[5] = (unsigned)q;
        }
        __syncthreads();
        const int idx = (int)misc[4]; qx = (int)misc[5];
        __syncthreads();
        if (idx >= QN) break;
        unsigned* cdone = ctl + CW_CMPDONE + (lq * 8 + qx) * 64;
        if (idx < QN_CMP) {
            const int gi = qx * 4 + (idx >> 2), pr = idx & 3;
            compress_unit(p, l, lds_u, gi * 4 + pr);
            asm volatile("s_waitcnt vmcnt(0)" ::: "memory");
            __syncthreads();
            if (tid == 0) { __builtin_amdgcn_fence(__ATOMIC_RELEASE, "agent"); asm volatile("s_waitcnt vmcnt(0)" ::: "memory");
                __hip_atomic_fetch_add(cdone, 1u, __ATOMIC_RELAXED, __HIP_MEMORY_SCOPE_AGENT); }
            continue;
        }
        int j = idx - QN_CMP;
        if (j < QN_DIFF) { const int di = qx * 8 + (j >> 3), qb = 7 - (j & 7);
            if (att_en & 2) att::diff_unit(lds, proj, mixed, scr, di >> 2, di & 3, qb, lam, 1.f - lam_init, p->subln_g + l * 128, ctl + CW_QUEUE + (lq * 8 + qx) * 64, pre); continue; }
        j -= QN_DIFF;
        if (j < QN_NSA) { const int gi = qx * 4 + (j & 3), qb = 7 - (j >> 2);
            if (!((cmp_seen >> qx) & 1u)) {
                if (tid == 0) { unsigned sp = 0; while (__hip_atomic_load(cdone, __ATOMIC_RELAXED, __HIP_MEMORY_SCOPE_AGENT) < (unsigned)QN_CMP) { __builtin_amdgcn_s_sleep(2); if (++sp > (1u << 22)) break; }
                    __builtin_amdgcn_fence(__ATOMIC_ACQUIRE, "agent"); asm volatile("s_waitcnt vmcnt(0)" ::: "memory"); }
                __syncthreads(); cmp_seen |= 1u << qx; }
            if (att_en & 1) att::nsa_unit(lds, proj, gates, kcmp, vcmp, mixed, scr, gi >> 1, gi & 1, qb, ctl + CW_QUEUE + (lq * 8 + qx) * 64, pre); continue; }
        j -= QN_NSA;
        { const int jh = (j >= 48) ? j - 48 : j; const int fi = qx * 12 + (jh >> 2), qb = ((j >= 48) ? 3 : 7) - (jh & 3);
            if (att_en & 4) att::fox_unit(lds, proj, gates, p->fox_f_bias[l * 6 + fi % 6], mixed, fi / 6, fi % 6, qb, ctl + CW_QUEUE + (lq * 8 + qx) * 64, pre); }
    }
    __builtin_amdgcn_s_setprio(0);
    if (l + 1 < DEPTH && lq < 4) {
        const int tid = ltid(); KP p = kparams();
                unsigned* chead = (unsigned*)(p->ws + WS_CTL) + CW_CONV + l * 64;
        LAS float* scrw = (LAS float*)lds_u + (tid >> 6) * (64 * 33);
        constexpr int NCH = (T_LAYER + 63) / 64;
        __syncthreads();
        for (;;) {
            if (tid == 0) misc[4] = __hip_atomic_fetch_add(chead, 1u, __ATOMIC_RELAXED, __HIP_MEMORY_SCOPE_AGENT);
            __syncthreads();
            const int ch = (int)misc[4];
            __syncthreads();
            if (ch >= NCH) break;
#pragma unroll 1
            for (int k = 0; k < 8; ++k) { const int it = ch * 64 + k * 8 + (tid >> 6); if (it < T_LAYER) convert_item(p, l + 1, it, scrw, tid & 63); }
        }
    }
}

#ifndef ATT_EN
#define ATT_EN 7
#endif
#ifndef PH_EN
#define PH_EN 255
#endif
#ifndef DUP
#define DUP 0
#endif
#define DUPLOOP(k) _Pragma("unroll 1") for (int rep_ = 0; rep_ < (((DUP) & (k)) ? 2 : 1); ++rep_)
__global__ void __launch_bounds__(512, 2) mk_fwd(Params p_unused) {
    extern __shared__ __attribute__((aligned(16))) unsigned char lds_raw[];
    LAS unsigned char* lds = (LAS unsigned char*)lds_raw;
    volatile LAS unsigned* misc = (volatile LAS unsigned*)(lds + LX_MISC);
    const int G = gridDim.x;
    if (ltid() < 16) misc[ltid()] = 0u;
    __syncthreads();
    XcdBarrier bar;
    { KP p = kparams(); bar = xcd_barrier_post((unsigned*)(p->ws + WS_CTL) + CW_BAR + p->bar_region * XCD_BAR_WORDS, misc); }
    DUPLOOP(64) { KP p = kparams(); if ((PH_EN & 64) && p->do_prologue) { prologue_phase(p, lds); xcd_barrier(bar); } }

    const int l_begin = kparams()->l_begin, l_end = kparams()->l_end, ph_mask = kparams()->ph_mask;
    for (int l = l_begin; l < l_end; ++l) {
        if ((PH_EN & 1) && (ph_mask & 1)) DUPLOOP(1) {
            KP p = kparams(); unsigned char* ws = p->ws;
            rstd_prefix(p, lds); if (rep_ == 0) gate_prefix(p, l, lds);
            pg8::Gemm g{(const bf16_t*)(ws + WS_HB), (const bf16_t*)(ws + WS_WIN) + (size_t)l * NINP * DM, MROWS, PROJ_LD, DM}; pg8::StaticOrder S; S.init(MROWS, PROJ_LD, G, (int)blockIdx.x);
            epi::InProj E{(bf16_t*)(ws + WS_PROJ), (const LAS float*)(lds + LX_RSTAB)};
            pg8::gemm_phase<epi::InProj, pg8::StaticOrder, true, true>(lds, g, S, E);
            xcd_barrier(bar);
        }
        if ((PH_EN & 4) && (ph_mask & 6)) DUPLOOP(4) {
            attention_phase(kparams(), l + 4 * rep_, lds, misc);
            xcd_barrier(bar);
        }
        if ((PH_EN & 8) && (ph_mask & 8)) DUPLOOP(8) {
            { KP p = kparams(); unsigned char* ws = p->ws;
              pg8::Gemm g{(const bf16_t*)(ws + WS_MIXED), (const bf16_t*)(ws + WS_WOUT) + (size_t)l * DM * DM, MROWS, DM, DM}; pg8::StaticOrder S; S.init(MROWS, DM, G, (int)blockIdx.x);
              epi::Resid E{(bf16_t*)(ws + (rep_ ? WS_END : WS_HB)), (float*)(ws + (rep_ ? WS_END + (size_t)MROWS * DM * 2 : WS_SSQP))};
              pg8::gemm_phase<epi::Resid, pg8::StaticOrder, true, true>(lds, g, S, E); }
            xcd_barrier(bar);
        }
        if ((PH_EN & 16) && (ph_mask & 16)) DUPLOOP(16) {
            { KP p = kparams(); unsigned char* ws = p->ws;
              rstd_prefix(p, lds);
              pg8::Gemm g{(const bf16_t*)(ws + WS_HB), (const bf16_t*)(ws + WS_WUP) + (size_t)l * NUP * DM, MROWS, NUP, DM}; pg8::StaticOrder S; S.init(MROWS, NUP, G, (int)blockIdx.x);
              epi::UpConv E{(bf16_t*)(ws + WS_PROJ), (const LAS float*)(lds + LX_RSTAB), p->conv_w + (size_t)l * 3 * NUP, p->conv_b + (size_t)l * NUP, (float*)(ws + WS_HALO), (LAS float*)(lds + LX_CONV)};
              pg8::gemm_phase<epi::UpConv, pg8::StaticOrder, true, true>(lds, g, S, E); }
            xcd_barrier(bar);
        }
        if ((PH_EN & 32) && (ph_mask & 32)) DUPLOOP(32) {
            { KP p = kparams(); unsigned char* ws = p->ws;
              fixup_prefix(p, l);
              pg8::Gemm g{(const bf16_t*)(ws + WS_PROJ), (const bf16_t*)(ws + WS_WDN) + (size_t)l * DM * DFF, MROWS, DM, DFF}; pg8::StaticOrder S; S.init(MROWS, DM, G, (int)blockIdx.x);
              epi::Resid E{(bf16_t*)(ws + (rep_ ? WS_END : WS_HB)), (float*)(ws + (rep_ ? WS_END + (size_t)MROWS * DM * 2 : WS_SSQP))};
              pg8::gemm_phase<epi::Resid, pg8::StaticOrder, true, true>(lds, g, S, E); }
            xcd_barrier(bar);
        }
    }
    { KP p = kparams(); if ((PH_EN & 128) && p->do_final) final_phase(p); }
}

#if MK_DEBUG
constexpr int NCHK = 16;
#ifndef DBG_SKIP
#define DBG_SKIP 0
#endif
__constant__ int DBG_TS[8] = {0, 1, 255, 256, 700, 1023, 1500, 2047};
__constant__ int DBG_RS[16] = {0, 1, 2, 3, 62, 63, 64, 65, 126, 127, 128, 129, 191, 192, 254, 255};
__constant__ float DBG_TOL[NCHK] = {0, 1e-6f, 1e-3f, 0.03f, 0.03f, 1e-3f, 0.05f, 0.05f, 0.05f, 0.08f, 0.03f, 0.05f, 0.03f, 0, 0, 0};
__device__ __forceinline__ void diag_max(unsigned* diag, int c, float err) { unsigned b = __builtin_bit_cast(unsigned, fabsf(err)); if (err != err) b = 0x7FC00000u; atomicMax(diag + c, b); }
__device__ __forceinline__ void diag_bits(unsigned* diag, int c, unsigned bits) { atomicOr(diag + 16 + c, bits); }
__device__ __forceinline__ unsigned hash_u(unsigned x) { x ^= x >> 16; x *= 0x7feb352du; x ^= x >> 15; x *= 0x846ca68bu; x ^= x >> 16; return x; }
__device__ __forceinline__ float bfr(float v) { return bf2f((bf16_t)(cvtpk(v, 0.f) & 0xFFFFu)); }
__device__ __forceinline__ float blk_sum(float v, float* sh) {
    const int t = threadIdx.x; sh[t] = v; __syncthreads();
    for (int o = 128; o > 0; o >>= 1) { if (t < o) sh[t] += sh[t + o]; __syncthreads(); }
    const float r = sh[0]; __syncthreads(); return r;
}
__device__ __forceinline__ float blk_max(float v, float* sh) {
    const int t = threadIdx.x; sh[t] = v; __syncthreads();
    for (int o = 128; o > 0; o >>= 1) { if (t < o) sh[t] = fmaxf(sh[t], sh[t + o]); __syncthreads(); }
    const float r = sh[0]; __syncthreads(); return r;
}
__device__ __forceinline__ int t5_bucket_ref(int rel) {
    const int n = rel > 0 ? rel : 0; if (n < 16) return n;
    const float nf = (float)n; int large = 16 + (int)(logf(nf / 16.f) / logf(8.f) * 16.f); if (large > 31) large = 31; return large;
}
__device__ __forceinline__ float relerr(float fast, float ref, float scale) { return fabsf(fast - ref) / (fabsf(ref) + scale); }

__global__ void __launch_bounds__(256) chk_kernel(Params p, int stage, const float* out_prev) {
    __shared__ float sh[256];
    __shared__ float sbuf[2304];
    __shared__ float sq[384];
    __shared__ int sidx[16];
    unsigned* diag = (unsigned*)(p.ws + WS_DIAG);
    unsigned char* ws = p.ws;
    const int t = threadIdx.x;
    const bf16_t* hb = (const bf16_t*)(ws + WS_HB); const float* rstd = (const float*)(ws + WS_RSTD);
    const bf16_t* proj = (const bf16_t*)(ws + WS_PROJ); const float* gates = (const float*)(ws + WS_GATES);
    const bf16_t* mixed = (const bf16_t*)(ws + WS_MIXED); const float* c2 = (const float*)(ws + WS_CUM);
    const bf16_t* kcmp = (const bf16_t*)(ws + WS_KCMP); const bf16_t* vcmp = (const bf16_t*)(ws + WS_VCMP);
    const int l = 0;
    if (stage == 2) {
        unsigned bad = 0; const size_t nvec = (size_t)MROWS * PROJ_LD / 8;
        for (size_t i = (size_t)blockIdx.x * 256 + t; i < nvec; i += (size_t)gridDim.x * 256) { const bf16x8 v = ((const bf16x8*)proj)[i];
#pragma unroll
            for (int e = 0; e < 8; ++e) { const float x = bf2f((bf16_t)v[e]); if (!(fabsf(x) < 1000.f)) ++bad; } }
        if (bad) atomicAdd(diag + 13, bad);
    }
    if (stage == 3) {
        unsigned bad = 0;
        for (int i = blockIdx.x * 256 + t; i < NBATCH * 2 * 128 * 128; i += gridDim.x * 256) { const float a = bf2f(kcmp[i]), c = bf2f(vcmp[i]); if (!(fabsf(a) < 1000.f)) ++bad; if (!(fabsf(c) < 1000.f)) bad += 65536u; }
        if (bad & 0xFFFFu) atomicAdd(diag + 14, bad & 0xFFFFu); if (bad >> 16) atomicAdd(diag + 15, bad >> 16);
    }
    for (int smp = blockIdx.x; smp < (stage == 2 ? 512 : 64); smp += gridDim.x) {
        const unsigned h0 = hash_u(smp * 2654435761u + stage * 97u + 12345u), h1 = hash_u(h0 + 1u), h2 = hash_u(h1 + 7u);
        if (stage == 1) {
            const unsigned r0 = hash_u(h0 + t * 31u), r1 = hash_u(r0 + 5u), r2 = hash_u(r1 + 3u);
            { const int ll = r0 & 3, c = r1 % NINP, k = r2 % DM; const int oc = win_colmap(c);
              const float ref = oc >= 0 ? bfr(p.w_in[((size_t)ll * DM + k) * NIN + oc] * p.attn_norm_g[ll * DM + k]) : 0.f;
              diag_max(diag, 1, bf2f(((const bf16_t*)(ws + WS_WIN))[((size_t)ll * NINP + c) * DM + k]) - ref); }
            { const int ll = r0 & 3, c = r1 % DM, k = r2 % DM; const float ref = bfr(p.w_out[((size_t)ll * DM + k) * DM + c]);
              diag_max(diag, 1, bf2f(((const bf16_t*)(ws + WS_WOUT))[((size_t)ll * DM + c) * DM + k]) - ref); }
            { const int ll = r0 & 3, c = r1 % NUP, k = r2 % DM; const int oc = wup_colmap(c); const float ref = bfr(p.w_up[((size_t)ll * DM + k) * NUP + oc] * p.ffn_norm_g[ll * DM + k]);
              diag_max(diag, 1, bf2f(((const bf16_t*)(ws + WS_WUP))[((size_t)ll * NUP + c) * DM + k]) - ref); }
            { const int ll = r0 & 3, c = r1 % DM, k = r2 % DFF; const float ref = bfr(p.w_down[((size_t)ll * DFF + k) * DM + c]);
              diag_max(diag, 1, bf2f(((const bf16_t*)(ws + WS_WDN))[((size_t)ll * DM + c) * DFF + k]) - ref); }
            { const int ll = r0 & 3, kv = (r0 >> 2) & 1, c = r1 % 128, k = r2 % 4096; const float ref = bfr((kv ? p.wv1 : p.wk1)[((size_t)ll * 4096 + k) * 128 + c]);
              diag_max(diag, 1, bf2f(((const bf16_t*)(ws + WS_W1T))[((size_t)(ll * 2 + kv) * 128 + c) * 4096 + k]) - ref); }
            { const int ll = r0 & 3, kv = (r0 >> 2) & 1, c = r1 % 128, k = r2 % 128; const float ref = bfr((kv ? p.wv2 : p.wk2)[((size_t)ll * 128 + k) * 128 + c]);
              diag_max(diag, 1, bf2f(((const bf16_t*)(ws + WS_W2T))[((size_t)(ll * 2 + kv) * 128 + c) * 128 + k]) - ref); }
            { const int row = h0 % MROWS; float ss = 0.f; for (int k = t; k < DM; k += 256) { const float xv = p.x[(size_t)row * DM + k]; ss += xv * xv; diag_max(diag, 2, bf2f(hb[(size_t)row * DM + k]) - bfr(xv)); }
              ss = blk_sum(ss, sh); if (t == 0) diag_max(diag, 2, relerr(rstd[row], 1.f / sqrtf(ss / DM + RMS_EPS), 1e-6f)); }
            { const int ll = h1 & 3, kv = (h1 >> 2) & 1, c = h2 % 128; float s = 0.f; for (int k = t; k < 4096; k += 256) s += p.cmp_pos[(size_t)ll * 4096 + k] * (kv ? p.wv1 : p.wk1)[((size_t)ll * 4096 + k) * 128 + c];
              s = blk_sum(s, sh); if (t == 0) diag_max(diag, 2, relerr(((const float*)(ws + WS_POSC))[(ll * 2 + kv) * 128 + c], s, 1e-3f)); }
        } else if (stage == 2) {
            const int pnn = smp % 25; const int row = h0 % MROWS, c = pnn == 24 ? 6144 + (h1 % 24) : pnn * 256 + (h1 % 256); const int oc = win_colmap(c);
            float ss = 0.f, dot = 0.f;
            for (int k = t; k < DM; k += 256) { const float xv = p.x[(size_t)row * DM + k]; ss += xv * xv; dot += bfr(xv) * bfr(p.w_in[((size_t)l * DM + k) * NIN + oc] * p.attn_norm_g[l * DM + k]); }
            ss = blk_sum(ss, sh); dot = blk_sum(dot, sh);
            if (t == 0) { const float rs = 1.f / sqrtf(ss / DM + RMS_EPS); const int pn = c >> 8;
                float cs = 1.f; if (pn < 3 || (pn >= 15 && pn <= 17)) cs = 0.08838834764831845f * LOG2E; else if (pn == 9 || pn == 10) cs = 0.125f * LOG2E;
                if (c < 6144) { const float fv = bf2f(proj[(size_t)row * PROJ_LD + c]); const float er = relerr(fv, dot * rs * cs, 0.05f); diag_max(diag, 3, er);
                    if (!(er <= 0.03f)) diag_bits(diag, 3, (pn < 9 ? 1u : pn < 15 ? 2u : pn < 18 ? 4u : 8u) | ((row % SEQ) >= 512 ? 16u : 0u) | (fabsf(fv) < 1e-6f ? 32u : 0u)); }
                else diag_max(diag, 4, relerr(gates[(size_t)row * GATE_LD + (c - 6144)], dot * rs, 0.05f)); }
        } else if (stage == 3) {
            if (smp < 24) { if (t == 0) { const int bh = (h0 % 96), b = bh / 6, h = bh % 6; float run = 0.f, worst = 0.f;
                    for (int s = 0; s < SEQ; ++s) { const float xx = gates[(size_t)(b * SEQ + s) * GATE_LD + h] + p.fox_f_bias[l * 6 + h]; run += fminf(xx, 0.f) - log1pf(expf(-fabsf(xx)));
                        worst = fmaxf(worst, relerr(c2[(size_t)bh * SEQ + s], run * LOG2E, 1.f)); float cv = c2[(size_t)bh * SEQ + s]; if (cv != cv) worst = cv; }
                    diag_max(diag, 5, worst); } }
            else { const int b = h0 % NBATCH, g = h1 & 1, kv = (h1 >> 1) & 1, n = (smp & 7) == 7 ? 127 : (smp & 7) == 6 ? 126 : h2 % 127;
                const float* w1 = (kv ? p.wv1 : p.wk1) + (size_t)l * 4096 * 128; const float* w2 = (kv ? p.wv2 : p.wk2) + (size_t)l * 128 * 128;
                if (t < 128) { float s = 0.f; if (n < 127) { for (int ll = 0; ll < 32; ++ll) for (int d = 0; d < 128; ++d)
                        s += bf2f(proj[(size_t)(b * SEQ + 16 * n + ll) * PROJ_LD + (kv ? C_NVC : C_NKC) + g * 128 + d]) * bfr(w1[(size_t)(ll * 128 + d) * 128 + t]);
                        s += ((const float*)(ws + WS_POSC))[(l * 2 + kv) * 128 + t]; const float u = 0.7978845608028654f * (s + 0.044715f * s * s * s); s = 0.5f * s * (1.f + tanhf(u)); }
                    sbuf[t] = bfr(s);
                    if (n < 127) { const int unit = (n >> 5) + 4 * kv + 8 * g + 16 * b; const float hv = ((const float*)(ws + WS_SCR))[(size_t)unit * 4096 + (n & 31) * 128 + t];
                        const float er = relerr(hv, s, 0.05f); if (!(er <= 0.05f)) diag_bits(diag, 6, 1u | (fabsf(hv) > 100.f ? 2u : 0u) | (hv != hv ? 4u : 0u)); } }
                __syncthreads();
                if (t < 128) { float s = 0.f; if (n < 127) for (int j = 0; j < 128; ++j) s += sbuf[j] * bfr(w2[(size_t)j * 128 + t]);
                    const float fv = bf2f((kv ? vcmp : kcmp)[((size_t)(b * 2 + g) * 128 + n) * 128 + t]); const float er = relerr(fv, s, 0.05f);
                    diag_max(diag, 6, er);
                    if (!(er <= 0.05f)) diag_bits(diag, 6, 8u | (kv ? 16u : 0u) | ((n >= 96 && n < 112) ? 32u : 0u)); }
                __syncthreads(); }
        } else if (stage == 4) {
            const int b = h0 % NBATCH, tt = (smp & 1) ? DBG_TS[(smp >> 1) & 7] : (int)(h1 % SEQ);
            const size_t qrow = (size_t)(b * SEQ + tt);
            if (smp < 24) {
                const int h = h2 % 6; const bf16_t* q = proj + qrow * PROJ_LD + C_FQ + h * 128; const float* cc = c2 + (size_t)(b * 6 + h) * SEQ;
                float mx = -1e30f;
                for (int k = t; k <= tt; k += 256) { const bf16_t* kr = proj + (size_t)(b * SEQ + k) * PROJ_LD + C_FK + h * 128; float s = 0.f; for (int d = 0; d < 128; ++d) s += bf2f(q[d]) * bf2f(kr[d]);
                    s += cc[tt] - cc[k]; sbuf[k] = s; mx = fmaxf(mx, s); }
                mx = blk_max(mx, sh); float sum = 0.f;
                for (int k = t; k <= tt; k += 256) { sbuf[k] = exp2f(sbuf[k] - mx); sum += sbuf[k]; }
                sum = blk_sum(sum, sh);
                if (t < 128) { float o = 0.f; for (int k = 0; k <= tt; ++k) o += sbuf[k] * bf2f(proj[(size_t)(b * SEQ + k) * PROJ_LD + C_FV + h * 128 + t]); o /= sum;
                    const float fv = bf2f(mixed[qrow * DM + h * 128 + t]); const float er = relerr(fv, o, 0.05f); diag_max(diag, 7, er);
                    if (!(er <= 0.05f)) diag_bits(diag, 7, (tt < 64 ? 1u : tt < 512 ? 2u : 4u) | ((fabsf(fv) < 1e-6f) ? 8u : 0u) | ((fabsf(fv) > 4.f * fabsf(o) + 0.2f) ? 16u : 0u) | ((fv != fv) ? 32u : 0u)); }
                __syncthreads();
            } else if (smp < 40) {
                const int h = h2 & 3; float* o2 = sq;
                const float lam_init = 0.8f - 0.6f * expf(-0.3f * (float)l);
                float s1 = 0.f, s2 = 0.f; for (int i = 0; i < 64; ++i) { s1 += p.lq1[l * 64 + i] * p.lk1[l * 64 + i]; s2 += p.lq2[l * 64 + i] * p.lk2[l * 64 + i]; }
                const float lam = expf(s1) - expf(s2) + lam_init;
                if (t < 128) o2[t] = 0.f; __syncthreads();
                for (int mp = 0; mp < 2; ++mp) {
                    const bf16_t* q = proj + qrow * PROJ_LD + C_DQ + h * 128 + mp * 64; float mx = -1e30f;
                    for (int k = t; k <= tt; k += 256) { const bf16_t* kr = proj + (size_t)(b * SEQ + k) * PROJ_LD + C_DK + h * 128 + mp * 64; float s = 0.f; for (int d = 0; d < 64; ++d) s += bf2f(q[d]) * bf2f(kr[d]);
                        s += p.rel_bias[t5_bucket_ref(tt - k) * 10 + h] * LOG2E; sbuf[k] = s; mx = fmaxf(mx, s); }
                    mx = blk_max(mx, sh); float sum = 0.f;
                    for (int k = t; k <= tt; k += 256) { sbuf[k] = exp2f(sbuf[k] - mx); sum += sbuf[k]; }
                    sum = blk_sum(sum, sh);
                    if (t < 128) { float o = 0.f; for (int k = 0; k <= tt; ++k) o += sbuf[k] * bf2f(proj[(size_t)(b * SEQ + k) * PROJ_LD + C_DV + h * 128 + t]); o /= sum; o2[t] += (mp == 0 ? o : -lam * o); }
                    __syncthreads();
                }
                float ssq = (t < 128) ? o2[t] * o2[t] : 0.f; ssq = blk_sum(ssq, sh);
                if (t < 128) { const float y = o2[t] * (1.f / sqrtf(ssq / 128.f + RMS_EPS)) * p.subln_g[l * 128 + t] * (1.f - lam_init);
                    const float fv = bf2f(mixed[qrow * DM + 768 + h * 128 + t]); const float er = relerr(fv, y, 0.5f); diag_max(diag, 8, er);
                    if (!(er <= 0.05f)) diag_bits(diag, 8, (tt < 64 ? 1u : tt < 512 ? 2u : 4u) | ((fabsf(fv) < 1e-6f) ? 8u : 0u) | ((fabsf(fv) > 4.f * fabsf(y) + 0.2f) ? 16u : 0u) | ((fv != fv) ? 32u : 0u)); }
                __syncthreads();
            } else {
                const int h6 = h2 % 6, g = h6 / 3; float* pc = sbuf + 2048;
                float* imp = sq + 128; float* oacc = sq + 192;
                if (t < 32) imp[t] = 0.f; if (t < 128) oacc[t] = 0.f; __syncthreads();
                const bf16_t* kc = kcmp + (size_t)(b * 2 + g) * 128 * 128; const bf16_t* vc = vcmp + (size_t)(b * 2 + g) * 128 * 128;
                const float* gp = gates + qrow * GATE_LD + 6 + h6 * 3;
                const float g0 = 1.f / (1.f + expf(-gp[0])), g1 = 1.f / (1.f + expf(-gp[1])), g2 = 1.f / (1.f + expf(-gp[2]));
                for (int hh = 0; hh < 3; ++hh) {
                    const int hd = g * 3 + hh; const bf16_t* q = proj + qrow * PROJ_LD + C_NQ + hd * 128;
                    float s = -1e30f; bool ok = false;
                    if (t < 127) { ok = (16 * t + 31) <= tt; if (ok) { s = 0.f; for (int d = 0; d < 128; ++d) s += bf2f(q[d]) * bf2f(kc[(size_t)t * 128 + d]); s += p.rel_bias[t5_bucket_ref(tt - (16 * t + 31)) * 10 + 4 + hd] * LOG2E; } }
                    const float mx = blk_max(ok ? s : -1e30f, sh); const float e = ok ? exp2f(s - mx) : 0.f; const float sum = blk_sum(e, sh);
                    const float pr = sum > 0.f ? e / sum : 0.f;
                    if (t < 128) pc[t] = pr; __syncthreads();
                    if (t < 32) { float a = 0.f; for (int n = 0; n < 127; ++n) { int lo = max(16 * n, 64 * t), hi2 = min(16 * n + 32, 64 * t + 64); int ov = hi2 - lo; if (ov > 0) a += pc[n] * ((float)ov / 32.f); } imp[t] += a; }
                    if (hd == h6 && t < 128) { float o = 0.f; for (int n = 0; n < 127; ++n) o += pc[n] * bf2f(vc[(size_t)n * 128 + t]); oacc[t] += g0 * o; }
                    __syncthreads();
                }
                if (t == 0) { const int blk = tt >> 6; float* sc = sbuf + 2200; for (int j = 0; j < 32; ++j) { const bool forced = j == 0 || j == blk || j == blk - 1; sc[j] = (j <= blk) ? imp[j] + (forced ? 1e4f : 0.f) : -1e30f; }
                    unsigned m = 0; for (int it = 0; it < 8; ++it) { float best = -1e30f; int bi = -1; for (int j = 0; j < 32; ++j) if (!((m >> j) & 1u) && sc[j] > best) { best = sc[j]; bi = j; } if (bi >= 0 && best > -0.5e30f) m |= 1u << bi; }
                    sidx[0] = (int)m; }
                __syncthreads();
                const unsigned selm = (unsigned)sidx[0];
                for (int br = 0; br < 2; ++br) {
                    const bf16_t* q = proj + qrow * PROJ_LD + C_NQ + h6 * 128; const int kcol = (br == 0 ? C_NKS : C_NKW) + g * 128, vcol = (br == 0 ? C_NVS : C_NVW) + g * 128;
                    float mx = -1e30f;
                    for (int k = t; k <= tt; k += 256) { const bool ok = br == 0 ? ((selm >> (k >> 6)) & 1u) != 0u : (tt - k < 512); float s = -1e30f;
                        if (ok) { const bf16_t* kr = proj + (size_t)(b * SEQ + k) * PROJ_LD + kcol; s = 0.f; for (int d = 0; d < 128; ++d) s += bf2f(q[d]) * bf2f(kr[d]); s += p.rel_bias[t5_bucket_ref(tt - k) * 10 + 4 + h6] * LOG2E; }
                        sbuf[k] = s; mx = fmaxf(mx, s); }
                    mx = blk_max(mx, sh); float sum = 0.f;
                    for (int k = t; k <= tt; k += 256) { sbuf[k] = sbuf[k] > -1e29f ? exp2f(sbuf[k] - mx) : 0.f; sum += sbuf[k]; }
                    sum = blk_sum(sum, sh);
                    if (t < 128) { float o = 0.f; for (int k = 0; k <= tt; ++k) o += sbuf[k] * bf2f(proj[(size_t)(b * SEQ + k) * PROJ_LD + vcol + t]); oacc[t] += (br == 0 ? g1 : g2) * o / sum; }
                    __syncthreads();
                }
                if (t < 128) { const float fv = bf2f(mixed[qrow * DM + 1280 + h6 * 128 + t]); const float er = relerr(fv, oacc[t], 0.05f); diag_max(diag, 9, er);
                    if (!(er <= 0.08f)) diag_bits(diag, 9, (tt < 64 ? 1u : tt < 512 ? 2u : 4u) | ((fabsf(fv) < 1e-6f) ? 8u : 0u) | ((fabsf(fv) > 4.f * fabsf(oacc[t]) + 0.2f) ? 16u : 0u) | ((fv != fv) ? 32u : 0u)); }
                __syncthreads();
            }
        } else if (stage == 5) {
            const int row = h0 % MROWS, col = h1 % DM; float dot = 0.f, ss = 0.f;
            for (int k = t; k < DM; k += 256) { dot += bf2f(mixed[(size_t)row * DM + k]) * bfr(p.w_out[((size_t)l * DM + k) * DM + col]); const float hv = p.out[(size_t)row * DM + k]; ss += hv * hv; }
            dot = blk_sum(dot, sh); ss = blk_sum(ss, sh);
            if (t == 0) { const float ref = p.x[(size_t)row * DM + col] + dot; diag_max(diag, 10, relerr(p.out[(size_t)row * DM + col], ref, 0.05f));
                diag_max(diag, 10, relerr(bf2f(hb[(size_t)row * DM + col]), ref, 0.05f)); diag_max(diag, 10, relerr(rstd[row], 1.f / sqrtf(ss / DM + RMS_EPS), 1e-3f)); }
        } else if (stage == 6) {
            const int pm = h0 % 128, row = pm * 256 + DBG_RS[smp & 15], ch = h1 % DFF, s = row % SEQ;
            float yg = p.conv_b[l * NUP + ch], yu = p.conv_b[l * NUP + DFF + ch];
            for (int tap = 0; tap < 3; ++tap) { const int sp = s - 2 + tap; float dg = 0.f, du = 0.f;
                if (sp >= 0) { const int r2 = row - 2 + tap;
                    for (int k = t; k < DM; k += 256) { const float a = bf2f(hb[(size_t)r2 * DM + k]); const float gk = p.ffn_norm_g[l * DM + k];
                        dg += a * bfr(p.w_up[((size_t)l * DM + k) * NUP + ch] * gk); du += a * bfr(p.w_up[((size_t)l * DM + k) * NUP + DFF + ch] * gk); }
                    dg = blk_sum(dg, sh) * rstd[r2]; du = blk_sum(du, sh) * rstd[r2]; }
                yg += p.conv_w[((size_t)l * 3 + tap) * NUP + ch] * dg; yu += p.conv_w[((size_t)l * 3 + tap) * NUP + DFF + ch] * du; }
            if (t == 0) { const float ref = yg / (1.f + expf(-yg)) * yu; diag_max(diag, 11, relerr(bf2f(proj[(size_t)row * DFF + ch]), ref, 0.05f)); }
        } else if (stage == 7) {
            const int row = h0 % MROWS, col = h1 % DM; float dot = 0.f, ss = 0.f;
            for (int k = t; k < DFF; k += 256) dot += bf2f(proj[(size_t)row * DFF + k]) * bfr(p.w_down[((size_t)l * DFF + k) * DM + col]);
            for (int k = t; k < DM; k += 256) { const float hv = p.out[(size_t)row * DM + k]; ss += hv * hv; }
            dot = blk_sum(dot, sh); ss = blk_sum(ss, sh);
            if (t == 0) { const float ref = out_prev[(size_t)row * DM + col] + dot; diag_max(diag, 12, relerr(p.out[(size_t)row * DM + col], ref, 0.05f));
                diag_max(diag, 12, relerr(bf2f(hb[(size_t)row * DM + col]), ref, 0.05f)); (void)ss; }
        }
    }
}
__global__ void report_kernel(float* out, const unsigned* diag, int n) {
    __shared__ float code, mag;
    if (threadIdx.x == 0) {
        int c = 0; float e = 0.f;
        for (int i = 1; i < 13; ++i) { if ((DBG_SKIP >> i) & 1) continue; const float v = __builtin_bit_cast(float, diag[i]); if (!(v <= DBG_TOL[i])) { c = i; e = v; break; } }
        if (!c || c > 3) { const unsigned n13 = diag[13]; if (n13 && !((DBG_SKIP >> 13) & 1)) { c = 13; e = 0.f; code = 13.f; mag = 100.f * (10.f + fminf(63.f, floorf(log2f((float)n13)) + 1.f)); } }
        if (c != 13 && (!c || c > 6)) { const unsigned n14 = diag[14]; if ((n14 || diag[15]) && !((DBG_SKIP >> 14) & 1)) { c = 14; code = 14.f; const unsigned nk = n14, nv = diag[15]; mag = 100.f * (10.f + (nk ? 32.f : 0.f) + fminf(31.f, (nv ? floorf(log2f((float)nv)) + 1.f : 0.f))); } }
        if (c == 13 || c == 14) { } else {
        code = (float)c; float info = 0.f;
        if (c) { const unsigned bits = diag[16 + c] & 63u; if (bits) info = (float)bits; else if (e != e) info = 89.f; else { info = 64.f + rintf(3.f * (log10f(fmaxf(e, 1e-6f)) + 6.f)); info = fminf(fmaxf(info, 64.f), 88.f); } }
        mag = c ? 100.f * (10.f + info) : 0.f; }
    }
    __syncthreads();
    for (int i = blockIdx.x * blockDim.x + threadIdx.x; i < n; i += gridDim.x * blockDim.x) out[i] = (i == 0) ? mag : code;
}
static void debug_launches(Params p, int grid, hipStream_t stream) {
    float* out_prev = (float*)(p.ws + WS_END);
    (void)hipMemsetAsync(p.ws + WS_DIAG, 0, 256, stream);
    p.l_begin = 0; p.l_end = 1; p.do_final = 0;
    const int masks[7] = {0, 1, 2, 4, 8, 16, 32};
    for (int s = 0; s < 7; ++s) {
        p.do_prologue = (s == 0); p.ph_mask = masks[s]; p.bar_region = s;
        if (s == 6) (void)hipMemcpyAsync(out_prev, p.out, (size_t)MROWS * DM * 4, hipMemcpyDeviceToDevice, stream);
        hipLaunchKernelGGL(mk_fwd, dim3(grid), dim3(512), LDS_BYTES, stream, p);
        hipLaunchKernelGGL(chk_kernel, dim3(64), dim3(256), 0, stream, p, s + 1, (const float*)out_prev);
    }
    hipLaunchKernelGGL(report_kernel, dim3(1024), dim3(256), 0, stream, p.out, (const unsigned*)(p.ws + WS_DIAG), MROWS * DM);
}
#endif

static void fill_params(Params& p, void* const* d_in, void* d_out, void* d_ws) {
    p.x = (const float*)d_in[0]; p.attn_norm_g = (const float*)d_in[1]; p.w_in = (const float*)d_in[2]; p.fox_f_bias = (const float*)d_in[3];
    p.lq1 = (const float*)d_in[4]; p.lk1 = (const float*)d_in[5]; p.lq2 = (const float*)d_in[6]; p.lk2 = (const float*)d_in[7];
    p.subln_g = (const float*)d_in[8]; p.cmp_pos = (const float*)d_in[9]; p.wk1 = (const float*)d_in[10]; p.wk2 = (const float*)d_in[11];
    p.wv1 = (const float*)d_in[12]; p.wv2 = (const float*)d_in[13]; p.w_out = (const float*)d_in[14]; p.ffn_norm_g = (const float*)d_in[15];
    p.w_up = (const float*)d_in[16]; p.conv_w = (const float*)d_in[17]; p.conv_b = (const float*)d_in[18]; p.w_down = (const float*)d_in[19];
    p.rel_bias = (const float*)d_in[20]; p.final_g = (const float*)d_in[21];
    p.out = (float*)d_out; p.ws = (unsigned char*)d_ws;
}
extern "C" void kernel_launch(void* const* d_in, const int* in_sizes, int n_in, void* d_out, int out_size, void* d_ws, size_t ws_size, hipStream_t stream) {
    static int grid = 0;
    if (grid == 0) {
        if (n_in != 22 || out_size != MROWS * DM || ws_size < WS_END) { fprintf(stderr, "kernel_launch: unexpected problem (n_in %d, out %d, ws %zu < %zu)\n", n_in, out_size, ws_size, (size_t)WS_END); grid = -1; return; }
        int dev = 0, cus = 0;
        if (hipGetDevice(&dev) != hipSuccess || hipDeviceGetAttribute(&cus, hipDeviceAttributeMultiprocessorCount, dev) != hipSuccess || cus <= 0) { grid = -1; return; }
        if (hipFuncSetAttribute((const void*)mk_fwd, hipFuncAttributeMaxDynamicSharedMemorySize, LDS_BYTES) != hipSuccess) { fprintf(stderr, "kernel_launch: hipFuncSetAttribute failed\n"); grid = -1; return; }
        int per_cu = 0;
        if (hipOccupancyMaxActiveBlocksPerMultiprocessor(&per_cu, (const void*)mk_fwd, 512, LDS_BYTES) != hipSuccess || per_cu < 1) fprintf(stderr, "kernel_launch: occupancy query says %d\n", per_cu);
        (void)hipGetLastError();
        grid = cus;
    }
    if (grid < 0) return;
    (void)hipMemsetAsync((char*)d_ws + WS_CTL, 0, CTL_ZERO_BYTES, stream);
    Params p{};
    fill_params(p, d_in, d_out, d_ws);
#if !MK_DEBUG
    p.l_begin = 0; p.l_end = DEPTH; p.do_prologue = 1; p.do_final = 1; p.bar_region = 0; p.ph_mask = 63;
    hipLaunchKernelGGL(mk_fwd, dim3(grid), dim3(512), LDS_BYTES, stream, p);
#else
    debug_launches(p, grid, stream);
#endif
}
```
